# Optimizing an MI355X kernel written in HIP

```python
import math
import jax, jax.numpy as jnp
from jax import lax
import numpy as np

D_MODEL = 2048
BATCH = 4
SEQ = 4096
DEPTH = 4

HEAD_DIM = 64
N_MIX_HEADS = D_MODEL // HEAD_DIM
A_Q_HEADS = N_MIX_HEADS // 2
A_KV_HEADS = A_Q_HEADS // 4
A_WINDOW = 128
B_Q_HEADS = N_MIX_HEADS - A_Q_HEADS
B_KV_HEADS = 2
NSA_CMP_LEN = 32
NSA_CMP_STRIDE = 16
NSA_CMP_HIDDEN = 4 * HEAD_DIM
NSA_SEL_LEN = 64
NSA_TOP_N = 16
NSA_WINDOW = 512
NSA_FORCE_SCORE = 1.0e4
C_HEADS = N_MIX_HEADS
D_FF = 4 * D_MODEL
REL_BUCKETS = 32
REL_MAX_DIST = 1024
REL_HEADS = A_Q_HEADS + B_Q_HEADS
Q_BLOCK = 128
RMS_EPS = 1e-6
ATTN_SCALE = HEAD_DIM ** -0.5
EVEN_SIZES = (A_Q_HEADS * HEAD_DIM, A_KV_HEADS * HEAD_DIM, A_KV_HEADS * HEAD_DIM, B_Q_HEADS * HEAD_DIM) + (B_KV_HEADS * HEAD_DIM,) * 6 + (3 * B_Q_HEADS,)
EVEN_IN = sum(EVEN_SIZES)
EVEN_MIX = (A_Q_HEADS + B_Q_HEADS) * HEAD_DIM
C_MIX = C_HEADS * HEAD_DIM
ODD_IN = 3 * C_MIX + C_HEADS

kernel_name = 'hybrid_swa_nsa_fox_trunk'


def rms_norm(x, g):
    xf = x.astype(jnp.float32)
    y = xf * lax.rsqrt(jnp.mean(xf * xf, axis=-1, keepdims=True) + RMS_EPS)
    return (y * g.astype(jnp.float32)).astype(x.dtype)


def rel_bucket(dist):
    n = jnp.maximum(dist, 0)
    max_exact = REL_BUCKETS // 2
    nf = jnp.maximum(n, 1).astype(jnp.float32)
    large = max_exact + (jnp.log(nf / max_exact) / math.log(REL_MAX_DIST / max_exact) * (REL_BUCKETS - max_exact)).astype(jnp.int32)
    return jnp.where(n < max_exact, n, jnp.minimum(large, REL_BUCKETS - 1))


def head_bias(tab, dist, g, r):
    b = tab[rel_bucket(dist)]
    return jnp.moveaxis(b, -1, 0).reshape(g, r, *dist.shape)


def masked_softmax(s, mask):
    s = jnp.where(mask, s.astype(jnp.float32), -jnp.inf)
    m = jnp.max(s, axis=-1, keepdims=True)
    m = jnp.where(jnp.isfinite(m), m, 0.0)
    e = jnp.exp(s - m)
    return e / jnp.maximum(jnp.sum(e, axis=-1, keepdims=True), 1e-30)


def sink_softmax(s, mask, sink):
    s = jnp.where(mask, s.astype(jnp.float32), -jnp.inf)
    m = jnp.maximum(jnp.max(s, axis=-1, keepdims=True), sink)
    e = jnp.exp(s - m)
    return e / (jnp.sum(e, axis=-1, keepdims=True) + jnp.exp(sink - m))


def swa_sink_attention(q, k, v, sinks, tab):
    B, T = q.shape[0], q.shape[1]
    G, R = A_KV_HEADS, A_Q_HEADS // A_KV_HEADS
    nb = T // Q_BLOCK
    n_prev = -(-A_WINDOW // Q_BLOCK)
    n_keys = (n_prev + 1) * Q_BLOCK

    def band(t):
        tp = jnp.pad(t, ((0, 0), (n_prev * Q_BLOCK, 0), (0, 0), (0, 0)))
        parts = [tp[:, j * Q_BLOCK:j * Q_BLOCK + T].reshape(B, nb, Q_BLOCK, G, HEAD_DIM) for j in range(n_prev + 1)]
        return jnp.concatenate(parts, axis=2)

    kb, vb = band(k), band(v)
    qb = q.reshape(B, nb, Q_BLOCK, G, R, HEAD_DIM)
    kk = jnp.arange(n_keys)
    dist = jnp.arange(Q_BLOCK)[:, None] + n_prev * Q_BLOCK - kk[None, :]
    kpos = jnp.arange(nb)[:, None] * Q_BLOCK - n_prev * Q_BLOCK + kk[None, :]
    mask = ((dist >= 0) & (dist < A_WINDOW))[None] & (kpos >= 0)[:, None, :]
    s = jnp.einsum('bnqgrd,bnkgd->bgrnqk', qb, kb) * ATTN_SCALE
    s = s.astype(jnp.float32) + head_bias(tab, dist, G, R)[:, :, None]
    p = sink_softmax(s, mask, sinks.astype(jnp.float32).reshape(G, R, 1, 1, 1))
    o = jnp.einsum('bgrnqk,bnkgd->bnqgrd', p.astype(v.dtype), vb)
    return o.reshape(B, T, A_Q_HEADS * HEAD_DIM)


def nsa_compress(kv, pe, w1, w2):
    T = kv.shape[1]
    n_cmp = (T - NSA_CMP_LEN) // NSA_CMP_STRIDE + 1
    idx = (jnp.arange(n_cmp) * NSA_CMP_STRIDE)[:, None] + jnp.arange(NSA_CMP_LEN)[None, :]
    blocks = kv[:, idx] + pe[None, None, :, None, :]
    hid = jax.nn.gelu(jnp.einsum('bnlgd,ldf->bngf', blocks, w1.reshape(NSA_CMP_LEN, HEAD_DIM, NSA_CMP_HIDDEN)))
    return jnp.einsum('bngf,fd->bngd', hid, w2)


def nsa_attention(q, k_c, v_c, k_s, v_s, k_w, v_w, gates, tab):
    B, T = q.shape[0], q.shape[1]
    G, R = B_KV_HEADS, B_Q_HEADS // B_KV_HEADS
    nb = T // Q_BLOCK
    NC = k_c.shape[1]
    NS = T // NSA_SEL_LEN
    top_n = min(NSA_TOP_N, NS)
    cstart = jnp.arange(NC) * NSA_CMP_STRIDE
    cend = cstart + NSA_CMP_LEN - 1
    sstart = jnp.arange(NS) * NSA_SEL_LEN
    overlap = ((cstart[:, None] < sstart[None, :] + NSA_SEL_LEN) & (cstart[:, None] + NSA_CMP_LEN > sstart[None, :])).astype(jnp.float32)
    tab_g = jnp.transpose(tab.reshape(REL_BUCKETS, G, R), (1, 0, 2))
    g_ids = jnp.arange(G)[None, :, None, None]
    ks_blk = jnp.transpose(k_s.reshape(B, NS, NSA_SEL_LEN, G, HEAD_DIM), (0, 3, 1, 2, 4))
    vs_blk = jnp.transpose(v_s.reshape(B, NS, NSA_SEL_LEN, G, HEAD_DIM), (0, 3, 1, 2, 4))
    kw_pad = jnp.pad(k_w, ((0, 0), (NSA_WINDOW, 0), (0, 0), (0, 0)))
    vw_pad = jnp.pad(v_w, ((0, 0), (NSA_WINDOW, 0), (0, 0), (0, 0)))
    take_blocks = jax.vmap(jax.vmap(lambda blk, ix: blk[ix]))
    q_blocks = jnp.transpose(q.reshape(B, nb, Q_BLOCK, G, R, HEAD_DIM), (1, 0, 2, 3, 4, 5))
    g_blocks = jnp.transpose(gates.reshape(B, nb, Q_BLOCK, G, R, 3), (1, 0, 2, 3, 4, 5))
    blk_ids = jnp.arange(NS)

    def one_block(args):
        i, qb, gb = args
        qpos = i * Q_BLOCK + jnp.arange(Q_BLOCK)
        dc = qpos[:, None] - cend[None, :]
        s_c = jnp.einsum('bqgrd,bcgd->bgrqc', qb, k_c) * ATTN_SCALE
        p_c = masked_softmax(s_c.astype(jnp.float32) + head_bias(tab, dc, G, R), dc >= 0)
        o_c = jnp.einsum('bgrqc,bcgd->bqgrd', p_c.astype(v_c.dtype), v_c)
        imp = jnp.einsum('bgrqc,cs->bgqs', p_c, overlap)
        cur = qpos // NSA_SEL_LEN
        forced = (blk_ids[None, :] == 0) | (blk_ids[None, :] == cur[:, None]) | (blk_ids[None, :] == cur[:, None] - 1)
        future = sstart[None, :] > qpos[:, None]
        imp = jnp.where(future, -jnp.inf, jnp.where(forced, NSA_FORCE_SCORE, imp))
        top_val, top_idx = lax.top_k(imp, top_n)
        n_sel = top_n * NSA_SEL_LEN
        ks = take_blocks(ks_blk, top_idx).reshape(B, G, Q_BLOCK, n_sel, HEAD_DIM)
        vs = take_blocks(vs_blk, top_idx).reshape(B, G, Q_BLOCK, n_sel, HEAD_DIM)
        kpos_s = (top_idx[..., None] * NSA_SEL_LEN + jnp.arange(NSA_SEL_LEN)).reshape(B, G, Q_BLOCK, n_sel)
        ds = qpos[None, None, :, None] - kpos_s
        mask_s = jnp.repeat(jnp.isfinite(top_val), NSA_SEL_LEN, axis=-1) & (ds >= 0)
        bias_s = jnp.moveaxis(tab_g[g_ids, rel_bucket(ds)], -1, 2)
        s_s = jnp.einsum('bqgrd,bgqkd->bgrqk', qb, ks) * ATTN_SCALE
        p_s = masked_softmax(s_s.astype(jnp.float32) + bias_s, mask_s[:, :, None])
        o_s = jnp.einsum('bgrqk,bgqkd->bqgrd', p_s.astype(vs.dtype), vs)
        kw = lax.dynamic_slice_in_dim(kw_pad, i * Q_BLOCK, Q_BLOCK + NSA_WINDOW, axis=1)
        vw = lax.dynamic_slice_in_dim(vw_pad, i * Q_BLOCK, Q_BLOCK + NSA_WINDOW, axis=1)
        kpos_w = i * Q_BLOCK - NSA_WINDOW + jnp.arange(Q_BLOCK + NSA_WINDOW)
        dw = qpos[:, None] - kpos_w[None, :]
        mask_w = (dw >= 0) & (dw < NSA_WINDOW) & (kpos_w >= 0)[None, :]
        s_w = jnp.einsum('bqgrd,bkgd->bgrqk', qb, kw) * ATTN_SCALE
        p_w = masked_softmax(s_w.astype(jnp.float32) + head_bias(tab, dw, G, R), mask_w)
        o_w = jnp.einsum('bgrqk,bkgd->bqgrd', p_w.astype(vw.dtype), vw)
        g = jax.nn.sigmoid(gb.astype(jnp.float32)).astype(qb.dtype)
        o = g[..., 0:1] * o_c + g[..., 1:2] * o_s + g[..., 2:3] * o_w
        return o.reshape(B, Q_BLOCK, B_Q_HEADS * HEAD_DIM)

    out = lax.map(one_block, (jnp.arange(nb), q_blocks, g_blocks))
    return jnp.transpose(out, (1, 0, 2, 3)).reshape(B, T, B_Q_HEADS * HEAD_DIM)


def forgetting_attention(q, k, v, f_logit):
    B, T, H = q.shape[0], q.shape[1], q.shape[2]
    nb = T // Q_BLOCK
    c = jnp.moveaxis(jnp.cumsum(jax.nn.log_sigmoid(f_logit.astype(jnp.float32)), axis=1), 1, 2)
    q_blocks = jnp.transpose(q.reshape(B, nb, Q_BLOCK, H, HEAD_DIM), (1, 0, 2, 3, 4))
    c_blocks = jnp.transpose(c.reshape(B, H, nb, Q_BLOCK), (2, 0, 1, 3))
    kpos = jnp.arange(T)

    def one_block(args):
        i, qb, cq = args
        qpos = i * Q_BLOCK + jnp.arange(Q_BLOCK)
        s = jnp.einsum('bqhd,bkhd->bhqk', qb, k).astype(jnp.float32) * ATTN_SCALE
        s = s + cq[..., None] - c[:, :, None, :]
        p = masked_softmax(s, kpos[None, :] <= qpos[:, None])
        return jnp.einsum('bhqk,bkhd->bqhd', p.astype(v.dtype), v)

    out = lax.map(one_block, (jnp.arange(nb), q_blocks, c_blocks))
    return jnp.transpose(out, (1, 0, 2, 3, 4)).reshape(B, T, H * HEAD_DIM)


def even_mixer(h, w_in, w_out, sinks, pe_k, pe_v, ck_w1, ck_w2, cv_w1, cv_w2, rel_bias):
    B, T = h.shape[0], h.shape[1]
    splits = [int(s) for s in np.cumsum(EVEN_SIZES)[:-1]]
    qa, ka, va, qb, kc, vc, ksl, vsl, kwn, vwn, gt = jnp.split(h @ w_in, splits, axis=-1)
    heads = lambda t, n: t.reshape(B, T, n, HEAD_DIM)
    a_out = swa_sink_attention(heads(qa, A_Q_HEADS), heads(ka, A_KV_HEADS), heads(va, A_KV_HEADS), sinks, rel_bias[:, :A_Q_HEADS])
    k_cmp = nsa_compress(heads(kc, B_KV_HEADS), pe_k, ck_w1, ck_w2)
    v_cmp = nsa_compress(heads(vc, B_KV_HEADS), pe_v, cv_w1, cv_w2)
    b_out = nsa_attention(heads(qb, B_Q_HEADS), k_cmp, v_cmp, heads(ksl, B_KV_HEADS), heads(vsl, B_KV_HEADS), heads(kwn, B_KV_HEADS), heads(vwn, B_KV_HEADS), gt, rel_bias[:, A_Q_HEADS:])
    return jnp.concatenate([a_out, b_out], axis=-1) @ w_out


def odd_mixer(h, w_in, w_out, f_bias):
    B, T = h.shape[0], h.shape[1]
    q, k, v, f = jnp.split(h @ w_in, [C_MIX, 2 * C_MIX, 3 * C_MIX], axis=-1)
    heads = lambda t: t.reshape(B, T, C_HEADS, HEAD_DIM)
    return forgetting_attention(heads(q), heads(k), heads(v), f + f_bias) @ w_out


def setup_inputs(seed: int = 0) -> dict:
    key = jax.random.key(seed)
    ks = jax.random.split(key, 20)
    ne = (DEPTH + 1) // 2
    no = DEPTH // 2
    nrm = lambda k, shape, scale: jax.random.normal(k, shape, jnp.float32) * scale
    flat_cmp = NSA_CMP_LEN * HEAD_DIM
    return {
        'x': nrm(ks[0], (BATCH, SEQ, D_MODEL), 1.0),
        'rel_bias': nrm(ks[1], (REL_BUCKETS, REL_HEADS), 0.3),
        'norm_mix': 1.0 + nrm(ks[2], (DEPTH, D_MODEL), 0.05),
        'norm_ffn': 1.0 + nrm(ks[3], (DEPTH, D_MODEL), 0.05),
        'norm_final': 1.0 + nrm(ks[4], (D_MODEL,), 0.05),
        'w_in_even': nrm(ks[5], (ne, D_MODEL, EVEN_IN), D_MODEL ** -0.5),
        'w_out_even': nrm(ks[6], (ne, EVEN_MIX, D_MODEL), EVEN_MIX ** -0.5),
        'a_sinks': nrm(ks[7], (ne, A_Q_HEADS), 0.5),
        'nsa_pe_k': nrm(ks[8], (ne, NSA_CMP_LEN, HEAD_DIM), 0.1),
        'nsa_pe_v': nrm(ks[9], (ne, NSA_CMP_LEN, HEAD_DIM), 0.1),
        'nsa_cmp_k_w1': nrm(ks[10], (ne, flat_cmp, NSA_CMP_HIDDEN), flat_cmp ** -0.5),
        'nsa_cmp_k_w2': nrm(ks[11], (ne, NSA_CMP_HIDDEN, HEAD_DIM), NSA_CMP_HIDDEN ** -0.5),
        'nsa_cmp_v_w1': nrm(ks[12], (ne, flat_cmp, NSA_CMP_HIDDEN), flat_cmp ** -0.5),
        'nsa_cmp_v_w2': nrm(ks[13], (ne, NSA_CMP_HIDDEN, HEAD_DIM), NSA_CMP_HIDDEN ** -0.5),
        'w_in_odd': nrm(ks[14], (no, D_MODEL, ODD_IN), D_MODEL ** -0.5),
        'w_out_odd': nrm(ks[15], (no, C_MIX, D_MODEL), C_MIX ** -0.5),
        'fox_fgate_b': 3.0 + nrm(ks[16], (no, C_HEADS), 0.5),
        'w_ffn_up': nrm(ks[17], (DEPTH, D_MODEL, D_FF), D_MODEL ** -0.5),
        'w_ffn_down': nrm(ks[18], (DEPTH, D_FF, D_MODEL), D_FF ** -0.5),
    }


def reference(x, rel_bias, norm_mix, norm_ffn, norm_final, w_in_even, w_out_even, a_sinks, nsa_pe_k, nsa_pe_v, nsa_cmp_k_w1, nsa_cmp_k_w2, nsa_cmp_v_w1, nsa_cmp_v_w2, w_in_odd, w_out_odd, fox_fgate_b, w_ffn_up, w_ffn_down):
    for layer in range(DEPTH):
        h = rms_norm(x, norm_mix[layer])
        if layer % 2 == 0:
            e = layer // 2
            x = x + even_mixer(h, w_in_even[e], w_out_even[e], a_sinks[e], nsa_pe_k[e], nsa_pe_v[e], nsa_cmp_k_w1[e], nsa_cmp_k_w2[e], nsa_cmp_v_w1[e], nsa_cmp_v_w2[e], rel_bias)
        else:
            o = layer // 2
            x = x + odd_mixer(h, w_in_odd[o], w_out_odd[o], fox_fgate_b[o])
        h = rms_norm(x, norm_ffn[layer])
        u = jax.nn.relu(h @ w_ffn_up[layer])
        x = x + (u * u) @ w_ffn_down[layer]
    return rms_norm(x, norm_final)
```

```cpp
#include <hip/hip_runtime.h>
#include <hip/hip_cooperative_groups.h>
#include <cstdio>
#include <cstdint>
#include <cmath>
namespace cg = cooperative_groups;
__device__ __forceinline__ int mk_ltid() { int t = threadIdx.x; asm volatile("" : "+v"(t)); return t; }
__device__ __forceinline__ int mk_bid() { int t = blockIdx.x; asm volatile("" : "+s"(t)); return t; }
__device__ __forceinline__ int mk_grid() { int t = gridDim.x; asm volatile("" : "+s"(t)); return t; }
namespace pg8 {
#define PG8_LAS __attribute__((address_space(3)))
typedef unsigned short bf16_t;
typedef short bf16x8 __attribute__((ext_vector_type(8)));
typedef float f32x4 __attribute__((ext_vector_type(4)));
typedef unsigned u32x4 __attribute__((ext_vector_type(4)));
constexpr int BM = 256, BK = 64, HALF = 128, HTB = HALF * BK * 2  , STAGE_BYTES = 8 * HTB, NXCD = 8, WGM = 8;

__host__ __device__ __forceinline__ int lds_byte(int r, int c) { const int st = (r >> 4) * 2 + (c >> 5), rr = r & 15, cc = c & 31, ob = rr * 64 + cc * 2; return st * 1024 + (ob ^ (((ob >> 9) & 1) << 5)); }
__host__ __device__ __forceinline__ void stage_rc(int b, int& R, int& C) { const int st = b / 1024, sb = b % 1024, swz = sb ^ (((sb >> 9) & 1) << 5); R = (st >> 1) * 16 + swz / 64; C = (st & 1) * 32 + (swz % 64) / 2; }
__host__ __device__ __forceinline__ int perm32(int rho) { const int n = rho >> 4, i = rho & 15; return 8 * (i >> 2) + 4 * n + (i & 3); }

struct Unit { int pm, pn; };
struct Gemm { const bf16_t* A; const bf16_t* Bt; int M, N, K; };

struct StaticOrder {
    int nM, nN, nwg, G, c;
    __host__ __device__ void init(int M, int N, int G_, int c_) { nM = M / BM; nN = N / BM; nwg = nM * nN; G = G_; c = c_; }
    __host__ __device__ bool next(int i, Unit& u) const {
        const long L = (long)i * G + c; if (L >= nwg) return false;
        int wgid = (int)L; { const int q = nwg / NXCD, r = nwg % NXCD, xcd = wgid % NXCD, off = wgid / NXCD; wgid = (xcd < r ? xcd * (q + 1) : r * (q + 1) + (xcd - r) * q) + off; }
        const int nig = WGM * nN, gid = wgid / nig, fm = gid * WGM, gsz = (nM - fm) < WGM ? (nM - fm) : WGM;
        u.pm = fm + ((wgid % nig) % gsz); u.pn = (wgid % nig) / gsz; return true;
    }
    __device__ __forceinline__ void a_ready(const Unit&) const {}
    __device__ __forceinline__ void done(const Unit&) const {}
};

__device__ __forceinline__ unsigned cvt_pk_bf16(float lo, float hi) { unsigned r; asm volatile("v_cvt_pk_bf16_f32 %0, %1, %2" : "=v"(r) : "v"(lo), "v"(hi)); return r; }
typedef float f32x2 __attribute__((ext_vector_type(2)));
template <int ACT  > struct EpiBf16 {
    static constexpr bool PERM = true, AFTER_DRAIN = false;
    bf16_t* O; int ldc;
    __device__ __forceinline__ void operator()(const f32x4 (&acc)[2][2][4][2], const Unit& u, int wr, int wc, int fr, int fq) const {
        const int row0 = u.pm * BM + wr * 64 + fr; const int col0 = u.pn * BM + wc * 32 + 8 * fq;
#pragma unroll
        for (int ai = 0; ai < 2; ++ai)
#pragma unroll
            for (int m = 0; m < 4; ++m) { bf16_t* rowp = O + (size_t)(row0 + ai * HALF + m * 16) * ldc + col0;
#pragma unroll
                for (int bj = 0; bj < 2; ++bj) { f32x4 v0 = acc[ai][bj][m][0], v1 = acc[ai][bj][m][1];
                    if (ACT == 2) {
#pragma unroll
                        for (int e = 0; e < 4; ++e) { float a = v0[e] > 0.f ? v0[e] : 0.f; v0[e] = a * a; float b = v1[e] > 0.f ? v1[e] : 0.f; v1[e] = b * b; } }
                    u32x4 w; w.x = cvt_pk_bf16(v0[0], v0[1]); w.y = cvt_pk_bf16(v0[2], v0[3]); w.z = cvt_pk_bf16(v1[0], v1[1]); w.w = cvt_pk_bf16(v1[2], v1[3]);
                    *(u32x4*)(rowp + bj * HALF) = w; } }
    }
};
struct EpiRes {
    static constexpr bool PERM = false, AFTER_DRAIN = false;
    const float* base; float* out; int ldc;
    __device__ __forceinline__ void operator()(const f32x4 (&acc)[2][2][4][2], const Unit& u, int wr, int wc, int fr, int fq) const {
        const int row0 = u.pm * BM + wr * 64 + fr; const int col0 = u.pn * BM + wc * 32 + 4 * fq;
#pragma unroll
        for (int ai = 0; ai < 2; ++ai)
#pragma unroll
            for (int m = 0; m < 4; ++m) { const size_t off = (size_t)(row0 + ai * HALF + m * 16) * ldc + col0;
#pragma unroll
                for (int bj = 0; bj < 2; ++bj)
#pragma unroll
                    for (int n = 0; n < 2; ++n) { const f32x4 b = *(const f32x4*)(base + off + bj * HALF + n * 16); *(f32x4*)(out + off + bj * HALF + n * 16) = b + acc[ai][bj][m][n]; } }
    }
};
template <class Epi, class Sched, bool ALIGN_EPI = false, bool SP2 = false>
__device__ __forceinline__ void gemm_phase(PG8_LAS unsigned char* lds, const Gemm g, const Sched& S, const Epi& E) {
    const int tid = mk_ltid(), wid = __builtin_amdgcn_readfirstlane(tid >> 6), lane = tid & 63, wr = wid >> 2, wc = wid & 3, fr = lane & 15, fq = lane >> 4;
    const int K = g.K, nt = K / BK;
    unsigned voffA[2], voffB[2];
#pragma unroll
    for (int i = 0; i < 2; ++i) { int R, C; stage_rc(tid * 16 + i * 8192, R, C); const int Rb = Epi::PERM ? ((R & ~31) + perm32(R & 31)) : R;
        voffA[i] = (unsigned)(R * K + C) * 2u; voffB[i] = (unsigned)(Rb * K + C) * 2u; }
    const size_t kstep = (size_t)(BK * 2);
    const size_t hstep = (size_t)HALF * K * 2;
    const size_t tstep = 2 * hstep;
    const unsigned ldsw = (unsigned)wid * 1024u;
    const int aoff = lds_byte(wr * 64 + fr, fq * 8), boff = lds_byte(wc * 32 + fr, fq * 8);
#define PG8_SA(b, h) (((b) * 2 + (h)) * HTB)
#define PG8_SB(b, h) ((4 + (b) * 2 + (h)) * HTB)
#define PG8_STAGE(bufoff, gbase, voff) do { _Pragma("unroll") for (int _i = 0; _i < 2; ++_i) \
        __builtin_amdgcn_global_load_lds((const unsigned*)((const char*)(gbase) + (voff)[_i]), (PG8_LAS unsigned*)(lds + (bufoff) + ldsw + _i * 8192), 16, 0, 0); } while (0)
#define PG8_LDA(dst, b, h) do { _Pragma("unroll") for (int m = 0; m < 4; ++m) _Pragma("unroll") for (int k = 0; k < 2; ++k) dst[m][k] = *(const PG8_LAS bf16x8*)(lds + PG8_SA(b, h) + aoff + m * 2048 + k * 1024); } while (0)
#define PG8_LDB(dst, b, h) do { _Pragma("unroll") for (int n = 0; n < 2; ++n) _Pragma("unroll") for (int k = 0; k < 2; ++k) dst[n][k] = *(const PG8_LAS bf16x8*)(lds + PG8_SB(b, h) + boff + n * 2048 + k * 1024); } while (0)
#define PG8_MMA(ai, bj, At, Bt) do { __builtin_amdgcn_s_setprio(1); _Pragma("unroll") for (int m = 0; m < 4; ++m) _Pragma("unroll") for (int n = 0; n < 2; ++n) _Pragma("unroll") for (int k = 0; k < 2; ++k) \
        acc[ai][bj][m][n] = __builtin_amdgcn_mfma_f32_16x16x32_bf16(Bt[n][k], At[m][k], acc[ai][bj][m][n], 0, 0, 0); __builtin_amdgcn_s_setprio(0); } while (0)
#define PG8_WAIT_V(n) asm volatile("s_waitcnt vmcnt(" #n ")" ::: "memory")
#define PG8_WAIT_L(n) asm volatile("s_waitcnt lgkmcnt(" #n ")" ::: "memory")
#define PG8_BAR __builtin_amdgcn_s_barrier()
#define PG8_SCHED __builtin_amdgcn_sched_barrier(0)
    Unit cur, nxt; int ui = 0;
    if (!S.next(0, cur)) return;
    f32x4 acc[2][2][4][2];
#pragma unroll
    for (int a = 0; a < 2; ++a)
#pragma unroll
        for (int b = 0; b < 2; ++b)
#pragma unroll
            for (int m = 0; m < 4; ++m)
#pragma unroll
                for (int n = 0; n < 2; ++n) acc[a][b][m][n] = (f32x4){0.f, 0.f, 0.f, 0.f};
    bf16x8 At[4][2], B0[2][2], B1[2][2];
    const char* cA = (const char*)g.A + (size_t)cur.pm * tstep; const char* cB = (const char*)g.Bt + (size_t)cur.pn * tstep;
    S.a_ready(cur);
    if constexpr (SP2) {
        PG8_STAGE(PG8_SB(0, 0), cB, voffB); PG8_STAGE(PG8_SB(0, 1), cB + hstep, voffB); PG8_STAGE(PG8_SA(0, 0), cA, voffA); PG8_STAGE(PG8_SA(0, 1), cA + hstep, voffA);
        if (wr == 1) PG8_BAR;
        PG8_WAIT_V(2); PG8_BAR;
        PG8_STAGE(PG8_SB(1, 0), cB + kstep, voffB); PG8_STAGE(PG8_SA(1, 0), cA + kstep, voffA); PG8_STAGE(PG8_SB(1, 1), cB + hstep + kstep, voffB);
        PG8_WAIT_V(6); PG8_BAR;
    } else {
        PG8_STAGE(PG8_SB(0, 0), cB, voffB); PG8_STAGE(PG8_SA(0, 0), cA, voffA); PG8_STAGE(PG8_SB(0, 1), cB + hstep, voffB); PG8_STAGE(PG8_SA(0, 1), cA + hstep, voffA);
        if (wr == 1) PG8_BAR;
        PG8_WAIT_V(4); PG8_BAR;
        PG8_STAGE(PG8_SB(1, 0), cB + kstep, voffB); PG8_STAGE(PG8_SA(1, 0), cA + kstep, voffA); PG8_STAGE(PG8_SB(1, 1), cB + hstep + kstep, voffB);
        PG8_WAIT_V(6); PG8_BAR;
    }
    for (;;) {
        const bool has_next = S.next(ui + 1, nxt);
        const char* nA = has_next ? (const char*)g.A + (size_t)nxt.pm * tstep : cA; const char* nB = has_next ? (const char*)g.Bt + (size_t)nxt.pn * tstep : cB;
        for (int t = 0; t < nt; t += 2) {
            const bool last = (t == nt - 2);
            const char* a1 = cA + (size_t)(t + 1) * kstep;
            const char* a2 = last ? nA : cA + (size_t)(t + 2) * kstep; const char* b2 = last ? nB : cB + (size_t)(t + 2) * kstep;
            const char* a3 = a2 + kstep; const char* b3 = b2 + kstep;
            if (last && has_next) S.a_ready(nxt);
            if constexpr (SP2) {
            PG8_LDB(B0, 0, 0); PG8_LDB(B1, 0, 1); PG8_SCHED; PG8_LDA(At, 0, 0); PG8_STAGE(PG8_SA(1, 1), a1 + hstep, voffA);
            PG8_WAIT_V(8); PG8_WAIT_L(0); PG8_BAR; PG8_MMA(0, 0, At, B0); PG8_MMA(0, 1, At, B1); PG8_BAR; PG8_SCHED;
            PG8_LDA(At, 0, 1); PG8_STAGE(PG8_SB(0, 0), b2, voffB); PG8_STAGE(PG8_SB(0, 1), b2 + hstep, voffB); PG8_STAGE(PG8_SA(0, 0), a2, voffA);
            PG8_WAIT_V(8); PG8_WAIT_L(0); PG8_BAR; PG8_MMA(1, 0, At, B0); PG8_MMA(1, 1, At, B1); PG8_BAR; PG8_SCHED;
            PG8_LDB(B0, 1, 0); PG8_LDB(B1, 1, 1); PG8_SCHED; PG8_LDA(At, 1, 0); PG8_STAGE(PG8_SA(0, 1), a2 + hstep, voffA);
            PG8_WAIT_V(8); PG8_WAIT_L(0); PG8_BAR; PG8_MMA(0, 0, At, B0); PG8_MMA(0, 1, At, B1); PG8_BAR; PG8_SCHED;
            PG8_LDA(At, 1, 1); PG8_STAGE(PG8_SB(1, 0), b3, voffB); PG8_STAGE(PG8_SB(1, 1), b3 + hstep, voffB); PG8_STAGE(PG8_SA(1, 0), a3, voffA);
            PG8_WAIT_V(8); PG8_WAIT_L(0); PG8_BAR; PG8_MMA(1, 0, At, B0); PG8_MMA(1, 1, At, B1); PG8_BAR; PG8_SCHED;
            } else {
            PG8_LDB(B0, 0, 0); PG8_SCHED; PG8_LDA(At, 0, 0); PG8_STAGE(PG8_SA(1, 1), a1 + hstep, voffA);
            PG8_WAIT_L(8); PG8_BAR; PG8_WAIT_L(0); PG8_MMA(0, 0, At, B0); PG8_BAR; PG8_SCHED;
            PG8_LDB(B1, 0, 1); PG8_STAGE(PG8_SB(0, 0), b2, voffB);
            PG8_BAR; PG8_WAIT_L(0); PG8_MMA(0, 1, At, B1); PG8_BAR;
            PG8_LDA(At, 0, 1); PG8_STAGE(PG8_SA(0, 0), a2, voffA);
            PG8_BAR; PG8_WAIT_L(0); PG8_MMA(1, 0, At, B0); PG8_BAR; PG8_SCHED;
            PG8_STAGE(PG8_SB(0, 1), b2 + hstep, voffB);
            PG8_WAIT_V(6); PG8_BAR; PG8_MMA(1, 1, At, B1); PG8_BAR;
            PG8_LDB(B0, 1, 0); PG8_SCHED; PG8_LDA(At, 1, 0); PG8_STAGE(PG8_SA(0, 1), a2 + hstep, voffA);
            PG8_WAIT_L(8); PG8_BAR; PG8_WAIT_L(0); PG8_MMA(0, 0, At, B0); PG8_BAR; PG8_SCHED;
            PG8_LDB(B1, 1, 1); PG8_STAGE(PG8_SB(1, 0), b3, voffB);
            PG8_BAR; PG8_WAIT_L(0); PG8_MMA(0, 1, At, B1); PG8_BAR;
            PG8_LDA(At, 1, 1); PG8_STAGE(PG8_SA(1, 0), a3, voffA);
            PG8_BAR; PG8_WAIT_L(0); PG8_MMA(1, 0, At, B0); PG8_BAR; PG8_SCHED;
            PG8_STAGE(PG8_SB(1, 1), b3 + hstep, voffB);
            PG8_WAIT_V(6); PG8_BAR; PG8_MMA(1, 1, At, B1); PG8_BAR;
            }
        }
        if constexpr (ALIGN_EPI) { if (wr == 0) PG8_BAR; }
        if constexpr (!Epi::AFTER_DRAIN) { E(acc, cur, wr, wc, fr, fq); S.done(cur); }
        if (!has_next) break;
#pragma unroll
        for (int a = 0; a < 2; ++a)
#pragma unroll
            for (int b = 0; b < 2; ++b)
#pragma unroll
                for (int m = 0; m < 4; ++m)
#pragma unroll
                    for (int n = 0; n < 2; ++n) acc[a][b][m][n] = (f32x4){0.f, 0.f, 0.f, 0.f};
        cur = nxt; cA = nA; cB = nB; ++ui;
        if constexpr (ALIGN_EPI) { if (wr == 1) PG8_BAR; }
    }
    PG8_WAIT_V(0);
    if constexpr (!ALIGN_EPI) { if (wr == 0) PG8_BAR; }
    PG8_BAR;
    if constexpr (Epi::AFTER_DRAIN) { E.fused(acc, cur, wr, wc, fr, fq, lds, wid, lane); S.done(cur); }
#undef PG8_SA
#undef PG8_SB
#undef PG8_STAGE
#undef PG8_LDA
#undef PG8_LDB
#undef PG8_MMA
#undef PG8_WAIT_V
#undef PG8_WAIT_L
#undef PG8_BAR
#undef PG8_SCHED
}
}

#define LAS __attribute__((address_space(3)))
typedef unsigned short bf16_t;
typedef short v8s __attribute__((ext_vector_type(8)));
typedef short v4s __attribute__((ext_vector_type(4)));
typedef float v4f __attribute__((ext_vector_type(4)));
typedef float v16f __attribute__((ext_vector_type(16)));
typedef unsigned v4u __attribute__((ext_vector_type(4)));
typedef unsigned v2u __attribute__((ext_vector_type(2)));

constexpr int DM = 2048, NB = 4, SEQ = 4096, MTOK = NB * SEQ, DFF = 8192;
constexpr int EVEN_IN = 3376, EVEN_PAD = 3584, ODD_IN = 6176, ODD_PAD = 6400;
constexpr int E_QA = 0, E_KA = 1024, E_VA = 1280, E_QB = 1536, E_KC = 2560, E_VC = 2688, E_KS = 2816, E_VS = 2944, E_KW = 3072, E_VW = 3200, E_GT = 3328;
constexpr int O_Q = 0, O_K = 2048, O_V = 4096, O_F = 6144;
constexpr float LOG2E = 1.4426950408889634f;
constexpr float C1 = 0.125f * LOG2E;
constexpr float RMS_EPS = 1e-6f;

constexpr size_t MiB = 1u << 20;
constexpr size_t WS_WUP = 16 * MiB, WS_WDN = 144 * MiB, WS_WIE = 272 * MiB, WS_WIO = 300 * MiB, WS_WOE = 350 * MiB, WS_WOO = 366 * MiB;
constexpr size_t WS_CW1 = 382 * MiB, WS_CW2 = 386 * MiB, WS_KCMP = 387 * MiB, WS_VCMP = 387 * MiB + 512 * 1024, WS_C = 388 * MiB;
constexpr size_t WS_XN = 392 * MiB, WS_QKV = 456 * MiB, WS_AO = 656 * MiB, WS_H = 456 * MiB, WS_END = 720 * MiB;

constexpr int KP = 144, VP = 144, TILEB = 64 * 144;
constexpr int LDS_BYTES = 160 * 1024;

struct Args { const float* in[19]; float* out; unsigned char* ws; };
__device__ __forceinline__ const unsigned char __attribute__((address_space(4)))* karg_base() {
    const unsigned char __attribute__((address_space(4)))* kp = (const unsigned char __attribute__((address_space(4)))*)__builtin_amdgcn_kernarg_segment_ptr();
    asm volatile("" : "+s"(kp)); return kp; }
__device__ __forceinline__ const float* arg_in(int i) { return *(const float* const __attribute__((address_space(4)))*)(karg_base() + 8 * i); }
__device__ __forceinline__ float* arg_out() { return *(float* const __attribute__((address_space(4)))*)(karg_base() + 8 * 19); }
__device__ __forceinline__ unsigned char* arg_ws() { return *(unsigned char* const __attribute__((address_space(4)))*)(karg_base() + 8 * 20); }

__device__ __forceinline__ unsigned pkbf(float lo, float hi) {
    typedef float f2 __attribute__((ext_vector_type(2))); typedef __bf16 b2 __attribute__((ext_vector_type(2)));
    f2 v = {lo, hi}; b2 b = __builtin_convertvector(v, b2); return __builtin_bit_cast(unsigned, b);
}
__device__ __forceinline__ float bf2f(unsigned short u) { return __uint_as_float(((unsigned)u) << 16); }
__device__ __forceinline__ float ex2(float x) { return __builtin_amdgcn_exp2f(x); }
__device__ __forceinline__ void lds_add(LAS unsigned* p, unsigned v) { (void)__hip_atomic_fetch_add(p, v, __ATOMIC_RELAXED, __HIP_MEMORY_SCOPE_WORKGROUP); }
__device__ __forceinline__ void lds_or(LAS unsigned* p, unsigned v) { (void)__hip_atomic_fetch_or(p, v, __ATOMIC_RELAXED, __HIP_MEMORY_SCOPE_WORKGROUP); }
__device__ __forceinline__ int crow(int r, int hi) { return (r & 3) + 8 * (r >> 2) + 4 * hi; }
__device__ __forceinline__ v16f mfma32(v8s a, v8s b, v16f c) { return __builtin_amdgcn_mfma_f32_32x32x16_bf16(a, b, c, 0, 0, 0); }
__device__ __forceinline__ float wave_sum(float v) {
#pragma unroll
    for (int o = 1; o < 64; o <<= 1) v += __shfl_xor(v, o);
    return v;
}

__device__ __forceinline__ void transpose_item(const float* W, int K, int N, bf16_t* WT, LAS float* scr, int item, int lane) {
    const int nblk = (N + 31) / 32, kb = item / nblk, nb = item % nblk, k0 = 64 * kb, n0 = 32 * nb;
    const int nn = n0 + (lane & 31); const bool ok = nn < N;
#pragma unroll 8
    for (int i = 0; i < 32; ++i) { const int kk = 2 * i + (lane >> 5); scr[kk * 33 + (lane & 31)] = ok ? W[(size_t)(k0 + kk) * N + nn] : 0.f; }
    asm volatile("s_waitcnt lgkmcnt(0)" ::: "memory");
    const int c = lane & 7;
#pragma unroll
    for (int j = 0; j < 4; ++j) { const int n = (lane >> 3) + 8 * j; const LAS float* s = scr + (8 * c) * 33 + n;
        v4u o; o.x = pkbf(s[0 * 33], s[1 * 33]); o.y = pkbf(s[2 * 33], s[3 * 33]); o.z = pkbf(s[4 * 33], s[5 * 33]); o.w = pkbf(s[6 * 33], s[7 * 33]);
        *(v4u*)(WT + (size_t)(n0 + n) * K + k0 + 8 * c) = o; }
    asm volatile("s_waitcnt lgkmcnt(0)" ::: "memory");
}

__device__ __forceinline__ void prologue_phase(LAS unsigned char* lds) {
    const int tid = mk_ltid(), lane = tid & 63, wave = __builtin_amdgcn_readfirstlane(tid >> 6);
    LAS float* scr = (LAS float*)(lds + wave * 16384);
    const int gw = mk_bid() * 8 + wave, NGW = mk_grid() * 8;
    for (int mi = 0; mi < 24; ++mi) {
        unsigned char* ws = arg_ws();
        const float* W; int K, N; bf16_t* WT;
        if (mi < 4) { W = arg_in(17) + (size_t)mi * DM * DFF; K = DM; N = DFF; WT = (bf16_t*)(ws + WS_WUP) + (size_t)mi * DFF * DM; }
        else if (mi < 8) { const int L = mi - 4; W = arg_in(18) + (size_t)L * DFF * DM; K = DFF; N = DM; WT = (bf16_t*)(ws + WS_WDN) + (size_t)L * DM * DFF; }
        else if (mi < 10) { const int e = mi - 8; W = arg_in(5) + (size_t)e * DM * EVEN_IN; K = DM; N = EVEN_IN; WT = (bf16_t*)(ws + WS_WIE) + (size_t)e * EVEN_PAD * DM; }
        else if (mi < 12) { const int e = mi - 10; W = arg_in(14) + (size_t)e * DM * ODD_IN; K = DM; N = ODD_IN; WT = (bf16_t*)(ws + WS_WIO) + (size_t)e * ODD_PAD * DM; }
        else if (mi < 14) { const int e = mi - 12; W = arg_in(6) + (size_t)e * DM * DM; K = DM; N = DM; WT = (bf16_t*)(ws + WS_WOE) + (size_t)e * DM * DM; }
        else if (mi < 16) { const int e = mi - 14; W = arg_in(15) + (size_t)e * DM * DM; K = DM; N = DM; WT = (bf16_t*)(ws + WS_WOO) + (size_t)e * DM * DM; }
        else if (mi < 20) { const int e = (mi - 16) & 1, kv = (mi - 16) >> 1; W = arg_in(kv ? 12 : 10) + (size_t)e * 2048 * 256; K = 2048; N = 256; WT = (bf16_t*)(ws + WS_CW1) + (size_t)(e * 2 + kv) * 256 * 2048; }
        else { const int e = (mi - 20) & 1, kv = (mi - 20) >> 1; W = arg_in(kv ? 13 : 11) + (size_t)e * 256 * 64; K = 256; N = 64; WT = (bf16_t*)(ws + WS_CW2) + (size_t)(e * 2 + kv) * 64 * 256; }
        const int nitems = (K / 64) * ((N + 31) / 32);
        for (int it = gw; it < nitems; it += NGW) transpose_item(W, K, N, WT, scr, it, lane);
    }
}

__device__ __forceinline__ void norm_phase(const float* X, const float* g, bf16_t* XN, float* OUTF) {
    const int tid = mk_ltid(), lane = tid & 63, wave = tid >> 6;
    const int gw = mk_bid() * 8 + wave, NGW = mk_grid() * 8;
    v4f gv[8];
#pragma unroll
    for (int j = 0; j < 8; ++j) gv[j] = *((const v4f*)g + lane + 64 * j);
    for (int m = gw; m < MTOK; m += NGW) {
        const v4f* xr = (const v4f*)(X + (size_t)m * DM) + lane;
        v4f v[8]; float s = 0.f;
#pragma unroll
        for (int j = 0; j < 8; ++j) { v[j] = xr[64 * j]; s += (v[j].x * v[j].x + v[j].y * v[j].y) + (v[j].z * v[j].z + v[j].w * v[j].w); }
        const float r = 1.0f / sqrtf(wave_sum(s) * (1.f / DM) + RMS_EPS);
        if (OUTF) {
            v4f* o = (v4f*)(OUTF + (size_t)m * DM) + lane;
#pragma unroll
            for (int j = 0; j < 8; ++j) o[64 * j] = v[j] * r * gv[j];
        } else {
            v2u* o = (v2u*)(XN + (size_t)m * DM) + lane;
#pragma unroll
            for (int j = 0; j < 8; ++j) { const v4f y = v[j] * r * gv[j]; v2u w; w.x = pkbf(y.x, y.y); w.y = pkbf(y.z, y.w); o[64 * j] = w; }
        }
    }
}

__device__ __forceinline__ void qk_tile(const LAS unsigned char* Kt, const v8s (&qf)[4], v16f& p0, v16f& p1, int r32, int hi) {
    const LAS unsigned char* kb = Kt + r32 * KP + hi * 16;
    v16f z;
#pragma unroll
    for (int r = 0; r < 16; ++r) z[r] = 0.f;
    p0 = z; p1 = z;
#pragma unroll
    for (int s = 0; s < 4; ++s) {
        const v8s a0 = *(const LAS v8s*)(kb + s * 32);
        const v8s a1 = *(const LAS v8s*)(kb + 32 * KP + s * 32);
        p0 = mfma32(a0, qf[s], p0); p1 = mfma32(a1, qf[s], p1);
    }
}
__device__ __forceinline__ v4s trrd(const LAS unsigned char* p) { return __builtin_bit_cast(v4s, __builtin_amdgcn_ds_read_tr16_b64_v4i16((LAS v4s*)p)); }
__device__ __forceinline__ void pv_tile(const LAS unsigned char* Vt, const v16f& p0, const v16f& p1, v16f (&oT)[2], int lane) {
    const int hi = lane >> 5;
    v4u w[4];
    w[0] = (v4u){pkbf(p0[0], p0[1]), pkbf(p0[2], p0[3]), pkbf(p0[4], p0[5]), pkbf(p0[6], p0[7])};
    w[1] = (v4u){pkbf(p0[8], p0[9]), pkbf(p0[10], p0[11]), pkbf(p0[12], p0[13]), pkbf(p0[14], p0[15])};
    w[2] = (v4u){pkbf(p1[0], p1[1]), pkbf(p1[2], p1[3]), pkbf(p1[4], p1[5]), pkbf(p1[6], p1[7])};
    w[3] = (v4u){pkbf(p1[8], p1[9]), pkbf(p1[10], p1[11]), pkbf(p1[12], p1[13]), pkbf(p1[14], p1[15])};
    const LAS unsigned char* vb = Vt + (4 * hi + ((lane & 15) >> 2)) * VP + (16 * ((lane >> 4) & 1) + 4 * (lane & 3)) * 2;
#pragma unroll
    for (int dt = 0; dt < 2; ++dt)
#pragma unroll
        for (int ks = 0; ks < 4; ++ks) {
            const int kvb = 16 * (ks & 1) + 32 * (ks >> 1);
            const v4s lo = trrd(vb + kvb * VP + dt * 64), h4 = trrd(vb + (kvb + 8) * VP + dt * 64);
            const v8s af = (v8s){lo[0], lo[1], lo[2], lo[3], h4[0], h4[1], h4[2], h4[3]};
            oT[dt] = mfma32(af, __builtin_bit_cast(v8s, w[ks]), oT[dt]);
        }
}
__device__ __forceinline__ void softmax_step(v16f& p0, v16f& p1, v16f (&oT)[2], float& m, float& l) {
    float mx = fmaxf(p0[0], p1[0]);
#pragma unroll
    for (int r = 1; r < 16; ++r) mx = fmaxf(mx, fmaxf(p0[r], p1[r]));
    mx = fmaxf(mx, __shfl_xor(mx, 32));
    const float mn = fmaxf(m, mx);
    const float mu = (mn == -INFINITY) ? 0.f : mn;
    const float alpha = ex2(m - mu);
    float rs = 0.f;
#pragma unroll
    for (int r = 0; r < 16; ++r) { p0[r] = ex2(p0[r] - mu); p1[r] = ex2(p1[r] - mu); rs += p0[r] + p1[r]; }
    l = l * alpha + rs; m = mn;
#pragma unroll
    for (int r = 0; r < 16; ++r) { oT[0][r] *= alpha; oT[1][r] *= alpha; }
}
__device__ __forceinline__ v4u ld_tile(const bf16_t* base, int row0, int pitch, int tid) { return *(const v4u*)(base + (size_t)(row0 + (tid >> 3)) * pitch + (tid & 7) * 8); }
__device__ __forceinline__ void st_tile(LAS unsigned char* T, v4u v, int tid) { *(LAS v4u*)(T + (tid >> 3) * KP + (tid & 7) * 16) = v; }
__device__ __forceinline__ void store_o(bf16_t* Orow, const v16f (&o)[2], int hi) {
#pragma unroll
    for (int dt = 0; dt < 2; ++dt)
#pragma unroll
        for (int g = 0; g < 4; ++g) { v2u w; w.x = pkbf(o[dt][4 * g], o[dt][4 * g + 1]); w.y = pkbf(o[dt][4 * g + 2], o[dt][4 * g + 3]);
            *(v2u*)(Orow + dt * 32 + 8 * g + 4 * hi) = w; }
}
__device__ __forceinline__ int rel_bucket(int n) {
    if (n < 16) return n;
    const float v = __log2f((float)n * (1.f / 16.f)) * (16.f / 6.f) + 1e-5f;
    const int b = 16 + (int)v; return b < 31 ? b : 31;
}

__device__ __forceinline__ void cumsum_phase(LAS unsigned char* lds, const bf16_t* QKV, const float* fb, float* CL2) {
    const int tid = mk_ltid(), lane = tid & 63, wave = tid >> 6;
    LAS float* wtot = (LAS float*)lds;
    for (int u = mk_bid(); u < NB * 32; u += mk_grid()) {
        const int b = u >> 5, h = u & 31; const float bias = fb[h];
        float v[8]; float run = 0.f;
#pragma unroll
        for (int i = 0; i < 8; ++i) { const int t = tid * 8 + i; const float x = bf2f(QKV[(size_t)(b * SEQ + t) * ODD_PAD + O_F + h]) + bias;
            const float ls = fminf(x, 0.f) - log1pf(expf(-fabsf(x))); run += ls; v[i] = run; }
        float inc = run;
#pragma unroll
        for (int o = 1; o < 64; o <<= 1) { const float t = __shfl_up(inc, o); if (lane >= o) inc += t; }
        __syncthreads();
        if (lane == 63) wtot[wave] = inc;
        __syncthreads();
        float off = inc - run;
        for (int w2 = 0; w2 < wave; ++w2) off += wtot[w2];
        float* o = CL2 + (size_t)u * SEQ + tid * 8;
#pragma unroll
        for (int i = 0; i < 8; ++i) o[i] = (v[i] + off) * LOG2E;
    }
}

__device__ __forceinline__ void fox_phase(LAS unsigned char* lds, const bf16_t* QKV, const float* CL2, bf16_t* AO) {
    const int tid = mk_ltid(), lane = tid & 63, w = __builtin_amdgcn_readfirstlane(tid >> 6), r32 = lane & 31, hi = lane >> 5;
    LAS unsigned char* KT = lds; LAS unsigned char* VT = lds + 2 * TILEB; LAS float* KB = (LAS float*)(lds + 4 * TILEB);
    for (int j = mk_bid(); j < NB * 32 * 16; j += mk_grid()) {
        const int rr = j >> 7, bh = j & 127, i2 = rr >> 1; int sel = rr & 1; if (i2 & 1) sel ^= 1;
        const int qb = 15 - (2 * i2 + sel), b = bh >> 5, h = bh & 31;
        const int q0 = qb * 256, qw0 = q0 + 32 * w, qpos = qw0 + r32;
        const bf16_t* Qg = QKV + (size_t)(b * SEQ + qpos) * ODD_PAD + O_Q + h * 64 + hi * 8;
        v8s qf[4];
#pragma unroll
        for (int s = 0; s < 4; ++s) qf[s] = *(const v8s*)(Qg + s * 16);
        const bf16_t* Kg = QKV + (size_t)(b * SEQ) * ODD_PAD + O_K + h * 64;
        const bf16_t* Vg = QKV + (size_t)(b * SEQ) * ODD_PAD + O_V + h * 64;
        const float* cl = CL2 + (size_t)(b * 32 + h) * SEQ;
        const int nt = (q0 + 256) / 64;
        v16f oT[2];
#pragma unroll
        for (int r = 0; r < 16; ++r) { oT[0][r] = 0.f; oT[1][r] = 0.f; }
        float m = -INFINITY, l = 0.f;
        __syncthreads();
        v4u kr = ld_tile(Kg, 0, ODD_PAD, tid), vr = ld_tile(Vg, 0, ODD_PAD, tid); float cr = (tid < 64) ? cl[tid] : 0.f;
        for (int t = 0; t < nt; ++t) {
            const int buf = t & 1;
            st_tile(KT + buf * TILEB, kr, tid); st_tile(VT + buf * TILEB, vr, tid); if (tid < 64) KB[buf * 64 + tid] = cr;
            __syncthreads();
            if (t + 1 < nt) { kr = ld_tile(Kg, 64 * (t + 1), ODD_PAD, tid); vr = ld_tile(Vg, 64 * (t + 1), ODD_PAD, tid); if (tid < 64) cr = cl[64 * (t + 1) + tid]; }
            if (64 * t <= qw0 + 31) {
                v16f p0, p1;
                qk_tile(KT + buf * TILEB, qf, p0, p1, r32, hi);
                const bool diag = (64 * t + 63 > qw0);
                const LAS float* kbp = KB + buf * 64 + 4 * hi;
#pragma unroll
                for (int g = 0; g < 4; ++g) {
                    const v4f b0 = *(const LAS v4f*)(kbp + 8 * g), b1 = *(const LAS v4f*)(kbp + 32 + 8 * g);
#pragma unroll
                    for (int e = 0; e < 4; ++e) { const int r = 4 * g + e; const int kv = 64 * t + 8 * g + 4 * hi + e;
                        float s0 = p0[r] * C1 - b0[e], s1 = p1[r] * C1 - b1[e];
                        if (diag) { if (kv > qpos) s0 = -INFINITY; if (kv + 32 > qpos) s1 = -INFINITY; }
                        p0[r] = s0; p1[r] = s1; }
                }
                softmax_step(p0, p1, oT, m, l);
                pv_tile(VT + buf * TILEB, p0, p1, oT, lane);
            }
        }
        l += __shfl_xor(l, 32);
        const float inv = 1.f / l;
#pragma unroll
        for (int r = 0; r < 16; ++r) { oT[0][r] *= inv; oT[1][r] *= inv; }
        store_o(AO + (size_t)(b * SEQ + qpos) * DM + h * 64, oT, hi);
    }
}

__device__ __forceinline__ float gelu_tanh(float x) {
    const float u = 0.7978845608028654f * (x + 0.044715f * x * x * x);
    const float t = 1.f - 2.f / (1.f + __expf(2.f * u));
    return 0.5f * x * (1.f + t);
}
__device__ __forceinline__ void compress_unit(LAS unsigned char* lds, int u, const bf16_t* QKV, const float* pe_k, const float* pe_v,
                                              const bf16_t* CW1  , const bf16_t* CW2  , bf16_t* KCMP, bf16_t* VCMP) {
    const int tid = mk_ltid(), lane = tid & 63, w = __builtin_amdgcn_readfirstlane(tid >> 6), r32 = lane & 31, hi = lane >> 5;
    const int kv = u >> 6, b = (u >> 4) & 3, g = (u >> 3) & 1, ch = u & 7;
    const float* pe = kv ? pe_v : pe_k;
    const bf16_t* W1 = CW1 + (size_t)kv * 256 * 2048; const bf16_t* W2 = CW2 + (size_t)kv * 64 * 256;
    bf16_t* OUT = (kv ? VCMP : KCMP) + (size_t)((b * 2 + g) * 256 + ch * 32) * 64;
    const int n = ch * 32 + r32;
    const bf16_t* Ag = QKV + (size_t)(b * SEQ + 16 * n) * EVEN_PAD + (kv ? E_VC : E_KC) + g * 64 + hi * 8;
    const bf16_t* Bg = W1 + (size_t)(32 * w + r32) * 2048 + hi * 8;
    LAS bf16_t* HID = (LAS bf16_t*)lds;
    v16f acc;
#pragma unroll
    for (int r = 0; r < 16; ++r) acc[r] = 0.f;
    __syncthreads();
#pragma unroll 4
    for (int st = 0; st < 128; ++st) {
        const int li = st >> 2, d0 = (st & 3) * 16;
        const v4u ar = *(const v4u*)(Ag + (size_t)li * EVEN_PAD + d0);
        const v4f pa = *(const v4f*)(pe + li * 64 + d0 + hi * 8), pb = *(const v4f*)(pe + li * 64 + d0 + hi * 8 + 4);
        const v8s bfr = *(const v8s*)(Bg + st * 16);
        v4u aw;
        aw.x = pkbf(__uint_as_float(ar.x << 16) + pa.x, __uint_as_float(ar.x & 0xffff0000u) + pa.y);
        aw.y = pkbf(__uint_as_float(ar.y << 16) + pa.z, __uint_as_float(ar.y & 0xffff0000u) + pa.w);
        aw.z = pkbf(__uint_as_float(ar.z << 16) + pb.x, __uint_as_float(ar.z & 0xffff0000u) + pb.y);
        aw.w = pkbf(__uint_as_float(ar.w << 16) + pb.z, __uint_as_float(ar.w & 0xffff0000u) + pb.w);
        acc = mfma32(__builtin_bit_cast(v8s, aw), bfr, acc);
    }
#pragma unroll
    for (int r = 0; r < 16; ++r) HID[crow(r, hi) * 264 + 32 * w + r32] = (bf16_t)(pkbf(gelu_tanh(acc[r]), 0.f) & 0xffffu);
    __syncthreads();
    if (w < 2) {
        v16f o;
#pragma unroll
        for (int r = 0; r < 16; ++r) o[r] = 0.f;
        const bf16_t* B2 = W2 + (size_t)(32 * w + r32) * 256 + hi * 8;
#pragma unroll
        for (int st = 0; st < 16; ++st) {
            const v8s af = *(const LAS v8s*)(HID + r32 * 264 + st * 16 + hi * 8);
            const v8s bfr = *(const v8s*)(B2 + st * 16);
            o = mfma32(af, bfr, o);
        }
#pragma unroll
        for (int r = 0; r < 16; ++r) { const int nl = crow(r, hi); const bool valid = (ch * 32 + nl) < 255;
            OUT[(size_t)nl * 64 + 32 * w + r32] = valid ? (bf16_t)(pkbf(o[r], 0.f) & 0xffffu) : (bf16_t)0; }
    }
}

__device__ __forceinline__ void swa_unit(LAS unsigned char* lds, int u, const bf16_t* QKV, const float* relb, const float* sinks, bf16_t* AO) {
    const int tid = mk_ltid(), lane = tid & 63, w = __builtin_amdgcn_readfirstlane(tid >> 6), r32 = lane & 31, hi = lane >> 5;
    LAS unsigned char* KT = lds; LAS unsigned char* VT = lds + 2 * TILEB; LAS float* TB = (LAS float*)(lds + 4 * TILEB);
    const int qblk = u >> 4, b = (u >> 2) & 3, g = u & 3;
    const int hq = 4 * g + (w >> 1), q0 = 64 * qblk, qw0 = q0 + 32 * (w & 1), qpos = qw0 + r32;
    __syncthreads();
    { const int hh = tid >> 7, d = tid & 127; TB[tid] = relb[rel_bucket(d) * 32 + 4 * g + hh] * LOG2E; }
    const bf16_t* Qg = QKV + (size_t)(b * SEQ + qpos) * EVEN_PAD + E_QA + hq * 64 + hi * 8;
    v8s qf[4];
#pragma unroll
    for (int s = 0; s < 4; ++s) qf[s] = *(const v8s*)(Qg + s * 16);
    const bf16_t* Kg = QKV + (size_t)(b * SEQ) * EVEN_PAD + E_KA + g * 64;
    const bf16_t* Vg = QKV + (size_t)(b * SEQ) * EVEN_PAD + E_VA + g * 64;
    const int t1 = qblk, t0 = (qblk >= 2) ? qblk - 2 : 0;
    v16f oT[2];
#pragma unroll
    for (int r = 0; r < 16; ++r) { oT[0][r] = 0.f; oT[1][r] = 0.f; }
    float m = -INFINITY, l = 0.f;
    const LAS float* tb = TB + (w >> 1) * 128;
    v4u kr = ld_tile(Kg, 64 * t0, EVEN_PAD, tid), vr = ld_tile(Vg, 64 * t0, EVEN_PAD, tid);
    for (int t = t0; t <= t1; ++t) {
        const int buf = t & 1;
        st_tile(KT + buf * TILEB, kr, tid); st_tile(VT + buf * TILEB, vr, tid);
        __syncthreads();
        if (t + 1 <= t1) { kr = ld_tile(Kg, 64 * (t + 1), EVEN_PAD, tid); vr = ld_tile(Vg, 64 * (t + 1), EVEN_PAD, tid); }
        if (64 * t + 63 >= qw0 - 127 && 64 * t <= qw0 + 31) {
            v16f p0, p1;
            qk_tile(KT + buf * TILEB, qf, p0, p1, r32, hi);
#pragma unroll
            for (int r = 0; r < 16; ++r) {
                const int d0 = qpos - (64 * t + crow(r, hi)), d1 = d0 - 32;
                const float s0 = p0[r] * C1 + tb[d0 & 127], s1 = p1[r] * C1 + tb[d1 & 127];
                p0[r] = (d0 >= 0 && d0 < 128) ? s0 : -INFINITY; p1[r] = (d1 >= 0 && d1 < 128) ? s1 : -INFINITY;
            }
            softmax_step(p0, p1, oT, m, l);
            pv_tile(VT + buf * TILEB, p0, p1, oT, lane);
        }
    }
    l += __shfl_xor(l, 32);
    const float sk = sinks[hq] * LOG2E;
    const float mf = fmaxf(m, sk);
    const float a = ex2(m - mf);
    const float inv = a / (l * a + ex2(sk - mf));
#pragma unroll
    for (int r = 0; r < 16; ++r) { oT[0][r] *= inv; oT[1][r] *= inv; }
    store_o(AO + (size_t)(b * SEQ + qpos) * DM + hq * 64, oT, hi);
}

__device__ __forceinline__ void evenA_phase(LAS unsigned char* lds, const bf16_t* QKV, const float* relb, const float* sinks, const float* pe_k, const float* pe_v,
                                            const bf16_t* CW1, const bf16_t* CW2, bf16_t* KCMP, bf16_t* VCMP, bf16_t* AO) {
    for (int u = mk_bid(); u < 128 + 1024; u += mk_grid()) {
        if (u < 128) compress_unit(lds, u, QKV, pe_k, pe_v, CW1, CW2, KCMP, VCMP);
        else swa_unit(lds, u - 128, QKV, relb, sinks, AO);
    }
}

constexpr int NSA_TBS = 1028;
constexpr int NSA_OFF_TB = 4 * TILEB, NSA_OFF_IMP = NSA_OFF_TB + 8 * NSA_TBS * 4, NSA_OFF_SEL = NSA_OFF_IMP + 32 * 64 * 4, NSA_OFF_UNI = NSA_OFF_SEL + 32 * 8;

__device__ __forceinline__ void nsa_phase(LAS unsigned char* lds, const bf16_t* QKV, const float* relb, const bf16_t* KCMP, const bf16_t* VCMP, bf16_t* AO) {
    const int tid = mk_ltid(), lane = tid & 63, w = __builtin_amdgcn_readfirstlane(tid >> 6), r32 = lane & 31, hi = lane >> 5;
    LAS unsigned char* KT = lds; LAS unsigned char* VT = lds + 2 * TILEB;
    LAS float* TB = (LAS float*)(lds + NSA_OFF_TB); LAS unsigned* IMP = (LAS unsigned*)(lds + NSA_OFF_IMP);
    LAS unsigned* SEL = (LAS unsigned*)(lds + NSA_OFF_SEL); LAS unsigned* UNI = (LAS unsigned*)(lds + NSA_OFF_UNI);
    const LAS float* tb = TB + w * NSA_TBS;
    int cur_g = -1;
    for (int u = mk_bid(); u < 1024; u += mk_grid()) {
        const int qblk = 127 - (u >> 3), b = (u >> 1) & 3, g = u & 1;
        const int hq = 8 * g + w, q0 = 32 * qblk, qpos = q0 + r32;
        __syncthreads();
        if (g != cur_g) { cur_g = g;
            for (int i = tid; i < 8 * 1025; i += 512) { const int hh = i / 1025, d = i - hh * 1025; TB[hh * NSA_TBS + d] = relb[rel_bucket(d) * 32 + 16 + 8 * g + hh] * LOG2E; } }
        for (int i = tid; i < 32 * 64; i += 512) IMP[i] = 0u;
        if (tid < 2) UNI[tid] = 0u;
        const bf16_t* Qrow = QKV + (size_t)(b * SEQ + qpos) * EVEN_PAD;
        v8s qf[4];
#pragma unroll
        for (int s = 0; s < 4; ++s) qf[s] = *(const v8s*)(Qrow + E_QB + hq * 64 + hi * 8 + s * 16);
        float gt[3];
#pragma unroll
        for (int i = 0; i < 3; ++i) gt[i] = 1.f / (1.f + __expf(-bf2f(Qrow[E_GT + hq * 3 + i])));
        v16f ot[2], oT[2];
#pragma unroll
        for (int r = 0; r < 16; ++r) { ot[0][r] = 0.f; ot[1][r] = 0.f; }
        const int bg = b * 2 + g;
        const bf16_t* Kc = KCMP + (size_t)bg * 256 * 64; const bf16_t* Vc = VCMP + (size_t)bg * 256 * 64;
        const int nct = (2 * qblk) / 64 + 1;
        float m = -INFINITY, l = 0.f;
        {
            const int tid = mk_ltid(), lane = tid & 63, r32 = lane & 31, hi = lane >> 5, qpos = q0 + r32; const LAS float* tb = TB + w * NSA_TBS; (void)lane; (void)hi; (void)tb; (void)qpos; (void)r32;
            v4u kr = ld_tile(Kc, 0, 64, tid);
            for (int t = 0; t < nct; ++t) {
                const int buf = t & 1;
                st_tile(KT + buf * TILEB, kr, tid);
                __syncthreads();
                if (t + 1 < nct) kr = ld_tile(Kc, 64 * (t + 1), 64, tid);
                v16f p0, p1;
                qk_tile(KT + buf * TILEB, qf, p0, p1, r32, hi);
                float mx = -INFINITY;
#pragma unroll
                for (int r = 0; r < 16; ++r) {
                    const int c0 = 64 * t + crow(r, hi); const int d0 = qpos - 16 * c0 - 31, d1 = d0 - 512;
                    const float s0 = p0[r] * C1 + tb[min(max(d0, 0), 1024)], s1 = p1[r] * C1 + tb[min(max(d1, 0), 1024)];
                    p0[r] = d0 >= 0 ? s0 : -INFINITY; p1[r] = d1 >= 0 ? s1 : -INFINITY;
                    mx = fmaxf(mx, fmaxf(p0[r], p1[r]));
                }
                mx = fmaxf(mx, __shfl_xor(mx, 32));
                const float mn = fmaxf(m, mx), mu = (mn == -INFINITY) ? 0.f : mn;
                float rs = 0.f;
#pragma unroll
                for (int r = 0; r < 16; ++r) rs += ex2(p0[r] - mu) + ex2(p1[r] - mu);
                l = l * ex2(m - mu) + rs; m = mn;
            }
        }
        l += __shfl_xor(l, 32);
        {
            const int tid = mk_ltid(), lane = tid & 63, r32 = lane & 31, hi = lane >> 5, qpos = q0 + r32; const LAS float* tb = TB + w * NSA_TBS; (void)lane; (void)hi; (void)tb; (void)qpos; (void)r32;
            const float mu = (m == -INFINITY) ? 0.f : m, il = (l > 0.f) ? 1.f / l : 0.f;
#pragma unroll
            for (int r = 0; r < 16; ++r) { oT[0][r] = 0.f; oT[1][r] = 0.f; }
            __syncthreads();
            v4u kr = ld_tile(Kc, 0, 64, tid), vr = ld_tile(Vc, 0, 64, tid);
            for (int t = 0; t < nct; ++t) {
                const int buf = t & 1;
                st_tile(KT + buf * TILEB, kr, tid); st_tile(VT + buf * TILEB, vr, tid);
                __syncthreads();
                if (t + 1 < nct) { kr = ld_tile(Kc, 64 * (t + 1), 64, tid); vr = ld_tile(Vc, 64 * (t + 1), 64, tid); }
                v16f p0, p1;
                qk_tile(KT + buf * TILEB, qf, p0, p1, r32, hi);
#pragma unroll
                for (int r = 0; r < 16; ++r) {
                    const int c0 = 64 * t + crow(r, hi); const int d0 = qpos - 16 * c0 - 31, d1 = d0 - 512;
                    const float s0 = p0[r] * C1 + tb[min(max(d0, 0), 1024)], s1 = p1[r] * C1 + tb[min(max(d1, 0), 1024)];
                    p0[r] = d0 >= 0 ? ex2(s0 - mu) * il : 0.f; p1[r] = d1 >= 0 ? ex2(s1 - mu) * il : 0.f;
                }
#pragma unroll
                for (int gq = 0; gq < 4; ++gq) {
                    const int sb0 = 16 * t + 2 * gq + hi, sb1 = sb0 + 8;
                    const unsigned a0 = (unsigned)(((p0[4 * gq] + p0[4 * gq + 1]) + (p0[4 * gq + 2] + p0[4 * gq + 3])) * 4194304.f + 0.5f);
                    const unsigned a1 = (unsigned)(((p1[4 * gq] + p1[4 * gq + 1]) + (p1[4 * gq + 2] + p1[4 * gq + 3])) * 4194304.f + 0.5f);
                    const unsigned e0 = (unsigned)(p0[4 * gq + 3] * 4194304.f + 0.5f), e1 = (unsigned)(p1[4 * gq + 3] * 4194304.f + 0.5f);
                    lds_add(IMP + r32 * 64 + sb0, a0); lds_add(IMP + r32 * 64 + sb1, a1);
                    lds_add(IMP + r32 * 64 + sb0 + 1, e0); if (sb1 + 1 < 64) lds_add(IMP + r32 * 64 + sb1 + 1, e1);
                }
                pv_tile(VT + buf * TILEB, p0, p1, oT, lane);
            }
#pragma unroll
            for (int r = 0; r < 16; ++r) { ot[0][r] += gt[0] * oT[0][r]; ot[1][r] += gt[0] * oT[1][r]; }
        }
        __syncthreads();
#pragma unroll 1
        for (int i = 0; i < 4; ++i) {
            const int lane = mk_ltid() & 63;
            const int qi = 4 * w + i, qp = q0 + qi, cur = qp >> 6;
            const unsigned v = IMP[qi * 64 + lane];
            const bool fut = lane > cur, forced = (lane == 0) || (lane == cur) || (lane == cur - 1);
            const unsigned key = ((fut ? 0u : (forced ? 0x3ffffffu : min(v + 1u, 0x3fffffeu))) << 6) | (unsigned)(63 - lane);
            int cnt = 0;
#pragma unroll
            for (int jj = 0; jj < 64; ++jj) { const unsigned kj = (unsigned)__builtin_amdgcn_readlane((int)key, jj); cnt += (kj > key) ? 1 : 0; }
            const unsigned long long msk = __ballot(!fut && cnt < 16);
            if (lane == 0) { SEL[2 * qi] = (unsigned)msk; SEL[2 * qi + 1] = (unsigned)(msk >> 32); lds_or(UNI, (unsigned)msk); lds_or(UNI + 1, (unsigned)(msk >> 32)); }
        }
        __syncthreads();
        unsigned long long uni = ((unsigned long long)__builtin_amdgcn_readfirstlane((int)UNI[1]) << 32) | (unsigned)__builtin_amdgcn_readfirstlane((int)UNI[0]);
        {
            const int tid = mk_ltid(), lane = tid & 63, r32 = lane & 31, hi = lane >> 5, qpos = q0 + r32; const LAS float* tb = TB + w * NSA_TBS; (void)lane; (void)hi; (void)tb; (void)qpos; (void)r32;
            const unsigned mlo = SEL[2 * r32], mhi = SEL[2 * r32 + 1];
            const bf16_t* Kg = QKV + (size_t)(b * SEQ) * EVEN_PAD + E_KS + g * 64; const bf16_t* Vg = QKV + (size_t)(b * SEQ) * EVEN_PAD + E_VS + g * 64;
#pragma unroll
            for (int r = 0; r < 16; ++r) { oT[0][r] = 0.f; oT[1][r] = 0.f; }
            m = -INFINITY; l = 0.f;
            int t = __builtin_ctzll(uni); uni &= uni - 1;
            v4u kr = ld_tile(Kg, 64 * t, EVEN_PAD, tid), vr = ld_tile(Vg, 64 * t, EVEN_PAD, tid);
            int it = 0;
            for (;;) {
                const int buf = it & 1; ++it;
                st_tile(KT + buf * TILEB, kr, tid); st_tile(VT + buf * TILEB, vr, tid);
                __syncthreads();
                const int tn = uni ? __builtin_ctzll(uni) : -1; uni &= uni - 1;
                if (tn >= 0) { kr = ld_tile(Kg, 64 * tn, EVEN_PAD, tid); vr = ld_tile(Vg, 64 * tn, EVEN_PAD, tid); }
                const bool mine = ((t < 32 ? (mlo >> t) : (mhi >> (t - 32))) & 1u) != 0u;
                v16f p0, p1;
                qk_tile(KT + buf * TILEB, qf, p0, p1, r32, hi);
#pragma unroll
                for (int r = 0; r < 16; ++r) {
                    const int d0 = qpos - (64 * t + crow(r, hi)), d1 = d0 - 32;
                    const float s0 = p0[r] * C1 + tb[min(max(d0, 0), 1024)], s1 = p1[r] * C1 + tb[min(max(d1, 0), 1024)];
                    p0[r] = (mine && d0 >= 0) ? s0 : -INFINITY; p1[r] = (mine && d1 >= 0) ? s1 : -INFINITY;
                }
                softmax_step(p0, p1, oT, m, l);
                pv_tile(VT + buf * TILEB, p0, p1, oT, lane);
                if (tn < 0) break;
                t = tn;
            }
            l += __shfl_xor(l, 32);
            const float sc = (l > 0.f) ? gt[1] / l : 0.f;
#pragma unroll
            for (int r = 0; r < 16; ++r) { ot[0][r] += sc * oT[0][r]; ot[1][r] += sc * oT[1][r]; }
        }
        {
            const int tid = mk_ltid(), lane = tid & 63, r32 = lane & 31, hi = lane >> 5, qpos = q0 + r32; const LAS float* tb = TB + w * NSA_TBS; (void)lane; (void)hi; (void)tb; (void)qpos; (void)r32;
            const bf16_t* Kg = QKV + (size_t)(b * SEQ) * EVEN_PAD + E_KW + g * 64; const bf16_t* Vg = QKV + (size_t)(b * SEQ) * EVEN_PAD + E_VW + g * 64;
#pragma unroll
            for (int r = 0; r < 16; ++r) { oT[0][r] = 0.f; oT[1][r] = 0.f; }
            m = -INFINITY; l = 0.f;
            const int t1 = (q0 + 31) >> 6, t0 = (q0 >= 511) ? ((q0 - 511) >> 6) : 0;
            __syncthreads();
            v4u kr = ld_tile(Kg, 64 * t0, EVEN_PAD, tid), vr = ld_tile(Vg, 64 * t0, EVEN_PAD, tid);
            for (int t = t0; t <= t1; ++t) {
                const int buf = t & 1;
                st_tile(KT + buf * TILEB, kr, tid); st_tile(VT + buf * TILEB, vr, tid);
                __syncthreads();
                if (t + 1 <= t1) { kr = ld_tile(Kg, 64 * (t + 1), EVEN_PAD, tid); vr = ld_tile(Vg, 64 * (t + 1), EVEN_PAD, tid); }
                v16f p0, p1;
                qk_tile(KT + buf * TILEB, qf, p0, p1, r32, hi);
#pragma unroll
                for (int r = 0; r < 16; ++r) {
                    const int d0 = qpos - (64 * t + crow(r, hi)), d1 = d0 - 32;
                    const float s0 = p0[r] * C1 + tb[min(max(d0, 0), 1024)], s1 = p1[r] * C1 + tb[min(max(d1, 0), 1024)];
                    p0[r] = (d0 >= 0 && d0 < 512) ? s0 : -INFINITY; p1[r] = (d1 >= 0 && d1 < 512) ? s1 : -INFINITY;
                }
                softmax_step(p0, p1, oT, m, l);
                pv_tile(VT + buf * TILEB, p0, p1, oT, lane);
            }
            l += __shfl_xor(l, 32);
            const float sc = (l > 0.f) ? gt[2] / l : 0.f;
#pragma unroll
            for (int r = 0; r < 16; ++r) { ot[0][r] += sc * oT[0][r]; ot[1][r] += sc * oT[1][r]; }
        }
        { const int tid = mk_ltid(), lane = tid & 63, r32 = lane & 31, hi = lane >> 5, qpos = q0 + r32; const LAS float* tb = TB + w * NSA_TBS; (void)lane; (void)hi; (void)tb; (void)qpos; (void)r32; store_o(AO + (size_t)(b * SEQ + qpos) * DM + 1024 + hq * 64, ot, hi); }
    }
}

__global__ void __launch_bounds__(512, 2) fwd_mega(Args a_unused) {
    extern __shared__ __attribute__((aligned(16))) unsigned char lds_raw[];
    LAS unsigned char* lds = (LAS unsigned char*)lds_raw;
    cg::grid_group grid = cg::this_grid();
#define WSP(off) (arg_ws() + (off))
    prologue_phase(lds);
    norm_phase(arg_in(0), arg_in(2), (bf16_t*)WSP(WS_XN), nullptr);
    grid.sync();
#pragma unroll 1
    for (int L = 0; L < 4; ++L) {
        const int e = L >> 1;
        if ((L & 1) == 0) {
            { pg8::Gemm gm{(const bf16_t*)WSP(WS_XN), (const bf16_t*)WSP(WS_WIE) + (size_t)e * EVEN_PAD * DM, MTOK, EVEN_PAD, DM}; pg8::StaticOrder S; S.init(MTOK, EVEN_PAD, mk_grid(), mk_bid());
              pg8::EpiBf16<0> E{(bf16_t*)WSP(WS_QKV), EVEN_PAD}; pg8::gemm_phase<pg8::EpiBf16<0>, pg8::StaticOrder, true, true>(lds, gm, S, E); }
            grid.sync();
            evenA_phase(lds, (const bf16_t*)WSP(WS_QKV), arg_in(1), arg_in(7) + e * 16, arg_in(8) + e * 2048, arg_in(9) + e * 2048,
                        (const bf16_t*)WSP(WS_CW1) + (size_t)e * 2 * 256 * 2048, (const bf16_t*)WSP(WS_CW2) + (size_t)e * 2 * 64 * 256, (bf16_t*)WSP(WS_KCMP), (bf16_t*)WSP(WS_VCMP), (bf16_t*)WSP(WS_AO));
            grid.sync();
            nsa_phase(lds, (const bf16_t*)WSP(WS_QKV), arg_in(1), (const bf16_t*)WSP(WS_KCMP), (const bf16_t*)WSP(WS_VCMP), (bf16_t*)WSP(WS_AO));
            grid.sync();
            { pg8::Gemm gm{(const bf16_t*)WSP(WS_AO), (const bf16_t*)WSP(WS_WOE) + (size_t)e * DM * DM, MTOK, DM, DM}; pg8::StaticOrder S; S.init(MTOK, DM, mk_grid(), mk_bid());
              pg8::EpiRes E{(L == 0) ? arg_in(0) : (const float*)arg_out(), arg_out(), DM}; pg8::gemm_phase<pg8::EpiRes, pg8::StaticOrder, true, true>(lds, gm, S, E); }
        } else {
            { pg8::Gemm gm{(const bf16_t*)WSP(WS_XN), (const bf16_t*)WSP(WS_WIO) + (size_t)e * ODD_PAD * DM, MTOK, ODD_PAD, DM}; pg8::StaticOrder S; S.init(MTOK, ODD_PAD, mk_grid(), mk_bid());
              pg8::EpiBf16<0> E{(bf16_t*)WSP(WS_QKV), ODD_PAD}; pg8::gemm_phase<pg8::EpiBf16<0>, pg8::StaticOrder, true, true>(lds, gm, S, E); }
            grid.sync();
            cumsum_phase(lds, (const bf16_t*)WSP(WS_QKV), arg_in(16) + e * 32, (float*)WSP(WS_C));
            grid.sync();
            fox_phase(lds, (const bf16_t*)WSP(WS_QKV), (const float*)WSP(WS_C), (bf16_t*)WSP(WS_AO));
            grid.sync();
            { pg8::Gemm gm{(const bf16_t*)WSP(WS_AO), (const bf16_t*)WSP(WS_WOO) + (size_t)e * DM * DM, MTOK, DM, DM}; pg8::StaticOrder S; S.init(MTOK, DM, mk_grid(), mk_bid());
              pg8::EpiRes E{(const float*)arg_out(), arg_out(), DM}; pg8::gemm_phase<pg8::EpiRes, pg8::StaticOrder, true, true>(lds, gm, S, E); }
        }
        grid.sync();
        norm_phase(arg_out(), arg_in(3) + L * DM, (bf16_t*)WSP(WS_XN), nullptr);
        grid.sync();
        { pg8::Gemm gm{(const bf16_t*)WSP(WS_XN), (const bf16_t*)WSP(WS_WUP) + (size_t)L * DFF * DM, MTOK, DFF, DM}; pg8::StaticOrder S; S.init(MTOK, DFF, mk_grid(), mk_bid());
          pg8::EpiBf16<2> E{(bf16_t*)WSP(WS_H), DFF}; pg8::gemm_phase<pg8::EpiBf16<2>, pg8::StaticOrder, true, true>(lds, gm, S, E); }
        grid.sync();
        { pg8::Gemm gm{(const bf16_t*)WSP(WS_H), (const bf16_t*)WSP(WS_WDN) + (size_t)L * DM * DFF, MTOK, DM, DFF}; pg8::StaticOrder S; S.init(MTOK, DM, mk_grid(), mk_bid());
          pg8::EpiRes E{(const float*)arg_out(), arg_out(), DM}; pg8::gemm_phase<pg8::EpiRes, pg8::StaticOrder, true, true>(lds, gm, S, E); }
        grid.sync();
        if (L < 3) { norm_phase(arg_out(), arg_in(2) + (L + 1) * DM, (bf16_t*)WSP(WS_XN), nullptr); grid.sync(); }
        else norm_phase(arg_out(), arg_in(4), nullptr, arg_out());
    }
#undef WSP
}

extern "C" void kernel_launch(void* const* d_in, const int* in_sizes, int n_in, void* d_out, int out_size, void* d_ws, size_t ws_size, hipStream_t stream) {
    static int grid = 0;
    if (grid == 0) {
        if (n_in != 19 || out_size != MTOK * DM || ws_size < WS_END) { fprintf(stderr, "kernel_launch: unexpected shapes (n_in %d out %d ws %zu)\n", n_in, out_size, ws_size); grid = -1; return; }
        int dev = 0, cus = 0, per_cu = 0;
        (void)hipGetDevice(&dev);
        (void)hipDeviceGetAttribute(&cus, hipDeviceAttributeMultiprocessorCount, dev);
        (void)hipFuncSetAttribute((const void*)fwd_mega, hipFuncAttributeMaxDynamicSharedMemorySize, LDS_BYTES);
        (void)hipOccupancyMaxActiveBlocksPerMultiprocessor(&per_cu, (const void*)fwd_mega, 512, LDS_BYTES);
        if (per_cu < 1) per_cu = 1;
        grid = cus * per_cu;
        fprintf(stderr, "kernel_launch: grid %d (cus %d x %d)\n", grid, cus, per_cu);
    }
    if (grid < 0) return;
    Args a{};
    for (int i = 0; i < 19; ++i) a.in[i] = (const float*)d_in[i];
    a.out = (float*)d_out; a.ws = (unsigned char*)d_ws;
    void* args[] = {&a};
    hipError_t e = hipLaunchCooperativeKernel((void*)fwd_mega, dim3(grid), dim3(512), args, LDS_BYTES, stream);
    if (e != hipSuccess) fprintf(stderr, "cooperative launch failed: %s (grid %d)\n", hipGetErrorString(e), grid);
}
```

```cpp
#include <hip/hip_runtime.h>
#include <hip/hip_cooperative_groups.h>
#include <cstdio>
#include <cstdint>
#include <cmath>
namespace cg = cooperative_groups;
__device__ __forceinline__ int mk_ltid() { int t = threadIdx.x; asm volatile("" : "+v"(t)); return t; }
__device__ __forceinline__ int mk_bid() { int t = blockIdx.x; asm volatile("" : "+s"(t)); return t; }
__device__ __forceinline__ int mk_grid() { int t = gridDim.x; asm volatile("" : "+s"(t)); return t; }
namespace pg8 {
#define PG8_LAS __attribute__((address_space(3)))
typedef unsigned short bf16_t;
typedef short bf16x8 __attribute__((ext_vector_type(8)));
typedef float f32x4 __attribute__((ext_vector_type(4)));
typedef unsigned u32x4 __attribute__((ext_vector_type(4)));
constexpr int BM = 256, BK = 64, HALF = 128, HTB = HALF * BK * 2  , STAGE_BYTES = 8 * HTB, NXCD = 8, WGM = 8;

__host__ __device__ __forceinline__ int lds_byte(int r, int c) { const int st = (r >> 4) * 2 + (c >> 5), rr = r & 15, cc = c & 31, ob = rr * 64 + cc * 2; return st * 1024 + (ob ^ (((ob >> 9) & 1) << 5)); }
__host__ __device__ __forceinline__ void stage_rc(int b, int& R, int& C) { const int st = b / 1024, sb = b % 1024, swz = sb ^ (((sb >> 9) & 1) << 5); R = (st >> 1) * 16 + swz / 64; C = (st & 1) * 32 + (swz % 64) / 2; }
__host__ __device__ __forceinline__ int perm32(int rho) { const int n = rho >> 4, i = rho & 15; return 8 * (i >> 2) + 4 * n + (i & 3); }

struct Unit { int pm, pn; };
struct Gemm { const bf16_t* A; const bf16_t* Bt; int M, N, K; };

struct StaticOrder {
    int nM, nN, nwg, G, c;
    __host__ __device__ void init(int M, int N, int G_, int c_) { nM = M / BM; nN = N / BM; nwg = nM * nN; G = G_; c = c_; }
    __host__ __device__ bool next(int i, Unit& u) const {
        const long L = (long)i * G + c; if (L >= nwg) return false;
        int wgid = (int)L; { const int q = nwg / NXCD, r = nwg % NXCD, xcd = wgid % NXCD, off = wgid / NXCD; wgid = (xcd < r ? xcd * (q + 1) : r * (q + 1) + (xcd - r) * q) + off; }
        const int nig = WGM * nN, gid = wgid / nig, fm = gid * WGM, gsz = (nM - fm) < WGM ? (nM - fm) : WGM;
        u.pm = fm + ((wgid % nig) % gsz); u.pn = (wgid % nig) / gsz; return true;
    }
    __device__ __forceinline__ void a_ready(const Unit&) const {}
    __device__ __forceinline__ void done(const Unit&) const {}
};

__device__ __forceinline__ unsigned cvt_pk_bf16(float lo, float hi) { unsigned r; asm volatile("v_cvt_pk_bf16_f32 %0, %1, %2" : "=v"(r) : "v"(lo), "v"(hi)); return r; }
typedef float f32x2 __attribute__((ext_vector_type(2)));
template <int ACT  > struct EpiBf16 {
    static constexpr bool PERM = true, AFTER_DRAIN = false;
    bf16_t* O; int ldc;
    __device__ __forceinline__ void operator()(const f32x4 (&acc)[2][2][4][2], const Unit& u, int wr, int wc, int fr, int fq) const {
        const int row0 = u.pm * BM + wr * 64 + fr; const int col0 = u.pn * BM + wc * 32 + 8 * fq;
#pragma unroll
        for (int ai = 0; ai < 2; ++ai)
#pragma unroll
            for (int m = 0; m < 4; ++m) { bf16_t* rowp = O + (size_t)(row0 + ai * HALF + m * 16) * ldc + col0;
#pragma unroll
                for (int bj = 0; bj < 2; ++bj) { f32x4 v0 = acc[ai][bj][m][0], v1 = acc[ai][bj][m][1];
                    if (ACT == 2) {
#pragma unroll
                        for (int e = 0; e < 4; ++e) { float a = v0[e] > 0.f ? v0[e] : 0.f; v0[e] = a * a; float b = v1[e] > 0.f ? v1[e] : 0.f; v1[e] = b * b; } }
                    u32x4 w; w.x = cvt_pk_bf16(v0[0], v0[1]); w.y = cvt_pk_bf16(v0[2], v0[3]); w.z = cvt_pk_bf16(v1[0], v1[1]); w.w = cvt_pk_bf16(v1[2], v1[3]);
                    *(u32x4*)(rowp + bj * HALF) = w; } }
    }
};
struct EpiRes {
    static constexpr bool PERM = false, AFTER_DRAIN = false;
    const float* base; float* out; int ldc;
    __device__ __forceinline__ void operator()(const f32x4 (&acc)[2][2][4][2], const Unit& u, int wr, int wc, int fr, int fq) const {
        const int row0 = u.pm * BM + wr * 64 + fr; const int col0 = u.pn * BM + wc * 32 + 4 * fq;
#pragma unroll
        for (int ai = 0; ai < 2; ++ai)
#pragma unroll
            for (int m = 0; m < 4; ++m) { const size_t off = (size_t)(row0 + ai * HALF + m * 16) * ldc + col0;
#pragma unroll
                for (int bj = 0; bj < 2; ++bj)
#pragma unroll
                    for (int n = 0; n < 2; ++n) { const f32x4 b = *(const f32x4*)(base + off + bj * HALF + n * 16); *(f32x4*)(out + off + bj * HALF + n * 16) = b + acc[ai][bj][m][n]; } }
    }
};
template <class Epi, class Sched, bool ALIGN_EPI = false, bool SP2 = false>
__device__ __forceinline__ void gemm_phase(PG8_LAS unsigned char* lds, const Gemm g, const Sched& S, const Epi& E) {
    const int tid = mk_ltid(), wid = __builtin_amdgcn_readfirstlane(tid >> 6), lane = tid & 63, wr = wid >> 2, wc = wid & 3, fr = lane & 15, fq = lane >> 4;
    const int K = g.K, nt = K / BK;
    unsigned voffA[2], voffB[2];
#pragma unroll
    for (int i = 0; i < 2; ++i) { int R, C; stage_rc(tid * 16 + i * 8192, R, C); const int Rb = Epi::PERM ? ((R & ~31) + perm32(R & 31)) : R;
        voffA[i] = (unsigned)(R * K + C) * 2u; voffB[i] = (unsigned)(Rb * K + C) * 2u; }
    const size_t kstep = (size_t)(BK * 2);
    const size_t hstep = (size_t)HALF * K * 2;
    const size_t tstep = 2 * hstep;
    const unsigned ldsw = (unsigned)wid * 1024u;
    const int aoff = lds_byte(wr * 64 + fr, fq * 8), boff = lds_byte(wc * 32 + fr, fq * 8);
#define PG8_SA(b, h) (((b) * 2 + (h)) * HTB)
#define PG8_SB(b, h) ((4 + (b) * 2 + (h)) * HTB)
#define PG8_STAGE(bufoff, gbase, voff) do { _Pragma("unroll") for (int _i = 0; _i < 2; ++_i) \
        __builtin_amdgcn_global_load_lds((const unsigned*)((const char*)(gbase) + (voff)[_i]), (PG8_LAS unsigned*)(lds + (bufoff) + ldsw + _i * 8192), 16, 0, 0); } while (0)
#define PG8_LDA(dst, b, h) do { _Pragma("unroll") for (int m = 0; m < 4; ++m) _Pragma("unroll") for (int k = 0; k < 2; ++k) dst[m][k] = *(const PG8_LAS bf16x8*)(lds + PG8_SA(b, h) + aoff + m * 2048 + k * 1024); } while (0)
#define PG8_LDB(dst, b, h) do { _Pragma("unroll") for (int n = 0; n < 2; ++n) _Pragma("unroll") for (int k = 0; k < 2; ++k) dst[n][k] = *(const PG8_LAS bf16x8*)(lds + PG8_SB(b, h) + boff + n * 2048 + k * 1024); } while (0)
#define PG8_MMA(ai, bj, At, Bt) do { __builtin_amdgcn_s_setprio(1); _Pragma("unroll") for (int m = 0; m < 4; ++m) _Pragma("unroll") for (int n = 0; n < 2; ++n) _Pragma("unroll") for (int k = 0; k < 2; ++k) \
        acc[ai][bj][m][n] = __builtin_amdgcn_mfma_f32_16x16x32_bf16(Bt[n][k], At[m][k], acc[ai][bj][m][n], 0, 0, 0); __builtin_amdgcn_s_setprio(0); } while (0)
#define PG8_WAIT_V(n) asm volatile("s_waitcnt vmcnt(" #n ")" ::: "memory")
#define PG8_WAIT_L(n) asm volatile("s_waitcnt lgkmcnt(" #n ")" ::: "memory")
#define PG8_BAR __builtin_amdgcn_s_barrier()
#define PG8_SCHED __builtin_amdgcn_sched_barrier(0)
    Unit cur, nxt; int ui = 0;
    if (!S.next(0, cur)) return;
    f32x4 acc[2][2][4][2];
#pragma unroll
    for (int a = 0; a < 2; ++a)
#pragma unroll
        for (int b = 0; b < 2; ++b)
#pragma unroll
            for (int m = 0; m < 4; ++m)
#pragma unroll
                for (int n = 0; n < 2; ++n) acc[a][b][m][n] = (f32x4){0.f, 0.f, 0.f, 0.f};
    bf16x8 At[4][2], B0[2][2], B1[2][2];
    const char* cA = (const char*)g.A + (size_t)cur.pm * tstep; const char* cB = (const char*)g.Bt + (size_t)cur.pn * tstep;
    S.a_ready(cur);
    if constexpr (SP2) {
        PG8_STAGE(PG8_SB(0, 0), cB, voffB); PG8_STAGE(PG8_SB(0, 1), cB + hstep, voffB); PG8_STAGE(PG8_SA(0, 0), cA, voffA); PG8_STAGE(PG8_SA(0, 1), cA + hstep, voffA);
        if (wr == 1) PG8_BAR;
        PG8_WAIT_V(2); PG8_BAR;
        PG8_STAGE(PG8_SB(1, 0), cB + kstep, voffB); PG8_STAGE(PG8_SA(1, 0), cA + kstep, voffA); PG8_STAGE(PG8_SB(1, 1), cB + hstep + kstep, voffB);
        PG8_WAIT_V(6); PG8_BAR;
    } else {
        PG8_STAGE(PG8_SB(0, 0), cB, voffB); PG8_STAGE(PG8_SA(0, 0), cA, voffA); PG8_STAGE(PG8_SB(0, 1), cB + hstep, voffB); PG8_STAGE(PG8_SA(0, 1), cA + hstep, voffA);
        if (wr == 1) PG8_BAR;
        PG8_WAIT_V(4); PG8_BAR;
        PG8_STAGE(PG8_SB(1, 0), cB + kstep, voffB); PG8_STAGE(PG8_SA(1, 0), cA + kstep, voffA); PG8_STAGE(PG8_SB(1, 1), cB + hstep + kstep, voffB);
        PG8_WAIT_V(6); PG8_BAR;
    }
    for (;;) {
        const bool has_next = S.next(ui + 1, nxt);
        const char* nA = has_next ? (const char*)g.A + (size_t)nxt.pm * tstep : cA; const char* nB = has_next ? (const char*)g.Bt + (size_t)nxt.pn * tstep : cB;
        for (int t = 0; t < nt; t += 2) {
            const bool last = (t == nt - 2);
            const char* a1 = cA + (size_t)(t + 1) * kstep;
            const char* a2 = last ? nA : cA + (size_t)(t + 2) * kstep; const char* b2 = last ? nB : cB + (size_t)(t + 2) * kstep;
            const char* a3 = a2 + kstep; const char* b3 = b2 + kstep;
            if (last && has_next) S.a_ready(nxt);
            if constexpr (SP2) {
            PG8_LDB(B0, 0, 0); PG8_LDB(B1, 0, 1); PG8_SCHED; PG8_LDA(At, 0, 0); PG8_STAGE(PG8_SA(1, 1), a1 + hstep, voffA);
            PG8_WAIT_V(8); PG8_WAIT_L(0); PG8_BAR; PG8_MMA(0, 0, At, B0); PG8_MMA(0, 1, At, B1); PG8_BAR; PG8_SCHED;
            PG8_LDA(At, 0, 1); PG8_STAGE(PG8_SB(0, 0), b2, voffB); PG8_STAGE(PG8_SB(0, 1), b2 + hstep, voffB); PG8_STAGE(PG8_SA(0, 0), a2, voffA);
            PG8_WAIT_V(8); PG8_WAIT_L(0); PG8_BAR; PG8_MMA(1, 0, At, B0); PG8_MMA(1, 1, At, B1); PG8_BAR; PG8_SCHED;
            PG8_LDB(B0, 1, 0); PG8_LDB(B1, 1, 1); PG8_SCHED; PG8_LDA(At, 1, 0); PG8_STAGE(PG8_SA(0, 1), a2 + hstep, voffA);
            PG8_WAIT_V(8); PG8_WAIT_L(0); PG8_BAR; PG8_MMA(0, 0, At, B0); PG8_MMA(0, 1, At, B1); PG8_BAR; PG8_SCHED;
            PG8_LDA(At, 1, 1); PG8_STAGE(PG8_SB(1, 0), b3, voffB); PG8_STAGE(PG8_SB(1, 1), b3 + hstep, voffB); PG8_STAGE(PG8_SA(1, 0), a3, voffA);
            PG8_WAIT_V(8); PG8_WAIT_L(0); PG8_BAR; PG8_MMA(1, 0, At, B0); PG8_MMA(1, 1, At, B1); PG8_BAR; PG8_SCHED;
            } else {
            PG8_LDB(B0, 0, 0); PG8_SCHED; PG8_LDA(At, 0, 0); PG8_STAGE(PG8_SA(1, 1), a1 + hstep, voffA);
            PG8_WAIT_L(8); PG8_BAR; PG8_WAIT_L(0); PG8_MMA(0, 0, At, B0); PG8_BAR; PG8_SCHED;
            PG8_LDB(B1, 0, 1); PG8_STAGE(PG8_SB(0, 0), b2, voffB);
            PG8_BAR; PG8_WAIT_L(0); PG8_MMA(0, 1, At, B1); PG8_BAR;
            PG8_LDA(At, 0, 1); PG8_STAGE(PG8_SA(0, 0), a2, voffA);
            PG8_BAR; PG8_WAIT_L(0); PG8_MMA(1, 0, At, B0); PG8_BAR; PG8_SCHED;
            PG8_STAGE(PG8_SB(0, 1), b2 + hstep, voffB);
            PG8_WAIT_V(6); PG8_BAR; PG8_MMA(1, 1, At, B1); PG8_BAR;
            PG8_LDB(B0, 1, 0); PG8_SCHED; PG8_LDA(At, 1, 0); PG8_STAGE(PG8_SA(0, 1), a2 + hstep, voffA);
            PG8_WAIT_L(8); PG8_BAR; PG8_WAIT_L(0); PG8_MMA(0, 0, At, B0); PG8_BAR; PG8_SCHED;
            PG8_LDB(B1, 1, 1); PG8_STAGE(PG8_SB(1, 0), b3, voffB);
            PG8_BAR; PG8_WAIT_L(0); PG8_MMA(0, 1, At, B1); PG8_BAR;
            PG8_LDA(At, 1, 1); PG8_STAGE(PG8_SA(1, 0), a3, voffA);
            PG8_BAR; PG8_WAIT_L(0); PG8_MMA(1, 0, At, B0); PG8_BAR; PG8_SCHED;
            PG8_STAGE(PG8_SB(1, 1), b3 + hstep, voffB);
            PG8_WAIT_V(6); PG8_BAR; PG8_MMA(1, 1, At, B1); PG8_BAR;
            }
        }
        if constexpr (ALIGN_EPI) { if (wr == 0) PG8_BAR; }
        if constexpr (!Epi::AFTER_DRAIN) { E(acc, cur, wr, wc, fr, fq); S.done(cur); }
        if (!has_next) break;
#pragma unroll
        for (int a = 0; a < 2; ++a)
#pragma unroll
            for (int b = 0; b < 2; ++b)
#pragma unroll
                for (int m = 0; m < 4; ++m)
#pragma unroll
                    for (int n = 0; n < 2; ++n) acc[a][b][m][n] = (f32x4){0.f, 0.f, 0.f, 0.f};
        cur = nxt; cA = nA; cB = nB; ++ui;
        if constexpr (ALIGN_EPI) { if (wr == 1) PG8_BAR; }
    }
    PG8_WAIT_V(0);
    if constexpr (!ALIGN_EPI) { if (wr == 0) PG8_BAR; }
    PG8_BAR;
    if constexpr (Epi::AFTER_DRAIN) { E.fused(acc, cur, wr, wc, fr, fq, lds, wid, lane); S.done(cur); }
#undef PG8_SA
#undef PG8_SB
#undef PG8_STAGE
#undef PG8_LDA
#undef PG8_LDB
#undef PG8_MMA
#undef PG8_WAIT_V
#undef PG8_WAIT_L
#undef PG8_BAR
#undef PG8_SCHED
}
}

#define LAS __attribute__((address_space(3)))
typedef unsigned short bf16_t;
typedef short v8s __attribute__((ext_vector_type(8)));
typedef short v4s __attribute__((ext_vector_type(4)));
typedef float v4f __attribute__((ext_vector_type(4)));
typedef float v16f __attribute__((ext_vector_type(16)));
typedef unsigned v4u __attribute__((ext_vector_type(4)));
typedef unsigned v2u __attribute__((ext_vector_type(2)));

constexpr int DM = 2048, NB = 4, SEQ = 4096, MTOK = NB * SEQ, DFF = 8192;
constexpr int EVEN_IN = 3376, EVEN_PAD = 3584, ODD_IN = 6176, ODD_PAD = 6400;
constexpr int E_QA = 0, E_KA = 1024, E_VA = 1280, E_QB = 1536, E_KC = 2560, E_VC = 2688, E_KS = 2816, E_VS = 2944, E_KW = 3072, E_VW = 3200, E_GT = 3328;
constexpr int O_Q = 0, O_K = 2048, O_V = 4096, O_F = 6144;
constexpr float LOG2E = 1.4426950408889634f;
constexpr float C1 = 0.125f * LOG2E;
constexpr float RMS_EPS = 1e-6f;

constexpr size_t MiB = 1u << 20;
constexpr size_t WS_WUP = 16 * MiB, WS_WDN = 144 * MiB, WS_WIE = 272 * MiB, WS_WIO = 300 * MiB, WS_WOE = 350 * MiB, WS_WOO = 366 * MiB;
constexpr size_t WS_CW1 = 382 * MiB, WS_CW2 = 386 * MiB, WS_KCMP = 387 * MiB, WS_VCMP = 387 * MiB + 512 * 1024, WS_C = 388 * MiB;
constexpr size_t WS_XN = 392 * MiB, WS_QKV = 456 * MiB, WS_AO = 656 * MiB, WS_H = 456 * MiB, WS_END = 720 * MiB;

constexpr int KP = 144, VP = 144, TILEB = 64 * 144;
constexpr int LDS_BYTES = 160 * 1024;

struct Args { const float* in[19]; float* out; unsigned char* ws; };
__device__ __forceinline__ const unsigned char __attribute__((address_space(4)))* karg_base() {
    const unsigned char __attribute__((address_space(4)))* kp = (const unsigned char __attribute__((address_space(4)))*)__builtin_amdgcn_kernarg_segment_ptr();
    asm volatile("" : "+s"(kp)); return kp; }
__device__ __forceinline__ const float* arg_in(int i) { return *(const float* const __attribute__((address_space(4)))*)(karg_base() + 8 * i); }
__device__ __forceinline__ float* arg_out() { return *(float* const __attribute__((address_space(4)))*)(karg_base() + 8 * 19); }
__device__ __forceinline__ unsigned char* arg_ws() { return *(unsigned char* const __attribute__((address_space(4)))*)(karg_base() + 8 * 20); }

__device__ __forceinline__ unsigned pkbf(float lo, float hi) {
    typedef float f2 __attribute__((ext_vector_type(2))); typedef __bf16 b2 __attribute__((ext_vector_type(2)));
    f2 v = {lo, hi}; b2 b = __builtin_convertvector(v, b2); return __builtin_bit_cast(unsigned, b);
}
__device__ __forceinline__ float bf2f(unsigned short u) { return __uint_as_float(((unsigned)u) << 16); }
__device__ __forceinline__ float ex2(float x) { return __builtin_amdgcn_exp2f(x); }
__device__ __forceinline__ void lds_add(LAS unsigned* p, unsigned v) { (void)__hip_atomic_fetch_add(p, v, __ATOMIC_RELAXED, __HIP_MEMORY_SCOPE_WORKGROUP); }
__device__ __forceinline__ void lds_or(LAS unsigned* p, unsigned v) { (void)__hip_atomic_fetch_or(p, v, __ATOMIC_RELAXED, __HIP_MEMORY_SCOPE_WORKGROUP); }
__device__ __forceinline__ int crow(int r, int hi) { return (r & 3) + 8 * (r >> 2) + 4 * hi; }
__device__ __forceinline__ v16f mfma32(v8s a, v8s b, v16f c) { return __builtin_amdgcn_mfma_f32_32x32x16_bf16(a, b, c, 0, 0, 0); }
__device__ __forceinline__ float wave_sum(float v) {
#pragma unroll
    for (int o = 1; o < 64; o <<= 1) v += __shfl_xor(v, o);
    return v;
}

__device__ __forceinline__ void tr_load(float (&v)[32], const float* W, int K, int N, int item, int lane) {
    const int nblk = (N + 31) / 32, kb = item / nblk, nb = item - kb * nblk, k0 = 64 * kb, n0 = 32 * nb;
    const int nn = n0 + (lane & 31); const bool ok = nn < N;
    const float* p = W + (size_t)(k0 + (lane >> 5)) * N + (ok ? nn : 0);
#pragma unroll
    for (int i = 0; i < 32; ++i) { const float x = p[(size_t)(2 * i) * N]; v[i] = ok ? x : 0.f; }
}
__device__ __forceinline__ void tr_put(const float (&v)[32], LAS float* scr, int lane) {
#pragma unroll
    for (int i = 0; i < 32; ++i) scr[(2 * i + (lane >> 5)) * 33 + (lane & 31)] = v[i];
}
__device__ __forceinline__ void tr_store(bf16_t* WT, int K, int N, LAS float* scr, int item, int lane) {
    const int nblk = (N + 31) / 32, kb = item / nblk, nb = item - kb * nblk, k0 = 64 * kb, n0 = 32 * nb;
    const int c = lane & 7;
#pragma unroll
    for (int j = 0; j < 4; ++j) { const int n = (lane >> 3) + 8 * j; const LAS float* s = scr + (8 * c) * 33 + n;
        v4u o; o.x = pkbf(s[0 * 33], s[1 * 33]); o.y = pkbf(s[2 * 33], s[3 * 33]); o.z = pkbf(s[4 * 33], s[5 * 33]); o.w = pkbf(s[6 * 33], s[7 * 33]);
        *(v4u*)(WT + (size_t)(n0 + n) * K + k0 + 8 * c) = o; }
}

__device__ __forceinline__ void prologue_phase(LAS unsigned char* lds) {
    const int tid = mk_ltid(), lane = tid & 63, wave = __builtin_amdgcn_readfirstlane(tid >> 6);
    LAS float* scr = (LAS float*)(lds + wave * 16384);
    const int gw = mk_bid() * 8 + wave, NGW = mk_grid() * 8;
    for (int mi = 0; mi < 24; ++mi) {
        unsigned char* ws = arg_ws();
        const float* W; int K, N; bf16_t* WT;
        if (mi < 4) { W = arg_in(17) + (size_t)mi * DM * DFF; K = DM; N = DFF; WT = (bf16_t*)(ws + WS_WUP) + (size_t)mi * DFF * DM; }
        else if (mi < 8) { const int L = mi - 4; W = arg_in(18) + (size_t)L * DFF * DM; K = DFF; N = DM; WT = (bf16_t*)(ws + WS_WDN) + (size_t)L * DM * DFF; }
        else if (mi < 10) { const int e = mi - 8; W = arg_in(5) + (size_t)e * DM * EVEN_IN; K = DM; N = EVEN_IN; WT = (bf16_t*)(ws + WS_WIE) + (size_t)e * EVEN_PAD * DM; }
        else if (mi < 12) { const int e = mi - 10; W = arg_in(14) + (size_t)e * DM * ODD_IN; K = DM; N = ODD_IN; WT = (bf16_t*)(ws + WS_WIO) + (size_t)e * ODD_PAD * DM; }
        else if (mi < 14) { const int e = mi - 12; W = arg_in(6) + (size_t)e * DM * DM; K = DM; N = DM; WT = (bf16_t*)(ws + WS_WOE) + (size_t)e * DM * DM; }
        else if (mi < 16) { const int e = mi - 14; W = arg_in(15) + (size_t)e * DM * DM; K = DM; N = DM; WT = (bf16_t*)(ws + WS_WOO) + (size_t)e * DM * DM; }
        else if (mi < 20) { const int e = (mi - 16) & 1, kv = (mi - 16) >> 1; W = arg_in(kv ? 12 : 10) + (size_t)e * 2048 * 256; K = 2048; N = 256; WT = (bf16_t*)(ws + WS_CW1) + (size_t)(e * 2 + kv) * 256 * 2048; }
        else { const int e = (mi - 20) & 1, kv = (mi - 20) >> 1; W = arg_in(kv ? 13 : 11) + (size_t)e * 256 * 64; K = 256; N = 64; WT = (bf16_t*)(ws + WS_CW2) + (size_t)(e * 2 + kv) * 64 * 256; }
        const int nitems = (K / 64) * ((N + 31) / 32);
        float v[32];
        int it = gw;
        if (it < nitems) tr_load(v, W, K, N, it, lane);
        while (it < nitems) {
            tr_put(v, scr, lane);
            const int nx = it + NGW;
            if (nx < nitems) tr_load(v, W, K, N, nx, lane);
            asm volatile("s_waitcnt lgkmcnt(0)" ::: "memory");
            tr_store(WT, K, N, scr, it, lane);
            asm volatile("s_waitcnt lgkmcnt(0)" ::: "memory");
            it = nx;
        }
    }
}

__device__ __forceinline__ void norm_phase(const float* X, const float* g, bf16_t* XN, float* OUTF) {
    const int tid = mk_ltid(), lane = tid & 63, wave = tid >> 6;
    const int gw = mk_bid() * 8 + wave, NGW = mk_grid() * 8;
    v4f gv[8];
#pragma unroll
    for (int j = 0; j < 8; ++j) gv[j] = *((const v4f*)g + lane + 64 * j);
    for (int m = gw; m < MTOK; m += NGW) {
        const v4f* xr = (const v4f*)(X + (size_t)m * DM) + lane;
        v4f v[8]; float s = 0.f;
#pragma unroll
        for (int j = 0; j < 8; ++j) { v[j] = xr[64 * j]; s += (v[j].x * v[j].x + v[j].y * v[j].y) + (v[j].z * v[j].z + v[j].w * v[j].w); }
        const float r = 1.0f / sqrtf(wave_sum(s) * (1.f / DM) + RMS_EPS);
        if (OUTF) {
            v4f* o = (v4f*)(OUTF + (size_t)m * DM) + lane;
#pragma unroll
            for (int j = 0; j < 8; ++j) o[64 * j] = v[j] * r * gv[j];
        } else {
            v2u* o = (v2u*)(XN + (size_t)m * DM) + lane;
#pragma unroll
            for (int j = 0; j < 8; ++j) { const v4f y = v[j] * r * gv[j]; v2u w; w.x = pkbf(y.x, y.y); w.y = pkbf(y.z, y.w); o[64 * j] = w; }
        }
    }
}

__device__ __forceinline__ void qk_tile(const LAS unsigned char* Kt, const v8s (&qf)[4], v16f& p0, v16f& p1, int r32, int hi) {
    const LAS unsigned char* kb = Kt + r32 * KP + hi * 16;
    v16f z;
#pragma unroll
    for (int r = 0; r < 16; ++r) z[r] = 0.f;
    p0 = z; p1 = z;
#pragma unroll
    for (int s = 0; s < 4; ++s) {
        const v8s a0 = *(const LAS v8s*)(kb + s * 32);
        const v8s a1 = *(const LAS v8s*)(kb + 32 * KP + s * 32);
        p0 = mfma32(a0, qf[s], p0); p1 = mfma32(a1, qf[s], p1);
    }
}
__device__ __forceinline__ v4s trrd(const LAS unsigned char* p) { return __builtin_bit_cast(v4s, __builtin_amdgcn_ds_read_tr16_b64_v4i16((LAS v4s*)p)); }
__device__ __forceinline__ void pv_tile(const LAS unsigned char* Vt, const v16f& p0, const v16f& p1, v16f (&oT)[2], int lane) {
    const int hi = lane >> 5;
    v4u w[4];
    w[0] = (v4u){pkbf(p0[0], p0[1]), pkbf(p0[2], p0[3]), pkbf(p0[4], p0[5]), pkbf(p0[6], p0[7])};
    w[1] = (v4u){pkbf(p0[8], p0[9]), pkbf(p0[10], p0[11]), pkbf(p0[12], p0[13]), pkbf(p0[14], p0[15])};
    w[2] = (v4u){pkbf(p1[0], p1[1]), pkbf(p1[2], p1[3]), pkbf(p1[4], p1[5]), pkbf(p1[6], p1[7])};
    w[3] = (v4u){pkbf(p1[8], p1[9]), pkbf(p1[10], p1[11]), pkbf(p1[12], p1[13]), pkbf(p1[14], p1[15])};
    const LAS unsigned char* vb = Vt + (4 * hi + ((lane & 15) >> 2)) * VP + (16 * ((lane >> 4) & 1) + 4 * (lane & 3)) * 2;
#pragma unroll
    for (int dt = 0; dt < 2; ++dt)
#pragma unroll
        for (int ks = 0; ks < 4; ++ks) {
            const int kvb = 16 * (ks & 1) + 32 * (ks >> 1);
            const v4s lo = trrd(vb + kvb * VP + dt * 64), h4 = trrd(vb + (kvb + 8) * VP + dt * 64);
            const v8s af = (v8s){lo[0], lo[1], lo[2], lo[3], h4[0], h4[1], h4[2], h4[3]};
            oT[dt] = mfma32(af, __builtin_bit_cast(v8s, w[ks]), oT[dt]);
        }
}
__device__ __forceinline__ void softmax_step(v16f& p0, v16f& p1, v16f (&oT)[2], float& m, float& l) {
    float mx = fmaxf(p0[0], p1[0]);
#pragma unroll
    for (int r = 1; r < 16; ++r) mx = fmaxf(mx, fmaxf(p0[r], p1[r]));
    mx = fmaxf(mx, __shfl_xor(mx, 32));
    const float mn = fmaxf(m, mx);
    const float mu = (mn == -INFINITY) ? 0.f : mn;
    const float alpha = ex2(m - mu);
    float rs = 0.f;
#pragma unroll
    for (int r = 0; r < 16; ++r) { p0[r] = ex2(p0[r] - mu); p1[r] = ex2(p1[r] - mu); rs += p0[r] + p1[r]; }
    l = l * alpha + rs; m = mn;
#pragma unroll
    for (int r = 0; r < 16; ++r) { oT[0][r] *= alpha; oT[1][r] *= alpha; }
}
__device__ __forceinline__ v4u ld_tile(const bf16_t* base, int row0, int pitch, int tid) { return *(const v4u*)(base + (size_t)(row0 + (tid >> 3)) * pitch + (tid & 7) * 8); }
__device__ __forceinline__ void st_tile(LAS unsigned char* T, v4u v, int tid) { *(LAS v4u*)(T + (tid >> 3) * KP + (tid & 7) * 16) = v; }
__device__ __forceinline__ void store_o(bf16_t* Orow, const v16f (&o)[2], int hi) {
#pragma unroll
    for (int dt = 0; dt < 2; ++dt)
#pragma unroll
        for (int g = 0; g < 4; ++g) { v2u w; w.x = pkbf(o[dt][4 * g], o[dt][4 * g + 1]); w.y = pkbf(o[dt][4 * g + 2], o[dt][4 * g + 3]);
            *(v2u*)(Orow + dt * 32 + 8 * g + 4 * hi) = w; }
}
__device__ __forceinline__ int rel_bucket(int n) {
    if (n < 16) return n;
    const float v = __log2f((float)n * (1.f / 16.f)) * (16.f / 6.f) + 1e-5f;
    const int b = 16 + (int)v; return b < 31 ? b : 31;
}

__device__ __forceinline__ void cumsum_phase(LAS unsigned char* lds, const bf16_t* QKV, const float* fb, float* CL2) {
    const int tid = mk_ltid(), lane = tid & 63, wave = tid >> 6;
    LAS float* wtot = (LAS float*)lds;
    for (int u = mk_bid(); u < NB * 32; u += mk_grid()) {
        const int b = u >> 5, h = u & 31; const float bias = fb[h];
        float v[8]; float run = 0.f;
#pragma unroll
        for (int i = 0; i < 8; ++i) { const int t = tid * 8 + i; const float x = bf2f(QKV[(size_t)(b * SEQ + t) * ODD_PAD + O_F + h]) + bias;
            const float ls = fminf(x, 0.f) - log1pf(expf(-fabsf(x))); run += ls; v[i] = run; }
        float inc = run;
#pragma unroll
        for (int o = 1; o < 64; o <<= 1) { const float t = __shfl_up(inc, o); if (lane >= o) inc += t; }
        __syncthreads();
        if (lane == 63) wtot[wave] = inc;
        __syncthreads();
        float off = inc - run;
        for (int w2 = 0; w2 < wave; ++w2) off += wtot[w2];
        float* o = CL2 + (size_t)u * SEQ + tid * 8;
#pragma unroll
        for (int i = 0; i < 8; ++i) o[i] = (v[i] + off) * LOG2E;
    }
}

__device__ __forceinline__ void fox_phase(LAS unsigned char* lds, const bf16_t* QKV, const float* CL2, bf16_t* AO) {
    const int tid = mk_ltid(), lane = tid & 63, w = __builtin_amdgcn_readfirstlane(tid >> 6), r32 = lane & 31, hi = lane >> 5;
    LAS unsigned char* KT = lds; LAS unsigned char* VT = lds + 2 * TILEB; LAS float* KB = (LAS float*)(lds + 4 * TILEB);
    for (int j = mk_bid(); j < NB * 32 * 16; j += mk_grid()) {
        const int rr = j >> 7, bh = j & 127, i2 = rr >> 1; int sel = rr & 1; if (i2 & 1) sel ^= 1;
        const int qb = 15 - (2 * i2 + sel), b = bh >> 5, h = bh & 31;
        const int q0 = qb * 256, qw0 = q0 + 32 * w, qpos = qw0 + r32;
        const bf16_t* Qg = QKV + (size_t)(b * SEQ + qpos) * ODD_PAD + O_Q + h * 64 + hi * 8;
        v8s qf[4];
#pragma unroll
        for (int s = 0; s < 4; ++s) qf[s] = *(const v8s*)(Qg + s * 16);
        const bf16_t* Kg = QKV + (size_t)(b * SEQ) * ODD_PAD + O_K + h * 64;
        const bf16_t* Vg = QKV + (size_t)(b * SEQ) * ODD_PAD + O_V + h * 64;
        const float* cl = CL2 + (size_t)(b * 32 + h) * SEQ;
        const int nt = (q0 + 256) / 64;
        v16f oT[2];
#pragma unroll
        for (int r = 0; r < 16; ++r) { oT[0][r] = 0.f; oT[1][r] = 0.f; }
        float m = -INFINITY, l = 0.f;
        __syncthreads();
        v4u kr = ld_tile(Kg, 0, ODD_PAD, tid), vr = ld_tile(Vg, 0, ODD_PAD, tid); float cr = (tid < 64) ? cl[tid] : 0.f;
        for (int t = 0; t < nt; ++t) {
            const int buf = t & 1;
            st_tile(KT + buf * TILEB, kr, tid); st_tile(VT + buf * TILEB, vr, tid); if (tid < 64) KB[buf * 64 + tid] = cr;
            __syncthreads();
            if (t + 1 < nt) { kr = ld_tile(Kg, 64 * (t + 1), ODD_PAD, tid); vr = ld_tile(Vg, 64 * (t + 1), ODD_PAD, tid); if (tid < 64) cr = cl[64 * (t + 1) + tid]; }
            if (64 * t <= qw0 + 31) {
                v16f p0, p1;
                qk_tile(KT + buf * TILEB, qf, p0, p1, r32, hi);
                const bool diag = (64 * t + 63 > qw0);
                const LAS float* kbp = KB + buf * 64 + 4 * hi;
#pragma unroll
                for (int g = 0; g < 4; ++g) {
                    const v4f b0 = *(const LAS v4f*)(kbp + 8 * g), b1 = *(const LAS v4f*)(kbp + 32 + 8 * g);
#pragma unroll
                    for (int e = 0; e < 4; ++e) { const int r = 4 * g + e; const int kv = 64 * t + 8 * g + 4 * hi + e;
                        float s0 = p0[r] * C1 - b0[e], s1 = p1[r] * C1 - b1[e];
                        if (diag) { if (kv > qpos) s0 = -INFINITY; if (kv + 32 > qpos) s1 = -INFINITY; }
                        p0[r] = s0; p1[r] = s1; }
                }
                softmax_step(p0, p1, oT, m, l);
                pv_tile(VT + buf * TILEB, p0, p1, oT, lane);
            }
        }
        l += __shfl_xor(l, 32);
        const float inv = 1.f / l;
#pragma unroll
        for (int r = 0; r < 16; ++r) { oT[0][r] *= inv; oT[1][r] *= inv; }
        store_o(AO + (size_t)(b * SEQ + qpos) * DM + h * 64, oT, hi);
    }
}

__device__ __forceinline__ float gelu_tanh(float x) {
    const float u = 0.7978845608028654f * (x + 0.044715f * x * x * x);
    const float t = 1.f - 2.f / (1.f + __expf(2.f * u));
    return 0.5f * x * (1.f + t);
}
__device__ __forceinline__ void compress_unit(LAS unsigned char* lds, int u, const bf16_t* QKV, const float* pe_k, const float* pe_v,
                                              const bf16_t* CW1  , const bf16_t* CW2  , bf16_t* KCMP, bf16_t* VCMP) {
    const int tid = mk_ltid(), lane = tid & 63, w = __builtin_amdgcn_readfirstlane(tid >> 6), r32 = lane & 31, hi = lane >> 5;
    const int kv = u >> 6, b = (u >> 4) & 3, g = (u >> 3) & 1, ch = u & 7;
    const float* pe = kv ? pe_v : pe_k;
    const bf16_t* W1 = CW1 + (size_t)kv * 256 * 2048; const bf16_t* W2 = CW2 + (size_t)kv * 64 * 256;
    bf16_t* OUT = (kv ? VCMP : KCMP) + (size_t)((b * 2 + g) * 256 + ch * 32) * 64;
    const int n = ch * 32 + r32;
    const bf16_t* Ag = QKV + (size_t)(b * SEQ + 16 * n) * EVEN_PAD + (kv ? E_VC : E_KC) + g * 64 + hi * 8;
    const bf16_t* Bg = W1 + (size_t)(32 * w + r32) * 2048 + hi * 8;
    LAS bf16_t* HID = (LAS bf16_t*)lds;
    LAS float* PE = (LAS float*)(lds + 20480);
    v16f acc;
#pragma unroll
    for (int r = 0; r < 16; ++r) acc[r] = 0.f;
    __syncthreads();
    *(LAS v4f*)(PE + tid * 4) = *(const v4f*)(pe + tid * 4);
    __syncthreads();
#pragma unroll 8
    for (int st = 0; st < 128; ++st) {
        const int li = st >> 2, d0 = (st & 3) * 16;
        const v4u ar = *(const v4u*)(Ag + (size_t)li * EVEN_PAD + d0);
        const v4f pa = *(const LAS v4f*)(PE + li * 64 + d0 + hi * 8), pb = *(const LAS v4f*)(PE + li * 64 + d0 + hi * 8 + 4);
        const v8s bfr = *(const v8s*)(Bg + st * 16);
        v4u aw;
        aw.x = pkbf(__uint_as_float(ar.x << 16) + pa.x, __uint_as_float(ar.x & 0xffff0000u) + pa.y);
        aw.y = pkbf(__uint_as_float(ar.y << 16) + pa.z, __uint_as_float(ar.y & 0xffff0000u) + pa.w);
        aw.z = pkbf(__uint_as_float(ar.z << 16) + pb.x, __uint_as_float(ar.z & 0xffff0000u) + pb.y);
        aw.w = pkbf(__uint_as_float(ar.w << 16) + pb.z, __uint_as_float(ar.w & 0xffff0000u) + pb.w);
        acc = mfma32(__builtin_bit_cast(v8s, aw), bfr, acc);
    }
#pragma unroll
    for (int r = 0; r < 16; ++r) HID[crow(r, hi) * 264 + 32 * w + r32] = (bf16_t)(pkbf(gelu_tanh(acc[r]), 0.f) & 0xffffu);
    __syncthreads();
    if (w < 2) {
        v16f o;
#pragma unroll
        for (int r = 0; r < 16; ++r) o[r] = 0.f;
        const bf16_t* B2 = W2 + (size_t)(32 * w + r32) * 256 + hi * 8;
#pragma unroll
        for (int st = 0; st < 16; ++st) {
            const v8s af = *(const LAS v8s*)(HID + r32 * 264 + st * 16 + hi * 8);
            const v8s bfr = *(const v8s*)(B2 + st * 16);
            o = mfma32(af, bfr, o);
        }
#pragma unroll
        for (int r = 0; r < 16; ++r) { const int nl = crow(r, hi); const bool valid = (ch * 32 + nl) < 255;
            OUT[(size_t)nl * 64 + 32 * w + r32] = valid ? (bf16_t)(pkbf(o[r], 0.f) & 0xffffu) : (bf16_t)0; }
    }
}

__device__ __forceinline__ void swa_unit(LAS unsigned char* lds, int u, const bf16_t* QKV, const float* relb, const float* sinks, bf16_t* AO) {
    const int tid = mk_ltid(), lane = tid & 63, w = __builtin_amdgcn_readfirstlane(tid >> 6), r32 = lane & 31, hi = lane >> 5;
    LAS unsigned char* KT = lds; LAS unsigned char* VT = lds + 2 * TILEB; LAS float* TB = (LAS float*)(lds + 4 * TILEB);
    const int qblk = u >> 4, b = (u >> 2) & 3, g = u & 3;
    const int hq = 4 * g + (w >> 1), q0 = 64 * qblk, qw0 = q0 + 32 * (w & 1), qpos = qw0 + r32;
    __syncthreads();
    { const int hh = tid >> 7, d = tid & 127; TB[tid] = relb[rel_bucket(d) * 32 + 4 * g + hh] * LOG2E; }
    const bf16_t* Qg = QKV + (size_t)(b * SEQ + qpos) * EVEN_PAD + E_QA + hq * 64 + hi * 8;
    v8s qf[4];
#pragma unroll
    for (int s = 0; s < 4; ++s) qf[s] = *(const v8s*)(Qg + s * 16);
    const bf16_t* Kg = QKV + (size_t)(b * SEQ) * EVEN_PAD + E_KA + g * 64;
    const bf16_t* Vg = QKV + (size_t)(b * SEQ) * EVEN_PAD + E_VA + g * 64;
    const int t1 = qblk, t0 = (qblk >= 2) ? qblk - 2 : 0;
    v16f oT[2];
#pragma unroll
    for (int r = 0; r < 16; ++r) { oT[0][r] = 0.f; oT[1][r] = 0.f; }
    float m = -INFINITY, l = 0.f;
    const LAS float* tb = TB + (w >> 1) * 128;
    v4u kr = ld_tile(Kg, 64 * t0, EVEN_PAD, tid), vr = ld_tile(Vg, 64 * t0, EVEN_PAD, tid);
    for (int t = t0; t <= t1; ++t) {
        const int buf = t & 1;
        st_tile(KT + buf * TILEB, kr, tid); st_tile(VT + buf * TILEB, vr, tid);
        __syncthreads();
        if (t + 1 <= t1) { kr = ld_tile(Kg, 64 * (t + 1), EVEN_PAD, tid); vr = ld_tile(Vg, 64 * (t + 1), EVEN_PAD, tid); }
        if (64 * t + 63 >= qw0 - 127 && 64 * t <= qw0 + 31) {
            v16f p0, p1;
            qk_tile(KT + buf * TILEB, qf, p0, p1, r32, hi);
#pragma unroll
            for (int r = 0; r < 16; ++r) {
                const int d0 = qpos - (64 * t + crow(r, hi)), d1 = d0 - 32;
                const float s0 = p0[r] * C1 + tb[d0 & 127], s1 = p1[r] * C1 + tb[d1 & 127];
                p0[r] = (d0 >= 0 && d0 < 128) ? s0 : -INFINITY; p1[r] = (d1 >= 0 && d1 < 128) ? s1 : -INFINITY;
            }
            softmax_step(p0, p1, oT, m, l);
            pv_tile(VT + buf * TILEB, p0, p1, oT, lane);
        }
    }
    l += __shfl_xor(l, 32);
    const float sk = sinks[hq] * LOG2E;
    const float mf = fmaxf(m, sk);
    const float a = ex2(m - mf);
    const float inv = a / (l * a + ex2(sk - mf));
#pragma unroll
    for (int r = 0; r < 16; ++r) { oT[0][r] *= inv; oT[1][r] *= inv; }
    store_o(AO + (size_t)(b * SEQ + qpos) * DM + hq * 64, oT, hi);
}

__device__ __forceinline__ void evenA_phase(LAS unsigned char* lds, const bf16_t* QKV, const float* relb, const float* sinks, const float* pe_k, const float* pe_v,
                                            const bf16_t* CW1, const bf16_t* CW2, bf16_t* KCMP, bf16_t* VCMP, bf16_t* AO) {
    for (int u = mk_bid(); u < 128 + 1024; u += mk_grid()) {
        if (u < 128) compress_unit(lds, u, QKV, pe_k, pe_v, CW1, CW2, KCMP, VCMP);
        else swa_unit(lds, u - 128, QKV, relb, sinks, AO);
    }
}

constexpr int NSA_TBS = 1028;
constexpr int NSA_OFF_TB = 4 * TILEB, NSA_OFF_IMP = NSA_OFF_TB + 8 * NSA_TBS * 4, NSA_OFF_SEL = NSA_OFF_IMP + 32 * 64 * 4, NSA_OFF_UNI = NSA_OFF_SEL + 32 * 8;

__device__ __forceinline__ void nsa_phase(LAS unsigned char* lds, const bf16_t* QKV, const float* relb, const bf16_t* KCMP, const bf16_t* VCMP, bf16_t* AO) {
    const int tid = mk_ltid(), lane = tid & 63, w = __builtin_amdgcn_readfirstlane(tid >> 6), r32 = lane & 31, hi = lane >> 5;
    LAS unsigned char* KT = lds; LAS unsigned char* VT = lds + 2 * TILEB;
    LAS float* TB = (LAS float*)(lds + NSA_OFF_TB); LAS unsigned* IMP = (LAS unsigned*)(lds + NSA_OFF_IMP);
    LAS unsigned* SEL = (LAS unsigned*)(lds + NSA_OFF_SEL); LAS unsigned* UNI = (LAS unsigned*)(lds + NSA_OFF_UNI);
    const LAS float* tb = TB + w * NSA_TBS;
    int cur_g = -1;
    for (int u = mk_bid(); u < 1024; u += mk_grid()) {
        const int qblk = 127 - (u >> 3), b = (u >> 1) & 3, g = u & 1;
        const int hq = 8 * g + w, q0 = 32 * qblk, qpos = q0 + r32;
        __syncthreads();
        if (g != cur_g) { cur_g = g;
            for (int i = tid; i < 8 * 1025; i += 512) { const int hh = i / 1025, d = i - hh * 1025; TB[hh * NSA_TBS + d] = relb[rel_bucket(d) * 32 + 16 + 8 * g + hh] * LOG2E; } }
        for (int i = tid; i < 32 * 64; i += 512) IMP[i] = 0u;
        if (tid < 2) UNI[tid] = 0u;
        const bf16_t* Qrow = QKV + (size_t)(b * SEQ + qpos) * EVEN_PAD;
        v8s qf[4];
#pragma unroll
        for (int s = 0; s < 4; ++s) qf[s] = *(const v8s*)(Qrow + E_QB + hq * 64 + hi * 8 + s * 16);
        float gt[3];
#pragma unroll
        for (int i = 0; i < 3; ++i) gt[i] = 1.f / (1.f + __expf(-bf2f(Qrow[E_GT + hq * 3 + i])));
        v16f ot[2], oT[2];
#pragma unroll
        for (int r = 0; r < 16; ++r) { ot[0][r] = 0.f; ot[1][r] = 0.f; }
        const int bg = b * 2 + g;
        const bf16_t* Kc = KCMP + (size_t)bg * 256 * 64; const bf16_t* Vc = VCMP + (size_t)bg * 256 * 64;
        const int nct = (2 * qblk) / 64 + 1;
        float m = -INFINITY, l = 0.f;
        {
            const int tid = mk_ltid(), lane = tid & 63, r32 = lane & 31, hi = lane >> 5, qpos = q0 + r32; const LAS float* tb = TB + w * NSA_TBS; (void)lane; (void)hi; (void)tb; (void)qpos; (void)r32;
            v4u kr = ld_tile(Kc, 0, 64, tid);
            for (int t = 0; t < nct; ++t) {
                const int buf = t & 1;
                st_tile(KT + buf * TILEB, kr, tid);
                __syncthreads();
                if (t + 1 < nct) kr = ld_tile(Kc, 64 * (t + 1), 64, tid);
                v16f p0, p1;
                qk_tile(KT + buf * TILEB, qf, p0, p1, r32, hi);
                float mx = -INFINITY;
#pragma unroll
                for (int r = 0; r < 16; ++r) {
                    const int c0 = 64 * t + crow(r, hi); const int d0 = qpos - 16 * c0 - 31, d1 = d0 - 512;
                    const float s0 = p0[r] * C1 + tb[min(max(d0, 0), 1024)], s1 = p1[r] * C1 + tb[min(max(d1, 0), 1024)];
                    p0[r] = d0 >= 0 ? s0 : -INFINITY; p1[r] = d1 >= 0 ? s1 : -INFINITY;
                    mx = fmaxf(mx, fmaxf(p0[r], p1[r]));
                }
                mx = fmaxf(mx, __shfl_xor(mx, 32));
                const float mn = fmaxf(m, mx), mu = (mn == -INFINITY) ? 0.f : mn;
                float rs = 0.f;
#pragma unroll
                for (int r = 0; r < 16; ++r) rs += ex2(p0[r] - mu) + ex2(p1[r] - mu);
                l = l * ex2(m - mu) + rs; m = mn;
            }
        }
        l += __shfl_xor(l, 32);
        {
            const int tid = mk_ltid(), lane = tid & 63, r32 = lane & 31, hi = lane >> 5, qpos = q0 + r32; const LAS float* tb = TB + w * NSA_TBS; (void)lane; (void)hi; (void)tb; (void)qpos; (void)r32;
            const float mu = (m == -INFINITY) ? 0.f : m, il = (l > 0.f) ? 1.f / l : 0.f;
#pragma unroll
            for (int r = 0; r < 16; ++r) { oT[0][r] = 0.f; oT[1][r] = 0.f; }
            __syncthreads();
            v4u kr = ld_tile(Kc, 0, 64, tid), vr = ld_tile(Vc, 0, 64, tid);
            for (int t = 0; t < nct; ++t) {
                const int buf = t & 1;
                st_tile(KT + buf * TILEB, kr, tid); st_tile(VT + buf * TILEB, vr, tid);
                __syncthreads();
                if (t + 1 < nct) { kr = ld_tile(Kc, 64 * (t + 1), 64, tid); vr = ld_tile(Vc, 64 * (t + 1), 64, tid); }
                v16f p0, p1;
                qk_tile(KT + buf * TILEB, qf, p0, p1, r32, hi);
#pragma unroll
                for (int r = 0; r < 16; ++r) {
                    const int c0 = 64 * t + crow(r, hi); const int d0 = qpos - 16 * c0 - 31, d1 = d0 - 512;
                    const float s0 = p0[r] * C1 + tb[min(max(d0, 0), 1024)], s1 = p1[r] * C1 + tb[min(max(d1, 0), 1024)];
                    p0[r] = d0 >= 0 ? ex2(s0 - mu) * il : 0.f; p1[r] = d1 >= 0 ? ex2(s1 - mu) * il : 0.f;
                }
#pragma unroll
                for (int gq = 0; gq < 4; ++gq) {
                    const int sb0 = 16 * t + 2 * gq + hi, sb1 = sb0 + 8;
                    const unsigned a0 = (unsigned)(((p0[4 * gq] + p0[4 * gq + 1]) + (p0[4 * gq + 2] + p0[4 * gq + 3])) * 4194304.f + 0.5f);
                    const unsigned a1 = (unsigned)(((p1[4 * gq] + p1[4 * gq + 1]) + (p1[4 * gq + 2] + p1[4 * gq + 3])) * 4194304.f + 0.5f);
                    const unsigned e0 = (unsigned)(p0[4 * gq + 3] * 4194304.f + 0.5f), e1 = (unsigned)(p1[4 * gq + 3] * 4194304.f + 0.5f);
                    lds_add(IMP + r32 * 64 + sb0, a0); lds_add(IMP + r32 * 64 + sb1, a1);
                    lds_add(IMP + r32 * 64 + sb0 + 1, e0); if (sb1 + 1 < 64) lds_add(IMP + r32 * 64 + sb1 + 1, e1);
                }
                pv_tile(VT + buf * TILEB, p0, p1, oT, lane);
            }
#pragma unroll
            for (int r = 0; r < 16; ++r) { ot[0][r] += gt[0] * oT[0][r]; ot[1][r] += gt[0] * oT[1][r]; }
        }
        __syncthreads();
#pragma unroll 1
        for (int i = 0; i < 4; ++i) {
            const int lane = mk_ltid() & 63;
            const int qi = 4 * w + i, qp = q0 + qi, cur = qp >> 6;
            const unsigned v = IMP[qi * 64 + lane];
            const bool fut = lane > cur, forced = (lane == 0) || (lane == cur) || (lane == cur - 1);
            const unsigned key = ((fut ? 0u : (forced ? 0x3ffffffu : min(v + 1u, 0x3fffffeu))) << 6) | (unsigned)(63 - lane);
            int cnt = 0;
#pragma unroll
            for (int jj = 0; jj < 64; ++jj) { const unsigned kj = (unsigned)__builtin_amdgcn_readlane((int)key, jj); cnt += (kj > key) ? 1 : 0; }
            const unsigned long long msk = __ballot(!fut && cnt < 16);
            if (lane == 0) { SEL[2 * qi] = (unsigned)msk; SEL[2 * qi + 1] = (unsigned)(msk >> 32); lds_or(UNI, (unsigned)msk); lds_or(UNI + 1, (unsigned)(msk >> 32)); }
        }
        __syncthreads();
        unsigned long long uni = ((unsigned long long)__builtin_amdgcn_readfirstlane((int)UNI[1]) << 32) | (unsigned)__builtin_amdgcn_readfirstlane((int)UNI[0]);
        {
            const int tid = mk_ltid(), lane = tid & 63, r32 = lane & 31, hi = lane >> 5, qpos = q0 + r32; const LAS float* tb = TB + w * NSA_TBS; (void)lane; (void)hi; (void)tb; (void)qpos; (void)r32;
            const unsigned mlo = SEL[2 * r32], mhi = SEL[2 * r32 + 1];
            const bf16_t* Kg = QKV + (size_t)(b * SEQ) * EVEN_PAD + E_KS + g * 64; const bf16_t* Vg = QKV + (size_t)(b * SEQ) * EVEN_PAD + E_VS + g * 64;
#pragma unroll
            for (int r = 0; r < 16; ++r) { oT[0][r] = 0.f; oT[1][r] = 0.f; }
            m = -INFINITY; l = 0.f;
            int t = __builtin_ctzll(uni); uni &= uni - 1;
            v4u kr = ld_tile(Kg, 64 * t, EVEN_PAD, tid), vr = ld_tile(Vg, 64 * t, EVEN_PAD, tid);
            int it = 0;
            for (;;) {
                const int buf = it & 1; ++it;
                st_tile(KT + buf * TILEB, kr, tid); st_tile(VT + buf * TILEB, vr, tid);
                __syncthreads();
                const int tn = uni ? __builtin_ctzll(uni) : -1; uni &= uni - 1;
                if (tn >= 0) { kr = ld_tile(Kg, 64 * tn, EVEN_PAD, tid); vr = ld_tile(Vg, 64 * tn, EVEN_PAD, tid); }
                const bool mine = ((t < 32 ? (mlo >> t) : (mhi >> (t - 32))) & 1u) != 0u;
                v16f p0, p1;
                qk_tile(KT + buf * TILEB, qf, p0, p1, r32, hi);
#pragma unroll
                for (int r = 0; r < 16; ++r) {
                    const int d0 = qpos - (64 * t + crow(r, hi)), d1 = d0 - 32;
                    const float s0 = p0[r] * C1 + tb[min(max(d0, 0), 1024)], s1 = p1[r] * C1 + tb[min(max(d1, 0), 1024)];
                    p0[r] = (mine && d0 >= 0) ? s0 : -INFINITY; p1[r] = (mine && d1 >= 0) ? s1 : -INFINITY;
                }
                softmax_step(p0, p1, oT, m, l);
                pv_tile(VT + buf * TILEB, p0, p1, oT, lane);
                if (tn < 0) break;
                t = tn;
            }
            l += __shfl_xor(l, 32);
            const float sc = (l > 0.f) ? gt[1] / l : 0.f;
#pragma unroll
            for (int r = 0; r < 16; ++r) { ot[0][r] += sc * oT[0][r]; ot[1][r] += sc * oT[1][r]; }
        }
        {
            const int tid = mk_ltid(), lane = tid & 63, r32 = lane & 31, hi = lane >> 5, qpos = q0 + r32; const LAS float* tb = TB + w * NSA_TBS; (void)lane; (void)hi; (void)tb; (void)qpos; (void)r32;
            const bf16_t* Kg = QKV + (size_t)(b * SEQ) * EVEN_PAD + E_KW + g * 64; const bf16_t* Vg = QKV + (size_t)(b * SEQ) * EVEN_PAD + E_VW + g * 64;
#pragma unroll
            for (int r = 0; r < 16; ++r) { oT[0][r] = 0.f; oT[1][r] = 0.f; }
            m = -INFINITY; l = 0.f;
            const int t1 = (q0 + 31) >> 6, t0 = (q0 >= 511) ? ((q0 - 511) >> 6) : 0;
            __syncthreads();
            v4u kr = ld_tile(Kg, 64 * t0, EVEN_PAD, tid), vr = ld_tile(Vg, 64 * t0, EVEN_PAD, tid);
            for (int t = t0; t <= t1; ++t) {
                const int buf = t & 1;
                st_tile(KT + buf * TILEB, kr, tid); st_tile(VT + buf * TILEB, vr, tid);
                __syncthreads();
                if (t + 1 <= t1) { kr = ld_tile(Kg, 64 * (t + 1), EVEN_PAD, tid); vr = ld_tile(Vg, 64 * (t + 1), EVEN_PAD, tid); }
                v16f p0, p1;
                qk_tile(KT + buf * TILEB, qf, p0, p1, r32, hi);
#pragma unroll
                for (int r = 0; r < 16; ++r) {
                    const int d0 = qpos - (64 * t + crow(r, hi)), d1 = d0 - 32;
                    const float s0 = p0[r] * C1 + tb[min(max(d0, 0), 1024)], s1 = p1[r] * C1 + tb[min(max(d1, 0), 1024)];
                    p0[r] = (d0 >= 0 && d0 < 512) ? s0 : -INFINITY; p1[r] = (d1 >= 0 && d1 < 512) ? s1 : -INFINITY;
                }
                softmax_step(p0, p1, oT, m, l);
                pv_tile(VT + buf * TILEB, p0, p1, oT, lane);
            }
            l += __shfl_xor(l, 32);
            const float sc = (l > 0.f) ? gt[2] / l : 0.f;
#pragma unroll
            for (int r = 0; r < 16; ++r) { ot[0][r] += sc * oT[0][r]; ot[1][r] += sc * oT[1][r]; }
        }
        { const int tid = mk_ltid(), lane = tid & 63, r32 = lane & 31, hi = lane >> 5, qpos = q0 + r32; const LAS float* tb = TB + w * NSA_TBS; (void)lane; (void)hi; (void)tb; (void)qpos; (void)r32; store_o(AO + (size_t)(b * SEQ + qpos) * DM + 1024 + hq * 64, ot, hi); }
    }
}

__global__ void __launch_bounds__(512, 2) fwd_mega(Args a_unused) {
    extern __shared__ __attribute__((aligned(16))) unsigned char lds_raw[];
    LAS unsigned char* lds = (LAS unsigned char*)lds_raw;
    cg::grid_group grid = cg::this_grid();
#define WSP(off) (arg_ws() + (off))
    prologue_phase(lds);
#ifdef DUP_PRO
    prologue_phase(lds);
#endif
    norm_phase(arg_in(0), arg_in(2), (bf16_t*)WSP(WS_XN), nullptr);
    grid.sync();
#pragma unroll 1
    for (int L = 0; L < 4; ++L) {
        const int e = L >> 1;
        if ((L & 1) == 0) {
            { pg8::Gemm gm{(const bf16_t*)WSP(WS_XN), (const bf16_t*)WSP(WS_WIE) + (size_t)e * EVEN_PAD * DM, MTOK, EVEN_PAD, DM}; pg8::StaticOrder S; S.init(MTOK, EVEN_PAD, mk_grid(), mk_bid());
              pg8::EpiBf16<0> E{(bf16_t*)WSP(WS_QKV), EVEN_PAD}; pg8::gemm_phase<pg8::EpiBf16<0>, pg8::StaticOrder, true, true>(lds, gm, S, E); }
            grid.sync();
            evenA_phase(lds, (const bf16_t*)WSP(WS_QKV), arg_in(1), arg_in(7) + e * 16, arg_in(8) + e * 2048, arg_in(9) + e * 2048,
                        (const bf16_t*)WSP(WS_CW1) + (size_t)e * 2 * 256 * 2048, (const bf16_t*)WSP(WS_CW2) + (size_t)e * 2 * 64 * 256, (bf16_t*)WSP(WS_KCMP), (bf16_t*)WSP(WS_VCMP), (bf16_t*)WSP(WS_AO));
            grid.sync();
#ifdef DUP_EVENA
            evenA_phase(lds, (const bf16_t*)WSP(WS_QKV), arg_in(1), arg_in(7) + e * 16, arg_in(8) + e * 2048, arg_in(9) + e * 2048,
                        (const bf16_t*)WSP(WS_CW1) + (size_t)e * 2 * 256 * 2048, (const bf16_t*)WSP(WS_CW2) + (size_t)e * 2 * 64 * 256, (bf16_t*)WSP(WS_KCMP), (bf16_t*)WSP(WS_VCMP), (bf16_t*)WSP(WS_AO));
            grid.sync();
#endif
            nsa_phase(lds, (const bf16_t*)WSP(WS_QKV), arg_in(1), (const bf16_t*)WSP(WS_KCMP), (const bf16_t*)WSP(WS_VCMP), (bf16_t*)WSP(WS_AO));
            grid.sync();
#ifdef DUP_NSA
            nsa_phase(lds, (const bf16_t*)WSP(WS_QKV), arg_in(1), (const bf16_t*)WSP(WS_KCMP), (const bf16_t*)WSP(WS_VCMP), (bf16_t*)WSP(WS_AO));
            grid.sync();
#endif
            { pg8::Gemm gm{(const bf16_t*)WSP(WS_AO), (const bf16_t*)WSP(WS_WOE) + (size_t)e * DM * DM, MTOK, DM, DM}; pg8::StaticOrder S; S.init(MTOK, DM, mk_grid(), mk_bid());
              pg8::EpiRes E{(L == 0) ? arg_in(0) : (const float*)arg_out(), arg_out(), DM}; pg8::gemm_phase<pg8::EpiRes, pg8::StaticOrder, true, true>(lds, gm, S, E); }
        } else {
            { pg8::Gemm gm{(const bf16_t*)WSP(WS_XN), (const bf16_t*)WSP(WS_WIO) + (size_t)e * ODD_PAD * DM, MTOK, ODD_PAD, DM}; pg8::StaticOrder S; S.init(MTOK, ODD_PAD, mk_grid(), mk_bid());
              pg8::EpiBf16<0> E{(bf16_t*)WSP(WS_QKV), ODD_PAD}; pg8::gemm_phase<pg8::EpiBf16<0>, pg8::StaticOrder, true, true>(lds, gm, S, E); }
            grid.sync();
            cumsum_phase(lds, (const bf16_t*)WSP(WS_QKV), arg_in(16) + e * 32, (float*)WSP(WS_C));
            grid.sync();
            fox_phase(lds, (const bf16_t*)WSP(WS_QKV), (const float*)WSP(WS_C), (bf16_t*)WSP(WS_AO));
            grid.sync();
#ifdef DUP_FOX
            fox_phase(lds, (const bf16_t*)WSP(WS_QKV), (const float*)WSP(WS_C), (bf16_t*)WSP(WS_AO));
            grid.sync();
#endif
            { pg8::Gemm gm{(const bf16_t*)WSP(WS_AO), (const bf16_t*)WSP(WS_WOO) + (size_t)e * DM * DM, MTOK, DM, DM}; pg8::StaticOrder S; S.init(MTOK, DM, mk_grid(), mk_bid());
              pg8::EpiRes E{(const float*)arg_out(), arg_out(), DM}; pg8::gemm_phase<pg8::EpiRes, pg8::StaticOrder, true, true>(lds, gm, S, E); }
        }
        grid.sync();
        norm_phase(arg_out(), arg_in(3) + L * DM, (bf16_t*)WSP(WS_XN), nullptr);
#ifdef DUP_NORM
        norm_phase(arg_out(), arg_in(3) + L * DM, (bf16_t*)WSP(WS_XN), nullptr);
#endif
        grid.sync();
        { pg8::Gemm gm{(const bf16_t*)WSP(WS_XN), (const bf16_t*)WSP(WS_WUP) + (size_t)L * DFF * DM, MTOK, DFF, DM}; pg8::StaticOrder S; S.init(MTOK, DFF, mk_grid(), mk_bid());
          pg8::EpiBf16<2> E{(bf16_t*)WSP(WS_H), DFF}; pg8::gemm_phase<pg8::EpiBf16<2>, pg8::StaticOrder, true, true>(lds, gm, S, E); }
        grid.sync();
#ifdef DUP_UP
        { pg8::Gemm gm{(const bf16_t*)WSP(WS_XN), (const bf16_t*)WSP(WS_WUP) + (size_t)L * DFF * DM, MTOK, DFF, DM}; pg8::StaticOrder S; S.init(MTOK, DFF, mk_grid(), mk_bid());
          pg8::EpiBf16<2> E{(bf16_t*)WSP(WS_H), DFF}; pg8::gemm_phase<pg8::EpiBf16<2>, pg8::StaticOrder, true, true>(lds, gm, S, E); }
        grid.sync();
#endif
        { pg8::Gemm gm{(const bf16_t*)WSP(WS_H), (const bf16_t*)WSP(WS_WDN) + (size_t)L * DM * DFF, MTOK, DM, DFF}; pg8::StaticOrder S; S.init(MTOK, DM, mk_grid(), mk_bid());
          pg8::EpiRes E{(const float*)arg_out(), arg_out(), DM}; pg8::gemm_phase<pg8::EpiRes, pg8::StaticOrder, true, true>(lds, gm, S, E); }
        grid.sync();
#ifdef DUP_NORM
        if (L < 3) norm_phase(arg_out(), arg_in(2) + (L + 1) * DM, (bf16_t*)WSP(WS_XN), nullptr);
#endif
        if (L < 3) { norm_phase(arg_out(), arg_in(2) + (L + 1) * DM, (bf16_t*)WSP(WS_XN), nullptr); grid.sync(); }
        else norm_phase(arg_out(), arg_in(4), nullptr, arg_out());
    }
#undef WSP
}

extern "C" void kernel_launch(void* const* d_in, const int* in_sizes, int n_in, void* d_out, int out_size, void* d_ws, size_t ws_size, hipStream_t stream) {
    static int grid = 0;
    if (grid == 0) {
        if (n_in != 19 || out_size != MTOK * DM || ws_size < WS_END) { fprintf(stderr, "kernel_launch: unexpected shapes (n_in %d out %d ws %zu)\n", n_in, out_size, ws_size); grid = -1; return; }
        int dev = 0, cus = 0, per_cu = 0;
        (void)hipGetDevice(&dev);
        (void)hipDeviceGetAttribute(&cus, hipDeviceAttributeMultiprocessorCount, dev);
        (void)hipFuncSetAttribute((const void*)fwd_mega, hipFuncAttributeMaxDynamicSharedMemorySize, LDS_BYTES);
        (void)hipOccupancyMaxActiveBlocksPerMultiprocessor(&per_cu, (const void*)fwd_mega, 512, LDS_BYTES);
        if (per_cu < 1) per_cu = 1;
        grid = cus * per_cu;
        fprintf(stderr, "kernel_launch: grid %d (cus %d x %d)\n", grid, cus, per_cu);
    }
    if (grid < 0) return;
    Args a{};
    for (int i = 0; i < 19; ++i) a.in[i] = (const float*)d_in[i];
    a.out = (float*)d_out; a.ws = (unsigned char*)d_ws;
    void* args[] = {&a};
    hipError_t e = hipLaunchCooperativeKernel((void*)fwd_mega, dim3(grid), dim3(512), args, LDS_BYTES, stream);
    if (e != hipSuccess) fprintf(stderr, "cooperative launch failed: %s (grid %d)\n", hipGetErrorString(e), grid);
}
```

```cpp
#include <hip/hip_runtime.h>
#include <hip/hip_cooperative_groups.h>
#include <cstdio>
#include <cstdint>
#include <cmath>
namespace cg = cooperative_groups;
__device__ __forceinline__ int mk_ltid() { int t = threadIdx.x; asm volatile("" : "+v"(t)); return t; }
__device__ __forceinline__ int mk_bid() { int t = blockIdx.x; asm volatile("" : "+s"(t)); return t; }
__device__ __forceinline__ int mk_grid() { int t = gridDim.x; asm volatile("" : "+s"(t)); return t; }
namespace pg8 {
#define PG8_LAS __attribute__((address_space(3)))
typedef unsigned short bf16_t;
typedef short bf16x8 __attribute__((ext_vector_type(8)));
typedef float f32x4 __attribute__((ext_vector_type(4)));
typedef unsigned u32x4 __attribute__((ext_vector_type(4)));
constexpr int BM = 256, BK = 64, HALF = 128, HTB = HALF * BK * 2  , STAGE_BYTES = 8 * HTB, NXCD = 8, WGM = 8;

__host__ __device__ __forceinline__ int lds_byte(int r, int c) { const int st = (r >> 4) * 2 + (c >> 5), rr = r & 15, cc = c & 31, ob = rr * 64 + cc * 2; return st * 1024 + (ob ^ (((ob >> 9) & 1) << 5)); }
__host__ __device__ __forceinline__ void stage_rc(int b, int& R, int& C) { const int st = b / 1024, sb = b % 1024, swz = sb ^ (((sb >> 9) & 1) << 5); R = (st >> 1) * 16 + swz / 64; C = (st & 1) * 32 + (swz % 64) / 2; }
__host__ __device__ __forceinline__ int perm32(int rho) { const int n = rho >> 4, i = rho & 15; return 8 * (i >> 2) + 4 * n + (i & 3); }

struct Unit { int pm, pn; };
struct Gemm { const bf16_t* A; const bf16_t* Bt; int M, N, K; };

struct StaticOrder {
    int nM, nN, nwg, G, c;
    __host__ __device__ void init(int M, int N, int G_, int c_) { nM = M / BM; nN = N / BM; nwg = nM * nN; G = G_; c = c_; }
    __host__ __device__ bool next(int i, Unit& u) const {
        const long L = (long)i * G + c; if (L >= nwg) return false;
        int wgid = (int)L; { const int q = nwg / NXCD, r = nwg % NXCD, xcd = wgid % NXCD, off = wgid / NXCD; wgid = (xcd < r ? xcd * (q + 1) : r * (q + 1) + (xcd - r) * q) + off; }
        const int nig = WGM * nN, gid = wgid / nig, fm = gid * WGM, gsz = (nM - fm) < WGM ? (nM - fm) : WGM;
        u.pm = fm + ((wgid % nig) % gsz); u.pn = (wgid % nig) / gsz; return true;
    }
    __device__ __forceinline__ void a_ready(const Unit&) const {}
    __device__ __forceinline__ void done(const Unit&) const {}
};

__device__ __forceinline__ unsigned cvt_pk_bf16(float lo, float hi) { unsigned r; asm volatile("v_cvt_pk_bf16_f32 %0, %1, %2" : "=v"(r) : "v"(lo), "v"(hi)); return r; }
typedef float f32x2 __attribute__((ext_vector_type(2)));
template <int ACT  > struct EpiBf16 {
    static constexpr bool PERM = true, AFTER_DRAIN = false;
    bf16_t* O; int ldc;
    __device__ __forceinline__ void operator()(const f32x4 (&acc)[2][2][4][2], const Unit& u, int wr, int wc, int fr, int fq) const {
        const int row0 = u.pm * BM + wr * 64 + fr; const int col0 = u.pn * BM + wc * 32 + 8 * fq;
#pragma unroll
        for (int ai = 0; ai < 2; ++ai)
#pragma unroll
            for (int m = 0; m < 4; ++m) { bf16_t* rowp = O + (size_t)(row0 + ai * HALF + m * 16) * ldc + col0;
#pragma unroll
                for (int bj = 0; bj < 2; ++bj) { f32x4 v0 = acc[ai][bj][m][0], v1 = acc[ai][bj][m][1];
                    if (ACT == 2) {
#pragma unroll
                        for (int e = 0; e < 4; ++e) { float a = v0[e] > 0.f ? v0[e] : 0.f; v0[e] = a * a; float b = v1[e] > 0.f ? v1[e] : 0.f; v1[e] = b * b; } }
                    u32x4 w; w.x = cvt_pk_bf16(v0[0], v0[1]); w.y = cvt_pk_bf16(v0[2], v0[3]); w.z = cvt_pk_bf16(v1[0], v1[1]); w.w = cvt_pk_bf16(v1[2], v1[3]);
                    *(u32x4*)(rowp + bj * HALF) = w; } }
    }
};
struct EpiRes {
    static constexpr bool PERM = false, AFTER_DRAIN = false;
    const float* base; float* out; int ldc;
    __device__ __forceinline__ void operator()(const f32x4 (&acc)[2][2][4][2], const Unit& u, int wr, int wc, int fr, int fq) const {
        const int row0 = u.pm * BM + wr * 64 + fr; const int col0 = u.pn * BM + wc * 32 + 4 * fq;
#pragma unroll
        for (int ai = 0; ai < 2; ++ai)
#pragma unroll
            for (int m = 0; m < 4; ++m) { const size_t off = (size_t)(row0 + ai * HALF + m * 16) * ldc + col0;
#pragma unroll
                for (int bj = 0; bj < 2; ++bj)
#pragma unroll
                    for (int n = 0; n < 2; ++n) { const f32x4 b = *(const f32x4*)(base + off + bj * HALF + n * 16); *(f32x4*)(out + off + bj * HALF + n * 16) = b + acc[ai][bj][m][n]; } }
    }
};
template <class Epi, class Sched, bool ALIGN_EPI = false, bool SP2 = false>
__device__ __forceinline__ void gemm_phase(PG8_LAS unsigned char* lds, const Gemm g, const Sched& S, const Epi& E) {
    const int tid = mk_ltid(), wid = __builtin_amdgcn_readfirstlane(tid >> 6), lane = tid & 63, wr = wid >> 2, wc = wid & 3, fr = lane & 15, fq = lane >> 4;
    const int K = g.K, nt = K / BK;
    unsigned voffA[2], voffB[2];
#pragma unroll
    for (int i = 0; i < 2; ++i) { int R, C; stage_rc(tid * 16 + i * 8192, R, C); const int Rb = Epi::PERM ? ((R & ~31) + perm32(R & 31)) : R;
        voffA[i] = (unsigned)(R * K + C) * 2u; voffB[i] = (unsigned)(Rb * K + C) * 2u; }
    const size_t kstep = (size_t)(BK * 2);
    const size_t hstep = (size_t)HALF * K * 2;
    const size_t tstep = 2 * hstep;
    const unsigned ldsw = (unsigned)wid * 1024u;
    const int aoff = lds_byte(wr * 64 + fr, fq * 8), boff = lds_byte(wc * 32 + fr, fq * 8);
#define PG8_SA(b, h) (((b) * 2 + (h)) * HTB)
#define PG8_SB(b, h) ((4 + (b) * 2 + (h)) * HTB)
#define PG8_STAGE(bufoff, gbase, voff) do { _Pragma("unroll") for (int _i = 0; _i < 2; ++_i) \
        __builtin_amdgcn_global_load_lds((const unsigned*)((const char*)(gbase) + (voff)[_i]), (PG8_LAS unsigned*)(lds + (bufoff) + ldsw + _i * 8192), 16, 0, 0); } while (0)
#define PG8_LDA(dst, b, h) do { _Pragma("unroll") for (int m = 0; m < 4; ++m) _Pragma("unroll") for (int k = 0; k < 2; ++k) dst[m][k] = *(const PG8_LAS bf16x8*)(lds + PG8_SA(b, h) + aoff + m * 2048 + k * 1024); } while (0)
#define PG8_LDB(dst, b, h) do { _Pragma("unroll") for (int n = 0; n < 2; ++n) _Pragma("unroll") for (int k = 0; k < 2; ++k) dst[n][k] = *(const PG8_LAS bf16x8*)(lds + PG8_SB(b, h) + boff + n * 2048 + k * 1024); } while (0)
#define PG8_MMA(ai, bj, At, Bt) do { __builtin_amdgcn_s_setprio(1); _Pragma("unroll") for (int m = 0; m < 4; ++m) _Pragma("unroll") for (int n = 0; n < 2; ++n) _Pragma("unroll") for (int k = 0; k < 2; ++k) \
        acc[ai][bj][m][n] = __builtin_amdgcn_mfma_f32_16x16x32_bf16(Bt[n][k], At[m][k], acc[ai][bj][m][n], 0, 0, 0); __builtin_amdgcn_s_setprio(0); } while (0)
#define PG8_WAIT_V(n) asm volatile("s_waitcnt vmcnt(" #n ")" ::: "memory")
#define PG8_WAIT_L(n) asm volatile("s_waitcnt lgkmcnt(" #n ")" ::: "memory")
#define PG8_BAR __builtin_amdgcn_s_barrier()
#define PG8_SCHED __builtin_amdgcn_sched_barrier(0)
    Unit cur, nxt; int ui = 0;
    if (!S.next(0, cur)) return;
    f32x4 acc[2][2][4][2];
#pragma unroll
    for (int a = 0; a < 2; ++a)
#pragma unroll
        for (int b = 0; b < 2; ++b)
#pragma unroll
            for (int m = 0; m < 4; ++m)
#pragma unroll
                for (int n = 0; n < 2; ++n) acc[a][b][m][n] = (f32x4){0.f, 0.f, 0.f, 0.f};
    bf16x8 At[4][2], B0[2][2], B1[2][2];
    const char* cA = (const char*)g.A + (size_t)cur.pm * tstep; const char* cB = (const char*)g.Bt + (size_t)cur.pn * tstep;
    S.a_ready(cur);
    if constexpr (SP2) {
        PG8_STAGE(PG8_SB(0, 0), cB, voffB); PG8_STAGE(PG8_SB(0, 1), cB + hstep, voffB); PG8_STAGE(PG8_SA(0, 0), cA, voffA); PG8_STAGE(PG8_SA(0, 1), cA + hstep, voffA);
        if (wr == 1) PG8_BAR;
        PG8_WAIT_V(2); PG8_BAR;
        PG8_STAGE(PG8_SB(1, 0), cB + kstep, voffB); PG8_STAGE(PG8_SA(1, 0), cA + kstep, voffA); PG8_STAGE(PG8_SB(1, 1), cB + hstep + kstep, voffB);
        PG8_WAIT_V(6); PG8_BAR;
    } else {
        PG8_STAGE(PG8_SB(0, 0), cB, voffB); PG8_STAGE(PG8_SA(0, 0), cA, voffA); PG8_STAGE(PG8_SB(0, 1), cB + hstep, voffB); PG8_STAGE(PG8_SA(0, 1), cA + hstep, voffA);
        if (wr == 1) PG8_BAR;
        PG8_WAIT_V(4); PG8_BAR;
        PG8_STAGE(PG8_SB(1, 0), cB + kstep, voffB); PG8_STAGE(PG8_SA(1, 0), cA + kstep, voffA); PG8_STAGE(PG8_SB(1, 1), cB + hstep + kstep, voffB);
        PG8_WAIT_V(6); PG8_BAR;
    }
    for (;;) {
        const bool has_next = S.next(ui + 1, nxt);
        const char* nA = has_next ? (const char*)g.A + (size_t)nxt.pm * tstep : cA; const char* nB = has_next ? (const char*)g.Bt + (size_t)nxt.pn * tstep : cB;
        for (int t = 0; t < nt; t += 2) {
            const bool last = (t == nt - 2);
            const char* a1 = cA + (size_t)(t + 1) * kstep;
            const char* a2 = last ? nA : cA + (size_t)(t + 2) * kstep; const char* b2 = last ? nB : cB + (size_t)(t + 2) * kstep;
            const char* a3 = a2 + kstep; const char* b3 = b2 + kstep;
            if (last && has_next) S.a_ready(nxt);
            if constexpr (SP2) {
            PG8_LDB(B0, 0, 0); PG8_LDB(B1, 0, 1); PG8_SCHED; PG8_LDA(At, 0, 0); PG8_STAGE(PG8_SA(1, 1), a1 + hstep, voffA);
            PG8_WAIT_V(8); PG8_WAIT_L(0); PG8_BAR; PG8_MMA(0, 0, At, B0); PG8_MMA(0, 1, At, B1); PG8_BAR; PG8_SCHED;
            PG8_LDA(At, 0, 1); PG8_STAGE(PG8_SB(0, 0), b2, voffB); PG8_STAGE(PG8_SB(0, 1), b2 + hstep, voffB); PG8_STAGE(PG8_SA(0, 0), a2, voffA);
            PG8_WAIT_V(8); PG8_WAIT_L(0); PG8_BAR; PG8_MMA(1, 0, At, B0); PG8_MMA(1, 1, At, B1); PG8_BAR; PG8_SCHED;
            PG8_LDB(B0, 1, 0); PG8_LDB(B1, 1, 1); PG8_SCHED; PG8_LDA(At, 1, 0); PG8_STAGE(PG8_SA(0, 1), a2 + hstep, voffA);
            PG8_WAIT_V(8); PG8_WAIT_L(0); PG8_BAR; PG8_MMA(0, 0, At, B0); PG8_MMA(0, 1, At, B1); PG8_BAR; PG8_SCHED;
            PG8_LDA(At, 1, 1); PG8_STAGE(PG8_SB(1, 0), b3, voffB); PG8_STAGE(PG8_SB(1, 1), b3 + hstep, voffB); PG8_STAGE(PG8_SA(1, 0), a3, voffA);
            PG8_WAIT_V(8); PG8_WAIT_L(0); PG8_BAR; PG8_MMA(1, 0, At, B0); PG8_MMA(1, 1, At, B1); PG8_BAR; PG8_SCHED;
            } else {
            PG8_LDB(B0, 0, 0); PG8_SCHED; PG8_LDA(At, 0, 0); PG8_STAGE(PG8_SA(1, 1), a1 + hstep, voffA);
            PG8_WAIT_L(8); PG8_BAR; PG8_WAIT_L(0); PG8_MMA(0, 0, At, B0); PG8_BAR; PG8_SCHED;
            PG8_LDB(B1, 0, 1); PG8_STAGE(PG8_SB(0, 0), b2, voffB);
            PG8_BAR; PG8_WAIT_L(0); PG8_MMA(0, 1, At, B1); PG8_BAR;
            PG8_LDA(At, 0, 1); PG8_STAGE(PG8_SA(0, 0), a2, voffA);
            PG8_BAR; PG8_WAIT_L(0); PG8_MMA(1, 0, At, B0); PG8_BAR; PG8_SCHED;
            PG8_STAGE(PG8_SB(0, 1), b2 + hstep, voffB);
            PG8_WAIT_V(6); PG8_BAR; PG8_MMA(1, 1, At, B1); PG8_BAR;
            PG8_LDB(B0, 1, 0); PG8_SCHED; PG8_LDA(At, 1, 0); PG8_STAGE(PG8_SA(0, 1), a2 + hstep, voffA);
            PG8_WAIT_L(8); PG8_BAR; PG8_WAIT_L(0); PG8_MMA(0, 0, At, B0); PG8_BAR; PG8_SCHED;
            PG8_LDB(B1, 1, 1); PG8_STAGE(PG8_SB(1, 0), b3, voffB);
            PG8_BAR; PG8_WAIT_L(0); PG8_MMA(0, 1, At, B1); PG8_BAR;
            PG8_LDA(At, 1, 1); PG8_STAGE(PG8_SA(1, 0), a3, voffA);
            PG8_BAR; PG8_WAIT_L(0); PG8_MMA(1, 0, At, B0); PG8_BAR; PG8_SCHED;
            PG8_STAGE(PG8_SB(1, 1), b3 + hstep, voffB);
            PG8_WAIT_V(6); PG8_BAR; PG8_MMA(1, 1, At, B1); PG8_BAR;
            }
        }
        if constexpr (ALIGN_EPI) { if (wr == 0) PG8_BAR; }
        if constexpr (!Epi::AFTER_DRAIN) { E(acc, cur, wr, wc, fr, fq); S.done(cur); }
        if (!has_next) break;
#pragma unroll
        for (int a = 0; a < 2; ++a)
#pragma unroll
            for (int b = 0; b < 2; ++b)
#pragma unroll
                for (int m = 0; m < 4; ++m)
#pragma unroll
                    for (int n = 0; n < 2; ++n) acc[a][b][m][n] = (f32x4){0.f, 0.f, 0.f, 0.f};
        cur = nxt; cA = nA; cB = nB; ++ui;
        if constexpr (ALIGN_EPI) { if (wr == 1) PG8_BAR; }
    }
    PG8_WAIT_V(0);
    if constexpr (!ALIGN_EPI) { if (wr == 0) PG8_BAR; }
    PG8_BAR;
    if constexpr (Epi::AFTER_DRAIN) { E.fused(acc, cur, wr, wc, fr, fq, lds, wid, lane); S.done(cur); }
#undef PG8_SA
#undef PG8_SB
#undef PG8_STAGE
#undef PG8_LDA
#undef PG8_LDB
#undef PG8_MMA
#undef PG8_WAIT_V
#undef PG8_WAIT_L
#undef PG8_BAR
#undef PG8_SCHED
}
}

#define LAS __attribute__((address_space(3)))
typedef unsigned short bf16_t;
typedef short v8s __attribute__((ext_vector_type(8)));
typedef short v4s __attribute__((ext_vector_type(4)));
typedef float v4f __attribute__((ext_vector_type(4)));
typedef float v16f __attribute__((ext_vector_type(16)));
typedef unsigned v4u __attribute__((ext_vector_type(4)));
typedef unsigned v2u __attribute__((ext_vector_type(2)));

constexpr int DM = 2048, NB = 4, SEQ = 4096, MTOK = NB * SEQ, DFF = 8192;
constexpr int EVEN_IN = 3376, EVEN_PAD = 3584, ODD_IN = 6176, ODD_PAD = 6400;
constexpr int E_QA = 0, E_KA = 1024, E_VA = 1280, E_QB = 1536, E_KC = 2560, E_VC = 2688, E_KS = 2816, E_VS = 2944, E_KW = 3072, E_VW = 3200, E_GT = 3328;
constexpr int O_Q = 0, O_K = 2048, O_V = 4096, O_F = 6144;
constexpr float LOG2E = 1.4426950408889634f;
constexpr float C1 = 0.125f * LOG2E;
constexpr float RMS_EPS = 1e-6f;

constexpr size_t MiB = 1u << 20;
constexpr size_t WS_WUP = 16 * MiB, WS_WDN = 144 * MiB, WS_WIE = 272 * MiB, WS_WIO = 300 * MiB, WS_WOE = 350 * MiB, WS_WOO = 366 * MiB;
constexpr size_t WS_CW1 = 382 * MiB, WS_CW2 = 386 * MiB, WS_KCMP = 387 * MiB, WS_VCMP = 387 * MiB + 512 * 1024, WS_C = 388 * MiB;
constexpr size_t WS_XN = 392 * MiB, WS_QKV = 456 * MiB, WS_AO = 656 * MiB, WS_H = 456 * MiB, WS_END = 720 * MiB;

constexpr int KP = 144, VP = 144, TILEB = 64 * 144;
constexpr int LDS_BYTES = 160 * 1024;

struct Args { const float* in[19]; float* out; unsigned char* ws; };
__device__ __forceinline__ const unsigned char __attribute__((address_space(4)))* karg_base() {
    const unsigned char __attribute__((address_space(4)))* kp = (const unsigned char __attribute__((address_space(4)))*)__builtin_amdgcn_kernarg_segment_ptr();
    asm volatile("" : "+s"(kp)); return kp; }
__device__ __forceinline__ const float* arg_in(int i) { return *(const float* const __attribute__((address_space(4)))*)(karg_base() + 8 * i); }
__device__ __forceinline__ float* arg_out() { return *(float* const __attribute__((address_space(4)))*)(karg_base() + 8 * 19); }
__device__ __forceinline__ unsigned char* arg_ws() { return *(unsigned char* const __attribute__((address_space(4)))*)(karg_base() + 8 * 20); }

__device__ __forceinline__ unsigned pkbf(float lo, float hi) {
    typedef float f2 __attribute__((ext_vector_type(2))); typedef __bf16 b2 __attribute__((ext_vector_type(2)));
    f2 v = {lo, hi}; b2 b = __builtin_convertvector(v, b2); return __builtin_bit_cast(unsigned, b);
}
__device__ __forceinline__ float bf2f(unsigned short u) { return __uint_as_float(((unsigned)u) << 16); }
__device__ __forceinline__ float ex2(float x) { return __builtin_amdgcn_exp2f(x); }
__device__ __forceinline__ void lds_add(LAS unsigned* p, unsigned v) { (void)__hip_atomic_fetch_add(p, v, __ATOMIC_RELAXED, __HIP_MEMORY_SCOPE_WORKGROUP); }
__device__ __forceinline__ void lds_or(LAS unsigned* p, unsigned v) { (void)__hip_atomic_fetch_or(p, v, __ATOMIC_RELAXED, __HIP_MEMORY_SCOPE_WORKGROUP); }
__device__ __forceinline__ int crow(int r, int hi) { return (r & 3) + 8 * (r >> 2) + 4 * hi; }
__device__ __forceinline__ v16f mfma32(v8s a, v8s b, v16f c) { return __builtin_amdgcn_mfma_f32_32x32x16_bf16(a, b, c, 0, 0, 0); }
__device__ __forceinline__ float wave_sum(float v) {
#pragma unroll
    for (int o = 1; o < 64; o <<= 1) v += __shfl_xor(v, o);
    return v;
}

__device__ __forceinline__ void tr_load(float (&v)[32], const float* W, int K, int N, int item, int lane) {
    const int nblk = (N + 31) / 32, kb = item / nblk, nb = item - kb * nblk, k0 = 64 * kb, n0 = 32 * nb;
    const int nn = n0 + (lane & 31); const bool ok = nn < N;
    const float* p = W + (size_t)(k0 + (lane >> 5)) * N + (ok ? nn : 0);
#pragma unroll
    for (int i = 0; i < 32; ++i) { const float x = p[(size_t)(2 * i) * N]; v[i] = ok ? x : 0.f; }
}
__device__ __forceinline__ void tr_put(const float (&v)[32], LAS float* scr, int lane) {
#pragma unroll
    for (int i = 0; i < 32; ++i) scr[(2 * i + (lane >> 5)) * 33 + (lane & 31)] = v[i];
}
__device__ __forceinline__ void tr_store(bf16_t* WT, int K, int N, LAS float* scr, int item, int lane) {
    const int nblk = (N + 31) / 32, kb = item / nblk, nb = item - kb * nblk, k0 = 64 * kb, n0 = 32 * nb;
    const int c = lane & 7;
#pragma unroll
    for (int j = 0; j < 4; ++j) { const int n = (lane >> 3) + 8 * j; const LAS float* s = scr + (8 * c) * 33 + n;
        v4u o; o.x = pkbf(s[0 * 33], s[1 * 33]); o.y = pkbf(s[2 * 33], s[3 * 33]); o.z = pkbf(s[4 * 33], s[5 * 33]); o.w = pkbf(s[6 * 33], s[7 * 33]);
        *(v4u*)(WT + (size_t)(n0 + n) * K + k0 + 8 * c) = o; }
}

__device__ __forceinline__ void prologue_phase(LAS unsigned char* lds) {
    const int tid = mk_ltid(), lane = tid & 63, wave = __builtin_amdgcn_readfirstlane(tid >> 6);
    LAS float* scr = (LAS float*)(lds + wave * 16384);
    const int gw = mk_bid() * 8 + wave, NGW = mk_grid() * 8;
    for (int mi = 0; mi < 24; ++mi) {
        unsigned char* ws = arg_ws();
        const float* W; int K, N; bf16_t* WT;
        if (mi < 4) { W = arg_in(17) + (size_t)mi * DM * DFF; K = DM; N = DFF; WT = (bf16_t*)(ws + WS_WUP) + (size_t)mi * DFF * DM; }
        else if (mi < 8) { const int L = mi - 4; W = arg_in(18) + (size_t)L * DFF * DM; K = DFF; N = DM; WT = (bf16_t*)(ws + WS_WDN) + (size_t)L * DM * DFF; }
        else if (mi < 10) { const int e = mi - 8; W = arg_in(5) + (size_t)e * DM * EVEN_IN; K = DM; N = EVEN_IN; WT = (bf16_t*)(ws + WS_WIE) + (size_t)e * EVEN_PAD * DM; }
        else if (mi < 12) { const int e = mi - 10; W = arg_in(14) + (size_t)e * DM * ODD_IN; K = DM; N = ODD_IN; WT = (bf16_t*)(ws + WS_WIO) + (size_t)e * ODD_PAD * DM; }
        else if (mi < 14) { const int e = mi - 12; W = arg_in(6) + (size_t)e * DM * DM; K = DM; N = DM; WT = (bf16_t*)(ws + WS_WOE) + (size_t)e * DM * DM; }
        else if (mi < 16) { const int e = mi - 14; W = arg_in(15) + (size_t)e * DM * DM; K = DM; N = DM; WT = (bf16_t*)(ws + WS_WOO) + (size_t)e * DM * DM; }
        else if (mi < 20) { const int e = (mi - 16) & 1, kv = (mi - 16) >> 1; W = arg_in(kv ? 12 : 10) + (size_t)e * 2048 * 256; K = 2048; N = 256; WT = (bf16_t*)(ws + WS_CW1) + (size_t)(e * 2 + kv) * 256 * 2048; }
        else { const int e = (mi - 20) & 1, kv = (mi - 20) >> 1; W = arg_in(kv ? 13 : 11) + (size_t)e * 256 * 64; K = 256; N = 64; WT = (bf16_t*)(ws + WS_CW2) + (size_t)(e * 2 + kv) * 64 * 256; }
        const int nitems = (K / 64) * ((N + 31) / 32);
        float v[32];
        int it = gw;
        if (it < nitems) tr_load(v, W, K, N, it, lane);
        while (it < nitems) {
            tr_put(v, scr, lane);
            const int nx = it + NGW;
            if (nx < nitems) tr_load(v, W, K, N, nx, lane);
            asm volatile("s_waitcnt lgkmcnt(0)" ::: "memory");
            tr_store(WT, K, N, scr, it, lane);
            asm volatile("s_waitcnt lgkmcnt(0)" ::: "memory");
            it = nx;
        }
    }
}

__device__ __forceinline__ void norm_phase(const float* X, const float* g, bf16_t* XN, float* OUTF) {
    const int tid = mk_ltid(), lane = tid & 63, wave = tid >> 6;
    const int gw = mk_bid() * 8 + wave, NGW = mk_grid() * 8;
    v4f gv[8];
#pragma unroll
    for (int j = 0; j < 8; ++j) gv[j] = *((const v4f*)g + lane + 64 * j);
    for (int m = gw; m < MTOK; m += NGW) {
        const v4f* xr = (const v4f*)(X + (size_t)m * DM) + lane;
        v4f v[8]; float s = 0.f;
#pragma unroll
        for (int j = 0; j < 8; ++j) { v[j] = xr[64 * j]; s += (v[j].x * v[j].x + v[j].y * v[j].y) + (v[j].z * v[j].z + v[j].w * v[j].w); }
        const float r = 1.0f / sqrtf(wave_sum(s) * (1.f / DM) + RMS_EPS);
        if (OUTF) {
            v4f* o = (v4f*)(OUTF + (size_t)m * DM) + lane;
#pragma unroll
            for (int j = 0; j < 8; ++j) o[64 * j] = v[j] * r * gv[j];
        } else {
            v2u* o = (v2u*)(XN + (size_t)m * DM) + lane;
#pragma unroll
            for (int j = 0; j < 8; ++j) { const v4f y = v[j] * r * gv[j]; v2u w; w.x = pkbf(y.x, y.y); w.y = pkbf(y.z, y.w); o[64 * j] = w; }
        }
    }
}

constexpr int KTB = 64 * KP, VHB = 4096 + 64, VTB = 2 * VHB;
constexpr int ATT_K = 0, ATT_V = 3 * KTB, ATT_AUX = ATT_V + 3 * VTB, ATT_END = ATT_AUX + 3 * 64 * 4 + 128;
static_assert(ATT_END == 53504, "attention LDS map");

__device__ __forceinline__ void qk_tile(const LAS unsigned char* Kt, const v8s (&qf)[4], v16f& p0, v16f& p1, int r32, int hi) {
    const LAS unsigned char* kb = Kt + r32 * KP + hi * 16;
    v16f z;
#pragma unroll
    for (int r = 0; r < 16; ++r) z[r] = 0.f;
    p0 = z; p1 = z;
#pragma unroll
    for (int s = 0; s < 4; ++s) {
        const v8s a0 = *(const LAS v8s*)(kb + s * 32);
        const v8s a1 = *(const LAS v8s*)(kb + 32 * KP + s * 32);
        p0 = mfma32(a0, qf[s], p0); p1 = mfma32(a1, qf[s], p1);
    }
}
__device__ __forceinline__ v4s trrd(const LAS unsigned char* p) { return __builtin_bit_cast(v4s, __builtin_amdgcn_ds_read_tr16_b64_v4i16((LAS v4s*)p)); }
__device__ __forceinline__ void pv_tile(const LAS unsigned char* Vt, const v16f& p0, const v16f& p1, v16f (&oT)[2], int lane) {
    const int hi = lane >> 5;
    v4u w[4];
    w[0] = (v4u){pkbf(p0[0], p0[1]), pkbf(p0[2], p0[3]), pkbf(p0[4], p0[5]), pkbf(p0[6], p0[7])};
    w[1] = (v4u){pkbf(p0[8], p0[9]), pkbf(p0[10], p0[11]), pkbf(p0[12], p0[13]), pkbf(p0[14], p0[15])};
    w[2] = (v4u){pkbf(p1[0], p1[1]), pkbf(p1[2], p1[3]), pkbf(p1[4], p1[5]), pkbf(p1[6], p1[7])};
    w[3] = (v4u){pkbf(p1[8], p1[9]), pkbf(p1[10], p1[11]), pkbf(p1[12], p1[13]), pkbf(p1[14], p1[15])};
    const LAS unsigned char* vb = Vt + (4 * hi + ((lane & 15) >> 2)) * 64 + (16 * ((lane >> 4) & 1) + 4 * (lane & 3)) * 2;
#pragma unroll
    for (int dt = 0; dt < 2; ++dt)
#pragma unroll
        for (int ks = 0; ks < 4; ++ks) {
            const int kvb = 16 * (ks & 1) + 32 * (ks >> 1);
            const v4s lo = trrd(vb + dt * VHB + kvb * 64), h4 = trrd(vb + dt * VHB + (kvb + 8) * 64);
            const v8s af = (v8s){lo[0], lo[1], lo[2], lo[3], h4[0], h4[1], h4[2], h4[3]};
            oT[dt] = mfma32(af, __builtin_bit_cast(v8s, w[ks]), oT[dt]);
        }
}
__device__ __forceinline__ float max3f(float a, float b, float c) { return __builtin_fmaxf(__builtin_fmaxf(a, b), c); }
__device__ __forceinline__ void softmax_step(v16f& p0, v16f& p1, v16f (&oT)[2], float& m, float& l, bool rowok) {
    float a = max3f(p0[0], p0[1], p1[0]), b = max3f(p0[2], p0[3], p1[1]); a = max3f(a, p1[2], p1[3]);
#pragma unroll
    for (int r = 4; r < 16; r += 4) { a = max3f(a, p0[r], p0[r + 1]); b = max3f(b, p0[r + 2], p0[r + 3]); a = max3f(a, p1[r], p1[r + 1]); b = max3f(b, p1[r + 2], p1[r + 3]); }
    float mx = fmaxf(a, b);
    mx = fmaxf(mx, __shfl_xor(mx, 32));
    if (!rowok) mx = -INFINITY;
    const float mn = fmaxf(m, mx);
    const float mu = (mn == -INFINITY) ? 0.f : mn;
    if (__any(mn > m)) {
        const float alpha = ex2(m - mu);
        oT[0] = oT[0] * alpha; oT[1] = oT[1] * alpha; l *= alpha;
    }
    const float mue = rowok ? mu : INFINITY;
    p0 = p0 - mue; p1 = p1 - mue;
#pragma unroll
    for (int r = 0; r < 16; ++r) { p0[r] = ex2(p0[r]); p1[r] = ex2(p1[r]); }
    const v16f s = p0 + p1;
    l += ((s[0] + s[1]) + (s[2] + s[3])) + ((s[4] + s[5]) + (s[6] + s[7])) + (((s[8] + s[9]) + (s[10] + s[11])) + ((s[12] + s[13]) + (s[14] + s[15])));
    m = mn;
}
__device__ __forceinline__ v4u ld_tile(const bf16_t* base, int row0, int pitch, int tid) { return *(const v4u*)(base + (size_t)(row0 + (tid >> 3)) * pitch + (tid & 7) * 8); }
__device__ __forceinline__ void st_k(LAS unsigned char* T, v4u v, int tid) { *(LAS v4u*)(T + (tid >> 3) * KP + (tid & 7) * 16) = v; }
__device__ __forceinline__ void st_v(LAS unsigned char* T, v4u v, int tid) { *(LAS v4u*)(T + ((tid >> 2) & 1) * VHB + (tid >> 3) * 64 + (tid & 3) * 16) = v; }
__device__ __forceinline__ void store_o(bf16_t* Orow, const v16f (&o)[2], int hi) {
#pragma unroll
    for (int dt = 0; dt < 2; ++dt)
#pragma unroll
        for (int g = 0; g < 4; ++g) { v2u w; w.x = pkbf(o[dt][4 * g], o[dt][4 * g + 1]); w.y = pkbf(o[dt][4 * g + 2], o[dt][4 * g + 3]);
            *(v2u*)(Orow + dt * 32 + 8 * g + 4 * hi) = w; }
}
__device__ __forceinline__ int rel_bucket(int n) {
    if (n < 16) return n;
    const float v = __log2f((float)n * (1.f / 16.f)) * (16.f / 6.f) + 1e-5f;
    const int b = 16 + (int)v; return b < 31 ? b : 31;
}

template <bool AUX, class Seq, class Sc>
__device__ __forceinline__ void attn_engine(LAS unsigned char* lds, const bf16_t* Kg, const bf16_t* Vg, int pitch, const float* auxg, Seq seq, const v8s (&qf)[4],
                                            v16f (&oT)[2], float& m, float& l, const Sc& sc, int tid, int lane) {
    const int r32 = lane & 31, hi = lane >> 5;
    int tc = seq.pop(); if (tc < 0) return;
    int tn = seq.pop(), tnn = (tn >= 0) ? seq.pop() : -1;
    LAS float* AUXL = (LAS float*)(lds + ATT_AUX);
    v4u kr = ld_tile(Kg, 64 * tc, pitch, tid), vr = ld_tile(Vg, 64 * tc, pitch, tid); float ar = 0.f;
    if (AUX && tid < 64) ar = auxg[64 * tc + tid];
    v4u kr2 = kr, vr2 = vr; float ar2 = 0.f;
    if (tn >= 0) { kr2 = ld_tile(Kg, 64 * tn, pitch, tid); vr2 = ld_tile(Vg, 64 * tn, pitch, tid); if (AUX && tid < 64) ar2 = auxg[64 * tn + tid]; }
    __syncthreads();
    st_k(lds + ATT_K, kr, tid); st_v(lds + ATT_V, vr, tid); if (AUX && tid < 64) AUXL[tid] = ar;
    if (tn >= 0) { st_k(lds + ATT_K + KTB, kr2, tid); st_v(lds + ATT_V + VTB, vr2, tid); if (AUX && tid < 64) AUXL[64 + tid] = ar2; }
    if (tnn >= 0) { kr = ld_tile(Kg, 64 * tnn, pitch, tid); vr = ld_tile(Vg, 64 * tnn, pitch, tid); if (AUX && tid < 64) ar = auxg[64 * tnn + tid]; }
    __syncthreads();
    v16f a0, a1, b0, b1;
    int bi = 0;
    if (sc.active(tc)) { qk_tile(lds + ATT_K, qf, a0, a1, r32, hi); sc.apply(a0, a1, tc, AUXL); }
#define ATT_STEP(C0, C1, N0, N1) { \
        __syncthreads(); \
        const int b2_ = (bi >= 1) ? bi - 1 : 2, b1_ = (bi == 2) ? 0 : bi + 1; int t3_ = -1; \
        if (tnn >= 0) { st_k(lds + ATT_K + b2_ * KTB, kr, tid); st_v(lds + ATT_V + b2_ * VTB, vr, tid); if (AUX && tid < 64) AUXL[b2_ * 64 + tid] = ar; \
            t3_ = seq.pop(); \
            if (t3_ >= 0) { kr = ld_tile(Kg, 64 * t3_, pitch, tid); vr = ld_tile(Vg, 64 * t3_, pitch, tid); if (AUX && tid < 64) ar = auxg[64 * t3_ + tid]; } } \
        const bool actn_ = (tn >= 0) && sc.active(tn); \
        if (actn_) qk_tile(lds + ATT_K + b1_ * KTB, qf, N0, N1, r32, hi); \
        __builtin_amdgcn_sched_barrier(0); \
        if (sc.active(tc)) { softmax_step(C0, C1, oT, m, l, sc.rowok(tc)); pv_tile(lds + ATT_V + bi * VTB, C0, C1, oT, lane); } \
        if (actn_) sc.apply(N0, N1, tn, AUXL + b1_ * 64); \
        tc = tn; tn = tnn; tnn = t3_; bi = b1_; \
        if (tc < 0) break; }
    for (;;) {
        ATT_STEP(a0, a1, b0, b1)
        ATT_STEP(b0, b1, a0, a1)
    }
#undef ATT_STEP
}
struct RangeSeq { int cur, last; __device__ __forceinline__ int pop() { const int t = cur; if (t > last) return -1; cur = t + 1; return t; } };
struct MaskSeq { unsigned long long rem; __device__ __forceinline__ int pop() { if (rem == 0ull) return -1; const int t = __builtin_ctzll(rem); rem &= rem - 1ull; return t; } };

__device__ __forceinline__ void cumsum_phase(LAS unsigned char* lds, const bf16_t* QKV, const float* fb, float* CL2) {
    const int tid = mk_ltid(), lane = tid & 63, wave = tid >> 6;
    LAS float* wtot = (LAS float*)lds;
    for (int u = mk_bid(); u < NB * 32; u += mk_grid()) {
        const int b = u >> 5, h = u & 31; const float bias = fb[h];
        float v[8]; float run = 0.f;
#pragma unroll
        for (int i = 0; i < 8; ++i) { const int t = tid * 8 + i; const float x = bf2f(QKV[(size_t)(b * SEQ + t) * ODD_PAD + O_F + h]) + bias;
            const float ls = fminf(x, 0.f) - log1pf(expf(-fabsf(x))); run += ls; v[i] = run; }
        float inc = run;
#pragma unroll
        for (int o = 1; o < 64; o <<= 1) { const float t = __shfl_up(inc, o); if (lane >= o) inc += t; }
        __syncthreads();
        if (lane == 63) wtot[wave] = inc;
        __syncthreads();
        float off = inc - run;
        for (int w2 = 0; w2 < wave; ++w2) off += wtot[w2];
        float* o = CL2 + (size_t)u * SEQ + tid * 8;
#pragma unroll
        for (int i = 0; i < 8; ++i) o[i] = (v[i] + off) * LOG2E;
    }
}

struct FoxSc {
    int qw0, qpos, hi;
    __device__ __forceinline__ bool active(int t) const { return 64 * t <= qw0 + 31; }
    __device__ __forceinline__ bool rowok(int) const { return true; }
    __device__ __forceinline__ void apply(v16f& p0, v16f& p1, int t, const LAS float* aux) const {
        const LAS float* kbp = aux + 4 * hi;
        v16f c0, c1;
#pragma unroll
        for (int g = 0; g < 4; ++g) {
            const v4f x0 = *(const LAS v4f*)(kbp + 8 * g), x1 = *(const LAS v4f*)(kbp + 32 + 8 * g);
#pragma unroll
            for (int e = 0; e < 4; ++e) { c0[4 * g + e] = x0[e]; c1[4 * g + e] = x1[e]; }
        }
        p0 = p0 * C1 - c0; p1 = p1 * C1 - c1;
        if (64 * t + 63 > qw0) {
#pragma unroll
            for (int r = 0; r < 16; ++r) { const int kv = 64 * t + crow(r, hi);
                if (kv > qpos) p0[r] = -INFINITY; if (kv + 32 > qpos) p1[r] = -INFINITY; }
        }
    }
};

__device__ __forceinline__ void fox_phase(LAS unsigned char* lds, const bf16_t* QKV, const float* CL2, bf16_t* AO) {
    const int w = __builtin_amdgcn_readfirstlane(mk_ltid() >> 6);
    for (int j = mk_bid(); j < NB * 32 * 16; j += mk_grid()) {
        const int tid = mk_ltid(), lane = tid & 63, r32 = lane & 31, hi = lane >> 5;
        const int rr = j >> 7, bh = j & 127, i2 = rr >> 1; int sel = rr & 1; if (i2 & 1) sel ^= 1;
        const int qb = 15 - (2 * i2 + sel), b = bh >> 5, h = bh & 31;
        const int q0 = qb * 256, qw0 = q0 + 32 * w, qpos = qw0 + r32;
        const bf16_t* Qg = QKV + (size_t)(b * SEQ + qpos) * ODD_PAD + O_Q + h * 64 + hi * 8;
        v8s qf[4];
#pragma unroll
        for (int s = 0; s < 4; ++s) qf[s] = *(const v8s*)(Qg + s * 16);
        const bf16_t* Kg = QKV + (size_t)(b * SEQ) * ODD_PAD + O_K + h * 64;
        const bf16_t* Vg = QKV + (size_t)(b * SEQ) * ODD_PAD + O_V + h * 64;
        v16f oT[2];
#pragma unroll
        for (int r = 0; r < 16; ++r) { oT[0][r] = 0.f; oT[1][r] = 0.f; }
        float m = -INFINITY, l = 0.f;
        const FoxSc sc{qw0, qpos, hi};
        attn_engine<true>(lds, Kg, Vg, ODD_PAD, CL2 + (size_t)(b * 32 + h) * SEQ, RangeSeq{0, (q0 + 256) / 64 - 1}, qf, oT, m, l, sc, tid, lane);
        l += __shfl_xor(l, 32);
        const float inv = 1.f / l;
        oT[0] = oT[0] * inv; oT[1] = oT[1] * inv;
        store_o(AO + (size_t)(b * SEQ + qpos) * DM + h * 64, oT, hi);
    }
}

__device__ __forceinline__ float gelu_tanh(float x) {
    const float u = 0.7978845608028654f * (x + 0.044715f * x * x * x);
    const float t = 1.f - 2.f / (1.f + __expf(2.f * u));
    return 0.5f * x * (1.f + t);
}
__device__ __forceinline__ void compress_unit(LAS unsigned char* lds, int u, const bf16_t* QKV, const float* pe_k, const float* pe_v,
                                              const bf16_t* CW1  , const bf16_t* CW2  , bf16_t* KCMP, bf16_t* VCMP) {
    const int tid = mk_ltid(), lane = tid & 63, w = __builtin_amdgcn_readfirstlane(tid >> 6), r32 = lane & 31, hi = lane >> 5;
    const int kv = u >> 6, b = (u >> 4) & 3, g = (u >> 3) & 1, ch = u & 7;
    const float* pe = kv ? pe_v : pe_k;
    const bf16_t* W1 = CW1 + (size_t)kv * 256 * 2048; const bf16_t* W2 = CW2 + (size_t)kv * 64 * 256;
    bf16_t* OUT = (kv ? VCMP : KCMP) + (size_t)((b * 2 + g) * 256 + ch * 32) * 64;
    const int n = ch * 32 + r32;
    const bf16_t* Ag = QKV + (size_t)(b * SEQ + 16 * n) * EVEN_PAD + (kv ? E_VC : E_KC) + g * 64 + hi * 8;
    const bf16_t* Bg = W1 + (size_t)(32 * w + r32) * 2048 + hi * 8;
    LAS bf16_t* HID = (LAS bf16_t*)lds;
    LAS float* PE = (LAS float*)(lds + 20480);
    v16f acc;
#pragma unroll
    for (int r = 0; r < 16; ++r) acc[r] = 0.f;
    __syncthreads();
    *(LAS v4f*)(PE + tid * 4) = *(const v4f*)(pe + tid * 4);
    __syncthreads();
#pragma unroll 8
    for (int st = 0; st < 128; ++st) {
        const int li = st >> 2, d0 = (st & 3) * 16;
        const v4u ar = *(const v4u*)(Ag + (size_t)li * EVEN_PAD + d0);
        const v4f pa = *(const LAS v4f*)(PE + li * 64 + d0 + hi * 8), pb = *(const LAS v4f*)(PE + li * 64 + d0 + hi * 8 + 4);
        const v8s bfr = *(const v8s*)(Bg + st * 16);
        v4u aw;
        aw.x = pkbf(__uint_as_float(ar.x << 16) + pa.x, __uint_as_float(ar.x & 0xffff0000u) + pa.y);
        aw.y = pkbf(__uint_as_float(ar.y << 16) + pa.z, __uint_as_float(ar.y & 0xffff0000u) + pa.w);
        aw.z = pkbf(__uint_as_float(ar.z << 16) + pb.x, __uint_as_float(ar.z & 0xffff0000u) + pb.y);
        aw.w = pkbf(__uint_as_float(ar.w << 16) + pb.z, __uint_as_float(ar.w & 0xffff0000u) + pb.w);
        acc = mfma32(__builtin_bit_cast(v8s, aw), bfr, acc);
    }
#pragma unroll
    for (int r = 0; r < 16; ++r) HID[crow(r, hi) * 264 + 32 * w + r32] = (bf16_t)(pkbf(gelu_tanh(acc[r]), 0.f) & 0xffffu);
    __syncthreads();
    if (w < 2) {
        v16f o;
#pragma unroll
        for (int r = 0; r < 16; ++r) o[r] = 0.f;
        const bf16_t* B2 = W2 + (size_t)(32 * w + r32) * 256 + hi * 8;
#pragma unroll
        for (int st = 0; st < 16; ++st) {
            const v8s af = *(const LAS v8s*)(HID + r32 * 264 + st * 16 + hi * 8);
            const v8s bfr = *(const v8s*)(B2 + st * 16);
            o = mfma32(af, bfr, o);
        }
#pragma unroll
        for (int r = 0; r < 16; ++r) { const int nl = crow(r, hi); const bool valid = (ch * 32 + nl) < 255;
            OUT[(size_t)nl * 64 + 32 * w + r32] = valid ? (bf16_t)(pkbf(o[r], 0.f) & 0xffffu) : (bf16_t)0; }
    }
}

template <int NEGPAD>
struct TabSc {
    const LAS float* tb;
    int qpos, hi;
    __device__ __forceinline__ void apply_tab(v16f& p0, v16f& p1, int t) const {
        const LAS float* bp = tb + (NEGPAD + qpos - 64 * t - 63 - 4 * hi);
        v16f c0, c1;
#pragma unroll
        for (int r = 0; r < 16; ++r) { c0[r] = bp[63 - ((r & 3) + 8 * (r >> 2))]; c1[r] = bp[31 - ((r & 3) + 8 * (r >> 2))]; }
        p0 = p0 * C1 + c0; p1 = p1 * C1 + c1;
    }
};
struct SwaSc : TabSc<64> {
    int qw0;
    __device__ __forceinline__ bool active(int t) const { return 64 * t + 63 >= qw0 - 127 && 64 * t <= qw0 + 31; }
    __device__ __forceinline__ bool rowok(int) const { return true; }
    __device__ __forceinline__ void apply(v16f& p0, v16f& p1, int t, const LAS float*) const { apply_tab(p0, p1, t); }
};

__device__ __forceinline__ void swa_unit(LAS unsigned char* lds, int u, const bf16_t* QKV, const float* relb, const float* sinks, bf16_t* AO) {
    const int tid = mk_ltid(), lane = tid & 63, w = __builtin_amdgcn_readfirstlane(tid >> 6), r32 = lane & 31, hi = lane >> 5;
    LAS float* TB = (LAS float*)(lds + ATT_END);
    const int qblk = u >> 4, b = (u >> 2) & 3, g = u & 3;
    const int hq = 4 * g + (w >> 1), q0 = 64 * qblk, qw0 = q0 + 32 * (w & 1), qpos = qw0 + r32;
    __syncthreads();
    for (int i = tid; i < 1024; i += 512) { const int hh = i >> 8, d = (i & 255) - 64; TB[i] = (d >= 0 && d < 128) ? relb[rel_bucket(d) * 32 + 4 * g + hh] * LOG2E : -INFINITY; }
    const bf16_t* Qg = QKV + (size_t)(b * SEQ + qpos) * EVEN_PAD + E_QA + hq * 64 + hi * 8;
    v8s qf[4];
#pragma unroll
    for (int s = 0; s < 4; ++s) qf[s] = *(const v8s*)(Qg + s * 16);
    const bf16_t* Kg = QKV + (size_t)(b * SEQ) * EVEN_PAD + E_KA + g * 64;
    const bf16_t* Vg = QKV + (size_t)(b * SEQ) * EVEN_PAD + E_VA + g * 64;
    v16f oT[2];
#pragma unroll
    for (int r = 0; r < 16; ++r) { oT[0][r] = 0.f; oT[1][r] = 0.f; }
    float m = -INFINITY, l = 0.f;
    SwaSc sc; sc.tb = TB + (w >> 1) * 256; sc.qpos = qpos; sc.hi = hi; sc.qw0 = qw0;
    attn_engine<false>(lds, Kg, Vg, EVEN_PAD, nullptr, RangeSeq{(qblk >= 2) ? qblk - 2 : 0, qblk}, qf, oT, m, l, sc, tid, lane);
    l += __shfl_xor(l, 32);
    const float sk = sinks[hq] * LOG2E;
    const float mf = fmaxf(m, sk);
    const float a = ex2(m - mf);
    const float inv = a / (l * a + ex2(sk - mf));
    oT[0] = oT[0] * inv; oT[1] = oT[1] * inv;
    store_o(AO + (size_t)(b * SEQ + qpos) * DM + hq * 64, oT, hi);
}

__device__ __forceinline__ void evenA_phase(LAS unsigned char* lds, const bf16_t* QKV, const float* relb, const float* sinks, const float* pe_k, const float* pe_v,
                                            const bf16_t* CW1, const bf16_t* CW2, bf16_t* KCMP, bf16_t* VCMP, bf16_t* AO) {
    for (int u = mk_bid(); u < 128 + 1024; u += mk_grid()) {
        if (u < 128) compress_unit(lds, u, QKV, pe_k, pe_v, CW1, CW2, KCMP, VCMP);
        else swa_unit(lds, u - 128, QKV, relb, sinks, AO);
    }
}

constexpr int NSA_TS = 1184, NSA_TW = 704;
constexpr int NSA_OFF_TS = ATT_END, NSA_OFF_TW = NSA_OFF_TS + 8 * NSA_TS * 4, NSA_OFF_IMP = NSA_OFF_TW + 8 * NSA_TW * 4, NSA_OFF_SEL = NSA_OFF_IMP + 32 * 64 * 4, NSA_OFF_UNI = NSA_OFF_SEL + 32 * 8;
static_assert(NSA_OFF_UNI + 64 <= LDS_BYTES, "NSA LDS map");

struct NsaSelSc : TabSc<64> {
    int q0; unsigned mlo, mhi;
    __device__ __forceinline__ bool active(int) const { return true; }
    __device__ __forceinline__ bool rowok(int t) const { return ((t < 32 ? (mlo >> t) : (mhi >> (t - 32))) & 1u) != 0u; }
    __device__ __forceinline__ void apply(v16f& p0, v16f& p1, int t, const LAS float*) const {
        if (q0 - (64 * t + 63) >= 1024) { const float b31 = tb[64 + 1024]; p0 = p0 * C1 + b31; p1 = p1 * C1 + b31; }
        else apply_tab(p0, p1, t);
    }
};
struct NsaWinSc : TabSc<64> {
    __device__ __forceinline__ bool active(int) const { return true; }
    __device__ __forceinline__ bool rowok(int) const { return true; }
    __device__ __forceinline__ void apply(v16f& p0, v16f& p1, int t, const LAS float*) const { apply_tab(p0, p1, t); }
};

__device__ __forceinline__ void nsa_phase(LAS unsigned char* lds, const bf16_t* QKV, const float* relb, const bf16_t* KCMP, const bf16_t* VCMP, bf16_t* AO) {
    const int w = __builtin_amdgcn_readfirstlane(mk_ltid() >> 6);
    LAS unsigned char* KT = lds + ATT_K; LAS unsigned char* VT = lds + ATT_V;
    LAS float* TS = (LAS float*)(lds + NSA_OFF_TS); LAS float* TW = (LAS float*)(lds + NSA_OFF_TW); LAS unsigned* IMP = (LAS unsigned*)(lds + NSA_OFF_IMP);
    LAS unsigned* SEL = (LAS unsigned*)(lds + NSA_OFF_SEL); LAS unsigned* UNI = (LAS unsigned*)(lds + NSA_OFF_UNI);
    int cur_g = -1;
#define NSA_GATE(i) (1.f / (1.f + __expf(-bf2f(QKV[(size_t)(b * SEQ + qpos) * EVEN_PAD + E_GT + hq * 3 + (i)]))))
    for (int u = mk_bid(); u < 1024; u += mk_grid()) {
        const int qblk = 127 - (u >> 3), b = (u >> 1) & 3, g = u & 1;
        const int hq = 8 * g + w, q0 = 32 * qblk, bg = b * 2 + g;
        v8s qf[4]; v16f ot[2], oT[2];
        {
            const int tid = mk_ltid(), lane = tid & 63, r32 = lane & 31, hi = lane >> 5, qpos = q0 + r32;
            __syncthreads();
            if (g != cur_g) { cur_g = g;
                for (int i = tid; i < 8 * NSA_TS; i += 512) { const int hh = i / NSA_TS, d = i - hh * NSA_TS - 64;
                    TS[i] = (d >= 0) ? relb[rel_bucket(d < 1024 ? d : 1024) * 32 + 16 + 8 * g + hh] * LOG2E : -INFINITY; }
                for (int i = tid; i < 8 * NSA_TW; i += 512) { const int hh = i / NSA_TW, d = i - hh * NSA_TW - 64;
                    TW[i] = (d >= 0 && d < 512) ? relb[rel_bucket(d) * 32 + 16 + 8 * g + hh] * LOG2E : -INFINITY; } }
            for (int i = tid; i < 32 * 64; i += 512) IMP[i] = 0u;
            if (tid < 2) UNI[tid] = 0u;
            const bf16_t* Qrow = QKV + (size_t)(b * SEQ + qpos) * EVEN_PAD;
#pragma unroll
            for (int s = 0; s < 4; ++s) qf[s] = *(const v8s*)(Qrow + E_QB + hq * 64 + hi * 8 + s * 16);
#pragma unroll
            for (int r = 0; r < 16; ++r) { ot[0][r] = 0.f; ot[1][r] = 0.f; }
        }
        const bf16_t* Kc = KCMP + (size_t)bg * 256 * 64; const bf16_t* Vc = VCMP + (size_t)bg * 256 * 64;
        const int nct = (2 * qblk) / 64 + 1;
        float m = -INFINITY, l = 0.f;
        {
            const int tid = mk_ltid(), lane = tid & 63, r32 = lane & 31, hi = lane >> 5, qpos = q0 + r32; const LAS float* tb = TS + w * NSA_TS + 64;
            v4u kr = ld_tile(Kc, 0, 64, tid);
            for (int t = 0; t < nct; ++t) {
                const int buf = t & 1;
                st_k(KT + buf * KTB, kr, tid);
                __syncthreads();
                if (t + 1 < nct) kr = ld_tile(Kc, 64 * (t + 1), 64, tid);
                v16f p0, p1;
                qk_tile(KT + buf * KTB, qf, p0, p1, r32, hi);
                float mx = -INFINITY;
#pragma unroll
                for (int r = 0; r < 16; ++r) {
                    const int c0 = 64 * t + crow(r, hi); const int d0 = qpos - 16 * c0 - 31, d1 = d0 - 512;
                    p0[r] = p0[r] * C1 + tb[min(max(d0, -1), 1024)]; p1[r] = p1[r] * C1 + tb[min(max(d1, -1), 1024)];
                    mx = fmaxf(mx, fmaxf(p0[r], p1[r]));
                }
                mx = fmaxf(mx, __shfl_xor(mx, 32));
                const float mn = fmaxf(m, mx), mu = (mn == -INFINITY) ? 0.f : mn;
                float rs = 0.f;
#pragma unroll
                for (int r = 0; r < 16; ++r) rs += ex2(p0[r] - mu) + ex2(p1[r] - mu);
                l = l * ex2(m - mu) + rs; m = mn;
            }
        }
        l += __shfl_xor(l, 32);
        {
            const int tid = mk_ltid(), lane = tid & 63, r32 = lane & 31, hi = lane >> 5, qpos = q0 + r32; const LAS float* tb = TS + w * NSA_TS + 64;
            const float mu = (m == -INFINITY) ? 0.f : m, il = (l > 0.f) ? 1.f / l : 0.f;
            const float gt0 = NSA_GATE(0);
            __syncthreads();
            v4u kr = ld_tile(Kc, 0, 64, tid), vr = ld_tile(Vc, 0, 64, tid);
            for (int t = 0; t < nct; ++t) {
                const int buf = t & 1;
                st_k(KT + buf * KTB, kr, tid); st_v(VT + buf * VTB, vr, tid);
                __syncthreads();
                if (t + 1 < nct) { kr = ld_tile(Kc, 64 * (t + 1), 64, tid); vr = ld_tile(Vc, 64 * (t + 1), 64, tid); }
                v16f p0, p1;
                qk_tile(KT + buf * KTB, qf, p0, p1, r32, hi);
#pragma unroll
                for (int r = 0; r < 16; ++r) {
                    const int c0 = 64 * t + crow(r, hi); const int d0 = qpos - 16 * c0 - 31, d1 = d0 - 512;
                    p0[r] = ex2(p0[r] * C1 + tb[min(max(d0, -1), 1024)] - mu) * il; p1[r] = ex2(p1[r] * C1 + tb[min(max(d1, -1), 1024)] - mu) * il;
                }
#pragma unroll
                for (int gq = 0; gq < 4; ++gq) {
                    const int sb0 = 16 * t + 2 * gq + hi, sb1 = sb0 + 8;
                    const unsigned a0 = (unsigned)(((p0[4 * gq] + p0[4 * gq + 1]) + (p0[4 * gq + 2] + p0[4 * gq + 3])) * 4194304.f + 0.5f);
                    const unsigned a1 = (unsigned)(((p1[4 * gq] + p1[4 * gq + 1]) + (p1[4 * gq + 2] + p1[4 * gq + 3])) * 4194304.f + 0.5f);
                    const unsigned e0 = (unsigned)(p0[4 * gq + 3] * 4194304.f + 0.5f), e1 = (unsigned)(p1[4 * gq + 3] * 4194304.f + 0.5f);
                    lds_add(IMP + r32 * 64 + sb0, a0); lds_add(IMP + r32 * 64 + sb1, a1);
                    lds_add(IMP + r32 * 64 + sb0 + 1, e0); if (sb1 + 1 < 64) lds_add(IMP + r32 * 64 + sb1 + 1, e1);
                }
                p0 = p0 * gt0; p1 = p1 * gt0;
                pv_tile(VT + buf * VTB, p0, p1, ot, lane);
            }
        }
        __syncthreads();
#pragma unroll 1
        for (int i = 0; i < 4; ++i) {
            const int lane = mk_ltid() & 63;
            const int qi = 4 * w + i, qp = q0 + qi, cur = qp >> 6;
            const unsigned v = IMP[qi * 64 + lane];
            const bool fut = lane > cur, forced = (lane == 0) || (lane == cur) || (lane == cur - 1);
            const unsigned key = ((fut ? 0u : (forced ? 0x3ffffffu : min(v + 1u, 0x3fffffeu))) << 6) | (unsigned)(63 - lane);
            int cnt = 0;
#pragma unroll
            for (int jj = 0; jj < 64; ++jj) { const unsigned kj = (unsigned)__builtin_amdgcn_readlane((int)key, jj); cnt += (kj > key) ? 1 : 0; }
            const unsigned long long msk = __ballot(!fut && cnt < 16);
            if (lane == 0) { SEL[2 * qi] = (unsigned)msk; SEL[2 * qi + 1] = (unsigned)(msk >> 32); lds_or(UNI, (unsigned)msk); lds_or(UNI + 1, (unsigned)(msk >> 32)); }
        }
        __syncthreads();
        {
            const int tid = mk_ltid(), lane = tid & 63, r32 = lane & 31, hi = lane >> 5, qpos = q0 + r32;
            const unsigned long long uni = ((unsigned long long)(unsigned)__builtin_amdgcn_readfirstlane((int)UNI[1]) << 32) | (unsigned)__builtin_amdgcn_readfirstlane((int)UNI[0]);
            const bf16_t* Kg = QKV + (size_t)(b * SEQ) * EVEN_PAD + E_KS + g * 64; const bf16_t* Vg = QKV + (size_t)(b * SEQ) * EVEN_PAD + E_VS + g * 64;
#pragma unroll
            for (int r = 0; r < 16; ++r) { oT[0][r] = 0.f; oT[1][r] = 0.f; }
            m = -INFINITY; l = 0.f;
            NsaSelSc sc; sc.tb = TS + w * NSA_TS; sc.qpos = qpos; sc.hi = hi; sc.q0 = q0; sc.mlo = SEL[2 * r32]; sc.mhi = SEL[2 * r32 + 1];
            attn_engine<false>(lds, Kg, Vg, EVEN_PAD, nullptr, MaskSeq{uni}, qf, oT, m, l, sc, tid, lane);
            l += __shfl_xor(l, 32);
            const float scl = (l > 0.f) ? NSA_GATE(1) / l : 0.f;
            ot[0] = ot[0] + oT[0] * scl; ot[1] = ot[1] + oT[1] * scl;
        }
        {
            const int tid = mk_ltid(), lane = tid & 63, r32 = lane & 31, hi = lane >> 5, qpos = q0 + r32;
            const bf16_t* Kg = QKV + (size_t)(b * SEQ) * EVEN_PAD + E_KW + g * 64; const bf16_t* Vg = QKV + (size_t)(b * SEQ) * EVEN_PAD + E_VW + g * 64;
#pragma unroll
            for (int r = 0; r < 16; ++r) { oT[0][r] = 0.f; oT[1][r] = 0.f; }
            m = -INFINITY; l = 0.f;
            NsaWinSc sc; sc.tb = TW + w * NSA_TW; sc.qpos = qpos; sc.hi = hi;
            attn_engine<false>(lds, Kg, Vg, EVEN_PAD, nullptr, RangeSeq{(q0 >= 511) ? ((q0 - 511) >> 6) : 0, (q0 + 31) >> 6}, qf, oT, m, l, sc, tid, lane);
            l += __shfl_xor(l, 32);
            const float scl = (l > 0.f) ? NSA_GATE(2) / l : 0.f;
            ot[0] = ot[0] + oT[0] * scl; ot[1] = ot[1] + oT[1] * scl;
            store_o(AO + (size_t)(b * SEQ + qpos) * DM + 1024 + hq * 64, ot, hi);
        }
    }
}

__global__ void __launch_bounds__(512, 2) fwd_mega(Args a_unused) {
    extern __shared__ __attribute__((aligned(16))) unsigned char lds_raw[];
    LAS unsigned char* lds = (LAS unsigned char*)lds_raw;
    cg::grid_group grid = cg::this_grid();
#define WSP(off) (arg_ws() + (off))
    prologue_phase(lds);
#ifdef DUP_PRO
    prologue_phase(lds);
#endif
    norm_phase(arg_in(0), arg_in(2), (bf16_t*)WSP(WS_XN), nullptr);
    grid.sync();
#pragma unroll 1
    for (int L = 0; L < 4; ++L) {
        const int e = L >> 1;
        if ((L & 1) == 0) {
            { pg8::Gemm gm{(const bf16_t*)WSP(WS_XN), (const bf16_t*)WSP(WS_WIE) + (size_t)e * EVEN_PAD * DM, MTOK, EVEN_PAD, DM}; pg8::StaticOrder S; S.init(MTOK, EVEN_PAD, mk_grid(), mk_bid());
              pg8::EpiBf16<0> E{(bf16_t*)WSP(WS_QKV), EVEN_PAD}; pg8::gemm_phase<pg8::EpiBf16<0>, pg8::StaticOrder, true, true>(lds, gm, S, E); }
            grid.sync();
            evenA_phase(lds, (const bf16_t*)WSP(WS_QKV), arg_in(1), arg_in(7) + e * 16, arg_in(8) + e * 2048, arg_in(9) + e * 2048,
                        (const bf16_t*)WSP(WS_CW1) + (size_t)e * 2 * 256 * 2048, (const bf16_t*)WSP(WS_CW2) + (size_t)e * 2 * 64 * 256, (bf16_t*)WSP(WS_KCMP), (bf16_t*)WSP(WS_VCMP), (bf16_t*)WSP(WS_AO));
            grid.sync();
#ifdef DUP_EVENA
            evenA_phase(lds, (const bf16_t*)WSP(WS_QKV), arg_in(1), arg_in(7) + e * 16, arg_in(8) + e * 2048, arg_in(9) + e * 2048,
                        (const bf16_t*)WSP(WS_CW1) + (size_t)e * 2 * 256 * 2048, (const bf16_t*)WSP(WS_CW2) + (size_t)e * 2 * 64 * 256, (bf16_t*)WSP(WS_KCMP), (bf16_t*)WSP(WS_VCMP), (bf16_t*)WSP(WS_AO));
            grid.sync();
#endif
            nsa_phase(lds, (const bf16_t*)WSP(WS_QKV), arg_in(1), (const bf16_t*)WSP(WS_KCMP), (const bf16_t*)WSP(WS_VCMP), (bf16_t*)WSP(WS_AO));
            grid.sync();
#ifdef DUP_NSA
            nsa_phase(lds, (const bf16_t*)WSP(WS_QKV), arg_in(1), (const bf16_t*)WSP(WS_KCMP), (const bf16_t*)WSP(WS_VCMP), (bf16_t*)WSP(WS_AO));
            grid.sync();
#endif
            { pg8::Gemm gm{(const bf16_t*)WSP(WS_AO), (const bf16_t*)WSP(WS_WOE) + (size_t)e * DM * DM, MTOK, DM, DM}; pg8::StaticOrder S; S.init(MTOK, DM, mk_grid(), mk_bid());
              pg8::EpiRes E{(L == 0) ? arg_in(0) : (const float*)arg_out(), arg_out(), DM}; pg8::gemm_phase<pg8::EpiRes, pg8::StaticOrder, true, true>(lds, gm, S, E); }
        } else {
            { pg8::Gemm gm{(const bf16_t*)WSP(WS_XN), (const bf16_t*)WSP(WS_WIO) + (size_t)e * ODD_PAD * DM, MTOK, ODD_PAD, DM}; pg8::StaticOrder S; S.init(MTOK, ODD_PAD, mk_grid(), mk_bid());
              pg8::EpiBf16<0> E{(bf16_t*)WSP(WS_QKV), ODD_PAD}; pg8::gemm_phase<pg8::EpiBf16<0>, pg8::StaticOrder, true, true>(lds, gm, S, E); }
            grid.sync();
            cumsum_phase(lds, (const bf16_t*)WSP(WS_QKV), arg_in(16) + e * 32, (float*)WSP(WS_C));
            grid.sync();
            fox_phase(lds, (const bf16_t*)WSP(WS_QKV), (const float*)WSP(WS_C), (bf16_t*)WSP(WS_AO));
            grid.sync();
#ifdef DUP_FOX
            fox_phase(lds, (const bf16_t*)WSP(WS_QKV), (const float*)WSP(WS_C), (bf16_t*)WSP(WS_AO));
            grid.sync();
#endif
            { pg8::Gemm gm{(const bf16_t*)WSP(WS_AO), (const bf16_t*)WSP(WS_WOO) + (size_t)e * DM * DM, MTOK, DM, DM}; pg8::StaticOrder S; S.init(MTOK, DM, mk_grid(), mk_bid());
              pg8::EpiRes E{(const float*)arg_out(), arg_out(), DM}; pg8::gemm_phase<pg8::EpiRes, pg8::StaticOrder, true, true>(lds, gm, S, E); }
        }
        grid.sync();
        norm_phase(arg_out(), arg_in(3) + L * DM, (bf16_t*)WSP(WS_XN), nullptr);
#ifdef DUP_NORM
        norm_phase(arg_out(), arg_in(3) + L * DM, (bf16_t*)WSP(WS_XN), nullptr);
#endif
        grid.sync();
        { pg8::Gemm gm{(const bf16_t*)WSP(WS_XN), (const bf16_t*)WSP(WS_WUP) + (size_t)L * DFF * DM, MTOK, DFF, DM}; pg8::StaticOrder S; S.init(MTOK, DFF, mk_grid(), mk_bid());
          pg8::EpiBf16<2> E{(bf16_t*)WSP(WS_H), DFF}; pg8::gemm_phase<pg8::EpiBf16<2>, pg8::StaticOrder, true, true>(lds, gm, S, E); }
        grid.sync();
#ifdef DUP_UP
        { pg8::Gemm gm{(const bf16_t*)WSP(WS_XN), (const bf16_t*)WSP(WS_WUP) + (size_t)L * DFF * DM, MTOK, DFF, DM}; pg8::StaticOrder S; S.init(MTOK, DFF, mk_grid(), mk_bid());
          pg8::EpiBf16<2> E{(bf16_t*)WSP(WS_H), DFF}; pg8::gemm_phase<pg8::EpiBf16<2>, pg8::StaticOrder, true, true>(lds, gm, S, E); }
        grid.sync();
#endif
        { pg8::Gemm gm{(const bf16_t*)WSP(WS_H), (const bf16_t*)WSP(WS_WDN) + (size_t)L * DM * DFF, MTOK, DM, DFF}; pg8::StaticOrder S; S.init(MTOK, DM, mk_grid(), mk_bid());
          pg8::EpiRes E{(const float*)arg_out(), arg_out(), DM}; pg8::gemm_phase<pg8::EpiRes, pg8::StaticOrder, true, true>(lds, gm, S, E); }
        grid.sync();
#ifdef DUP_NORM
        if (L < 3) norm_phase(arg_out(), arg_in(2) + (L + 1) * DM, (bf16_t*)WSP(WS_XN), nullptr);
#endif
        if (L < 3) { norm_phase(arg_out(), arg_in(2) + (L + 1) * DM, (bf16_t*)WSP(WS_XN), nullptr); grid.sync(); }
        else norm_phase(arg_out(), arg_in(4), nullptr, arg_out());
    }
#undef WSP
}

extern "C" void kernel_launch(void* const* d_in, const int* in_sizes, int n_in, void* d_out, int out_size, void* d_ws, size_t ws_size, hipStream_t stream) {
    static int grid = 0;
    if (grid == 0) {
        if (n_in != 19 || out_size != MTOK * DM || ws_size < WS_END) { fprintf(stderr, "kernel_launch: unexpected shapes (n_in %d out %d ws %zu)\n", n_in, out_size, ws_size); grid = -1; return; }
        int dev = 0, cus = 0, per_cu = 0;
        (void)hipGetDevice(&dev);
        (void)hipDeviceGetAttribute(&cus, hipDeviceAttributeMultiprocessorCount, dev);
        (void)hipFuncSetAttribute((const void*)fwd_mega, hipFuncAttributeMaxDynamicSharedMemorySize, LDS_BYTES);
        (void)hipOccupancyMaxActiveBlocksPerMultiprocessor(&per_cu, (const void*)fwd_mega, 512, LDS_BYTES);
        if (per_cu < 1) per_cu = 1;
        grid = cus * per_cu;
        fprintf(stderr, "kernel_launch: grid %d (cus %d x %d)\n", grid, cus, per_cu);
    }
    if (grid < 0) return;
    Args a{};
    for (int i = 0; i < 19; ++i) a.in[i] = (const float*)d_in[i];
    a.out = (float*)d_out; a.ws = (unsigned char*)d_ws;
    void* args[] = {&a};
    hipError_t e = hipLaunchCooperativeKernel((void*)fwd_mega, dim3(grid), dim3(512), args, LDS_BYTES, stream);
    if (e != hipSuccess) fprintf(stderr, "cooperative launch failed: %s (grid %d)\n", hipGetErrorString(e), grid);
}
```

```cpp
#include <hip/hip_runtime.h>
#include <hip/hip_cooperative_groups.h>
#include <cstdio>
#include <cstdint>
#include <cmath>
namespace cg = cooperative_groups;
__device__ __forceinline__ int mk_ltid() { int t = threadIdx.x; asm volatile("" : "+v"(t)); return t; }
__device__ __forceinline__ int mk_bid() { int t = blockIdx.x; asm volatile("" : "+s"(t)); return t; }
__device__ __forceinline__ int mk_grid() { int t = gridDim.x; asm volatile("" : "+s"(t)); return t; }
namespace pg8 {
#define PG8_LAS __attribute__((address_space(3)))
typedef unsigned short bf16_t;
typedef short bf16x8 __attribute__((ext_vector_type(8)));
typedef float f32x4 __attribute__((ext_vector_type(4)));
typedef unsigned u32x4 __attribute__((ext_vector_type(4)));
constexpr int BM = 256, BK = 64, HALF = 128, HTB = HALF * BK * 2  , STAGE_BYTES = 8 * HTB, NXCD = 8, WGM = 8;

__host__ __device__ __forceinline__ int lds_byte(int r, int c) { const int st = (r >> 4) * 2 + (c >> 5), rr = r & 15, cc = c & 31, ob = rr * 64 + cc * 2; return st * 1024 + (ob ^ (((ob >> 9) & 1) << 5)); }
__host__ __device__ __forceinline__ void stage_rc(int b, int& R, int& C) { const int st = b / 1024, sb = b % 1024, swz = sb ^ (((sb >> 9) & 1) << 5); R = (st >> 1) * 16 + swz / 64; C = (st & 1) * 32 + (swz % 64) / 2; }
__host__ __device__ __forceinline__ int perm32(int rho) { const int n = rho >> 4, i = rho & 15; return 8 * (i >> 2) + 4 * n + (i & 3); }

struct Unit { int pm, pn; };
struct Gemm { const bf16_t* A; const bf16_t* Bt; int M, N, K; };

struct StaticOrder {
    int nM, nN, nwg, G, c;
    __host__ __device__ void init(int M, int N, int G_, int c_) { nM = M / BM; nN = N / BM; nwg = nM * nN; G = G_; c = c_; }
    __host__ __device__ bool next(int i, Unit& u) const {
        const long L = (long)i * G + c; if (L >= nwg) return false;
        int wgid = (int)L; { const int q = nwg / NXCD, r = nwg % NXCD, xcd = wgid % NXCD, off = wgid / NXCD; wgid = (xcd < r ? xcd * (q + 1) : r * (q + 1) + (xcd - r) * q) + off; }
        const int nig = WGM * nN, gid = wgid / nig, fm = gid * WGM, gsz = (nM - fm) < WGM ? (nM - fm) : WGM;
        u.pm = fm + ((wgid % nig) % gsz); u.pn = (wgid % nig) / gsz; return true;
    }
    __device__ __forceinline__ void a_ready(const Unit&) const {}
    __device__ __forceinline__ void done(const Unit&) const {}
};

__device__ __forceinline__ unsigned cvt_pk_bf16(float lo, float hi) { unsigned r; asm volatile("v_cvt_pk_bf16_f32 %0, %1, %2" : "=v"(r) : "v"(lo), "v"(hi)); return r; }
typedef float f32x2 __attribute__((ext_vector_type(2)));
template <int ACT  > struct EpiBf16 {
    static constexpr bool PERM = true, AFTER_DRAIN = false;
    bf16_t* O; int ldc;
    __device__ __forceinline__ void operator()(const f32x4 (&acc)[2][2][4][2], const Unit& u, int wr, int wc, int fr, int fq) const {
        const int row0 = u.pm * BM + wr * 64 + fr; const int col0 = u.pn * BM + wc * 32 + 8 * fq;
#pragma unroll
        for (int ai = 0; ai < 2; ++ai)
#pragma unroll
            for (int m = 0; m < 4; ++m) { bf16_t* rowp = O + (size_t)(row0 + ai * HALF + m * 16) * ldc + col0;
#pragma unroll
                for (int bj = 0; bj < 2; ++bj) { f32x4 v0 = acc[ai][bj][m][0], v1 = acc[ai][bj][m][1];
                    if (ACT == 2) {
#pragma unroll
                        for (int e = 0; e < 4; ++e) { float a = v0[e] > 0.f ? v0[e] : 0.f; v0[e] = a * a; float b = v1[e] > 0.f ? v1[e] : 0.f; v1[e] = b * b; } }
                    u32x4 w; w.x = cvt_pk_bf16(v0[0], v0[1]); w.y = cvt_pk_bf16(v0[2], v0[3]); w.z = cvt_pk_bf16(v1[0], v1[1]); w.w = cvt_pk_bf16(v1[2], v1[3]);
                    *(u32x4*)(rowp + bj * HALF) = w; } }
    }
};
struct EpiRes {
    static constexpr bool PERM = false, AFTER_DRAIN = false;
    const float* base; float* out; int ldc;
    __device__ __forceinline__ void operator()(const f32x4 (&acc)[2][2][4][2], const Unit& u, int wr, int wc, int fr, int fq) const {
        const int row0 = u.pm * BM + wr * 64 + fr; const int col0 = u.pn * BM + wc * 32 + 4 * fq;
#pragma unroll
        for (int ai = 0; ai < 2; ++ai)
#pragma unroll
            for (int m = 0; m < 4; ++m) { const size_t off = (size_t)(row0 + ai * HALF + m * 16) * ldc + col0;
#pragma unroll
                for (int bj = 0; bj < 2; ++bj)
#pragma unroll
                    for (int n = 0; n < 2; ++n) { const f32x4 b = *(const f32x4*)(base + off + bj * HALF + n * 16); *(f32x4*)(out + off + bj * HALF + n * 16) = b + acc[ai][bj][m][n]; } }
    }
};
template <class Epi, class Sched, bool ALIGN_EPI = false, bool SP2 = false>
__device__ __forceinline__ void gemm_phase(PG8_LAS unsigned char* lds, const Gemm g, const Sched& S, const Epi& E) {
    const int tid = mk_ltid(), wid = __builtin_amdgcn_readfirstlane(tid >> 6), lane = tid & 63, wr = wid >> 2, wc = wid & 3, fr = lane & 15, fq = lane >> 4;
    const int K = g.K, nt = K / BK;
    unsigned voffA[2], voffB[2];
#pragma unroll
    for (int i = 0; i < 2; ++i) { int R, C; stage_rc(tid * 16 + i * 8192, R, C); const int Rb = Epi::PERM ? ((R & ~31) + perm32(R & 31)) : R;
        voffA[i] = (unsigned)(R * K + C) * 2u; voffB[i] = (unsigned)(Rb * K + C) * 2u; }
    const size_t kstep = (size_t)(BK * 2);
    const size_t hstep = (size_t)HALF * K * 2;
    const size_t tstep = 2 * hstep;
    const unsigned ldsw = (unsigned)wid * 1024u;
    const int aoff = lds_byte(wr * 64 + fr, fq * 8), boff = lds_byte(wc * 32 + fr, fq * 8);
#define PG8_SA(b, h) (((b) * 2 + (h)) * HTB)
#define PG8_SB(b, h) ((4 + (b) * 2 + (h)) * HTB)
#define PG8_STAGE(bufoff, gbase, voff) do { _Pragma("unroll") for (int _i = 0; _i < 2; ++_i) \
        __builtin_amdgcn_global_load_lds((const unsigned*)((const char*)(gbase) + (voff)[_i]), (PG8_LAS unsigned*)(lds + (bufoff) + ldsw + _i * 8192), 16, 0, 0); } while (0)
#define PG8_LDA(dst, b, h) do { _Pragma("unroll") for (int m = 0; m < 4; ++m) _Pragma("unroll") for (int k = 0; k < 2; ++k) dst[m][k] = *(const PG8_LAS bf16x8*)(lds + PG8_SA(b, h) + aoff + m * 2048 + k * 1024); } while (0)
#define PG8_LDB(dst, b, h) do { _Pragma("unroll") for (int n = 0; n < 2; ++n) _Pragma("unroll") for (int k = 0; k < 2; ++k) dst[n][k] = *(const PG8_LAS bf16x8*)(lds + PG8_SB(b, h) + boff + n * 2048 + k * 1024); } while (0)
#define PG8_MMA(ai, bj, At, Bt) do { __builtin_amdgcn_s_setprio(1); _Pragma("unroll") for (int m = 0; m < 4; ++m) _Pragma("unroll") for (int n = 0; n < 2; ++n) _Pragma("unroll") for (int k = 0; k < 2; ++k) \
        acc[ai][bj][m][n] = __builtin_amdgcn_mfma_f32_16x16x32_bf16(Bt[n][k], At[m][k], acc[ai][bj][m][n], 0, 0, 0); __builtin_amdgcn_s_setprio(0); } while (0)
#define PG8_WAIT_V(n) asm volatile("s_waitcnt vmcnt(" #n ")" ::: "memory")
#define PG8_WAIT_L(n) asm volatile("s_waitcnt lgkmcnt(" #n ")" ::: "memory")
#define PG8_BAR __builtin_amdgcn_s_barrier()
#define PG8_SCHED __builtin_amdgcn_sched_barrier(0)
    Unit cur, nxt; int ui = 0;
    if (!S.next(0, cur)) return;
    f32x4 acc[2][2][4][2];
#pragma unroll
    for (int a = 0; a < 2; ++a)
#pragma unroll
        for (int b = 0; b < 2; ++b)
#pragma unroll
            for (int m = 0; m < 4; ++m)
#pragma unroll
                for (int n = 0; n < 2; ++n) acc[a][b][m][n] = (f32x4){0.f, 0.f, 0.f, 0.f};
    bf16x8 At[4][2], B0[2][2], B1[2][2];
    const char* cA = (const char*)g.A + (size_t)cur.pm * tstep; const char* cB = (const char*)g.Bt + (size_t)cur.pn * tstep;
    S.a_ready(cur);
    if constexpr (SP2) {
        PG8_STAGE(PG8_SB(0, 0), cB, voffB); PG8_STAGE(PG8_SB(0, 1), cB + hstep, voffB); PG8_STAGE(PG8_SA(0, 0), cA, voffA); PG8_STAGE(PG8_SA(0, 1), cA + hstep, voffA);
        if (wr == 1) PG8_BAR;
        PG8_WAIT_V(2); PG8_BAR;
        PG8_STAGE(PG8_SB(1, 0), cB + kstep, voffB); PG8_STAGE(PG8_SA(1, 0), cA + kstep, voffA); PG8_STAGE(PG8_SB(1, 1), cB + hstep + kstep, voffB);
        PG8_WAIT_V(6); PG8_BAR;
    } else {
        PG8_STAGE(PG8_SB(0, 0), cB, voffB); PG8_STAGE(PG8_SA(0, 0), cA, voffA); PG8_STAGE(PG8_SB(0, 1), cB + hstep, voffB); PG8_STAGE(PG8_SA(0, 1), cA + hstep, voffA);
        if (wr == 1) PG8_BAR;
        PG8_WAIT_V(4); PG8_BAR;
        PG8_STAGE(PG8_SB(1, 0), cB + kstep, voffB); PG8_STAGE(PG8_SA(1, 0), cA + kstep, voffA); PG8_STAGE(PG8_SB(1, 1), cB + hstep + kstep, voffB);
        PG8_WAIT_V(6); PG8_BAR;
    }
    for (;;) {
        const bool has_next = S.next(ui + 1, nxt);
        const char* nA = has_next ? (const char*)g.A + (size_t)nxt.pm * tstep : cA; const char* nB = has_next ? (const char*)g.Bt + (size_t)nxt.pn * tstep : cB;
        for (int t = 0; t < nt; t += 2) {
            const bool last = (t == nt - 2);
            const char* a1 = cA + (size_t)(t + 1) * kstep;
            const char* a2 = last ? nA : cA + (size_t)(t + 2) * kstep; const char* b2 = last ? nB : cB + (size_t)(t + 2) * kstep;
            const char* a3 = a2 + kstep; const char* b3 = b2 + kstep;
            if (last && has_next) S.a_ready(nxt);
            if constexpr (SP2) {
            PG8_LDB(B0, 0, 0); PG8_LDB(B1, 0, 1); PG8_SCHED; PG8_LDA(At, 0, 0); PG8_STAGE(PG8_SA(1, 1), a1 + hstep, voffA);
            PG8_WAIT_V(8); PG8_WAIT_L(0); PG8_BAR; PG8_MMA(0, 0, At, B0); PG8_MMA(0, 1, At, B1); PG8_BAR; PG8_SCHED;
            PG8_LDA(At, 0, 1); PG8_STAGE(PG8_SB(0, 0), b2, voffB); PG8_STAGE(PG8_SB(0, 1), b2 + hstep, voffB); PG8_STAGE(PG8_SA(0, 0), a2, voffA);
            PG8_WAIT_V(8); PG8_WAIT_L(0); PG8_BAR; PG8_MMA(1, 0, At, B0); PG8_MMA(1, 1, At, B1); PG8_BAR; PG8_SCHED;
            PG8_LDB(B0, 1, 0); PG8_LDB(B1, 1, 1); PG8_SCHED; PG8_LDA(At, 1, 0); PG8_STAGE(PG8_SA(0, 1), a2 + hstep, voffA);
            PG8_WAIT_V(8); PG8_WAIT_L(0); PG8_BAR; PG8_MMA(0, 0, At, B0); PG8_MMA(0, 1, At, B1); PG8_BAR; PG8_SCHED;
            PG8_LDA(At, 1, 1); PG8_STAGE(PG8_SB(1, 0), b3, voffB); PG8_STAGE(PG8_SB(1, 1), b3 + hstep, voffB); PG8_STAGE(PG8_SA(1, 0), a3, voffA);
            PG8_WAIT_V(8); PG8_WAIT_L(0); PG8_BAR; PG8_MMA(1, 0, At, B0); PG8_MMA(1, 1, At, B1); PG8_BAR; PG8_SCHED;
            } else {
            PG8_LDB(B0, 0, 0); PG8_SCHED; PG8_LDA(At, 0, 0); PG8_STAGE(PG8_SA(1, 1), a1 + hstep, voffA);
            PG8_WAIT_L(8); PG8_BAR; PG8_WAIT_L(0); PG8_MMA(0, 0, At, B0); PG8_BAR; PG8_SCHED;
            PG8_LDB(B1, 0, 1); PG8_STAGE(PG8_SB(0, 0), b2, voffB);
            PG8_BAR; PG8_WAIT_L(0); PG8_MMA(0, 1, At, B1); PG8_BAR;
            PG8_LDA(At, 0, 1); PG8_STAGE(PG8_SA(0, 0), a2, voffA);
            PG8_BAR; PG8_WAIT_L(0); PG8_MMA(1, 0, At, B0); PG8_BAR; PG8_SCHED;
            PG8_STAGE(PG8_SB(0, 1), b2 + hstep, voffB);
            PG8_WAIT_V(6); PG8_BAR; PG8_MMA(1, 1, At, B1); PG8_BAR;
            PG8_LDB(B0, 1, 0); PG8_SCHED; PG8_LDA(At, 1, 0); PG8_STAGE(PG8_SA(0, 1), a2 + hstep, voffA);
            PG8_WAIT_L(8); PG8_BAR; PG8_WAIT_L(0); PG8_MMA(0, 0, At, B0); PG8_BAR; PG8_SCHED;
            PG8_LDB(B1, 1, 1); PG8_STAGE(PG8_SB(1, 0), b3, voffB);
            PG8_BAR; PG8_WAIT_L(0); PG8_MMA(0, 1, At, B1); PG8_BAR;
            PG8_LDA(At, 1, 1); PG8_STAGE(PG8_SA(1, 0), a3, voffA);
            PG8_BAR; PG8_WAIT_L(0); PG8_MMA(1, 0, At, B0); PG8_BAR; PG8_SCHED;
            PG8_STAGE(PG8_SB(1, 1), b3 + hstep, voffB);
            PG8_WAIT_V(6); PG8_BAR; PG8_MMA(1, 1, At, B1); PG8_BAR;
            }
        }
        if constexpr (ALIGN_EPI) { if (wr == 0) PG8_BAR; }
        if constexpr (!Epi::AFTER_DRAIN) { E(acc, cur, wr, wc, fr, fq); S.done(cur); }
        if (!has_next) break;
#pragma unroll
        for (int a = 0; a < 2; ++a)
#pragma unroll
            for (int b = 0; b < 2; ++b)
#pragma unroll
                for (int m = 0; m < 4; ++m)
#pragma unroll
                    for (int n = 0; n < 2; ++n) acc[a][b][m][n] = (f32x4){0.f, 0.f, 0.f, 0.f};
        cur = nxt; cA = nA; cB = nB; ++ui;
        if constexpr (ALIGN_EPI) { if (wr == 1) PG8_BAR; }
    }
    PG8_WAIT_V(0);
    if constexpr (!ALIGN_EPI) { if (wr == 0) PG8_BAR; }
    PG8_BAR;
    if constexpr (Epi::AFTER_DRAIN) { E.fused(acc, cur, wr, wc, fr, fq, lds, wid, lane); S.done(cur); }
#undef PG8_SA
#undef PG8_SB
#undef PG8_STAGE
#undef PG8_LDA
#undef PG8_LDB
#undef PG8_MMA
#undef PG8_WAIT_V
#undef PG8_WAIT_L
#undef PG8_BAR
#undef PG8_SCHED
}
}

#define LAS __attribute__((address_space(3)))
typedef unsigned short bf16_t;
typedef short v8s __attribute__((ext_vector_type(8)));
typedef short v4s __attribute__((ext_vector_type(4)));
typedef float v4f __attribute__((ext_vector_type(4)));
typedef float v16f __attribute__((ext_vector_type(16)));
typedef unsigned v4u __attribute__((ext_vector_type(4)));
typedef unsigned v2u __attribute__((ext_vector_type(2)));

constexpr int DM = 2048, NB = 4, SEQ = 4096, MTOK = NB * SEQ, DFF = 8192;
constexpr int EVEN_IN = 3376, EVEN_PAD = 3584, ODD_IN = 6176, ODD_PAD = 6400;
constexpr int E_QA = 0, E_KA = 1024, E_VA = 1280, E_QB = 1536, E_KC = 2560, E_VC = 2688, E_KS = 2816, E_VS = 2944, E_KW = 3072, E_VW = 3200, E_GT = 3328;
constexpr int O_Q = 0, O_K = 2048, O_V = 4096, O_F = 6144;
constexpr float LOG2E = 1.4426950408889634f;
constexpr float C1 = 0.125f * LOG2E;
constexpr float RMS_EPS = 1e-6f;

constexpr size_t MiB = 1u << 20;
constexpr size_t WS_WUP = 16 * MiB, WS_WDN = 144 * MiB, WS_WIE = 272 * MiB, WS_WIO = 300 * MiB, WS_WOE = 350 * MiB, WS_WOO = 366 * MiB;
constexpr size_t WS_CW1 = 382 * MiB, WS_CW2 = 386 * MiB, WS_KCMP = 387 * MiB, WS_VCMP = 387 * MiB + 512 * 1024, WS_C = 388 * MiB;
constexpr size_t WS_XN = 392 * MiB, WS_QKV = 456 * MiB, WS_AO = 656 * MiB, WS_H = 456 * MiB, WS_END = 720 * MiB;

constexpr int KP = 144, VP = 144, TILEB = 64 * 144;
constexpr int LDS_BYTES = 160 * 1024;

struct Args { const float* in[19]; float* out; unsigned char* ws; };
__device__ __forceinline__ const unsigned char __attribute__((address_space(4)))* karg_base() {
    const unsigned char __attribute__((address_space(4)))* kp = (const unsigned char __attribute__((address_space(4)))*)__builtin_amdgcn_kernarg_segment_ptr();
    asm volatile("" : "+s"(kp)); return kp; }
__device__ __forceinline__ const float* arg_in(int i) { return *(const float* const __attribute__((address_space(4)))*)(karg_base() + 8 * i); }
__device__ __forceinline__ float* arg_out() { return *(float* const __attribute__((address_space(4)))*)(karg_base() + 8 * 19); }
__device__ __forceinline__ unsigned char* arg_ws() { return *(unsigned char* const __attribute__((address_space(4)))*)(karg_base() + 8 * 20); }

__device__ __forceinline__ unsigned pkbf(float lo, float hi) {
    typedef float f2 __attribute__((ext_vector_type(2))); typedef __bf16 b2 __attribute__((ext_vector_type(2)));
    f2 v = {lo, hi}; b2 b = __builtin_convertvector(v, b2); return __builtin_bit_cast(unsigned, b);
}
__device__ __forceinline__ float bf2f(unsigned short u) { return __uint_as_float(((unsigned)u) << 16); }
__device__ __forceinline__ float ex2(float x) { return __builtin_amdgcn_exp2f(x); }
__device__ __forceinline__ void lds_add(LAS unsigned* p, unsigned v) { (void)__hip_atomic_fetch_add(p, v, __ATOMIC_RELAXED, __HIP_MEMORY_SCOPE_WORKGROUP); }
__device__ __forceinline__ void lds_or(LAS unsigned* p, unsigned v) { (void)__hip_atomic_fetch_or(p, v, __ATOMIC_RELAXED, __HIP_MEMORY_SCOPE_WORKGROUP); }
__device__ __forceinline__ int crow(int r, int hi) { return (r & 3) + 8 * (r >> 2) + 4 * hi; }
__device__ __forceinline__ v16f mfma32(v8s a, v8s b, v16f c) { return __builtin_amdgcn_mfma_f32_32x32x16_bf16(a, b, c, 0, 0, 0); }
__device__ __forceinline__ float wave_sum(float v) {
#pragma unroll
    for (int o = 1; o < 64; o <<= 1) v += __shfl_xor(v, o);
    return v;
}

__device__ __forceinline__ void tr_load(float (&v)[32], const float* W, int K, int N, int item, int lane) {
    const int nblk = (N + 31) / 32, kb = item / nblk, nb = item - kb * nblk, k0 = 64 * kb, n0 = 32 * nb;
    const int nn = n0 + (lane & 31); const bool ok = nn < N;
    const float* p = W + (size_t)(k0 + (lane >> 5)) * N + (ok ? nn : 0);
#pragma unroll
    for (int i = 0; i < 32; ++i) { const float x = p[(size_t)(2 * i) * N]; v[i] = ok ? x : 0.f; }
}
__device__ __forceinline__ void tr_put(const float (&v)[32], LAS float* scr, int lane) {
#pragma unroll
    for (int i = 0; i < 32; ++i) scr[(2 * i + (lane >> 5)) * 33 + (lane & 31)] = v[i];
}
__device__ __forceinline__ void tr_store(bf16_t* WT, int K, int N, LAS float* scr, int item, int lane) {
    const int nblk = (N + 31) / 32, kb = item / nblk, nb = item - kb * nblk, k0 = 64 * kb, n0 = 32 * nb;
    const int c = lane & 7;
#pragma unroll
    for (int j = 0; j < 4; ++j) { const int n = (lane >> 3) + 8 * j; const LAS float* s = scr + (8 * c) * 33 + n;
        v4u o; o.x = pkbf(s[0 * 33], s[1 * 33]); o.y = pkbf(s[2 * 33], s[3 * 33]); o.z = pkbf(s[4 * 33], s[5 * 33]); o.w = pkbf(s[6 * 33], s[7 * 33]);
        *(v4u*)(WT + (size_t)(n0 + n) * K + k0 + 8 * c) = o; }
}

__device__ __forceinline__ void prologue_phase(LAS unsigned char* lds) {
    const int tid = mk_ltid(), lane = tid & 63, wave = __builtin_amdgcn_readfirstlane(tid >> 6);
    LAS float* scr = (LAS float*)(lds + wave * 16384);
    const int gw = mk_bid() * 8 + wave, NGW = mk_grid() * 8;
    for (int mi = 0; mi < 24; ++mi) {
        unsigned char* ws = arg_ws();
        const float* W; int K, N; bf16_t* WT;
        if (mi < 4) { W = arg_in(17) + (size_t)mi * DM * DFF; K = DM; N = DFF; WT = (bf16_t*)(ws + WS_WUP) + (size_t)mi * DFF * DM; }
        else if (mi < 8) { const int L = mi - 4; W = arg_in(18) + (size_t)L * DFF * DM; K = DFF; N = DM; WT = (bf16_t*)(ws + WS_WDN) + (size_t)L * DM * DFF; }
        else if (mi < 10) { const int e = mi - 8; W = arg_in(5) + (size_t)e * DM * EVEN_IN; K = DM; N = EVEN_IN; WT = (bf16_t*)(ws + WS_WIE) + (size_t)e * EVEN_PAD * DM; }
        else if (mi < 12) { const int e = mi - 10; W = arg_in(14) + (size_t)e * DM * ODD_IN; K = DM; N = ODD_IN; WT = (bf16_t*)(ws + WS_WIO) + (size_t)e * ODD_PAD * DM; }
        else if (mi < 14) { const int e = mi - 12; W = arg_in(6) + (size_t)e * DM * DM; K = DM; N = DM; WT = (bf16_t*)(ws + WS_WOE) + (size_t)e * DM * DM; }
        else if (mi < 16) { const int e = mi - 14; W = arg_in(15) + (size_t)e * DM * DM; K = DM; N = DM; WT = (bf16_t*)(ws + WS_WOO) + (size_t)e * DM * DM; }
        else if (mi < 20) { const int e = (mi - 16) & 1, kv = (mi - 16) >> 1; W = arg_in(kv ? 12 : 10) + (size_t)e * 2048 * 256; K = 2048; N = 256; WT = (bf16_t*)(ws + WS_CW1) + (size_t)(e * 2 + kv) * 256 * 2048; }
        else { const int e = (mi - 20) & 1, kv = (mi - 20) >> 1; W = arg_in(kv ? 13 : 11) + (size_t)e * 256 * 64; K = 256; N = 64; WT = (bf16_t*)(ws + WS_CW2) + (size_t)(e * 2 + kv) * 64 * 256; }
        const int nitems = (K / 64) * ((N + 31) / 32);
        float v[32];
        int it = gw;
        if (it < nitems) tr_load(v, W, K, N, it, lane);
        while (it < nitems) {
            tr_put(v, scr, lane);
            const int nx = it + NGW;
            if (nx < nitems) tr_load(v, W, K, N, nx, lane);
            asm volatile("s_waitcnt lgkmcnt(0)" ::: "memory");
            tr_store(WT, K, N, scr, it, lane);
            asm volatile("s_waitcnt lgkmcnt(0)" ::: "memory");
            it = nx;
        }
    }
}

__device__ __forceinline__ void norm_phase(const float* X, const float* g, bf16_t* XN, float* OUTF) {
    const int tid = mk_ltid(), lane = tid & 63, wave = tid >> 6;
    const int gw = mk_bid() * 8 + wave, NGW = mk_grid() * 8;
    v4f gv[8];
#pragma unroll
    for (int j = 0; j < 8; ++j) gv[j] = *((const v4f*)g + lane + 64 * j);
    for (int m = gw; m < MTOK; m += NGW) {
        const v4f* xr = (const v4f*)(X + (size_t)m * DM) + lane;
        v4f v[8]; float s = 0.f;
#pragma unroll
        for (int j = 0; j < 8; ++j) { v[j] = xr[64 * j]; s += (v[j].x * v[j].x + v[j].y * v[j].y) + (v[j].z * v[j].z + v[j].w * v[j].w); }
        const float r = 1.0f / sqrtf(wave_sum(s) * (1.f / DM) + RMS_EPS);
        if (OUTF) {
            v4f* o = (v4f*)(OUTF + (size_t)m * DM) + lane;
#pragma unroll
            for (int j = 0; j < 8; ++j) o[64 * j] = v[j] * r * gv[j];
        } else {
            v2u* o = (v2u*)(XN + (size_t)m * DM) + lane;
#pragma unroll
            for (int j = 0; j < 8; ++j) { const v4f y = v[j] * r * gv[j]; v2u w; w.x = pkbf(y.x, y.y); w.y = pkbf(y.z, y.w); o[64 * j] = w; }
        }
    }
}

constexpr int KTB = 64 * KP, VHB = 4096 + 64, VTB = 2 * VHB;
constexpr int ATT_K = 0, ATT_V = 3 * KTB, ATT_AUX = ATT_V + 3 * VTB, ATT_END = ATT_AUX + 3 * 64 * 4 + 128;
static_assert(ATT_END == 53504, "attention LDS map");

__device__ __forceinline__ void qk_tile(const LAS unsigned char* Kt, const v8s (&qf)[4], v16f& p0, v16f& p1, int r32, int hi) {
    const LAS unsigned char* kb = Kt + r32 * KP + hi * 16;
    v16f z;
#pragma unroll
    for (int r = 0; r < 16; ++r) z[r] = 0.f;
    p0 = z; p1 = z;
#pragma unroll
    for (int s = 0; s < 4; ++s) {
        const v8s a0 = *(const LAS v8s*)(kb + s * 32);
        const v8s a1 = *(const LAS v8s*)(kb + 32 * KP + s * 32);
        p0 = mfma32(a0, qf[s], p0); p1 = mfma32(a1, qf[s], p1);
    }
}
__device__ __forceinline__ v4s trrd(const LAS unsigned char* p) { return __builtin_bit_cast(v4s, __builtin_amdgcn_ds_read_tr16_b64_v4i16((LAS v4s*)p)); }
__device__ __forceinline__ void pv_tile(const LAS unsigned char* Vt, const v16f& p0, const v16f& p1, v16f (&oT)[2], int lane) {
    const int hi = lane >> 5;
    v4u w[4];
    w[0] = (v4u){pkbf(p0[0], p0[1]), pkbf(p0[2], p0[3]), pkbf(p0[4], p0[5]), pkbf(p0[6], p0[7])};
    w[1] = (v4u){pkbf(p0[8], p0[9]), pkbf(p0[10], p0[11]), pkbf(p0[12], p0[13]), pkbf(p0[14], p0[15])};
    w[2] = (v4u){pkbf(p1[0], p1[1]), pkbf(p1[2], p1[3]), pkbf(p1[4], p1[5]), pkbf(p1[6], p1[7])};
    w[3] = (v4u){pkbf(p1[8], p1[9]), pkbf(p1[10], p1[11]), pkbf(p1[12], p1[13]), pkbf(p1[14], p1[15])};
    const LAS unsigned char* vb = Vt + (4 * hi + ((lane & 15) >> 2)) * 64 + (16 * ((lane >> 4) & 1) + 4 * (lane & 3)) * 2;
#pragma unroll
    for (int dt = 0; dt < 2; ++dt)
#pragma unroll
        for (int ks = 0; ks < 4; ++ks) {
            const int kvb = 16 * (ks & 1) + 32 * (ks >> 1);
            const v4s lo = trrd(vb + dt * VHB + kvb * 64), h4 = trrd(vb + dt * VHB + (kvb + 8) * 64);
            const v8s af = (v8s){lo[0], lo[1], lo[2], lo[3], h4[0], h4[1], h4[2], h4[3]};
            oT[dt] = mfma32(af, __builtin_bit_cast(v8s, w[ks]), oT[dt]);
        }
}

__device__ __forceinline__ void k_load(const LAS unsigned char* Kt, v8s (&kf)[8], int r32, int hi) {
    const LAS unsigned char* kb = Kt + r32 * KP + hi * 16;
#pragma unroll
    for (int s = 0; s < 4; ++s) { kf[2 * s] = *(const LAS v8s*)(kb + s * 32); kf[2 * s + 1] = *(const LAS v8s*)(kb + 32 * KP + s * 32); }
}
__device__ __forceinline__ void qk_mma(const v8s (&kf)[8], const v8s (&qf)[4], v16f& p0, v16f& p1) {
    v16f z;
#pragma unroll
    for (int r = 0; r < 16; ++r) z[r] = 0.f;
    p0 = z; p1 = z;
#pragma unroll
    for (int s = 0; s < 4; ++s) { p0 = mfma32(kf[2 * s], qf[s], p0); p1 = mfma32(kf[2 * s + 1], qf[s], p1); }
}
__device__ __forceinline__ void v_load(const LAS unsigned char* Vt, v4s (&vf)[16], int lane) {
    const int hi = lane >> 5;
    const LAS unsigned char* vb = Vt + (4 * hi + ((lane & 15) >> 2)) * 64 + (16 * ((lane >> 4) & 1) + 4 * (lane & 3)) * 2;
#pragma unroll
    for (int ks = 0; ks < 4; ++ks)
#pragma unroll
        for (int dt = 0; dt < 2; ++dt) {
            const int kvb = 16 * (ks & 1) + 32 * (ks >> 1);
            vf[4 * ks + 2 * dt] = trrd(vb + dt * VHB + kvb * 64); vf[4 * ks + 2 * dt + 1] = trrd(vb + dt * VHB + (kvb + 8) * 64);
        }
}
__device__ __forceinline__ void pv_mma(const v4s (&vf)[16], const v16f& p0, const v16f& p1, v16f (&oT)[2]) {
    v4u w[4];
    w[0] = (v4u){pkbf(p0[0], p0[1]), pkbf(p0[2], p0[3]), pkbf(p0[4], p0[5]), pkbf(p0[6], p0[7])};
    w[1] = (v4u){pkbf(p0[8], p0[9]), pkbf(p0[10], p0[11]), pkbf(p0[12], p0[13]), pkbf(p0[14], p0[15])};
    w[2] = (v4u){pkbf(p1[0], p1[1]), pkbf(p1[2], p1[3]), pkbf(p1[4], p1[5]), pkbf(p1[6], p1[7])};
    w[3] = (v4u){pkbf(p1[8], p1[9]), pkbf(p1[10], p1[11]), pkbf(p1[12], p1[13]), pkbf(p1[14], p1[15])};
#pragma unroll
    for (int ks = 0; ks < 4; ++ks)
#pragma unroll
        for (int dt = 0; dt < 2; ++dt) {
            const v4s lo = vf[4 * ks + 2 * dt], h4 = vf[4 * ks + 2 * dt + 1];
            const v8s af = (v8s){lo[0], lo[1], lo[2], lo[3], h4[0], h4[1], h4[2], h4[3]};
            oT[dt] = mfma32(af, __builtin_bit_cast(v8s, w[ks]), oT[dt]);
        }
}
__device__ __forceinline__ float max3f(float a, float b, float c) { return __builtin_fmaxf(__builtin_fmaxf(a, b), c); }
__device__ __forceinline__ void softmax_step(v16f& p0, v16f& p1, v16f (&oT)[2], float& m, float& l, bool rowok) {
    float a = max3f(p0[0], p0[1], p1[0]), b = max3f(p0[2], p0[3], p1[1]); a = max3f(a, p1[2], p1[3]);
#pragma unroll
    for (int r = 4; r < 16; r += 4) { a = max3f(a, p0[r], p0[r + 1]); b = max3f(b, p0[r + 2], p0[r + 3]); a = max3f(a, p1[r], p1[r + 1]); b = max3f(b, p1[r + 2], p1[r + 3]); }
    float mx = fmaxf(a, b);
    mx = fmaxf(mx, __shfl_xor(mx, 32));
    if (!rowok) mx = -INFINITY;
    const float mn = fmaxf(m, mx);
    const float mu = (mn == -INFINITY) ? 0.f : mn;
    if (__any(mn > m)) {
        const float alpha = ex2(m - mu);
        oT[0] = oT[0] * alpha; oT[1] = oT[1] * alpha; l *= alpha;
    }
    const float mue = rowok ? mu : INFINITY;
    p0 = p0 - mue; p1 = p1 - mue;
#pragma unroll
    for (int r = 0; r < 16; ++r) { p0[r] = ex2(p0[r]); p1[r] = ex2(p1[r]); }
    const v16f s = p0 + p1;
    l += ((s[0] + s[1]) + (s[2] + s[3])) + ((s[4] + s[5]) + (s[6] + s[7])) + (((s[8] + s[9]) + (s[10] + s[11])) + ((s[12] + s[13]) + (s[14] + s[15])));
    m = mn;
}
__device__ __forceinline__ v4u ld_tile(const bf16_t* base, int row0, int pitch, int tid) { return *(const v4u*)(base + (size_t)(row0 + (tid >> 3)) * pitch + (tid & 7) * 8); }
__device__ __forceinline__ void st_k(LAS unsigned char* T, v4u v, int tid) { *(LAS v4u*)(T + (tid >> 3) * KP + (tid & 7) * 16) = v; }
__device__ __forceinline__ void st_v(LAS unsigned char* T, v4u v, int tid) { *(LAS v4u*)(T + ((tid >> 2) & 1) * VHB + (tid >> 3) * 64 + (tid & 3) * 16) = v; }
__device__ __forceinline__ void store_o(bf16_t* Orow, const v16f (&o)[2], int hi) {
#pragma unroll
    for (int dt = 0; dt < 2; ++dt)
#pragma unroll
        for (int g = 0; g < 4; ++g) { v2u w; w.x = pkbf(o[dt][4 * g], o[dt][4 * g + 1]); w.y = pkbf(o[dt][4 * g + 2], o[dt][4 * g + 3]);
            *(v2u*)(Orow + dt * 32 + 8 * g + 4 * hi) = w; }
}
__device__ __forceinline__ int rel_bucket(int n) {
    if (n < 16) return n;
    const float v = __log2f((float)n * (1.f / 16.f)) * (16.f / 6.f) + 1e-5f;
    const int b = 16 + (int)v; return b < 31 ? b : 31;
}

template <bool AUX, int VAR = 0, class Seq, class Sc>
__device__ __forceinline__ void attn_engine(LAS unsigned char* lds, const bf16_t* Kg, const bf16_t* Vg, int pitch, const float* auxg, Seq seq, const v8s (&qf)[4],
                                            v16f (&oT)[2], float& m, float& l, const Sc& sc, int tid, int lane) {
    const int r32 = lane & 31, hi = lane >> 5;
    int tc = seq.pop(); if (tc < 0) return;
    int tn = seq.pop(), tnn = (tn >= 0) ? seq.pop() : -1;
    LAS float* AUXL = (LAS float*)(lds + ATT_AUX);
    v4u kr = ld_tile(Kg, 64 * tc, pitch, tid), vr = ld_tile(Vg, 64 * tc, pitch, tid); float ar = 0.f;
    if (AUX && tid < 64) ar = auxg[64 * tc + tid];
    v4u kr2 = kr, vr2 = vr; float ar2 = 0.f;
    if (tn >= 0) { kr2 = ld_tile(Kg, 64 * tn, pitch, tid); vr2 = ld_tile(Vg, 64 * tn, pitch, tid); if (AUX && tid < 64) ar2 = auxg[64 * tn + tid]; }
    __syncthreads();
    st_k(lds + ATT_K, kr, tid); st_v(lds + ATT_V, vr, tid); if (AUX && tid < 64) AUXL[tid] = ar;
    if (tn >= 0) { st_k(lds + ATT_K + KTB, kr2, tid); st_v(lds + ATT_V + VTB, vr2, tid); if (AUX && tid < 64) AUXL[64 + tid] = ar2; }
    if (tnn >= 0) { kr = ld_tile(Kg, 64 * tnn, pitch, tid); vr = ld_tile(Vg, 64 * tnn, pitch, tid); if (AUX && tid < 64) ar = auxg[64 * tnn + tid]; }
    __syncthreads();
    v16f a0, a1, b0, b1;
    int bi = 0;
    if (sc.active(tc)) { qk_tile(lds + ATT_K, qf, a0, a1, r32, hi); sc.apply(a0, a1, tc, AUXL); }
#define ATT_STEP(C0, C1, N0, N1) { \
        __syncthreads(); \
        const int b2_ = (bi >= 1) ? bi - 1 : 2, b1_ = (bi == 2) ? 0 : bi + 1; int t3_ = -1; \
        if (tnn >= 0) { st_k(lds + ATT_K + b2_ * KTB, kr, tid); st_v(lds + ATT_V + b2_ * VTB, vr, tid); if (AUX && tid < 64) AUXL[b2_ * 64 + tid] = ar; \
            t3_ = seq.pop(); \
            if (t3_ >= 0 && VAR != 3) { kr = ld_tile(Kg, 64 * t3_, pitch, tid); vr = ld_tile(Vg, 64 * t3_, pitch, tid); if (AUX && tid < 64) ar = auxg[64 * t3_ + tid]; } } \
        const bool actn_ = (tn >= 0) && sc.active(tn), actc_ = sc.active(tc); \
        v8s kf_[8]; v4s vf_[16]; \
        if (actn_) { k_load(lds + ATT_K + b1_ * KTB, kf_, r32, hi); __builtin_amdgcn_sched_barrier(0); if (VAR != 2) qk_mma(kf_, qf, N0, N1); else { N0 = oT[0] + __builtin_bit_cast(v4f, kf_[0])[0]; N1 = oT[1] + __builtin_bit_cast(v4f, kf_[5])[1]; } } \
        __builtin_amdgcn_sched_barrier(0); \
        if (actc_) v_load(lds + ATT_V + bi * VTB, vf_, lane); \
        __builtin_amdgcn_sched_barrier(0); \
        if (actc_) { if (VAR != 1) softmax_step(C0, C1, oT, m, l, sc.rowok(tc)); if (VAR != 2) pv_mma(vf_, C0, C1, oT); else { oT[0] = oT[0] + C0 * __builtin_bit_cast(v2u, vf_[3])[0]; oT[1] = oT[1] + C1 * __builtin_bit_cast(v2u, vf_[9])[1]; } } \
        if (actn_) sc.apply(N0, N1, tn, AUXL + b1_ * 64); \
        tc = tn; tn = tnn; tnn = t3_; bi = b1_; \
        if (tc < 0) break; }
    for (;;) {
        ATT_STEP(a0, a1, b0, b1)
        ATT_STEP(b0, b1, a0, a1)
    }
#undef ATT_STEP
}
struct RangeSeq { int cur, last; __device__ __forceinline__ int pop() { const int t = cur; if (t > last) return -1; cur = t + 1; return t; } };
struct MaskSeq { unsigned long long rem; __device__ __forceinline__ int pop() { if (rem == 0ull) return -1; const int t = __builtin_ctzll(rem); rem &= rem - 1ull; return t; } };

__device__ __forceinline__ void cumsum_phase(LAS unsigned char* lds, const bf16_t* QKV, const float* fb, float* CL2) {
    const int tid = mk_ltid(), lane = tid & 63, wave = tid >> 6;
    LAS float* wtot = (LAS float*)lds;
    for (int u = mk_bid(); u < NB * 32; u += mk_grid()) {
        const int b = u >> 5, h = u & 31; const float bias = fb[h];
        float v[8]; float run = 0.f;
#pragma unroll
        for (int i = 0; i < 8; ++i) { const int t = tid * 8 + i; const float x = bf2f(QKV[(size_t)(b * SEQ + t) * ODD_PAD + O_F + h]) + bias;
            const float ls = fminf(x, 0.f) - log1pf(expf(-fabsf(x))); run += ls; v[i] = run; }
        float inc = run;
#pragma unroll
        for (int o = 1; o < 64; o <<= 1) { const float t = __shfl_up(inc, o); if (lane >= o) inc += t; }
        __syncthreads();
        if (lane == 63) wtot[wave] = inc;
        __syncthreads();
        float off = inc - run;
        for (int w2 = 0; w2 < wave; ++w2) off += wtot[w2];
        float* o = CL2 + (size_t)u * SEQ + tid * 8;
#pragma unroll
        for (int i = 0; i < 8; ++i) o[i] = (v[i] + off) * LOG2E;
    }
}

struct FoxSc {
    int qw0, qpos, hi;
    __device__ __forceinline__ bool active(int t) const { return 64 * t <= qw0 + 31; }
    __device__ __forceinline__ bool rowok(int) const { return true; }
    __device__ __forceinline__ void apply(v16f& p0, v16f& p1, int t, const LAS float* aux) const {
        const LAS float* kbp = aux + 4 * hi;
        v16f c0, c1;
#pragma unroll
        for (int g = 0; g < 4; ++g) {
            const v4f x0 = *(const LAS v4f*)(kbp + 8 * g), x1 = *(const LAS v4f*)(kbp + 32 + 8 * g);
#pragma unroll
            for (int e = 0; e < 4; ++e) { c0[4 * g + e] = x0[e]; c1[4 * g + e] = x1[e]; }
        }
        p0 = p0 * C1 - c0; p1 = p1 * C1 - c1;
        if (64 * t + 63 > qw0) {
#pragma unroll
            for (int r = 0; r < 16; ++r) { const int kv = 64 * t + crow(r, hi);
                if (kv > qpos) p0[r] = -INFINITY; if (kv + 32 > qpos) p1[r] = -INFINITY; }
        }
    }
};

template <int VAR = 0>
__device__ __forceinline__ void fox_phase(LAS unsigned char* lds, const bf16_t* QKV, const float* CL2, bf16_t* AO) {
    const int w = __builtin_amdgcn_readfirstlane(mk_ltid() >> 6);
    for (int j = mk_bid(); j < NB * 32 * 16; j += mk_grid()) {
        const int tid = mk_ltid(), lane = tid & 63, r32 = lane & 31, hi = lane >> 5;
        const int rr = j >> 7, bh = j & 127, i2 = rr >> 1; int sel = rr & 1; if (i2 & 1) sel ^= 1;
        const int qb = 15 - (2 * i2 + sel), b = bh >> 5, h = bh & 31;
        const int q0 = qb * 256, qw0 = q0 + 32 * w, qpos = qw0 + r32;
        const bf16_t* Qg = QKV + (size_t)(b * SEQ + qpos) * ODD_PAD + O_Q + h * 64 + hi * 8;
        v8s qf[4];
#pragma unroll
        for (int s = 0; s < 4; ++s) qf[s] = *(const v8s*)(Qg + s * 16);
        const bf16_t* Kg = QKV + (size_t)(b * SEQ) * ODD_PAD + O_K + h * 64;
        const bf16_t* Vg = QKV + (size_t)(b * SEQ) * ODD_PAD + O_V + h * 64;
        v16f oT[2];
#pragma unroll
        for (int r = 0; r < 16; ++r) { oT[0][r] = 0.f; oT[1][r] = 0.f; }
        float m = -INFINITY, l = 0.f;
        const FoxSc sc{qw0, qpos, hi};
        attn_engine<true, VAR>(lds, Kg, Vg, ODD_PAD, CL2 + (size_t)(b * 32 + h) * SEQ, RangeSeq{0, (q0 + 256) / 64 - 1}, qf, oT, m, l, sc, tid, lane);
        l += __shfl_xor(l, 32);
        const float inv = 1.f / l;
        oT[0] = oT[0] * inv; oT[1] = oT[1] * inv;
        store_o(AO + (size_t)(b * SEQ + qpos) * DM + h * 64, oT, hi);
    }
}

__device__ __forceinline__ float gelu_tanh(float x) {
    const float u = 0.7978845608028654f * (x + 0.044715f * x * x * x);
    const float t = 1.f - 2.f / (1.f + __expf(2.f * u));
    return 0.5f * x * (1.f + t);
}
__device__ __forceinline__ void compress_unit(LAS unsigned char* lds, int u, const bf16_t* QKV, const float* pe_k, const float* pe_v,
                                              const bf16_t* CW1  , const bf16_t* CW2  , bf16_t* KCMP, bf16_t* VCMP) {
    const int tid = mk_ltid(), lane = tid & 63, w = __builtin_amdgcn_readfirstlane(tid >> 6), r32 = lane & 31, hi = lane >> 5;
    const int kv = u >> 6, b = (u >> 4) & 3, g = (u >> 3) & 1, ch = u & 7;
    const float* pe = kv ? pe_v : pe_k;
    const bf16_t* W1 = CW1 + (size_t)kv * 256 * 2048; const bf16_t* W2 = CW2 + (size_t)kv * 64 * 256;
    bf16_t* OUT = (kv ? VCMP : KCMP) + (size_t)((b * 2 + g) * 256 + ch * 32) * 64;
    const int n = ch * 32 + r32;
    const bf16_t* Ag = QKV + (size_t)(b * SEQ + 16 * n) * EVEN_PAD + (kv ? E_VC : E_KC) + g * 64 + hi * 8;
    const bf16_t* Bg = W1 + (size_t)(32 * w + r32) * 2048 + hi * 8;
    LAS bf16_t* HID = (LAS bf16_t*)lds;
    LAS float* PE = (LAS float*)(lds + 20480);
    v16f acc;
#pragma unroll
    for (int r = 0; r < 16; ++r) acc[r] = 0.f;
    __syncthreads();
    *(LAS v4f*)(PE + tid * 4) = *(const v4f*)(pe + tid * 4);
    __syncthreads();
#pragma unroll 8
    for (int st = 0; st < 128; ++st) {
        const int li = st >> 2, d0 = (st & 3) * 16;
        const v4u ar = *(const v4u*)(Ag + (size_t)li * EVEN_PAD + d0);
        const v4f pa = *(const LAS v4f*)(PE + li * 64 + d0 + hi * 8), pb = *(const LAS v4f*)(PE + li * 64 + d0 + hi * 8 + 4);
        const v8s bfr = *(const v8s*)(Bg + st * 16);
        v4u aw;
        aw.x = pkbf(__uint_as_float(ar.x << 16) + pa.x, __uint_as_float(ar.x & 0xffff0000u) + pa.y);
        aw.y = pkbf(__uint_as_float(ar.y << 16) + pa.z, __uint_as_float(ar.y & 0xffff0000u) + pa.w);
        aw.z = pkbf(__uint_as_float(ar.z << 16) + pb.x, __uint_as_float(ar.z & 0xffff0000u) + pb.y);
        aw.w = pkbf(__uint_as_float(ar.w << 16) + pb.z, __uint_as_float(ar.w & 0xffff0000u) + pb.w);
        acc = mfma32(__builtin_bit_cast(v8s, aw), bfr, acc);
    }
#pragma unroll
    for (int r = 0; r < 16; ++r) HID[crow(r, hi) * 264 + 32 * w + r32] = (bf16_t)(pkbf(gelu_tanh(acc[r]), 0.f) & 0xffffu);
    __syncthreads();
    if (w < 2) {
        v16f o;
#pragma unroll
        for (int r = 0; r < 16; ++r) o[r] = 0.f;
        const bf16_t* B2 = W2 + (size_t)(32 * w + r32) * 256 + hi * 8;
#pragma unroll
        for (int st = 0; st < 16; ++st) {
            const v8s af = *(const LAS v8s*)(HID + r32 * 264 + st * 16 + hi * 8);
            const v8s bfr = *(const v8s*)(B2 + st * 16);
            o = mfma32(af, bfr, o);
        }
#pragma unroll
        for (int r = 0; r < 16; ++r) { const int nl = crow(r, hi); const bool valid = (ch * 32 + nl) < 255;
            OUT[(size_t)nl * 64 + 32 * w + r32] = valid ? (bf16_t)(pkbf(o[r], 0.f) & 0xffffu) : (bf16_t)0; }
    }
}

template <int NEGPAD>
struct TabSc {
    const LAS float* tb;
    int qpos, hi;
    __device__ __forceinline__ void apply_tab(v16f& p0, v16f& p1, int t) const {
        const LAS float* bp = tb + (NEGPAD + qpos - 64 * t - 63 - 4 * hi);
        v16f c0, c1;
#pragma unroll
        for (int r = 0; r < 16; ++r) { c0[r] = bp[63 - ((r & 3) + 8 * (r >> 2))]; c1[r] = bp[31 - ((r & 3) + 8 * (r >> 2))]; }
        p0 = p0 * C1 + c0; p1 = p1 * C1 + c1;
    }
};
struct SwaSc : TabSc<64> {
    int qw0;
    __device__ __forceinline__ bool active(int t) const { return 64 * t + 63 >= qw0 - 127 && 64 * t <= qw0 + 31; }
    __device__ __forceinline__ bool rowok(int) const { return true; }
    __device__ __forceinline__ void apply(v16f& p0, v16f& p1, int t, const LAS float*) const { apply_tab(p0, p1, t); }
};

__device__ __forceinline__ void swa_unit(LAS unsigned char* lds, int u, const bf16_t* QKV, const float* relb, const float* sinks, bf16_t* AO) {
    const int tid = mk_ltid(), lane = tid & 63, w = __builtin_amdgcn_readfirstlane(tid >> 6), r32 = lane & 31, hi = lane >> 5;
    LAS float* TB = (LAS float*)(lds + ATT_END);
    const int qblk = u >> 4, b = (u >> 2) & 3, g = u & 3;
    const int hq = 4 * g + (w >> 1), q0 = 64 * qblk, qw0 = q0 + 32 * (w & 1), qpos = qw0 + r32;
    __syncthreads();
    for (int i = tid; i < 1024; i += 512) { const int hh = i >> 8, d = (i & 255) - 64; TB[i] = (d >= 0 && d < 128) ? relb[rel_bucket(d) * 32 + 4 * g + hh] * LOG2E : -INFINITY; }
    const bf16_t* Qg = QKV + (size_t)(b * SEQ + qpos) * EVEN_PAD + E_QA + hq * 64 + hi * 8;
    v8s qf[4];
#pragma unroll
    for (int s = 0; s < 4; ++s) qf[s] = *(const v8s*)(Qg + s * 16);
    const bf16_t* Kg = QKV + (size_t)(b * SEQ) * EVEN_PAD + E_KA + g * 64;
    const bf16_t* Vg = QKV + (size_t)(b * SEQ) * EVEN_PAD + E_VA + g * 64;
    v16f oT[2];
#pragma unroll
    for (int r = 0; r < 16; ++r) { oT[0][r] = 0.f; oT[1][r] = 0.f; }
    float m = -INFINITY, l = 0.f;
    SwaSc sc; sc.tb = TB + (w >> 1) * 256; sc.qpos = qpos; sc.hi = hi; sc.qw0 = qw0;
    attn_engine<false>(lds, Kg, Vg, EVEN_PAD, nullptr, RangeSeq{(qblk >= 2) ? qblk - 2 : 0, qblk}, qf, oT, m, l, sc, tid, lane);
    l += __shfl_xor(l, 32);
    const float sk = sinks[hq] * LOG2E;
    const float mf = fmaxf(m, sk);
    const float a = ex2(m - mf);
    const float inv = a / (l * a + ex2(sk - mf));
    oT[0] = oT[0] * inv; oT[1] = oT[1] * inv;
    store_o(AO + (size_t)(b * SEQ + qpos) * DM + hq * 64, oT, hi);
}

__device__ __forceinline__ void evenA_phase(LAS unsigned char* lds, const bf16_t* QKV, const float* relb, const float* sinks, const float* pe_k, const float* pe_v,
                                            const bf16_t* CW1, const bf16_t* CW2, bf16_t* KCMP, bf16_t* VCMP, bf16_t* AO) {
    for (int u = mk_bid(); u < 128 + 1024; u += mk_grid()) {
        if (u < 128) compress_unit(lds, u, QKV, pe_k, pe_v, CW1, CW2, KCMP, VCMP);
        else swa_unit(lds, u - 128, QKV, relb, sinks, AO);
    }
}

constexpr int NSA_TS = 1184, NSA_TW = 704;
constexpr int NSA_OFF_TS = ATT_END, NSA_OFF_TW = NSA_OFF_TS + 8 * NSA_TS * 4, NSA_OFF_IMP = NSA_OFF_TW + 8 * NSA_TW * 4, NSA_OFF_SEL = NSA_OFF_IMP + 32 * 64 * 4, NSA_OFF_UNI = NSA_OFF_SEL + 32 * 8;
static_assert(NSA_OFF_UNI + 64 <= LDS_BYTES, "NSA LDS map");

struct NsaSelSc : TabSc<64> {
    int q0; unsigned mlo, mhi;
    __device__ __forceinline__ bool active(int) const { return true; }
    __device__ __forceinline__ bool rowok(int t) const { return ((t < 32 ? (mlo >> t) : (mhi >> (t - 32))) & 1u) != 0u; }
    __device__ __forceinline__ void apply(v16f& p0, v16f& p1, int t, const LAS float*) const {
        if (q0 - (64 * t + 63) >= 1024) { const float b31 = tb[64 + 1024]; p0 = p0 * C1 + b31; p1 = p1 * C1 + b31; }
        else apply_tab(p0, p1, t);
    }
};
struct NsaWinSc : TabSc<64> {
    __device__ __forceinline__ bool active(int) const { return true; }
    __device__ __forceinline__ bool rowok(int) const { return true; }
    __device__ __forceinline__ void apply(v16f& p0, v16f& p1, int t, const LAS float*) const { apply_tab(p0, p1, t); }
};

__device__ __forceinline__ void nsa_phase(LAS unsigned char* lds, const bf16_t* QKV, const float* relb, const bf16_t* KCMP, const bf16_t* VCMP, bf16_t* AO, float* SCRG) {
    const int w = __builtin_amdgcn_readfirstlane(mk_ltid() >> 6);
    LAS unsigned char* KT = lds + ATT_K; LAS unsigned char* VT = lds + ATT_V;
    LAS float* TS = (LAS float*)(lds + NSA_OFF_TS); LAS float* TW = (LAS float*)(lds + NSA_OFF_TW); LAS unsigned* IMP = (LAS unsigned*)(lds + NSA_OFF_IMP);
    LAS unsigned* SEL = (LAS unsigned*)(lds + NSA_OFF_SEL); LAS unsigned* UNI = (LAS unsigned*)(lds + NSA_OFF_UNI);
    int cur_g = -1;
#define NSA_GATE(i) (1.f / (1.f + __expf(-bf2f(QKV[(size_t)(b * SEQ + qpos) * EVEN_PAD + E_GT + hq * 3 + (i)]))))
    for (int u = mk_bid(); u < 1024; u += mk_grid()) {
        const int qblk = 127 - (u >> 3), b = (u >> 1) & 3, g = u & 1;
        const int hq = 8 * g + w, q0 = 32 * qblk, bg = b * 2 + g;
        v8s qf[4]; v16f oT[2];
        float* SCR = SCRG + (size_t)mk_bid() * (512 * 32);
        {
            const int tid = mk_ltid(), lane = tid & 63, r32 = lane & 31, hi = lane >> 5, qpos = q0 + r32;
            __syncthreads();
            if (g != cur_g) { cur_g = g;
                for (int i = tid; i < 8 * NSA_TS; i += 512) { const int hh = i / NSA_TS, d = i - hh * NSA_TS - 64;
                    TS[i] = (d >= 0) ? relb[rel_bucket(d < 1024 ? d : 1024) * 32 + 16 + 8 * g + hh] * LOG2E : -INFINITY; }
                for (int i = tid; i < 8 * NSA_TW; i += 512) { const int hh = i / NSA_TW, d = i - hh * NSA_TW - 64;
                    TW[i] = (d >= 0 && d < 512) ? relb[rel_bucket(d) * 32 + 16 + 8 * g + hh] * LOG2E : -INFINITY; } }
            for (int i = tid; i < 32 * 64; i += 512) IMP[i] = 0u;
            if (tid < 2) UNI[tid] = 0u;
            const bf16_t* Qrow = QKV + (size_t)(b * SEQ + qpos) * EVEN_PAD;
#pragma unroll
            for (int s = 0; s < 4; ++s) qf[s] = *(const v8s*)(Qrow + E_QB + hq * 64 + hi * 8 + s * 16);
        }
        const bf16_t* Kc = KCMP + (size_t)bg * 256 * 64; const bf16_t* Vc = VCMP + (size_t)bg * 256 * 64;
        const int nct = (2 * qblk) / 64 + 1;
        float m = -INFINITY, l = 0.f;
        {
            const int tid = mk_ltid(), lane = tid & 63, r32 = lane & 31, hi = lane >> 5, qpos = q0 + r32; const LAS float* tb = TS + w * NSA_TS + 64;
            v4u kr = ld_tile(Kc, 0, 64, tid);
            for (int t = 0; t < nct; ++t) {
                const int buf = t & 1;
                st_k(KT + buf * KTB, kr, tid);
                __syncthreads();
                if (t + 1 < nct) kr = ld_tile(Kc, 64 * (t + 1), 64, tid);
                v16f p0, p1;
                qk_tile(KT + buf * KTB, qf, p0, p1, r32, hi);
                float mx = -INFINITY;
#pragma unroll
                for (int r = 0; r < 16; ++r) {
                    const int c0 = 64 * t + crow(r, hi); const int d0 = qpos - 16 * c0 - 31, d1 = d0 - 512;
                    p0[r] = p0[r] * C1 + tb[min(max(d0, -1), 1024)]; p1[r] = p1[r] * C1 + tb[min(max(d1, -1), 1024)];
                    mx = fmaxf(mx, fmaxf(p0[r], p1[r]));
                }
                mx = fmaxf(mx, __shfl_xor(mx, 32));
                const float mn = fmaxf(m, mx), mu = (mn == -INFINITY) ? 0.f : mn;
                float rs = 0.f;
#pragma unroll
                for (int r = 0; r < 16; ++r) rs += ex2(p0[r] - mu) + ex2(p1[r] - mu);
                l = l * ex2(m - mu) + rs; m = mn;
            }
        }
        l += __shfl_xor(l, 32);
        {
            const int tid = mk_ltid(), lane = tid & 63, r32 = lane & 31, hi = lane >> 5, qpos = q0 + r32; const LAS float* tb = TS + w * NSA_TS + 64;
            const float mu = (m == -INFINITY) ? 0.f : m, il = (l > 0.f) ? 1.f / l : 0.f;
            const float gt0 = NSA_GATE(0);
#pragma unroll
            for (int r = 0; r < 16; ++r) { oT[0][r] = 0.f; oT[1][r] = 0.f; }
            __syncthreads();
            v4u kr = ld_tile(Kc, 0, 64, tid), vr = ld_tile(Vc, 0, 64, tid);
            for (int t = 0; t < nct; ++t) {
                const int buf = t & 1;
                st_k(KT + buf * KTB, kr, tid); st_v(VT + buf * VTB, vr, tid);
                __syncthreads();
                if (t + 1 < nct) { kr = ld_tile(Kc, 64 * (t + 1), 64, tid); vr = ld_tile(Vc, 64 * (t + 1), 64, tid); }
                v16f p0, p1;
                qk_tile(KT + buf * KTB, qf, p0, p1, r32, hi);
#pragma unroll
                for (int r = 0; r < 16; ++r) {
                    const int c0 = 64 * t + crow(r, hi); const int d0 = qpos - 16 * c0 - 31, d1 = d0 - 512;
                    p0[r] = ex2(p0[r] * C1 + tb[min(max(d0, -1), 1024)] - mu) * il; p1[r] = ex2(p1[r] * C1 + tb[min(max(d1, -1), 1024)] - mu) * il;
                }
#pragma unroll
                for (int gq = 0; gq < 4; ++gq) {
                    const int sb0 = 16 * t + 2 * gq + hi, sb1 = sb0 + 8;
                    const unsigned a0 = (unsigned)(((p0[4 * gq] + p0[4 * gq + 1]) + (p0[4 * gq + 2] + p0[4 * gq + 3])) * 4194304.f + 0.5f);
                    const unsigned a1 = (unsigned)(((p1[4 * gq] + p1[4 * gq + 1]) + (p1[4 * gq + 2] + p1[4 * gq + 3])) * 4194304.f + 0.5f);
                    const unsigned e0 = (unsigned)(p0[4 * gq + 3] * 4194304.f + 0.5f), e1 = (unsigned)(p1[4 * gq + 3] * 4194304.f + 0.5f);
                    lds_add(IMP + r32 * 64 + sb0, a0); lds_add(IMP + r32 * 64 + sb1, a1);
                    lds_add(IMP + r32 * 64 + sb0 + 1, e0); if (sb1 + 1 < 64) lds_add(IMP + r32 * 64 + sb1 + 1, e1);
                }
                p0 = p0 * gt0; p1 = p1 * gt0;
                pv_tile(VT + buf * VTB, p0, p1, oT, lane);
            }
#pragma unroll
            for (int r = 0; r < 16; ++r) { SCR[r * 512 + tid] = oT[0][r]; SCR[(16 + r) * 512 + tid] = oT[1][r]; }
        }
        __syncthreads();
#pragma unroll 1
        for (int i = 0; i < 4; ++i) {
            const int lane = mk_ltid() & 63;
            const int qi = 4 * w + i, qp = q0 + qi, cur = qp >> 6;
            const unsigned v = IMP[qi * 64 + lane];
            const bool fut = lane > cur, forced = (lane == 0) || (lane == cur) || (lane == cur - 1);
            const unsigned key = ((fut ? 0u : (forced ? 0x3ffffffu : min(v + 1u, 0x3fffffeu))) << 6) | (unsigned)(63 - lane);
            int cnt = 0;
#pragma unroll
            for (int jj = 0; jj < 64; ++jj) { const unsigned kj = (unsigned)__builtin_amdgcn_readlane((int)key, jj); cnt += (kj > key) ? 1 : 0; }
            const unsigned long long msk = __ballot(!fut && cnt < 16);
            if (lane == 0) { SEL[2 * qi] = (unsigned)msk; SEL[2 * qi + 1] = (unsigned)(msk >> 32); lds_or(UNI, (unsigned)msk); lds_or(UNI + 1, (unsigned)(msk >> 32)); }
        }
        __syncthreads();
        {
            const int tid = mk_ltid(), lane = tid & 63, r32 = lane & 31, hi = lane >> 5, qpos = q0 + r32;
            const unsigned long long uni = ((unsigned long long)(unsigned)__builtin_amdgcn_readfirstlane((int)UNI[1]) << 32) | (unsigned)__builtin_amdgcn_readfirstlane((int)UNI[0]);
            const bf16_t* Kg = QKV + (size_t)(b * SEQ) * EVEN_PAD + E_KS + g * 64; const bf16_t* Vg = QKV + (size_t)(b * SEQ) * EVEN_PAD + E_VS + g * 64;
#pragma unroll
            for (int r = 0; r < 16; ++r) { oT[0][r] = 0.f; oT[1][r] = 0.f; }
            m = -INFINITY; l = 0.f;
            NsaSelSc sc; sc.tb = TS + w * NSA_TS; sc.qpos = qpos; sc.hi = hi; sc.q0 = q0; sc.mlo = SEL[2 * r32]; sc.mhi = SEL[2 * r32 + 1];
            attn_engine<false>(lds, Kg, Vg, EVEN_PAD, nullptr, MaskSeq{uni}, qf, oT, m, l, sc, tid, lane);
            l += __shfl_xor(l, 32);
            const float scl = (l > 0.f) ? NSA_GATE(1) / l : 0.f;
#pragma unroll
            for (int r = 0; r < 16; ++r) { SCR[r * 512 + tid] += oT[0][r] * scl; SCR[(16 + r) * 512 + tid] += oT[1][r] * scl; }
        }
        {
            const int tid = mk_ltid(), lane = tid & 63, r32 = lane & 31, hi = lane >> 5, qpos = q0 + r32;
            const bf16_t* Kg = QKV + (size_t)(b * SEQ) * EVEN_PAD + E_KW + g * 64; const bf16_t* Vg = QKV + (size_t)(b * SEQ) * EVEN_PAD + E_VW + g * 64;
#pragma unroll
            for (int r = 0; r < 16; ++r) { oT[0][r] = 0.f; oT[1][r] = 0.f; }
            m = -INFINITY; l = 0.f;
            NsaWinSc sc; sc.tb = TW + w * NSA_TW; sc.qpos = qpos; sc.hi = hi;
            attn_engine<false>(lds, Kg, Vg, EVEN_PAD, nullptr, RangeSeq{(q0 >= 511) ? ((q0 - 511) >> 6) : 0, (q0 + 31) >> 6}, qf, oT, m, l, sc, tid, lane);
            l += __shfl_xor(l, 32);
            const float scl = (l > 0.f) ? NSA_GATE(2) / l : 0.f;
#pragma unroll
            for (int r = 0; r < 16; ++r) { oT[0][r] = SCR[r * 512 + tid] + oT[0][r] * scl; oT[1][r] = SCR[(16 + r) * 512 + tid] + oT[1][r] * scl; }
            store_o(AO + (size_t)(b * SEQ + qpos) * DM + 1024 + hq * 64, oT, hi);
        }
    }
}

__device__ __forceinline__ unsigned xb_ld(unsigned* p)              { return __hip_atomic_load(p, __ATOMIC_RELAXED, __HIP_MEMORY_SCOPE_AGENT); }
__device__ __forceinline__ unsigned xb_add(unsigned* p, unsigned v) { return __hip_atomic_fetch_add(p, v, __ATOMIC_RELAXED, __HIP_MEMORY_SCOPE_AGENT); }
__device__ __forceinline__ unsigned xb_xcc_id() { return (unsigned)__builtin_amdgcn_s_getreg((3 << 11) | 20) & 0xFu; }
#define XB_TMO      128
#define XB_XCNT(j)  (256  + 64 * (j))
#define XB_XSUB(j)  (1280 + 64 * (j))
#define XB_XGEN(j)  (2304 + 64 * (j))
#define XB_TOP      3328
#define XB_TOPGEN   3392
#define XCD_BAR_WORDS 3456
#define XB_SPIN_CAP (1u << 18)

#define XB_SPIN(cond, bar) do { unsigned _sp = 0; while (cond) { __builtin_amdgcn_s_sleep(1); \
    if ((++_sp & 255u) == 0u) { if (xb_ld(&(bar)[XB_TMO])) break; if (_sp > XB_SPIN_CAP) { atomicAdd(&(bar)[XB_TMO], 1u); break; } } } } while (0)

struct XcdBarrier {
    unsigned* bar; unsigned x;
    volatile LAS unsigned* st;
};

__device__ __forceinline__ XcdBarrier xcd_barrier_post(unsigned* bar, volatile LAS unsigned* st) {
    XcdBarrier b; b.bar = bar; b.x = xb_xcc_id(); b.st = st;
    if (threadIdx.x == 0) (void)xb_add(&bar[XB_XCNT(b.x)], 1u);
    return b;
}
__device__ __forceinline__ void xcd_barrier_complete(unsigned* bar, unsigned x, unsigned& nloc, unsigned& nx) {
    const unsigned G = gridDim.x * gridDim.y * gridDim.z;
    unsigned sum, cnt, mine, sp = 0u;
    for (;;) {
        sum = 0u; cnt = 0u; mine = 0u;
#pragma unroll
        for (unsigned j = 0; j < 16; ++j) { const unsigned c = xb_ld(&bar[XB_XCNT(j)]); sum += c; cnt += (c > 0u) ? 1u : 0u; mine = (j == x) ? c : mine; }
        if (sum == G) break;
        __builtin_amdgcn_s_sleep(1);
        if ((++sp & 255u) == 0u) { if (xb_ld(&bar[XB_TMO])) break; if (sp > XB_SPIN_CAP) { atomicAdd(&bar[XB_TMO], 1u); break; } }
    }
    nloc = mine > 0u ? mine : 1u; nx = cnt > 0u ? cnt : 1u;
}

__device__ __forceinline__ void xcd_barrier(const XcdBarrier& b) {
    asm volatile("s_waitcnt vmcnt(0)" ::: "memory");
    __syncthreads();
    if (threadIdx.x == 0) {
        unsigned* bar = b.bar;
        __builtin_amdgcn_s_waitcnt(0);
        unsigned nloc = b.st[0], nx = b.st[1];
        if (nloc == 0u) { xcd_barrier_complete(bar, b.x, nloc, nx); b.st[0] = nloc; b.st[1] = nx; }
        const unsigned old = xb_add(&bar[XB_XSUB(b.x)], 1u);
        const unsigned gen = old / nloc;
        if (old + 1u == (gen + 1u) * nloc) {
            __builtin_amdgcn_fence(__ATOMIC_RELEASE, "agent");
            asm volatile("s_waitcnt vmcnt(0)" ::: "memory");
            const unsigned og = xb_add(&bar[XB_TOP], 1u);
            const unsigned tg = og / nx;
            if (og + 1u == (tg + 1u) * nx) xb_add(&bar[XB_TOPGEN], 1u);
            else XB_SPIN(xb_ld(&bar[XB_TOPGEN]) == tg, bar);
            __builtin_amdgcn_fence(__ATOMIC_ACQUIRE, "agent");
            xb_add(&bar[XB_XGEN(b.x)], 1u);
            asm volatile("s_waitcnt vmcnt(0)" ::: "memory");
        } else {
            XB_SPIN(xb_ld(&bar[XB_XGEN(b.x)]) == gen, bar);
            __builtin_amdgcn_fence(__ATOMIC_ACQUIRE, "agent");
            asm volatile("s_waitcnt vmcnt(0)" ::: "memory");
        }
    }
    __syncthreads();
}

__global__ void __launch_bounds__(512, 2) fwd_mega(Args a_unused) {
    extern __shared__ __attribute__((aligned(16))) unsigned char lds_raw[];
    LAS unsigned char* lds = (LAS unsigned char*)lds_raw;
    cg::grid_group grid = cg::this_grid();
    volatile LAS unsigned* xst = (volatile LAS unsigned*)(lds + LDS_BYTES - 64);
    if (threadIdx.x < 2) xst[threadIdx.x] = 0u;
    __syncthreads();
    XcdBarrier xb = xcd_barrier_post((unsigned*)arg_ws(), xst);
#define WSP(off) (arg_ws() + (off))
    prologue_phase(lds);
#ifdef DUP_PRO
    prologue_phase(lds);
#endif
    norm_phase(arg_in(0), arg_in(2), (bf16_t*)WSP(WS_XN), nullptr);
    grid.sync();
#pragma unroll 1
    for (int L = 0; L < 4; ++L) {
        const int e = L >> 1;
        if ((L & 1) == 0) {
            { pg8::Gemm gm{(const bf16_t*)WSP(WS_XN), (const bf16_t*)WSP(WS_WIE) + (size_t)e * EVEN_PAD * DM, MTOK, EVEN_PAD, DM}; pg8::StaticOrder S; S.init(MTOK, EVEN_PAD, mk_grid(), mk_bid());
              pg8::EpiBf16<0> E{(bf16_t*)WSP(WS_QKV), EVEN_PAD}; pg8::gemm_phase<pg8::EpiBf16<0>, pg8::StaticOrder, true, true>(lds, gm, S, E); }
            xcd_barrier(xb);
            evenA_phase(lds, (const bf16_t*)WSP(WS_QKV), arg_in(1), arg_in(7) + e * 16, arg_in(8) + e * 2048, arg_in(9) + e * 2048,
                        (const bf16_t*)WSP(WS_CW1) + (size_t)e * 2 * 256 * 2048, (const bf16_t*)WSP(WS_CW2) + (size_t)e * 2 * 64 * 256, (bf16_t*)WSP(WS_KCMP), (bf16_t*)WSP(WS_VCMP), (bf16_t*)WSP(WS_AO));
            xcd_barrier(xb);
#ifdef DUP_EVENA
            evenA_phase(lds, (const bf16_t*)WSP(WS_QKV), arg_in(1), arg_in(7) + e * 16, arg_in(8) + e * 2048, arg_in(9) + e * 2048,
                        (const bf16_t*)WSP(WS_CW1) + (size_t)e * 2 * 256 * 2048, (const bf16_t*)WSP(WS_CW2) + (size_t)e * 2 * 64 * 256, (bf16_t*)WSP(WS_KCMP), (bf16_t*)WSP(WS_VCMP), (bf16_t*)WSP(WS_AO));
            xcd_barrier(xb);
#endif
            nsa_phase(lds, (const bf16_t*)WSP(WS_QKV), arg_in(1), (const bf16_t*)WSP(WS_KCMP), (const bf16_t*)WSP(WS_VCMP), (bf16_t*)WSP(WS_AO), (float*)WSP(WS_XN));
            xcd_barrier(xb);
#ifdef DUP_NSA
            nsa_phase(lds, (const bf16_t*)WSP(WS_QKV), arg_in(1), (const bf16_t*)WSP(WS_KCMP), (const bf16_t*)WSP(WS_VCMP), (bf16_t*)WSP(WS_AO), (float*)WSP(WS_XN));
            xcd_barrier(xb);
#endif
            { pg8::Gemm gm{(const bf16_t*)WSP(WS_AO), (const bf16_t*)WSP(WS_WOE) + (size_t)e * DM * DM, MTOK, DM, DM}; pg8::StaticOrder S; S.init(MTOK, DM, mk_grid(), mk_bid());
              pg8::EpiRes E{(L == 0) ? arg_in(0) : (const float*)arg_out(), arg_out(), DM}; pg8::gemm_phase<pg8::EpiRes, pg8::StaticOrder, true, true>(lds, gm, S, E); }
        } else {
            { pg8::Gemm gm{(const bf16_t*)WSP(WS_XN), (const bf16_t*)WSP(WS_WIO) + (size_t)e * ODD_PAD * DM, MTOK, ODD_PAD, DM}; pg8::StaticOrder S; S.init(MTOK, ODD_PAD, mk_grid(), mk_bid());
              pg8::EpiBf16<0> E{(bf16_t*)WSP(WS_QKV), ODD_PAD}; pg8::gemm_phase<pg8::EpiBf16<0>, pg8::StaticOrder, true, true>(lds, gm, S, E); }
            xcd_barrier(xb);
            cumsum_phase(lds, (const bf16_t*)WSP(WS_QKV), arg_in(16) + e * 32, (float*)WSP(WS_C));
            xcd_barrier(xb);
            fox_phase(lds, (const bf16_t*)WSP(WS_QKV), (const float*)WSP(WS_C), (bf16_t*)WSP(WS_AO));
            xcd_barrier(xb);
#ifdef DUP_FOX
            fox_phase<DUP_FOX>(lds, (const bf16_t*)WSP(WS_QKV), (const float*)WSP(WS_C), (bf16_t*)WSP(WS_XN));
            xcd_barrier(xb);
#endif
#ifdef DUP_SYNC
            for (int i_ = 0; i_ < 20; ++i_) xcd_barrier(xb);
#endif
            { pg8::Gemm gm{(const bf16_t*)WSP(WS_AO), (const bf16_t*)WSP(WS_WOO) + (size_t)e * DM * DM, MTOK, DM, DM}; pg8::StaticOrder S; S.init(MTOK, DM, mk_grid(), mk_bid());
              pg8::EpiRes E{(const float*)arg_out(), arg_out(), DM}; pg8::gemm_phase<pg8::EpiRes, pg8::StaticOrder, true, true>(lds, gm, S, E); }
        }
        xcd_barrier(xb);
        norm_phase(arg_out(), arg_in(3) + L * DM, (bf16_t*)WSP(WS_XN), nullptr);
#ifdef DUP_NORM
        norm_phase(arg_out(), arg_in(3) + L * DM, (bf16_t*)WSP(WS_XN), nullptr);
#endif
        xcd_barrier(xb);
        { pg8::Gemm gm{(const bf16_t*)WSP(WS_XN), (const bf16_t*)WSP(WS_WUP) + (size_t)L * DFF * DM, MTOK, DFF, DM}; pg8::StaticOrder S; S.init(MTOK, DFF, mk_grid(), mk_bid());
          pg8::EpiBf16<2> E{(bf16_t*)WSP(WS_H), DFF}; pg8::gemm_phase<pg8::EpiBf16<2>, pg8::StaticOrder, true, true>(lds, gm, S, E); }
        xcd_barrier(xb);
#ifdef DUP_UP
        { pg8::Gemm gm{(const bf16_t*)WSP(WS_XN), (const bf16_t*)WSP(WS_WUP) + (size_t)L * DFF * DM, MTOK, DFF, DM}; pg8::StaticOrder S; S.init(MTOK, DFF, mk_grid(), mk_bid());
          pg8::EpiBf16<2> E{(bf16_t*)WSP(WS_H), DFF}; pg8::gemm_phase<pg8::EpiBf16<2>, pg8::StaticOrder, true, true>(lds, gm, S, E); }
        xcd_barrier(xb);
#endif
        { pg8::Gemm gm{(const bf16_t*)WSP(WS_H), (const bf16_t*)WSP(WS_WDN) + (size_t)L * DM * DFF, MTOK, DM, DFF}; pg8::StaticOrder S; S.init(MTOK, DM, mk_grid(), mk_bid());
          pg8::EpiRes E{(const float*)arg_out(), arg_out(), DM}; pg8::gemm_phase<pg8::EpiRes, pg8::StaticOrder, true, true>(lds, gm, S, E); }
        xcd_barrier(xb);
#ifdef DUP_NORM
        if (L < 3) norm_phase(arg_out(), arg_in(2) + (L + 1) * DM, (bf16_t*)WSP(WS_XN), nullptr);
#endif
        if (L < 3) { norm_phase(arg_out(), arg_in(2) + (L + 1) * DM, (bf16_t*)WSP(WS_XN), nullptr); xcd_barrier(xb); }
        else norm_phase(arg_out(), arg_in(4), nullptr, arg_out());
    }
#undef WSP
}

extern "C" void kernel_launch(void* const* d_in, const int* in_sizes, int n_in, void* d_out, int out_size, void* d_ws, size_t ws_size, hipStream_t stream) {
    static int grid = 0;
    if (grid == 0) {
        if (n_in != 19 || out_size != MTOK * DM || ws_size < WS_END) { fprintf(stderr, "kernel_launch: unexpected shapes (n_in %d out %d ws %zu)\n", n_in, out_size, ws_size); grid = -1; return; }
        int dev = 0, cus = 0, per_cu = 0;
        (void)hipGetDevice(&dev);
        (void)hipDeviceGetAttribute(&cus, hipDeviceAttributeMultiprocessorCount, dev);
        (void)hipFuncSetAttribute((const void*)fwd_mega, hipFuncAttributeMaxDynamicSharedMemorySize, LDS_BYTES);
        (void)hipOccupancyMaxActiveBlocksPerMultiprocessor(&per_cu, (const void*)fwd_mega, 512, LDS_BYTES);
        if (per_cu < 1) per_cu = 1;
        grid = cus * per_cu;
        fprintf(stderr, "kernel_launch: grid %d (cus %d x %d)\n", grid, cus, per_cu);
    }
    if (grid < 0) return;
    if (hipMemsetAsync(d_ws, 0, 16384, stream) != hipSuccess) { fprintf(stderr, "kernel_launch: memset of the barrier words failed\n"); return; }
    Args a{};
    for (int i = 0; i < 19; ++i) a.in[i] = (const float*)d_in[i];
    a.out = (float*)d_out; a.ws = (unsigned char*)d_ws;
    void* args[] = {&a};
    hipError_t e = hipLaunchCooperativeKernel((void*)fwd_mega, dim3(grid), dim3(512), args, LDS_BYTES, stream);
    if (e != hipSuccess) fprintf(stderr, "cooperative launch failed: %s (grid %d)\n", hipGetErrorString(e), grid);
}
```

```cpp
#include <hip/hip_runtime.h>
#include <hip/hip_cooperative_groups.h>
#include <cstdio>
#include <cstdint>
#include <cmath>
namespace cg = cooperative_groups;
__device__ __forceinline__ int mk_ltid() { int t = threadIdx.x; asm volatile("" : "+v"(t)); return t; }
__device__ __forceinline__ int mk_bid() { int t = blockIdx.x; asm volatile("" : "+s"(t)); return t; }
__device__ __forceinline__ int mk_grid() { int t = gridDim.x; asm volatile("" : "+s"(t)); return t; }
#define FOX2 1
namespace pg8 {
#define PG8_LAS __attribute__((address_space(3)))
typedef unsigned short bf16_t;
typedef short bf16x8 __attribute__((ext_vector_type(8)));
typedef float f32x4 __attribute__((ext_vector_type(4)));
typedef unsigned u32x4 __attribute__((ext_vector_type(4)));
constexpr int BM = 256, BK = 64, HALF = 128, HTB = HALF * BK * 2  , STAGE_BYTES = 8 * HTB, NXCD = 8, WGM = 8;

__host__ __device__ __forceinline__ int lds_byte(int r, int c) { const int st = (r >> 4) * 2 + (c >> 5), rr = r & 15, cc = c & 31, ob = rr * 64 + cc * 2; return st * 1024 + (ob ^ (((ob >> 9) & 1) << 5)); }
__host__ __device__ __forceinline__ void stage_rc(int b, int& R, int& C) { const int st = b / 1024, sb = b % 1024, swz = sb ^ (((sb >> 9) & 1) << 5); R = (st >> 1) * 16 + swz / 64; C = (st & 1) * 32 + (swz % 64) / 2; }
__host__ __device__ __forceinline__ int perm32(int rho) { const int n = rho >> 4, i = rho & 15; return 8 * (i >> 2) + 4 * n + (i & 3); }

struct Unit { int pm, pn; };
struct Gemm { const bf16_t* A; const bf16_t* Bt; int M, N, K; };

struct StaticOrder {
    int nM, nN, nwg, G, c;
    __host__ __device__ void init(int M, int N, int G_, int c_) { nM = M / BM; nN = N / BM; nwg = nM * nN; G = G_; c = c_; }
    __host__ __device__ bool next(int i, Unit& u) const {
        const long L = (long)i * G + c; if (L >= nwg) return false;
        int wgid = (int)L; { const int q = nwg / NXCD, r = nwg % NXCD, xcd = wgid % NXCD, off = wgid / NXCD; wgid = (xcd < r ? xcd * (q + 1) : r * (q + 1) + (xcd - r) * q) + off; }
        const int nig = WGM * nN, gid = wgid / nig, fm = gid * WGM, gsz = (nM - fm) < WGM ? (nM - fm) : WGM;
        u.pm = fm + ((wgid % nig) % gsz); u.pn = (wgid % nig) / gsz; return true;
    }
    __device__ __forceinline__ void a_ready(const Unit&) const {}
    __device__ __forceinline__ void done(const Unit&) const {}
};

__device__ __forceinline__ unsigned cvt_pk_bf16(float lo, float hi) { unsigned r; asm volatile("v_cvt_pk_bf16_f32 %0, %1, %2" : "=v"(r) : "v"(lo), "v"(hi)); return r; }
typedef float f32x2 __attribute__((ext_vector_type(2)));
template <int ACT  > struct EpiBf16 {
    static constexpr bool PERM = true, AFTER_DRAIN = false;
    bf16_t* O; int ldc;
    __device__ __forceinline__ void operator()(const f32x4 (&acc)[2][2][4][2], const Unit& u, int wr, int wc, int fr, int fq) const {
        const int row0 = u.pm * BM + wr * 64 + fr; const int col0 = u.pn * BM + wc * 32 + 8 * fq;
#pragma unroll
        for (int ai = 0; ai < 2; ++ai)
#pragma unroll
            for (int m = 0; m < 4; ++m) { bf16_t* rowp = O + (size_t)(row0 + ai * HALF + m * 16) * ldc + col0;
#pragma unroll
                for (int bj = 0; bj < 2; ++bj) { f32x4 v0 = acc[ai][bj][m][0], v1 = acc[ai][bj][m][1];
                    if (ACT == 2) {
#pragma unroll
                        for (int e = 0; e < 4; ++e) { float a = v0[e] > 0.f ? v0[e] : 0.f; v0[e] = a * a; float b = v1[e] > 0.f ? v1[e] : 0.f; v1[e] = b * b; } }
                    u32x4 w; w.x = cvt_pk_bf16(v0[0], v0[1]); w.y = cvt_pk_bf16(v0[2], v0[3]); w.z = cvt_pk_bf16(v1[0], v1[1]); w.w = cvt_pk_bf16(v1[2], v1[3]);
                    *(u32x4*)(rowp + bj * HALF) = w; } }
    }
};
struct EpiRes {
    static constexpr bool PERM = false, AFTER_DRAIN = false;
    const float* base; float* out; int ldc;
    __device__ __forceinline__ void operator()(const f32x4 (&acc)[2][2][4][2], const Unit& u, int wr, int wc, int fr, int fq) const {
        const int row0 = u.pm * BM + wr * 64 + fr; const int col0 = u.pn * BM + wc * 32 + 4 * fq;
#pragma unroll
        for (int ai = 0; ai < 2; ++ai)
#pragma unroll
            for (int m = 0; m < 4; ++m) { const size_t off = (size_t)(row0 + ai * HALF + m * 16) * ldc + col0;
#pragma unroll
                for (int bj = 0; bj < 2; ++bj)
#pragma unroll
                    for (int n = 0; n < 2; ++n) { const f32x4 b = *(const f32x4*)(base + off + bj * HALF + n * 16); *(f32x4*)(out + off + bj * HALF + n * 16) = b + acc[ai][bj][m][n]; } }
    }
};
template <class Epi, class Sched, bool ALIGN_EPI = false, bool SP2 = false>
__device__ __forceinline__ void gemm_phase(PG8_LAS unsigned char* lds, const Gemm g, const Sched& S, const Epi& E) {
    const int tid = mk_ltid(), wid = __builtin_amdgcn_readfirstlane(tid >> 6), lane = tid & 63, wr = wid >> 2, wc = wid & 3, fr = lane & 15, fq = lane >> 4;
    const int K = g.K, nt = K / BK;
    unsigned voffA[2], voffB[2];
#pragma unroll
    for (int i = 0; i < 2; ++i) { int R, C; stage_rc(tid * 16 + i * 8192, R, C); const int Rb = Epi::PERM ? ((R & ~31) + perm32(R & 31)) : R;
        voffA[i] = (unsigned)(R * K + C) * 2u; voffB[i] = (unsigned)(Rb * K + C) * 2u; }
    const size_t kstep = (size_t)(BK * 2);
    const size_t hstep = (size_t)HALF * K * 2;
    const size_t tstep = 2 * hstep;
    const unsigned ldsw = (unsigned)wid * 1024u;
    const int aoff = lds_byte(wr * 64 + fr, fq * 8), boff = lds_byte(wc * 32 + fr, fq * 8);
#define PG8_SA(b, h) (((b) * 2 + (h)) * HTB)
#define PG8_SB(b, h) ((4 + (b) * 2 + (h)) * HTB)
#define PG8_STAGE(bufoff, gbase, voff) do { _Pragma("unroll") for (int _i = 0; _i < 2; ++_i) \
        __builtin_amdgcn_global_load_lds((const unsigned*)((const char*)(gbase) + (voff)[_i]), (PG8_LAS unsigned*)(lds + (bufoff) + ldsw + _i * 8192), 16, 0, 0); } while (0)
#define PG8_LDA(dst, b, h) do { _Pragma("unroll") for (int m = 0; m < 4; ++m) _Pragma("unroll") for (int k = 0; k < 2; ++k) dst[m][k] = *(const PG8_LAS bf16x8*)(lds + PG8_SA(b, h) + aoff + m * 2048 + k * 1024); } while (0)
#define PG8_LDB(dst, b, h) do { _Pragma("unroll") for (int n = 0; n < 2; ++n) _Pragma("unroll") for (int k = 0; k < 2; ++k) dst[n][k] = *(const PG8_LAS bf16x8*)(lds + PG8_SB(b, h) + boff + n * 2048 + k * 1024); } while (0)
#define PG8_MMA(ai, bj, At, Bt) do { __builtin_amdgcn_s_setprio(1); _Pragma("unroll") for (int m = 0; m < 4; ++m) _Pragma("unroll") for (int n = 0; n < 2; ++n) _Pragma("unroll") for (int k = 0; k < 2; ++k) \
        acc[ai][bj][m][n] = __builtin_amdgcn_mfma_f32_16x16x32_bf16(Bt[n][k], At[m][k], acc[ai][bj][m][n], 0, 0, 0); __builtin_amdgcn_s_setprio(0); } while (0)
#define PG8_WAIT_V(n) asm volatile("s_waitcnt vmcnt(" #n ")" ::: "memory")
#define PG8_WAIT_L(n) asm volatile("s_waitcnt lgkmcnt(" #n ")" ::: "memory")
#define PG8_BAR __builtin_amdgcn_s_barrier()
#define PG8_SCHED __builtin_amdgcn_sched_barrier(0)
    Unit cur, nxt; int ui = 0;
    if (!S.next(0, cur)) return;
    f32x4 acc[2][2][4][2];
#pragma unroll
    for (int a = 0; a < 2; ++a)
#pragma unroll
        for (int b = 0; b < 2; ++b)
#pragma unroll
            for (int m = 0; m < 4; ++m)
#pragma unroll
                for (int n = 0; n < 2; ++n) acc[a][b][m][n] = (f32x4){0.f, 0.f, 0.f, 0.f};
    bf16x8 At[4][2], B0[2][2], B1[2][2];
    const char* cA = (const char*)g.A + (size_t)cur.pm * tstep; const char* cB = (const char*)g.Bt + (size_t)cur.pn * tstep;
    S.a_ready(cur);
    if constexpr (SP2) {
        PG8_STAGE(PG8_SB(0, 0), cB, voffB); PG8_STAGE(PG8_SB(0, 1), cB + hstep, voffB); PG8_STAGE(PG8_SA(0, 0), cA, voffA); PG8_STAGE(PG8_SA(0, 1), cA + hstep, voffA);
        if (wr == 1) PG8_BAR;
        PG8_WAIT_V(2); PG8_BAR;
        PG8_STAGE(PG8_SB(1, 0), cB + kstep, voffB); PG8_STAGE(PG8_SA(1, 0), cA + kstep, voffA); PG8_STAGE(PG8_SB(1, 1), cB + hstep + kstep, voffB);
        PG8_WAIT_V(6); PG8_BAR;
    } else {
        PG8_STAGE(PG8_SB(0, 0), cB, voffB); PG8_STAGE(PG8_SA(0, 0), cA, voffA); PG8_STAGE(PG8_SB(0, 1), cB + hstep, voffB); PG8_STAGE(PG8_SA(0, 1), cA + hstep, voffA);
        if (wr == 1) PG8_BAR;
        PG8_WAIT_V(4); PG8_BAR;
        PG8_STAGE(PG8_SB(1, 0), cB + kstep, voffB); PG8_STAGE(PG8_SA(1, 0), cA + kstep, voffA); PG8_STAGE(PG8_SB(1, 1), cB + hstep + kstep, voffB);
        PG8_WAIT_V(6); PG8_BAR;
    }
    for (;;) {
        const bool has_next = S.next(ui + 1, nxt);
        const char* nA = has_next ? (const char*)g.A + (size_t)nxt.pm * tstep : cA; const char* nB = has_next ? (const char*)g.Bt + (size_t)nxt.pn * tstep : cB;
        for (int t = 0; t < nt; t += 2) {
            const bool last = (t == nt - 2);
            const char* a1 = cA + (size_t)(t + 1) * kstep;
            const char* a2 = last ? nA : cA + (size_t)(t + 2) * kstep; const char* b2 = last ? nB : cB + (size_t)(t + 2) * kstep;
            const char* a3 = a2 + kstep; const char* b3 = b2 + kstep;
            if (last && has_next) S.a_ready(nxt);
            if constexpr (SP2) {
            PG8_LDB(B0, 0, 0); PG8_LDB(B1, 0, 1); PG8_SCHED; PG8_LDA(At, 0, 0); PG8_STAGE(PG8_SA(1, 1), a1 + hstep, voffA);
            PG8_WAIT_V(8); PG8_WAIT_L(0); PG8_BAR; PG8_MMA(0, 0, At, B0); PG8_MMA(0, 1, At, B1); PG8_BAR; PG8_SCHED;
            PG8_LDA(At, 0, 1); PG8_STAGE(PG8_SB(0, 0), b2, voffB); PG8_STAGE(PG8_SB(0, 1), b2 + hstep, voffB); PG8_STAGE(PG8_SA(0, 0), a2, voffA);
            PG8_WAIT_V(8); PG8_WAIT_L(0); PG8_BAR; PG8_MMA(1, 0, At, B0); PG8_MMA(1, 1, At, B1); PG8_BAR; PG8_SCHED;
            PG8_LDB(B0, 1, 0); PG8_LDB(B1, 1, 1); PG8_SCHED; PG8_LDA(At, 1, 0); PG8_STAGE(PG8_SA(0, 1), a2 + hstep, voffA);
            PG8_WAIT_V(8); PG8_WAIT_L(0); PG8_BAR; PG8_MMA(0, 0, At, B0); PG8_MMA(0, 1, At, B1); PG8_BAR; PG8_SCHED;
            PG8_LDA(At, 1, 1); PG8_STAGE(PG8_SB(1, 0), b3, voffB); PG8_STAGE(PG8_SB(1, 1), b3 + hstep, voffB); PG8_STAGE(PG8_SA(1, 0), a3, voffA);
            PG8_WAIT_V(8); PG8_WAIT_L(0); PG8_BAR; PG8_MMA(1, 0, At, B0); PG8_MMA(1, 1, At, B1); PG8_BAR; PG8_SCHED;
            } else {
            PG8_LDB(B0, 0, 0); PG8_SCHED; PG8_LDA(At, 0, 0); PG8_STAGE(PG8_SA(1, 1), a1 + hstep, voffA);
            PG8_WAIT_L(8); PG8_BAR; PG8_WAIT_L(0); PG8_MMA(0, 0, At, B0); PG8_BAR; PG8_SCHED;
            PG8_LDB(B1, 0, 1); PG8_STAGE(PG8_SB(0, 0), b2, voffB);
            PG8_BAR; PG8_WAIT_L(0); PG8_MMA(0, 1, At, B1); PG8_BAR;
            PG8_LDA(At, 0, 1); PG8_STAGE(PG8_SA(0, 0), a2, voffA);
            PG8_BAR; PG8_WAIT_L(0); PG8_MMA(1, 0, At, B0); PG8_BAR; PG8_SCHED;
            PG8_STAGE(PG8_SB(0, 1), b2 + hstep, voffB);
            PG8_WAIT_V(6); PG8_BAR; PG8_MMA(1, 1, At, B1); PG8_BAR;
            PG8_LDB(B0, 1, 0); PG8_SCHED; PG8_LDA(At, 1, 0); PG8_STAGE(PG8_SA(0, 1), a2 + hstep, voffA);
            PG8_WAIT_L(8); PG8_BAR; PG8_WAIT_L(0); PG8_MMA(0, 0, At, B0); PG8_BAR; PG8_SCHED;
            PG8_LDB(B1, 1, 1); PG8_STAGE(PG8_SB(1, 0), b3, voffB);
            PG8_BAR; PG8_WAIT_L(0); PG8_MMA(0, 1, At, B1); PG8_BAR;
            PG8_LDA(At, 1, 1); PG8_STAGE(PG8_SA(1, 0), a3, voffA);
            PG8_BAR; PG8_WAIT_L(0); PG8_MMA(1, 0, At, B0); PG8_BAR; PG8_SCHED;
            PG8_STAGE(PG8_SB(1, 1), b3 + hstep, voffB);
            PG8_WAIT_V(6); PG8_BAR; PG8_MMA(1, 1, At, B1); PG8_BAR;
            }
        }
        if constexpr (ALIGN_EPI) { if (wr == 0) PG8_BAR; }
        if constexpr (!Epi::AFTER_DRAIN) { E(acc, cur, wr, wc, fr, fq); S.done(cur); }
        if (!has_next) break;
#pragma unroll
        for (int a = 0; a < 2; ++a)
#pragma unroll
            for (int b = 0; b < 2; ++b)
#pragma unroll
                for (int m = 0; m < 4; ++m)
#pragma unroll
                    for (int n = 0; n < 2; ++n) acc[a][b][m][n] = (f32x4){0.f, 0.f, 0.f, 0.f};
        cur = nxt; cA = nA; cB = nB; ++ui;
        if constexpr (ALIGN_EPI) { if (wr == 1) PG8_BAR; }
    }
    PG8_WAIT_V(0);
    if constexpr (!ALIGN_EPI) { if (wr == 0) PG8_BAR; }
    PG8_BAR;
    if constexpr (Epi::AFTER_DRAIN) { E.fused(acc, cur, wr, wc, fr, fq, lds, wid, lane); S.done(cur); }
#undef PG8_SA
#undef PG8_SB
#undef PG8_STAGE
#undef PG8_LDA
#undef PG8_LDB
#undef PG8_MMA
#undef PG8_WAIT_V
#undef PG8_WAIT_L
#undef PG8_BAR
#undef PG8_SCHED
}
}

#define LAS __attribute__((address_space(3)))
typedef unsigned short bf16_t;
typedef short v8s __attribute__((ext_vector_type(8)));
typedef short v4s __attribute__((ext_vector_type(4)));
typedef float v4f __attribute__((ext_vector_type(4)));
typedef float v16f __attribute__((ext_vector_type(16)));
typedef unsigned v4u __attribute__((ext_vector_type(4)));
typedef unsigned v2u __attribute__((ext_vector_type(2)));

constexpr int DM = 2048, NB = 4, SEQ = 4096, MTOK = NB * SEQ, DFF = 8192;
constexpr int EVEN_IN = 3376, EVEN_PAD = 3584, ODD_IN = 6176, ODD_PAD = 6400;
constexpr int E_QA = 0, E_KA = 1024, E_VA = 1280, E_QB = 1536, E_KC = 2560, E_VC = 2688, E_KS = 2816, E_VS = 2944, E_KW = 3072, E_VW = 3200, E_GT = 3328;
constexpr int O_Q = 0, O_K = 2048, O_V = 4096, O_F = 6144;
constexpr float LOG2E = 1.4426950408889634f;
constexpr float C1 = 0.125f * LOG2E;
constexpr float RMS_EPS = 1e-6f;

constexpr size_t MiB = 1u << 20;
constexpr size_t WS_WUP = 16 * MiB, WS_WDN = 144 * MiB, WS_WIE = 272 * MiB, WS_WIO = 300 * MiB, WS_WOE = 350 * MiB, WS_WOO = 366 * MiB;
constexpr size_t WS_CW1 = 382 * MiB, WS_CW2 = 386 * MiB, WS_KCMP = 387 * MiB, WS_VCMP = 387 * MiB + 512 * 1024, WS_C = 388 * MiB;
constexpr size_t WS_XN = 392 * MiB, WS_QKV = 456 * MiB, WS_AO = 656 * MiB, WS_H = 456 * MiB, WS_END = 720 * MiB;

constexpr int KP = 144, VP = 144, TILEB = 64 * 144;
constexpr int LDS_BYTES = 160 * 1024;

struct Args { const float* in[19]; float* out; unsigned char* ws; };
__device__ __forceinline__ const unsigned char __attribute__((address_space(4)))* karg_base() {
    const unsigned char __attribute__((address_space(4)))* kp = (const unsigned char __attribute__((address_space(4)))*)__builtin_amdgcn_kernarg_segment_ptr();
    asm volatile("" : "+s"(kp)); return kp; }
__device__ __forceinline__ const float* arg_in(int i) { return *(const float* const __attribute__((address_space(4)))*)(karg_base() + 8 * i); }
__device__ __forceinline__ float* arg_out() { return *(float* const __attribute__((address_space(4)))*)(karg_base() + 8 * 19); }
__device__ __forceinline__ unsigned char* arg_ws() { return *(unsigned char* const __attribute__((address_space(4)))*)(karg_base() + 8 * 20); }

__device__ __forceinline__ unsigned pkbf(float lo, float hi) {
    typedef float f2 __attribute__((ext_vector_type(2))); typedef __bf16 b2 __attribute__((ext_vector_type(2)));
    f2 v = {lo, hi}; b2 b = __builtin_convertvector(v, b2); return __builtin_bit_cast(unsigned, b);
}
__device__ __forceinline__ float bf2f(unsigned short u) { return __uint_as_float(((unsigned)u) << 16); }
__device__ __forceinline__ float ex2(float x) { return __builtin_amdgcn_exp2f(x); }
__device__ __forceinline__ void lds_add(LAS unsigned* p, unsigned v) { (void)__hip_atomic_fetch_add(p, v, __ATOMIC_RELAXED, __HIP_MEMORY_SCOPE_WORKGROUP); }
__device__ __forceinline__ void lds_or(LAS unsigned* p, unsigned v) { (void)__hip_atomic_fetch_or(p, v, __ATOMIC_RELAXED, __HIP_MEMORY_SCOPE_WORKGROUP); }
__device__ __forceinline__ int crow(int r, int hi) { return (r & 3) + 8 * (r >> 2) + 4 * hi; }
__device__ __forceinline__ v16f mfma32(v8s a, v8s b, v16f c) { return __builtin_amdgcn_mfma_f32_32x32x16_bf16(a, b, c, 0, 0, 0); }
__device__ __forceinline__ float wave_sum(float v) {
#pragma unroll
    for (int o = 1; o < 64; o <<= 1) v += __shfl_xor(v, o);
    return v;
}

__device__ __forceinline__ void tr_load(float (&v)[32], const float* W, int K, int N, int item, int lane) {
    const int nblk = (N + 31) / 32, kb = item / nblk, nb = item - kb * nblk, k0 = 64 * kb, n0 = 32 * nb;
    const int nn = n0 + (lane & 31); const bool ok = nn < N;
    const float* p = W + (size_t)(k0 + (lane >> 5)) * N + (ok ? nn : 0);
#pragma unroll
    for (int i = 0; i < 32; ++i) { const float x = p[(size_t)(2 * i) * N]; v[i] = ok ? x : 0.f; }
}
__device__ __forceinline__ void tr_put(const float (&v)[32], LAS float* scr, int lane) {
#pragma unroll
    for (int i = 0; i < 32; ++i) scr[(2 * i + (lane >> 5)) * 33 + (lane & 31)] = v[i];
}
__device__ __forceinline__ void tr_store(bf16_t* WT, int K, int N, LAS float* scr, int item, int lane) {
    const int nblk = (N + 31) / 32, kb = item / nblk, nb = item - kb * nblk, k0 = 64 * kb, n0 = 32 * nb;
    const int c = lane & 7;
#pragma unroll
    for (int j = 0; j < 4; ++j) { const int n = (lane >> 3) + 8 * j; const LAS float* s = scr + (8 * c) * 33 + n;
        v4u o; o.x = pkbf(s[0 * 33], s[1 * 33]); o.y = pkbf(s[2 * 33], s[3 * 33]); o.z = pkbf(s[4 * 33], s[5 * 33]); o.w = pkbf(s[6 * 33], s[7 * 33]);
        *(v4u*)(WT + (size_t)(n0 + n) * K + k0 + 8 * c) = o; }
}

__device__ __forceinline__ void prologue_phase(LAS unsigned char* lds) {
    const int tid = mk_ltid(), lane = tid & 63, wave = __builtin_amdgcn_readfirstlane(tid >> 6);
    LAS float* scr = (LAS float*)(lds + wave * 16384);
    const int gw = mk_bid() * 8 + wave, NGW = mk_grid() * 8;
    for (int mi = 0; mi < 24; ++mi) {
        unsigned char* ws = arg_ws();
        const float* W; int K, N; bf16_t* WT;
        if (mi < 4) { W = arg_in(17) + (size_t)mi * DM * DFF; K = DM; N = DFF; WT = (bf16_t*)(ws + WS_WUP) + (size_t)mi * DFF * DM; }
        else if (mi < 8) { const int L = mi - 4; W = arg_in(18) + (size_t)L * DFF * DM; K = DFF; N = DM; WT = (bf16_t*)(ws + WS_WDN) + (size_t)L * DM * DFF; }
        else if (mi < 10) { const int e = mi - 8; W = arg_in(5) + (size_t)e * DM * EVEN_IN; K = DM; N = EVEN_IN; WT = (bf16_t*)(ws + WS_WIE) + (size_t)e * EVEN_PAD * DM; }
        else if (mi < 12) { const int e = mi - 10; W = arg_in(14) + (size_t)e * DM * ODD_IN; K = DM; N = ODD_IN; WT = (bf16_t*)(ws + WS_WIO) + (size_t)e * ODD_PAD * DM; }
        else if (mi < 14) { const int e = mi - 12; W = arg_in(6) + (size_t)e * DM * DM; K = DM; N = DM; WT = (bf16_t*)(ws + WS_WOE) + (size_t)e * DM * DM; }
        else if (mi < 16) { const int e = mi - 14; W = arg_in(15) + (size_t)e * DM * DM; K = DM; N = DM; WT = (bf16_t*)(ws + WS_WOO) + (size_t)e * DM * DM; }
        else if (mi < 20) { const int e = (mi - 16) & 1, kv = (mi - 16) >> 1; W = arg_in(kv ? 12 : 10) + (size_t)e * 2048 * 256; K = 2048; N = 256; WT = (bf16_t*)(ws + WS_CW1) + (size_t)(e * 2 + kv) * 256 * 2048; }
        else { const int e = (mi - 20) & 1, kv = (mi - 20) >> 1; W = arg_in(kv ? 13 : 11) + (size_t)e * 256 * 64; K = 256; N = 64; WT = (bf16_t*)(ws + WS_CW2) + (size_t)(e * 2 + kv) * 64 * 256; }
        const int nitems = (K / 64) * ((N + 31) / 32);
        float v[32];
        int it = gw;
        if (it < nitems) tr_load(v, W, K, N, it, lane);
        while (it < nitems) {
            tr_put(v, scr, lane);
            const int nx = it + NGW;
            if (nx < nitems) tr_load(v, W, K, N, nx, lane);
            asm volatile("s_waitcnt lgkmcnt(0)" ::: "memory");
            tr_store(WT, K, N, scr, it, lane);
            asm volatile("s_waitcnt lgkmcnt(0)" ::: "memory");
            it = nx;
        }
    }
}

__device__ __forceinline__ void norm_phase(const float* X, const float* g, bf16_t* XN, float* OUTF) {
    const int tid = mk_ltid(), lane = tid & 63, wave = tid >> 6;
    const int gw = mk_bid() * 8 + wave, NGW = mk_grid() * 8;
    v4f gv[8];
#pragma unroll
    for (int j = 0; j < 8; ++j) gv[j] = *((const v4f*)g + lane + 64 * j);
    for (int m = gw; m < MTOK; m += NGW) {
        const v4f* xr = (const v4f*)(X + (size_t)m * DM) + lane;
        v4f v[8]; float s = 0.f;
#pragma unroll
        for (int j = 0; j < 8; ++j) { v[j] = xr[64 * j]; s += (v[j].x * v[j].x + v[j].y * v[j].y) + (v[j].z * v[j].z + v[j].w * v[j].w); }
        const float r = 1.0f / sqrtf(wave_sum(s) * (1.f / DM) + RMS_EPS);
        if (OUTF) {
            v4f* o = (v4f*)(OUTF + (size_t)m * DM) + lane;
#pragma unroll
            for (int j = 0; j < 8; ++j) o[64 * j] = v[j] * r * gv[j];
        } else {
            v2u* o = (v2u*)(XN + (size_t)m * DM) + lane;
#pragma unroll
            for (int j = 0; j < 8; ++j) { const v4f y = v[j] * r * gv[j]; v2u w; w.x = pkbf(y.x, y.y); w.y = pkbf(y.z, y.w); o[64 * j] = w; }
        }
    }
}

constexpr int KTB = 64 * KP, VHB = 4096 + 64, VTB = 2 * VHB;
constexpr int ATT_K = 0, ATT_V = 3 * KTB, ATT_AUX = ATT_V + 3 * VTB, ATT_END = ATT_AUX + 3 * 64 * 4 + 128;
static_assert(ATT_END == 53504, "attention LDS map");

__device__ __forceinline__ void qk_tile(const LAS unsigned char* Kt, const v8s (&qf)[4], v16f& p0, v16f& p1, int r32, int hi) {
    const LAS unsigned char* kb = Kt + r32 * KP + hi * 16;
    v16f z;
#pragma unroll
    for (int r = 0; r < 16; ++r) z[r] = 0.f;
    p0 = z; p1 = z;
#pragma unroll
    for (int s = 0; s < 4; ++s) {
        const v8s a0 = *(const LAS v8s*)(kb + s * 32);
        const v8s a1 = *(const LAS v8s*)(kb + 32 * KP + s * 32);
        p0 = mfma32(a0, qf[s], p0); p1 = mfma32(a1, qf[s], p1);
    }
}
__device__ __forceinline__ v4s trrd(const LAS unsigned char* p) { return __builtin_bit_cast(v4s, __builtin_amdgcn_ds_read_tr16_b64_v4i16((LAS v4s*)p)); }
__device__ __forceinline__ void pv_tile(const LAS unsigned char* Vt, const v16f& p0, const v16f& p1, v16f (&oT)[2], int lane) {
    const int hi = lane >> 5;
    v4u w[4];
    w[0] = (v4u){pkbf(p0[0], p0[1]), pkbf(p0[2], p0[3]), pkbf(p0[4], p0[5]), pkbf(p0[6], p0[7])};
    w[1] = (v4u){pkbf(p0[8], p0[9]), pkbf(p0[10], p0[11]), pkbf(p0[12], p0[13]), pkbf(p0[14], p0[15])};
    w[2] = (v4u){pkbf(p1[0], p1[1]), pkbf(p1[2], p1[3]), pkbf(p1[4], p1[5]), pkbf(p1[6], p1[7])};
    w[3] = (v4u){pkbf(p1[8], p1[9]), pkbf(p1[10], p1[11]), pkbf(p1[12], p1[13]), pkbf(p1[14], p1[15])};
    const LAS unsigned char* vb = Vt + (4 * hi + ((lane & 15) >> 2)) * 64 + (16 * ((lane >> 4) & 1) + 4 * (lane & 3)) * 2;
#pragma unroll
    for (int dt = 0; dt < 2; ++dt)
#pragma unroll
        for (int ks = 0; ks < 4; ++ks) {
            const int kvb = 16 * (ks & 1) + 32 * (ks >> 1);
            const v4s lo = trrd(vb + dt * VHB + kvb * 64), h4 = trrd(vb + dt * VHB + (kvb + 8) * 64);
            const v8s af = (v8s){lo[0], lo[1], lo[2], lo[3], h4[0], h4[1], h4[2], h4[3]};
            oT[dt] = mfma32(af, __builtin_bit_cast(v8s, w[ks]), oT[dt]);
        }
}

__device__ __forceinline__ void k_load(const LAS unsigned char* Kt, v8s (&kf)[8], int r32, int hi) {
    const LAS unsigned char* kb = Kt + r32 * KP + hi * 16;
#pragma unroll
    for (int s = 0; s < 4; ++s) { kf[2 * s] = *(const LAS v8s*)(kb + s * 32); kf[2 * s + 1] = *(const LAS v8s*)(kb + 32 * KP + s * 32); }
}
__device__ __forceinline__ void qk_mma(const v8s (&kf)[8], const v8s (&qf)[4], v16f& p0, v16f& p1) {
    v16f z;
#pragma unroll
    for (int r = 0; r < 16; ++r) z[r] = 0.f;
    p0 = z; p1 = z;
#pragma unroll
    for (int s = 0; s < 4; ++s) { p0 = mfma32(kf[2 * s], qf[s], p0); p1 = mfma32(kf[2 * s + 1], qf[s], p1); }
}
__device__ __forceinline__ void v_load(const LAS unsigned char* Vt, v4s (&vf)[16], int lane) {
    const int hi = lane >> 5;
    const LAS unsigned char* vb = Vt + (4 * hi + ((lane & 15) >> 2)) * 64 + (16 * ((lane >> 4) & 1) + 4 * (lane & 3)) * 2;
#pragma unroll
    for (int ks = 0; ks < 4; ++ks)
#pragma unroll
        for (int dt = 0; dt < 2; ++dt) {
            const int kvb = 16 * (ks & 1) + 32 * (ks >> 1);
            vf[4 * ks + 2 * dt] = trrd(vb + dt * VHB + kvb * 64); vf[4 * ks + 2 * dt + 1] = trrd(vb + dt * VHB + (kvb + 8) * 64);
        }
}
__device__ __forceinline__ void pv_mma(const v4s (&vf)[16], const v16f& p0, const v16f& p1, v16f (&oT)[2]) {
    v4u w[4];
    w[0] = (v4u){pkbf(p0[0], p0[1]), pkbf(p0[2], p0[3]), pkbf(p0[4], p0[5]), pkbf(p0[6], p0[7])};
    w[1] = (v4u){pkbf(p0[8], p0[9]), pkbf(p0[10], p0[11]), pkbf(p0[12], p0[13]), pkbf(p0[14], p0[15])};
    w[2] = (v4u){pkbf(p1[0], p1[1]), pkbf(p1[2], p1[3]), pkbf(p1[4], p1[5]), pkbf(p1[6], p1[7])};
    w[3] = (v4u){pkbf(p1[8], p1[9]), pkbf(p1[10], p1[11]), pkbf(p1[12], p1[13]), pkbf(p1[14], p1[15])};
#pragma unroll
    for (int ks = 0; ks < 4; ++ks)
#pragma unroll
        for (int dt = 0; dt < 2; ++dt) {
            const v4s lo = vf[4 * ks + 2 * dt], h4 = vf[4 * ks + 2 * dt + 1];
            const v8s af = (v8s){lo[0], lo[1], lo[2], lo[3], h4[0], h4[1], h4[2], h4[3]};
            oT[dt] = mfma32(af, __builtin_bit_cast(v8s, w[ks]), oT[dt]);
        }
}
__device__ __forceinline__ float max3f(float a, float b, float c) { return __builtin_fmaxf(__builtin_fmaxf(a, b), c); }
__device__ __forceinline__ void softmax_step(v16f& p0, v16f& p1, v16f (&oT)[2], float& m, float& l, bool rowok) {
    float a = max3f(p0[0], p0[1], p1[0]), b = max3f(p0[2], p0[3], p1[1]); a = max3f(a, p1[2], p1[3]);
#pragma unroll
    for (int r = 4; r < 16; r += 4) { a = max3f(a, p0[r], p0[r + 1]); b = max3f(b, p0[r + 2], p0[r + 3]); a = max3f(a, p1[r], p1[r + 1]); b = max3f(b, p1[r + 2], p1[r + 3]); }
    float mx = fmaxf(a, b);
    mx = fmaxf(mx, __shfl_xor(mx, 32));
    if (!rowok) mx = -INFINITY;
    const float mn = fmaxf(m, mx);
    const float mu = (mn == -INFINITY) ? 0.f : mn;
    if (__any(mn > m)) {
        const float alpha = ex2(m - mu);
        oT[0] = oT[0] * alpha; oT[1] = oT[1] * alpha; l *= alpha;
    }
    const float mue = rowok ? mu : INFINITY;
    p0 = p0 - mue; p1 = p1 - mue;
#pragma unroll
    for (int r = 0; r < 16; ++r) { p0[r] = ex2(p0[r]); p1[r] = ex2(p1[r]); }
    const v16f s = p0 + p1;
    l += ((s[0] + s[1]) + (s[2] + s[3])) + ((s[4] + s[5]) + (s[6] + s[7])) + (((s[8] + s[9]) + (s[10] + s[11])) + ((s[12] + s[13]) + (s[14] + s[15])));
    m = mn;
}
__device__ __forceinline__ v4u ld_tile(const bf16_t* base, int row0, int pitch, int tid) { return *(const v4u*)(base + (size_t)(row0 + (tid >> 3)) * pitch + (tid & 7) * 8); }
__device__ __forceinline__ void st_k(LAS unsigned char* T, v4u v, int tid) { *(LAS v4u*)(T + (tid >> 3) * KP + (tid & 7) * 16) = v; }
__device__ __forceinline__ void st_v(LAS unsigned char* T, v4u v, int tid) { *(LAS v4u*)(T + ((tid >> 2) & 1) * VHB + (tid >> 3) * 64 + (tid & 3) * 16) = v; }
__device__ __forceinline__ void store_o(bf16_t* Orow, const v16f (&o)[2], int hi) {
#pragma unroll
    for (int dt = 0; dt < 2; ++dt)
#pragma unroll
        for (int g = 0; g < 4; ++g) { v2u w; w.x = pkbf(o[dt][4 * g], o[dt][4 * g + 1]); w.y = pkbf(o[dt][4 * g + 2], o[dt][4 * g + 3]);
            *(v2u*)(Orow + dt * 32 + 8 * g + 4 * hi) = w; }
}
__device__ __forceinline__ int rel_bucket(int n) {
    if (n < 16) return n;
    const float v = __log2f((float)n * (1.f / 16.f)) * (16.f / 6.f) + 1e-5f;
    const int b = 16 + (int)v; return b < 31 ? b : 31;
}

template <bool AUX, int VAR = 0, class Seq, class Sc>
__device__ __forceinline__ void attn_engine(LAS unsigned char* lds, const bf16_t* Kg, const bf16_t* Vg, int pitch, const float* auxg, Seq seq, const v8s (&qf)[4],
                                            v16f (&oT)[2], float& m, float& l, const Sc& sc, int tid, int lane) {
    const int r32 = lane & 31, hi = lane >> 5;
    int tc = seq.pop(); if (tc < 0) return;
    int tn = seq.pop(), tnn = (tn >= 0) ? seq.pop() : -1;
    LAS float* AUXL = (LAS float*)(lds + ATT_AUX);
    v4u kr = ld_tile(Kg, 64 * tc, pitch, tid), vr = ld_tile(Vg, 64 * tc, pitch, tid); float ar = 0.f;
    if (AUX && tid < 64) ar = auxg[64 * tc + tid];
    v4u kr2 = kr, vr2 = vr; float ar2 = 0.f;
    if (tn >= 0) { kr2 = ld_tile(Kg, 64 * tn, pitch, tid); vr2 = ld_tile(Vg, 64 * tn, pitch, tid); if (AUX && tid < 64) ar2 = auxg[64 * tn + tid]; }
    __syncthreads();
    st_k(lds + ATT_K, kr, tid); st_v(lds + ATT_V, vr, tid); if (AUX && tid < 64) AUXL[tid] = ar;
    if (tn >= 0) { st_k(lds + ATT_K + KTB, kr2, tid); st_v(lds + ATT_V + VTB, vr2, tid); if (AUX && tid < 64) AUXL[64 + tid] = ar2; }
    if (tnn >= 0) { kr = ld_tile(Kg, 64 * tnn, pitch, tid); vr = ld_tile(Vg, 64 * tnn, pitch, tid); if (AUX && tid < 64) ar = auxg[64 * tnn + tid]; }
    __syncthreads();
    v16f a0, a1, b0, b1;
    int bi = 0;
    if (sc.active(tc)) { qk_tile(lds + ATT_K, qf, a0, a1, r32, hi); sc.apply(a0, a1, tc, AUXL); }
#define ATT_STEP(C0, C1, N0, N1) { \
        __syncthreads(); \
        const int b2_ = (bi >= 1) ? bi - 1 : 2, b1_ = (bi == 2) ? 0 : bi + 1; int t3_ = -1; \
        if (tnn >= 0) { st_k(lds + ATT_K + b2_ * KTB, kr, tid); st_v(lds + ATT_V + b2_ * VTB, vr, tid); if (AUX && tid < 64) AUXL[b2_ * 64 + tid] = ar; \
            t3_ = seq.pop(); \
            if (t3_ >= 0 && VAR != 3) { kr = ld_tile(Kg, 64 * t3_, pitch, tid); vr = ld_tile(Vg, 64 * t3_, pitch, tid); if (AUX && tid < 64) ar = auxg[64 * t3_ + tid]; } } \
        const bool actn_ = (tn >= 0) && sc.active(tn), actc_ = sc.active(tc); \
        v8s kf_[8]; v4s vf_[16]; \
        if (actn_) { k_load(lds + ATT_K + b1_ * KTB, kf_, r32, hi); __builtin_amdgcn_sched_barrier(0); if (VAR != 2) qk_mma(kf_, qf, N0, N1); else { N0 = oT[0] + __builtin_bit_cast(v4f, kf_[0])[0]; N1 = oT[1] + __builtin_bit_cast(v4f, kf_[5])[1]; } } \
        __builtin_amdgcn_sched_barrier(0); \
        if (actc_) v_load(lds + ATT_V + bi * VTB, vf_, lane); \
        __builtin_amdgcn_sched_barrier(0); \
        if (actc_) { if (VAR != 1) softmax_step(C0, C1, oT, m, l, sc.rowok(tc)); if (VAR != 2) pv_mma(vf_, C0, C1, oT); else { oT[0] = oT[0] + C0 * __builtin_bit_cast(v2u, vf_[3])[0]; oT[1] = oT[1] + C1 * __builtin_bit_cast(v2u, vf_[9])[1]; } } \
        if (actn_) sc.apply(N0, N1, tn, AUXL + b1_ * 64); \
        tc = tn; tn = tnn; tnn = t3_; bi = b1_; \
        if (tc < 0) break; }
    for (;;) {
        ATT_STEP(a0, a1, b0, b1)
        ATT_STEP(b0, b1, a0, a1)
    }
#undef ATT_STEP
}
struct RangeSeq { int cur, last; __device__ __forceinline__ int pop() { const int t = cur; if (t > last) return -1; cur = t + 1; return t; } };
struct MaskSeq { unsigned long long rem; __device__ __forceinline__ int pop() { if (rem == 0ull) return -1; const int t = __builtin_ctzll(rem); rem &= rem - 1ull; return t; } };

__device__ __forceinline__ void cumsum_phase(LAS unsigned char* lds, const bf16_t* QKV, const float* fb, float* CL2) {
    const int tid = mk_ltid(), lane = tid & 63, wave = tid >> 6;
    LAS float* wtot = (LAS float*)lds;
    for (int u = mk_bid(); u < NB * 32; u += mk_grid()) {
        const int b = u >> 5, h = u & 31; const float bias = fb[h];
        float v[8]; float run = 0.f;
#pragma unroll
        for (int i = 0; i < 8; ++i) { const int t = tid * 8 + i; const float x = bf2f(QKV[(size_t)(b * SEQ + t) * ODD_PAD + O_F + h]) + bias;
            const float ls = fminf(x, 0.f) - log1pf(expf(-fabsf(x))); run += ls; v[i] = run; }
        float inc = run;
#pragma unroll
        for (int o = 1; o < 64; o <<= 1) { const float t = __shfl_up(inc, o); if (lane >= o) inc += t; }
        __syncthreads();
        if (lane == 63) wtot[wave] = inc;
        __syncthreads();
        float off = inc - run;
        for (int w2 = 0; w2 < wave; ++w2) off += wtot[w2];
        float* o = CL2 + (size_t)u * SEQ + tid * 8;
#pragma unroll
        for (int i = 0; i < 8; ++i) o[i] = (v[i] + off) * LOG2E;
    }
}

struct FoxSc {
    int qw0, qpos, hi;
    __device__ __forceinline__ bool active(int t) const { return 64 * t <= qw0 + 31; }
    __device__ __forceinline__ bool rowok(int) const { return true; }
    __device__ __forceinline__ void apply(v16f& p0, v16f& p1, int t, const LAS float* aux) const {
        const LAS float* kbp = aux + 4 * hi;
        v16f c0, c1;
#pragma unroll
        for (int g = 0; g < 4; ++g) {
            const v4f x0 = *(const LAS v4f*)(kbp + 8 * g), x1 = *(const LAS v4f*)(kbp + 32 + 8 * g);
#pragma unroll
            for (int e = 0; e < 4; ++e) { c0[4 * g + e] = x0[e]; c1[4 * g + e] = x1[e]; }
        }
        p0 = p0 * C1 - c0; p1 = p1 * C1 - c1;
        if (64 * t + 63 > qw0) {
#pragma unroll
            for (int r = 0; r < 16; ++r) { const int kv = 64 * t + crow(r, hi);
                if (kv > qpos) p0[r] = -INFINITY; if (kv + 32 > qpos) p1[r] = -INFINITY; }
        }
    }
};

template <int VAR = 0>
__device__ __forceinline__ void fox_phase(LAS unsigned char* lds, const bf16_t* QKV, const float* CL2, bf16_t* AO) {
    const int w = __builtin_amdgcn_readfirstlane(mk_ltid() >> 6);
    for (int j = mk_bid(); j < NB * 32 * 16; j += mk_grid()) {
        const int tid = mk_ltid(), lane = tid & 63, r32 = lane & 31, hi = lane >> 5;
        const int rr = j >> 7, bh = j & 127, i2 = rr >> 1; int sel = rr & 1; if (i2 & 1) sel ^= 1;
        const int qb = 15 - (2 * i2 + sel), b = bh >> 5, h = bh & 31;
        const int q0 = qb * 256, qw0 = q0 + 32 * w, qpos = qw0 + r32;
        const bf16_t* Qg = QKV + (size_t)(b * SEQ + qpos) * ODD_PAD + O_Q + h * 64 + hi * 8;
        v8s qf[4];
#pragma unroll
        for (int s = 0; s < 4; ++s) qf[s] = *(const v8s*)(Qg + s * 16);
        const bf16_t* Kg = QKV + (size_t)(b * SEQ) * ODD_PAD + O_K + h * 64;
        const bf16_t* Vg = QKV + (size_t)(b * SEQ) * ODD_PAD + O_V + h * 64;
        v16f oT[2];
#pragma unroll
        for (int r = 0; r < 16; ++r) { oT[0][r] = 0.f; oT[1][r] = 0.f; }
        float m = -INFINITY, l = 0.f;
        const FoxSc sc{qw0, qpos, hi};
        attn_engine<true, VAR>(lds, Kg, Vg, ODD_PAD, CL2 + (size_t)(b * 32 + h) * SEQ, RangeSeq{0, (q0 + 256) / 64 - 1}, qf, oT, m, l, sc, tid, lane);
        l += __shfl_xor(l, 32);
        const float inv = 1.f / l;
        oT[0] = oT[0] * inv; oT[1] = oT[1] * inv;
        store_o(AO + (size_t)(b * SEQ + qpos) * DM + h * 64, oT, hi);
    }
}

__device__ __forceinline__ void fox_scores(v16f& p0, v16f& p1, const v16f& c0, const v16f& c1, bool diag, int t, int qpos, int hi) {
    p0 = p0 * C1 - c0; p1 = p1 * C1 - c1;
    if (diag) {
#pragma unroll
        for (int r = 0; r < 16; ++r) { const int kv = 64 * t + crow(r, hi); if (kv > qpos) p0[r] = -INFINITY; if (kv + 32 > qpos) p1[r] = -INFINITY; }
    }
}
__device__ __forceinline__ void fox2_phase(LAS unsigned char* lds, const bf16_t* QKV, const float* CL2, bf16_t* AO) {
    const int w = __builtin_amdgcn_readfirstlane(mk_ltid() >> 6);
    LAS float* AUXL = (LAS float*)(lds + ATT_AUX);
    for (int j = mk_bid(); j < NB * 32 * 8; j += mk_grid()) {
        const int tid = mk_ltid(), lane = tid & 63, r32 = lane & 31, hi = lane >> 5;
        const int rr = j >> 7, bh = j & 127, i2 = rr >> 1; int sel = rr & 1; if (i2 & 1) sel ^= 1;
        const int qb = 7 - (2 * i2 + sel), b = bh >> 5, h = bh & 31;
        const int q0 = qb * 512, qw0 = q0 + 64 * w, qposA = qw0 + r32, qposB = qposA + 32;
        const bf16_t* Qg = QKV + (size_t)(b * SEQ + qposA) * ODD_PAD + O_Q + h * 64 + hi * 8;
        v8s qa[4], qb_[4];
#pragma unroll
        for (int s = 0; s < 4; ++s) { qa[s] = *(const v8s*)(Qg + s * 16); qb_[s] = *(const v8s*)(Qg + (size_t)32 * ODD_PAD + s * 16); }
        const bf16_t* Kg = QKV + (size_t)(b * SEQ) * ODD_PAD + O_K + h * 64;
        const bf16_t* Vg = QKV + (size_t)(b * SEQ) * ODD_PAD + O_V + h * 64;
        const float* cl = CL2 + (size_t)(b * 32 + h) * SEQ;
        const int nt = (q0 + 512) / 64, tw = qw0 >> 6;
        v16f oA[2], oB[2];
#pragma unroll
        for (int r = 0; r < 16; ++r) { oA[0][r] = 0.f; oA[1][r] = 0.f; oB[0][r] = 0.f; oB[1][r] = 0.f; }
        float mA = -INFINITY, lA = 0.f, mB = -INFINITY, lB = 0.f;
        v4u kr = ld_tile(Kg, 0, ODD_PAD, tid), vr = ld_tile(Vg, 0, ODD_PAD, tid); float ar = (tid < 64) ? cl[tid] : 0.f;
        v4u kr2 = ld_tile(Kg, 64, ODD_PAD, tid), vr2 = ld_tile(Vg, 64, ODD_PAD, tid); float ar2 = (tid < 64) ? cl[64 + tid] : 0.f;
        __syncthreads();
        st_k(lds + ATT_K, kr, tid); st_v(lds + ATT_V, vr, tid); if (tid < 64) AUXL[tid] = ar;
        st_k(lds + ATT_K + KTB, kr2, tid); st_v(lds + ATT_V + VTB, vr2, tid); if (tid < 64) AUXL[64 + tid] = ar2;
        kr = ld_tile(Kg, 128, ODD_PAD, tid); vr = ld_tile(Vg, 128, ODD_PAD, tid); if (tid < 64) ar = cl[128 + tid];
        int bi = 0;
#pragma unroll 1
        for (int t = 0; t < nt; ++t) {
            __syncthreads();
            const int b2 = (bi >= 1) ? bi - 1 : 2;
            if (t + 2 < nt) { st_k(lds + ATT_K + b2 * KTB, kr, tid); st_v(lds + ATT_V + b2 * VTB, vr, tid); if (tid < 64) AUXL[b2 * 64 + tid] = ar;
                if (t + 3 < nt) { kr = ld_tile(Kg, 64 * (t + 3), ODD_PAD, tid); vr = ld_tile(Vg, 64 * (t + 3), ODD_PAD, tid); if (tid < 64) ar = cl[64 * (t + 3) + tid]; } }
            if (t <= tw) {
                const bool diag = (t == tw);
                v16f a0, a1, b0, b1;
                { v8s kf[8]; k_load(lds + ATT_K + bi * KTB, kf, r32, hi); qk_mma(kf, qa, a0, a1); qk_mma(kf, qb_, b0, b1); }
                { v16f c0, c1; const LAS float* kbp = AUXL + bi * 64 + 4 * hi;
#pragma unroll
                  for (int g = 0; g < 4; ++g) { const v4f x0 = *(const LAS v4f*)(kbp + 8 * g), x1 = *(const LAS v4f*)(kbp + 32 + 8 * g);
#pragma unroll
                      for (int e = 0; e < 4; ++e) { c0[4 * g + e] = x0[e]; c1[4 * g + e] = x1[e]; } }
                  fox_scores(a0, a1, c0, c1, diag, t, qposA, hi); fox_scores(b0, b1, c0, c1, diag, t, qposB, hi); }
                softmax_step(a0, a1, oA, mA, lA, true); softmax_step(b0, b1, oB, mB, lB, true);
                { v4s vf[16]; v_load(lds + ATT_V + bi * VTB, vf, lane); pv_mma(vf, a0, a1, oA); pv_mma(vf, b0, b1, oB); }
            }
            bi = (bi == 2) ? 0 : bi + 1;
        }
        lA += __shfl_xor(lA, 32); lB += __shfl_xor(lB, 32);
        const float ia = 1.f / lA, ib = 1.f / lB;
        oA[0] = oA[0] * ia; oA[1] = oA[1] * ia; oB[0] = oB[0] * ib; oB[1] = oB[1] * ib;
        store_o(AO + (size_t)(b * SEQ + qposA) * DM + h * 64, oA, hi);
        store_o(AO + (size_t)(b * SEQ + qposB) * DM + h * 64, oB, hi);
    }
}

__device__ __forceinline__ float gelu_tanh(float x) {
    const float u = 0.7978845608028654f * (x + 0.044715f * x * x * x);
    const float t = 1.f - 2.f / (1.f + __expf(2.f * u));
    return 0.5f * x * (1.f + t);
}
__device__ __forceinline__ void compress_unit(LAS unsigned char* lds, int u, const bf16_t* QKV, const float* pe_k, const float* pe_v,
                                              const bf16_t* CW1  , const bf16_t* CW2  , bf16_t* KCMP, bf16_t* VCMP) {
    const int tid = mk_ltid(), lane = tid & 63, w = __builtin_amdgcn_readfirstlane(tid >> 6), r32 = lane & 31, hi = lane >> 5;
    const int kv = u >> 6, b = (u >> 4) & 3, g = (u >> 3) & 1, ch = u & 7;
    const float* pe = kv ? pe_v : pe_k;
    const bf16_t* W1 = CW1 + (size_t)kv * 256 * 2048; const bf16_t* W2 = CW2 + (size_t)kv * 64 * 256;
    bf16_t* OUT = (kv ? VCMP : KCMP) + (size_t)((b * 2 + g) * 256 + ch * 32) * 64;
    const int n = ch * 32 + r32;
    const bf16_t* Ag = QKV + (size_t)(b * SEQ + 16 * n) * EVEN_PAD + (kv ? E_VC : E_KC) + g * 64 + hi * 8;
    const bf16_t* Bg = W1 + (size_t)(32 * w + r32) * 2048 + hi * 8;
    LAS bf16_t* HID = (LAS bf16_t*)lds;
    LAS float* PE = (LAS float*)(lds + 20480);
    v16f acc;
#pragma unroll
    for (int r = 0; r < 16; ++r) acc[r] = 0.f;
    __syncthreads();
    *(LAS v4f*)(PE + tid * 4) = *(const v4f*)(pe + tid * 4);
    __syncthreads();
#pragma unroll 8
    for (int st = 0; st < 128; ++st) {
        const int li = st >> 2, d0 = (st & 3) * 16;
        const v4u ar = *(const v4u*)(Ag + (size_t)li * EVEN_PAD + d0);
        const v4f pa = *(const LAS v4f*)(PE + li * 64 + d0 + hi * 8), pb = *(const LAS v4f*)(PE + li * 64 + d0 + hi * 8 + 4);
        const v8s bfr = *(const v8s*)(Bg + st * 16);
        v4u aw;
        aw.x = pkbf(__uint_as_float(ar.x << 16) + pa.x, __uint_as_float(ar.x & 0xffff0000u) + pa.y);
        aw.y = pkbf(__uint_as_float(ar.y << 16) + pa.z, __uint_as_float(ar.y & 0xffff0000u) + pa.w);
        aw.z = pkbf(__uint_as_float(ar.z << 16) + pb.x, __uint_as_float(ar.z & 0xffff0000u) + pb.y);
        aw.w = pkbf(__uint_as_float(ar.w << 16) + pb.z, __uint_as_float(ar.w & 0xffff0000u) + pb.w);
        acc = mfma32(__builtin_bit_cast(v8s, aw), bfr, acc);
    }
#pragma unroll
    for (int r = 0; r < 16; ++r) HID[crow(r, hi) * 264 + 32 * w + r32] = (bf16_t)(pkbf(gelu_tanh(acc[r]), 0.f) & 0xffffu);
    __syncthreads();
    if (w < 2) {
        v16f o;
#pragma unroll
        for (int r = 0; r < 16; ++r) o[r] = 0.f;
        const bf16_t* B2 = W2 + (size_t)(32 * w + r32) * 256 + hi * 8;
#pragma unroll
        for (int st = 0; st < 16; ++st) {
            const v8s af = *(const LAS v8s*)(HID + r32 * 264 + st * 16 + hi * 8);
            const v8s bfr = *(const v8s*)(B2 + st * 16);
            o = mfma32(af, bfr, o);
        }
#pragma unroll
        for (int r = 0; r < 16; ++r) { const int nl = crow(r, hi); const bool valid = (ch * 32 + nl) < 255;
            OUT[(size_t)nl * 64 + 32 * w + r32] = valid ? (bf16_t)(pkbf(o[r], 0.f) & 0xffffu) : (bf16_t)0; }
    }
}

template <int NEGPAD>
struct TabSc {
    const LAS float* tb;
    int qpos, hi;
    __device__ __forceinline__ void apply_tab(v16f& p0, v16f& p1, int t) const {
        const LAS float* bp = tb + (NEGPAD + qpos - 64 * t - 63 - 4 * hi);
        v16f c0, c1;
#pragma unroll
        for (int r = 0; r < 16; ++r) { c0[r] = bp[63 - ((r & 3) + 8 * (r >> 2))]; c1[r] = bp[31 - ((r & 3) + 8 * (r >> 2))]; }
        p0 = p0 * C1 + c0; p1 = p1 * C1 + c1;
    }
};
struct SwaSc : TabSc<64> {
    int qw0;
    __device__ __forceinline__ bool active(int t) const { return 64 * t + 63 >= qw0 - 127 && 64 * t <= qw0 + 31; }
    __device__ __forceinline__ bool rowok(int) const { return true; }
    __device__ __forceinline__ void apply(v16f& p0, v16f& p1, int t, const LAS float*) const { apply_tab(p0, p1, t); }
};

__device__ __forceinline__ void swa_unit(LAS unsigned char* lds, int u, const bf16_t* QKV, const float* relb, const float* sinks, bf16_t* AO) {
    const int tid = mk_ltid(), lane = tid & 63, w = __builtin_amdgcn_readfirstlane(tid >> 6), r32 = lane & 31, hi = lane >> 5;
    LAS float* TB = (LAS float*)(lds + ATT_END);
    const int qblk = u >> 4, b = (u >> 2) & 3, g = u & 3;
    const int hq = 4 * g + (w >> 1), q0 = 64 * qblk, qw0 = q0 + 32 * (w & 1), qpos = qw0 + r32;
    __syncthreads();
    for (int i = tid; i < 1024; i += 512) { const int hh = i >> 8, d = (i & 255) - 64; TB[i] = (d >= 0 && d < 128) ? relb[rel_bucket(d) * 32 + 4 * g + hh] * LOG2E : -INFINITY; }
    const bf16_t* Qg = QKV + (size_t)(b * SEQ + qpos) * EVEN_PAD + E_QA + hq * 64 + hi * 8;
    v8s qf[4];
#pragma unroll
    for (int s = 0; s < 4; ++s) qf[s] = *(const v8s*)(Qg + s * 16);
    const bf16_t* Kg = QKV + (size_t)(b * SEQ) * EVEN_PAD + E_KA + g * 64;
    const bf16_t* Vg = QKV + (size_t)(b * SEQ) * EVEN_PAD + E_VA + g * 64;
    v16f oT[2];
#pragma unroll
    for (int r = 0; r < 16; ++r) { oT[0][r] = 0.f; oT[1][r] = 0.f; }
    float m = -INFINITY, l = 0.f;
    SwaSc sc; sc.tb = TB + (w >> 1) * 256; sc.qpos = qpos; sc.hi = hi; sc.qw0 = qw0;
    attn_engine<false>(lds, Kg, Vg, EVEN_PAD, nullptr, RangeSeq{(qblk >= 2) ? qblk - 2 : 0, qblk}, qf, oT, m, l, sc, tid, lane);
    l += __shfl_xor(l, 32);
    const float sk = sinks[hq] * LOG2E;
    const float mf = fmaxf(m, sk);
    const float a = ex2(m - mf);
    const float inv = a / (l * a + ex2(sk - mf));
    oT[0] = oT[0] * inv; oT[1] = oT[1] * inv;
    store_o(AO + (size_t)(b * SEQ + qpos) * DM + hq * 64, oT, hi);
}

__device__ __forceinline__ void evenA_phase(LAS unsigned char* lds, const bf16_t* QKV, const float* relb, const float* sinks, const float* pe_k, const float* pe_v,
                                            const bf16_t* CW1, const bf16_t* CW2, bf16_t* KCMP, bf16_t* VCMP, bf16_t* AO) {
    for (int u = mk_bid(); u < 128 + 1024; u += mk_grid()) {
        if (u < 128) compress_unit(lds, u, QKV, pe_k, pe_v, CW1, CW2, KCMP, VCMP);
        else swa_unit(lds, u - 128, QKV, relb, sinks, AO);
    }
}

constexpr int NSA_TS = 1184, NSA_TW = 704;
constexpr int NSA_OFF_TS = ATT_END, NSA_OFF_TW = NSA_OFF_TS + 8 * NSA_TS * 4, NSA_OFF_IMP = NSA_OFF_TW + 8 * NSA_TW * 4, NSA_OFF_SEL = NSA_OFF_IMP + 32 * 64 * 4, NSA_OFF_UNI = NSA_OFF_SEL + 32 * 8;
static_assert(NSA_OFF_UNI + 64 <= LDS_BYTES, "NSA LDS map");

struct NsaSelSc : TabSc<64> {
    int q0; unsigned mlo, mhi;
    __device__ __forceinline__ bool active(int) const { return true; }
    __device__ __forceinline__ bool rowok(int t) const { return ((t < 32 ? (mlo >> t) : (mhi >> (t - 32))) & 1u) != 0u; }
    __device__ __forceinline__ void apply(v16f& p0, v16f& p1, int t, const LAS float*) const {
        if (q0 - (64 * t + 63) >= 1024) { const float b31 = tb[64 + 1024]; p0 = p0 * C1 + b31; p1 = p1 * C1 + b31; }
        else apply_tab(p0, p1, t);
    }
};
struct NsaWinSc : TabSc<64> {
    __device__ __forceinline__ bool active(int) const { return true; }
    __device__ __forceinline__ bool rowok(int) const { return true; }
    __device__ __forceinline__ void apply(v16f& p0, v16f& p1, int t, const LAS float*) const { apply_tab(p0, p1, t); }
};

__device__ __forceinline__ void nsa_phase(LAS unsigned char* lds, const bf16_t* QKV, const float* relb, const bf16_t* KCMP, const bf16_t* VCMP, bf16_t* AO, float* SCRG) {
    const int w = __builtin_amdgcn_readfirstlane(mk_ltid() >> 6);
    LAS unsigned char* KT = lds + ATT_K; LAS unsigned char* VT = lds + ATT_V;
    LAS float* TS = (LAS float*)(lds + NSA_OFF_TS); LAS float* TW = (LAS float*)(lds + NSA_OFF_TW); LAS unsigned* IMP = (LAS unsigned*)(lds + NSA_OFF_IMP);
    LAS unsigned* SEL = (LAS unsigned*)(lds + NSA_OFF_SEL); LAS unsigned* UNI = (LAS unsigned*)(lds + NSA_OFF_UNI);
    int cur_g = -1;
#define NSA_GATE(i) (1.f / (1.f + __expf(-bf2f(QKV[(size_t)(b * SEQ + qpos) * EVEN_PAD + E_GT + hq * 3 + (i)]))))
    for (int u = mk_bid(); u < 1024; u += mk_grid()) {
        const int qblk = 127 - (u >> 3), b = (u >> 1) & 3, g = u & 1;
        const int hq = 8 * g + w, q0 = 32 * qblk, bg = b * 2 + g;
        v8s qf[4]; v16f oT[2];
        float* SCR = SCRG + (size_t)mk_bid() * (512 * 32);
        {
            const int tid = mk_ltid(), lane = tid & 63, r32 = lane & 31, hi = lane >> 5, qpos = q0 + r32;
            __syncthreads();
            if (g != cur_g) { cur_g = g;
                for (int i = tid; i < 8 * NSA_TS; i += 512) { const int hh = i / NSA_TS, d = i - hh * NSA_TS - 64;
                    TS[i] = (d >= 0) ? relb[rel_bucket(d < 1024 ? d : 1024) * 32 + 16 + 8 * g + hh] * LOG2E : -INFINITY; }
                for (int i = tid; i < 8 * NSA_TW; i += 512) { const int hh = i / NSA_TW, d = i - hh * NSA_TW - 64;
                    TW[i] = (d >= 0 && d < 512) ? relb[rel_bucket(d) * 32 + 16 + 8 * g + hh] * LOG2E : -INFINITY; } }
            for (int i = tid; i < 32 * 64; i += 512) IMP[i] = 0u;
            if (tid < 2) UNI[tid] = 0u;
            const bf16_t* Qrow = QKV + (size_t)(b * SEQ + qpos) * EVEN_PAD;
#pragma unroll
            for (int s = 0; s < 4; ++s) qf[s] = *(const v8s*)(Qrow + E_QB + hq * 64 + hi * 8 + s * 16);
        }
        const bf16_t* Kc = KCMP + (size_t)bg * 256 * 64; const bf16_t* Vc = VCMP + (size_t)bg * 256 * 64;
        const int nct = (2 * qblk) / 64 + 1;
        float m = -INFINITY, l = 0.f;
        {
            const int tid = mk_ltid(), lane = tid & 63, r32 = lane & 31, hi = lane >> 5, qpos = q0 + r32; const LAS float* tb = TS + w * NSA_TS + 64;
            v4u kr = ld_tile(Kc, 0, 64, tid);
            for (int t = 0; t < nct; ++t) {
                const int buf = t & 1;
                st_k(KT + buf * KTB, kr, tid);
                __syncthreads();
                if (t + 1 < nct) kr = ld_tile(Kc, 64 * (t + 1), 64, tid);
                v16f p0, p1;
                qk_tile(KT + buf * KTB, qf, p0, p1, r32, hi);
                float mx = -INFINITY;
#pragma unroll
                for (int r = 0; r < 16; ++r) {
                    const int c0 = 64 * t + crow(r, hi); const int d0 = qpos - 16 * c0 - 31, d1 = d0 - 512;
                    p0[r] = p0[r] * C1 + tb[min(max(d0, -1), 1024)]; p1[r] = p1[r] * C1 + tb[min(max(d1, -1), 1024)];
                    mx = fmaxf(mx, fmaxf(p0[r], p1[r]));
                }
                mx = fmaxf(mx, __shfl_xor(mx, 32));
                const float mn = fmaxf(m, mx), mu = (mn == -INFINITY) ? 0.f : mn;
                float rs = 0.f;
#pragma unroll
                for (int r = 0; r < 16; ++r) rs += ex2(p0[r] - mu) + ex2(p1[r] - mu);
                l = l * ex2(m - mu) + rs; m = mn;
            }
        }
        l += __shfl_xor(l, 32);
        {
            const int tid = mk_ltid(), lane = tid & 63, r32 = lane & 31, hi = lane >> 5, qpos = q0 + r32; const LAS float* tb = TS + w * NSA_TS + 64;
            const float mu = (m == -INFINITY) ? 0.f : m, il = (l > 0.f) ? 1.f / l : 0.f;
            const float gt0 = NSA_GATE(0);
#pragma unroll
            for (int r = 0; r < 16; ++r) { oT[0][r] = 0.f; oT[1][r] = 0.f; }
            __syncthreads();
            v4u kr = ld_tile(Kc, 0, 64, tid), vr = ld_tile(Vc, 0, 64, tid);
            for (int t = 0; t < nct; ++t) {
                const int buf = t & 1;
                st_k(KT + buf * KTB, kr, tid); st_v(VT + buf * VTB, vr, tid);
                __syncthreads();
                if (t + 1 < nct) { kr = ld_tile(Kc, 64 * (t + 1), 64, tid); vr = ld_tile(Vc, 64 * (t + 1), 64, tid); }
                v16f p0, p1;
                qk_tile(KT + buf * KTB, qf, p0, p1, r32, hi);
#pragma unroll
                for (int r = 0; r < 16; ++r) {
                    const int c0 = 64 * t + crow(r, hi); const int d0 = qpos - 16 * c0 - 31, d1 = d0 - 512;
                    p0[r] = ex2(p0[r] * C1 + tb[min(max(d0, -1), 1024)] - mu) * il; p1[r] = ex2(p1[r] * C1 + tb[min(max(d1, -1), 1024)] - mu) * il;
                }
#pragma unroll
                for (int gq = 0; gq < 4; ++gq) {
                    const int sb0 = 16 * t + 2 * gq + hi, sb1 = sb0 + 8;
                    const unsigned a0 = (unsigned)(((p0[4 * gq] + p0[4 * gq + 1]) + (p0[4 * gq + 2] + p0[4 * gq + 3])) * 4194304.f + 0.5f);
                    const unsigned a1 = (unsigned)(((p1[4 * gq] + p1[4 * gq + 1]) + (p1[4 * gq + 2] + p1[4 * gq + 3])) * 4194304.f + 0.5f);
                    const unsigned e0 = (unsigned)(p0[4 * gq + 3] * 4194304.f + 0.5f), e1 = (unsigned)(p1[4 * gq + 3] * 4194304.f + 0.5f);
                    lds_add(IMP + r32 * 64 + sb0, a0); lds_add(IMP + r32 * 64 + sb1, a1);
                    lds_add(IMP + r32 * 64 + sb0 + 1, e0); if (sb1 + 1 < 64) lds_add(IMP + r32 * 64 + sb1 + 1, e1);
                }
                p0 = p0 * gt0; p1 = p1 * gt0;
                pv_tile(VT + buf * VTB, p0, p1, oT, lane);
            }
#pragma unroll
            for (int r = 0; r < 16; ++r) { SCR[r * 512 + tid] = oT[0][r]; SCR[(16 + r) * 512 + tid] = oT[1][r]; }
        }
        __syncthreads();
#pragma unroll 1
        for (int i = 0; i < 4; ++i) {
            const int lane = mk_ltid() & 63;
            const int qi = 4 * w + i, qp = q0 + qi, cur = qp >> 6;
            const unsigned v = IMP[qi * 64 + lane];
            const bool fut = lane > cur, forced = (lane == 0) || (lane == cur) || (lane == cur - 1);
            const unsigned key = ((fut ? 0u : (forced ? 0x3ffffffu : min(v + 1u, 0x3fffffeu))) << 6) | (unsigned)(63 - lane);
            int cnt = 0;
#pragma unroll
            for (int jj = 0; jj < 64; ++jj) { const unsigned kj = (unsigned)__builtin_amdgcn_readlane((int)key, jj); cnt += (kj > key) ? 1 : 0; }
            const unsigned long long msk = __ballot(!fut && cnt < 16);
            if (lane == 0) { SEL[2 * qi] = (unsigned)msk; SEL[2 * qi + 1] = (unsigned)(msk >> 32); lds_or(UNI, (unsigned)msk); lds_or(UNI + 1, (unsigned)(msk >> 32)); }
        }
        __syncthreads();
        {
            const int tid = mk_ltid(), lane = tid & 63, r32 = lane & 31, hi = lane >> 5, qpos = q0 + r32;
            const unsigned long long uni = ((unsigned long long)(unsigned)__builtin_amdgcn_readfirstlane((int)UNI[1]) << 32) | (unsigned)__builtin_amdgcn_readfirstlane((int)UNI[0]);
            const bf16_t* Kg = QKV + (size_t)(b * SEQ) * EVEN_PAD + E_KS + g * 64; const bf16_t* Vg = QKV + (size_t)(b * SEQ) * EVEN_PAD + E_VS + g * 64;
#pragma unroll
            for (int r = 0; r < 16; ++r) { oT[0][r] = 0.f; oT[1][r] = 0.f; }
            m = -INFINITY; l = 0.f;
            NsaSelSc sc; sc.tb = TS + w * NSA_TS; sc.qpos = qpos; sc.hi = hi; sc.q0 = q0; sc.mlo = SEL[2 * r32]; sc.mhi = SEL[2 * r32 + 1];
            attn_engine<false>(lds, Kg, Vg, EVEN_PAD, nullptr, MaskSeq{uni}, qf, oT, m, l, sc, tid, lane);
            l += __shfl_xor(l, 32);
            const float scl = (l > 0.f) ? NSA_GATE(1) / l : 0.f;
#pragma unroll
            for (int r = 0; r < 16; ++r) { SCR[r * 512 + tid] += oT[0][r] * scl; SCR[(16 + r) * 512 + tid] += oT[1][r] * scl; }
        }
        {
            const int tid = mk_ltid(), lane = tid & 63, r32 = lane & 31, hi = lane >> 5, qpos = q0 + r32;
            const bf16_t* Kg = QKV + (size_t)(b * SEQ) * EVEN_PAD + E_KW + g * 64; const bf16_t* Vg = QKV + (size_t)(b * SEQ) * EVEN_PAD + E_VW + g * 64;
#pragma unroll
            for (int r = 0; r < 16; ++r) { oT[0][r] = 0.f; oT[1][r] = 0.f; }
            m = -INFINITY; l = 0.f;
            NsaWinSc sc; sc.tb = TW + w * NSA_TW; sc.qpos = qpos; sc.hi = hi;
            attn_engine<false>(lds, Kg, Vg, EVEN_PAD, nullptr, RangeSeq{(q0 >= 511) ? ((q0 - 511) >> 6) : 0, (q0 + 31) >> 6}, qf, oT, m, l, sc, tid, lane);
            l += __shfl_xor(l, 32);
            const float scl = (l > 0.f) ? NSA_GATE(2) / l : 0.f;
#pragma unroll
            for (int r = 0; r < 16; ++r) { oT[0][r] = SCR[r * 512 + tid] + oT[0][r] * scl; oT[1][r] = SCR[(16 + r) * 512 + tid] + oT[1][r] * scl; }
            store_o(AO + (size_t)(b * SEQ + qpos) * DM + 1024 + hq * 64, oT, hi);
        }
    }
}

__device__ __forceinline__ unsigned xb_ld(unsigned* p)              { return __hip_atomic_load(p, __ATOMIC_RELAXED, __HIP_MEMORY_SCOPE_AGENT); }
__device__ __forceinline__ unsigned xb_add(unsigned* p, unsigned v) { return __hip_atomic_fetch_add(p, v, __ATOMIC_RELAXED, __HIP_MEMORY_SCOPE_AGENT); }
__device__ __forceinline__ unsigned xb_xcc_id() { return (unsigned)__builtin_amdgcn_s_getreg((3 << 11) | 20) & 0xFu; }
#define XB_TMO      128
#define XB_XCNT(j)  (256  + 64 * (j))
#define XB_XSUB(j)  (1280 + 64 * (j))
#define XB_XGEN(j)  (2304 + 64 * (j))
#define XB_TOP      3328
#define XB_TOPGEN   3392
#define XCD_BAR_WORDS 3456
#define XB_SPIN_CAP (1u << 18)

#define XB_SPIN(cond, bar) do { unsigned _sp = 0; while (cond) { __builtin_amdgcn_s_sleep(1); \
    if ((++_sp & 255u) == 0u) { if (xb_ld(&(bar)[XB_TMO])) break; if (_sp > XB_SPIN_CAP) { atomicAdd(&(bar)[XB_TMO], 1u); break; } } } } while (0)

struct XcdBarrier {
    unsigned* bar; unsigned x;
    volatile LAS unsigned* st;
};

__device__ __forceinline__ XcdBarrier xcd_barrier_post(unsigned* bar, volatile LAS unsigned* st) {
    XcdBarrier b; b.bar = bar; b.x = xb_xcc_id(); b.st = st;
    if (threadIdx.x == 0) (void)xb_add(&bar[XB_XCNT(b.x)], 1u);
    return b;
}
__device__ __forceinline__ void xcd_barrier_complete(unsigned* bar, unsigned x, unsigned& nloc, unsigned& nx) {
    const unsigned G = gridDim.x * gridDim.y * gridDim.z;
    unsigned sum, cnt, mine, sp = 0u;
    for (;;) {
        sum = 0u; cnt = 0u; mine = 0u;
#pragma unroll
        for (unsigned j = 0; j < 16; ++j) { const unsigned c = xb_ld(&bar[XB_XCNT(j)]); sum += c; cnt += (c > 0u) ? 1u : 0u; mine = (j == x) ? c : mine; }
        if (sum == G) break;
        __builtin_amdgcn_s_sleep(1);
        if ((++sp & 255u) == 0u) { if (xb_ld(&bar[XB_TMO])) break; if (sp > XB_SPIN_CAP) { atomicAdd(&bar[XB_TMO], 1u); break; } }
    }
    nloc = mine > 0u ? mine : 1u; nx = cnt > 0u ? cnt : 1u;
}

__device__ __forceinline__ void xcd_barrier(const XcdBarrier& b) {
    asm volatile("s_waitcnt vmcnt(0)" ::: "memory");
    __syncthreads();
    if (threadIdx.x == 0) {
        unsigned* bar = b.bar;
        __builtin_amdgcn_s_waitcnt(0);
        unsigned nloc = b.st[0], nx = b.st[1];
        if (nloc == 0u) { xcd_barrier_complete(bar, b.x, nloc, nx); b.st[0] = nloc; b.st[1] = nx; }
        const unsigned old = xb_add(&bar[XB_XSUB(b.x)], 1u);
        const unsigned gen = old / nloc;
        if (old + 1u == (gen + 1u) * nloc) {
            __builtin_amdgcn_fence(__ATOMIC_RELEASE, "agent");
            asm volatile("s_waitcnt vmcnt(0)" ::: "memory");
            const unsigned og = xb_add(&bar[XB_TOP], 1u);
            const unsigned tg = og / nx;
            if (og + 1u == (tg + 1u) * nx) xb_add(&bar[XB_TOPGEN], 1u);
            else XB_SPIN(xb_ld(&bar[XB_TOPGEN]) == tg, bar);
            __builtin_amdgcn_fence(__ATOMIC_ACQUIRE, "agent");
            xb_add(&bar[XB_XGEN(b.x)], 1u);
            asm volatile("s_waitcnt vmcnt(0)" ::: "memory");
        } else {
            XB_SPIN(xb_ld(&bar[XB_XGEN(b.x)]) == gen, bar);
            __builtin_amdgcn_fence(__ATOMIC_ACQUIRE, "agent");
            asm volatile("s_waitcnt vmcnt(0)" ::: "memory");
        }
    }
    __syncthreads();
}

__global__ void __launch_bounds__(512, 2) fwd_mega(Args a_unused) {
    extern __shared__ __attribute__((aligned(16))) unsigned char lds_raw[];
    LAS unsigned char* lds = (LAS unsigned char*)lds_raw;
    cg::grid_group grid = cg::this_grid();
    volatile LAS unsigned* xst = (volatile LAS unsigned*)(lds + LDS_BYTES - 64);
    if (threadIdx.x < 2) xst[threadIdx.x] = 0u;
    __syncthreads();
    XcdBarrier xb = xcd_barrier_post((unsigned*)arg_ws(), xst);
#define WSP(off) (arg_ws() + (off))
    prologue_phase(lds);
#ifdef DUP_PRO
    prologue_phase(lds);
#endif
    norm_phase(arg_in(0), arg_in(2), (bf16_t*)WSP(WS_XN), nullptr);
    grid.sync();
#pragma unroll 1
    for (int L = 0; L < 4; ++L) {
        const int e = L >> 1;
        if ((L & 1) == 0) {
            { pg8::Gemm gm{(const bf16_t*)WSP(WS_XN), (const bf16_t*)WSP(WS_WIE) + (size_t)e * EVEN_PAD * DM, MTOK, EVEN_PAD, DM}; pg8::StaticOrder S; S.init(MTOK, EVEN_PAD, mk_grid(), mk_bid());
              pg8::EpiBf16<0> E{(bf16_t*)WSP(WS_QKV), EVEN_PAD}; pg8::gemm_phase<pg8::EpiBf16<0>, pg8::StaticOrder, true, true>(lds, gm, S, E); }
            xcd_barrier(xb);
            evenA_phase(lds, (const bf16_t*)WSP(WS_QKV), arg_in(1), arg_in(7) + e * 16, arg_in(8) + e * 2048, arg_in(9) + e * 2048,
                        (const bf16_t*)WSP(WS_CW1) + (size_t)e * 2 * 256 * 2048, (const bf16_t*)WSP(WS_CW2) + (size_t)e * 2 * 64 * 256, (bf16_t*)WSP(WS_KCMP), (bf16_t*)WSP(WS_VCMP), (bf16_t*)WSP(WS_AO));
            xcd_barrier(xb);
#ifdef DUP_EVENA
            evenA_phase(lds, (const bf16_t*)WSP(WS_QKV), arg_in(1), arg_in(7) + e * 16, arg_in(8) + e * 2048, arg_in(9) + e * 2048,
                        (const bf16_t*)WSP(WS_CW1) + (size_t)e * 2 * 256 * 2048, (const bf16_t*)WSP(WS_CW2) + (size_t)e * 2 * 64 * 256, (bf16_t*)WSP(WS_KCMP), (bf16_t*)WSP(WS_VCMP), (bf16_t*)WSP(WS_AO));
            xcd_barrier(xb);
#endif
            nsa_phase(lds, (const bf16_t*)WSP(WS_QKV), arg_in(1), (const bf16_t*)WSP(WS_KCMP), (const bf16_t*)WSP(WS_VCMP), (bf16_t*)WSP(WS_AO), (float*)WSP(WS_XN));
            xcd_barrier(xb);
#ifdef DUP_NSA
            nsa_phase(lds, (const bf16_t*)WSP(WS_QKV), arg_in(1), (const bf16_t*)WSP(WS_KCMP), (const bf16_t*)WSP(WS_VCMP), (bf16_t*)WSP(WS_AO), (float*)WSP(WS_XN));
            xcd_barrier(xb);
#endif
            { pg8::Gemm gm{(const bf16_t*)WSP(WS_AO), (const bf16_t*)WSP(WS_WOE) + (size_t)e * DM * DM, MTOK, DM, DM}; pg8::StaticOrder S; S.init(MTOK, DM, mk_grid(), mk_bid());
              pg8::EpiRes E{(L == 0) ? arg_in(0) : (const float*)arg_out(), arg_out(), DM}; pg8::gemm_phase<pg8::EpiRes, pg8::StaticOrder, true, true>(lds, gm, S, E); }
        } else {
            { pg8::Gemm gm{(const bf16_t*)WSP(WS_XN), (const bf16_t*)WSP(WS_WIO) + (size_t)e * ODD_PAD * DM, MTOK, ODD_PAD, DM}; pg8::StaticOrder S; S.init(MTOK, ODD_PAD, mk_grid(), mk_bid());
              pg8::EpiBf16<0> E{(bf16_t*)WSP(WS_QKV), ODD_PAD}; pg8::gemm_phase<pg8::EpiBf16<0>, pg8::StaticOrder, true, true>(lds, gm, S, E); }
            xcd_barrier(xb);
            cumsum_phase(lds, (const bf16_t*)WSP(WS_QKV), arg_in(16) + e * 32, (float*)WSP(WS_C));
            xcd_barrier(xb);
#ifdef FOX2
            fox2_phase(lds, (const bf16_t*)WSP(WS_QKV), (const float*)WSP(WS_C), (bf16_t*)WSP(WS_AO));
#else
            fox_phase(lds, (const bf16_t*)WSP(WS_QKV), (const float*)WSP(WS_C), (bf16_t*)WSP(WS_AO));
#endif
            xcd_barrier(xb);
#ifdef DUP_FOX
            fox_phase<DUP_FOX>(lds, (const bf16_t*)WSP(WS_QKV), (const float*)WSP(WS_C), (bf16_t*)WSP(WS_XN));
            xcd_barrier(xb);
#endif
#ifdef DUP_SYNC
            for (int i_ = 0; i_ < 20; ++i_) xcd_barrier(xb);
#endif
            { pg8::Gemm gm{(const bf16_t*)WSP(WS_AO), (const bf16_t*)WSP(WS_WOO) + (size_t)e * DM * DM, MTOK, DM, DM}; pg8::StaticOrder S; S.init(MTOK, DM, mk_grid(), mk_bid());
              pg8::EpiRes E{(const float*)arg_out(), arg_out(), DM}; pg8::gemm_phase<pg8::EpiRes, pg8::StaticOrder, true, true>(lds, gm, S, E); }
        }
        xcd_barrier(xb);
        norm_phase(arg_out(), arg_in(3) + L * DM, (bf16_t*)WSP(WS_XN), nullptr);
#ifdef DUP_NORM
        norm_phase(arg_out(), arg_in(3) + L * DM, (bf16_t*)WSP(WS_XN), nullptr);
#endif
        xcd_barrier(xb);
        { pg8::Gemm gm{(const bf16_t*)WSP(WS_XN), (const bf16_t*)WSP(WS_WUP) + (size_t)L * DFF * DM, MTOK, DFF, DM}; pg8::StaticOrder S; S.init(MTOK, DFF, mk_grid(), mk_bid());
          pg8::EpiBf16<2> E{(bf16_t*)WSP(WS_H), DFF}; pg8::gemm_phase<pg8::EpiBf16<2>, pg8::StaticOrder, true, true>(lds, gm, S, E); }
        xcd_barrier(xb);
#ifdef DUP_UP
        { pg8::Gemm gm{(const bf16_t*)WSP(WS_XN), (const bf16_t*)WSP(WS_WUP) + (size_t)L * DFF * DM, MTOK, DFF, DM}; pg8::StaticOrder S; S.init(MTOK, DFF, mk_grid(), mk_bid());
          pg8::EpiBf16<2> E{(bf16_t*)WSP(WS_H), DFF}; pg8::gemm_phase<pg8::EpiBf16<2>, pg8::StaticOrder, true, true>(lds, gm, S, E); }
        xcd_barrier(xb);
#endif
        { pg8::Gemm gm{(const bf16_t*)WSP(WS_H), (const bf16_t*)WSP(WS_WDN) + (size_t)L * DM * DFF, MTOK, DM, DFF}; pg8::StaticOrder S; S.init(MTOK, DM, mk_grid(), mk_bid());
          pg8::EpiRes E{(const float*)arg_out(), arg_out(), DM}; pg8::gemm_phase<pg8::EpiRes, pg8::StaticOrder, true, true>(lds, gm, S, E); }
        xcd_barrier(xb);
#ifdef DUP_NORM
        if (L < 3) norm_phase(arg_out(), arg_in(2) + (L + 1) * DM, (bf16_t*)WSP(WS_XN), nullptr);
#endif
        if (L < 3) { norm_phase(arg_out(), arg_in(2) + (L + 1) * DM, (bf16_t*)WSP(WS_XN), nullptr); xcd_barrier(xb); }
        else norm_phase(arg_out(), arg_in(4), nullptr, arg_out());
    }
#undef WSP
}

extern "C" void kernel_launch(void* const* d_in, const int* in_sizes, int n_in, void* d_out, int out_size, void* d_ws, size_t ws_size, hipStream_t stream) {
    static int grid = 0;
    if (grid == 0) {
        if (n_in != 19 || out_size != MTOK * DM || ws_size < WS_END) { fprintf(stderr, "kernel_launch: unexpected shapes (n_in %d out %d ws %zu)\n", n_in, out_size, ws_size); grid = -1; return; }
        int dev = 0, cus = 0, per_cu = 0;
        (void)hipGetDevice(&dev);
        (void)hipDeviceGetAttribute(&cus, hipDeviceAttributeMultiprocessorCount, dev);
        (void)hipFuncSetAttribute((const void*)fwd_mega, hipFuncAttributeMaxDynamicSharedMemorySize, LDS_BYTES);
        (void)hipOccupancyMaxActiveBlocksPerMultiprocessor(&per_cu, (const void*)fwd_mega, 512, LDS_BYTES);
        if (per_cu < 1) per_cu = 1;
        grid = cus * per_cu;
        fprintf(stderr, "kernel_launch: grid %d (cus %d x %d)\n", grid, cus, per_cu);
    }
    if (grid < 0) return;
    if (hipMemsetAsync(d_ws, 0, 16384, stream) != hipSuccess) { fprintf(stderr, "kernel_launch: memset of the barrier words failed\n"); return; }
    Args a{};
    for (int i = 0; i < 19; ++i) a.in[i] = (const float*)d_in[i];
    a.out = (float*)d_out; a.ws = (unsigned char*)d_ws;
    void* args[] = {&a};
    hipError_t e = hipLaunchCooperativeKernel((void*)fwd_mega, dim3(grid), dim3(512), args, LDS_BYTES, stream);
    if (e != hipSuccess) fprintf(stderr, "cooperative launch failed: %s (grid %d)\n", hipGetErrorString(e), grid);
}
```

```cpp
#include <hip/hip_runtime.h>
#include <hip/hip_cooperative_groups.h>
#include <cstdio>
#include <cstdint>
#include <cmath>
namespace cg = cooperative_groups;
__device__ __forceinline__ int mk_ltid() { int t = threadIdx.x; asm volatile("" : "+v"(t)); return t; }
__device__ __forceinline__ int mk_bid() { int t = blockIdx.x; asm volatile("" : "+s"(t)); return t; }
__device__ __forceinline__ int mk_grid() { int t = gridDim.x; asm volatile("" : "+s"(t)); return t; }
namespace pg8 {
#define PG8_LAS __attribute__((address_space(3)))
typedef unsigned short bf16_t;
typedef short bf16x8 __attribute__((ext_vector_type(8)));
typedef float f32x4 __attribute__((ext_vector_type(4)));
typedef unsigned u32x4 __attribute__((ext_vector_type(4)));
constexpr int BM = 256, BK = 64, HALF = 128, HTB = HALF * BK * 2  , STAGE_BYTES = 8 * HTB, NXCD = 8, WGM = 8;

__host__ __device__ __forceinline__ int lds_byte(int r, int c) { const int st = (r >> 4) * 2 + (c >> 5), rr = r & 15, cc = c & 31, ob = rr * 64 + cc * 2; return st * 1024 + (ob ^ (((ob >> 9) & 1) << 5)); }
__host__ __device__ __forceinline__ void stage_rc(int b, int& R, int& C) { const int st = b / 1024, sb = b % 1024, swz = sb ^ (((sb >> 9) & 1) << 5); R = (st >> 1) * 16 + swz / 64; C = (st & 1) * 32 + (swz % 64) / 2; }
__host__ __device__ __forceinline__ int perm32(int rho) { const int n = rho >> 4, i = rho & 15; return 8 * (i >> 2) + 4 * n + (i & 3); }

struct Unit { int pm, pn; };
struct Gemm { const bf16_t* A; const bf16_t* Bt; int M, N, K; };

struct StaticOrder {
    int nM, nN, nwg, G, c;
    __host__ __device__ void init(int M, int N, int G_, int c_) { nM = M / BM; nN = N / BM; nwg = nM * nN; G = G_; c = c_; }
    __host__ __device__ bool next(int i, Unit& u) const {
        const long L = (long)i * G + c; if (L >= nwg) return false;
        int wgid = (int)L; { const int q = nwg / NXCD, r = nwg % NXCD, xcd = wgid % NXCD, off = wgid / NXCD; wgid = (xcd < r ? xcd * (q + 1) : r * (q + 1) + (xcd - r) * q) + off; }
        const int nig = WGM * nN, gid = wgid / nig, fm = gid * WGM, gsz = (nM - fm) < WGM ? (nM - fm) : WGM;
        u.pm = fm + ((wgid % nig) % gsz); u.pn = (wgid % nig) / gsz; return true;
    }
    __device__ __forceinline__ void a_ready(const Unit&) const {}
    __device__ __forceinline__ void done(const Unit&) const {}
};

__device__ __forceinline__ unsigned cvt_pk_bf16(float lo, float hi) { unsigned r; asm volatile("v_cvt_pk_bf16_f32 %0, %1, %2" : "=v"(r) : "v"(lo), "v"(hi)); return r; }
typedef float f32x2 __attribute__((ext_vector_type(2)));
template <int ACT  > struct EpiBf16 {
    static constexpr bool PERM = true, AFTER_DRAIN = false;
    bf16_t* O; int ldc; PG8_LAS const float* rl; int rbase;
    __device__ __forceinline__ void operator()(const f32x4 (&acc)[2][2][4][2], const Unit& u, int wr, int wc, int fr, int fq) const {
        const int row0 = u.pm * BM + wr * 64 + fr; const int col0 = u.pn * BM + wc * 32 + 8 * fq;
        float rs[2][4];
#pragma unroll
        for (int ai = 0; ai < 2; ++ai)
#pragma unroll
            for (int m = 0; m < 4; ++m) rs[ai][m] = rl[row0 + ai * HALF + m * 16 - rbase];
#pragma unroll
        for (int ai = 0; ai < 2; ++ai)
#pragma unroll
            for (int m = 0; m < 4; ++m) { bf16_t* rowp = O + (size_t)(row0 + ai * HALF + m * 16) * ldc + col0;
#pragma unroll
                for (int bj = 0; bj < 2; ++bj) { f32x4 v0 = acc[ai][bj][m][0] * rs[ai][m], v1 = acc[ai][bj][m][1] * rs[ai][m];
                    if (ACT == 2) {
#pragma unroll
                        for (int e = 0; e < 4; ++e) { float a = v0[e] > 0.f ? v0[e] : 0.f; v0[e] = a * a; float b = v1[e] > 0.f ? v1[e] : 0.f; v1[e] = b * b; } }
                    u32x4 w; w.x = cvt_pk_bf16(v0[0], v0[1]); w.y = cvt_pk_bf16(v0[2], v0[3]); w.z = cvt_pk_bf16(v1[0], v1[1]); w.w = cvt_pk_bf16(v1[2], v1[3]);
                    *(u32x4*)(rowp + bj * HALF) = w; } }
    }
};
struct EpiRes {
    static constexpr bool PERM = false, AFTER_DRAIN = false;
    const bf16_t* base; bf16_t* xb; int ldc; float* ssp; PG8_LAS float* red;
    __device__ __forceinline__ void operator()(const f32x4 (&acc)[2][2][4][2], const Unit& u, int wr, int wc, int fr, int fq) const {
        typedef unsigned u32x2_ __attribute__((ext_vector_type(2)));
        const int row0 = u.pm * BM + wr * 64 + fr; const int col0 = u.pn * BM + wc * 32 + 4 * fq;
#pragma unroll
        for (int ai = 0; ai < 2; ++ai)
#pragma unroll
            for (int m = 0; m < 4; ++m) { const size_t off = (size_t)(row0 + ai * HALF + m * 16) * ldc + col0; float q = 0.f;
                u32x2_ bv[2][2];
#pragma unroll
                for (int bj = 0; bj < 2; ++bj)
#pragma unroll
                    for (int n = 0; n < 2; ++n) bv[bj][n] = *(const u32x2_*)(base + off + bj * HALF + n * 16);
#pragma unroll
                for (int bj = 0; bj < 2; ++bj)
#pragma unroll
                    for (int n = 0; n < 2; ++n) { const u32x2_ bb = bv[bj][n]; f32x4 v = acc[ai][bj][m][n];
                        v[0] += __uint_as_float(bb.x << 16); v[1] += __uint_as_float(bb.x & 0xffff0000u); v[2] += __uint_as_float(bb.y << 16); v[3] += __uint_as_float(bb.y & 0xffff0000u);
                        u32x2_ w; w.x = cvt_pk_bf16(v[0], v[1]); w.y = cvt_pk_bf16(v[2], v[3]);
                        *(u32x2_*)(xb + off + bj * HALF + n * 16) = w;
                        q += (v[0] * v[0] + v[1] * v[1]) + (v[2] * v[2] + v[3] * v[3]); }
                q += __shfl_xor(q, 16); q += __shfl_xor(q, 32);
                if (fq == 0) red[wc * 256 + ai * HALF + wr * 64 + m * 16 + fr] = q; }
        asm volatile("s_waitcnt lgkmcnt(0)" ::: "memory"); __builtin_amdgcn_s_barrier(); asm volatile("" ::: "memory");
        const int t = threadIdx.x;
        if (t < 256) ssp[(size_t)u.pn * 16384 + u.pm * BM + t] = (red[t] + red[256 + t]) + (red[512 + t] + red[768 + t]);
    }
};
template <class Epi, class Sched, bool ALIGN_EPI = false, bool SP2 = false>
__device__ __forceinline__ void gemm_phase(PG8_LAS unsigned char* lds, const Gemm g, const Sched& S, const Epi& E) {
    const int tid = mk_ltid(), wid = __builtin_amdgcn_readfirstlane(tid >> 6), lane = tid & 63, wr = wid >> 2, wc = wid & 3, fr = lane & 15, fq = lane >> 4;
    const int K = g.K, nt = K / BK;
    unsigned voffA[2], voffB[2];
#pragma unroll
    for (int i = 0; i < 2; ++i) { int R, C; stage_rc(tid * 16 + i * 8192, R, C); const int Rb = Epi::PERM ? ((R & ~31) + perm32(R & 31)) : R;
        voffA[i] = (unsigned)(R * K + C) * 2u; voffB[i] = (unsigned)(Rb * K + C) * 2u; }
    const size_t kstep = (size_t)(BK * 2);
    const size_t hstep = (size_t)HALF * K * 2;
    const size_t tstep = 2 * hstep;
    const unsigned ldsw = (unsigned)wid * 1024u;
    const int aoff = lds_byte(wr * 64 + fr, fq * 8), boff = lds_byte(wc * 32 + fr, fq * 8);
#define PG8_SA(b, h) (((b) * 2 + (h)) * HTB)
#define PG8_SB(b, h) ((4 + (b) * 2 + (h)) * HTB)
#define PG8_STAGE(bufoff, gbase, voff) do { _Pragma("unroll") for (int _i = 0; _i < 2; ++_i) \
        __builtin_amdgcn_global_load_lds((const unsigned*)((const char*)(gbase) + (voff)[_i]), (PG8_LAS unsigned*)(lds + (bufoff) + ldsw + _i * 8192), 16, 0, 0); } while (0)
#define PG8_LDA(dst, b, h) do { _Pragma("unroll") for (int m = 0; m < 4; ++m) _Pragma("unroll") for (int k = 0; k < 2; ++k) dst[m][k] = *(const PG8_LAS bf16x8*)(lds + PG8_SA(b, h) + aoff + m * 2048 + k * 1024); } while (0)
#define PG8_LDB(dst, b, h) do { _Pragma("unroll") for (int n = 0; n < 2; ++n) _Pragma("unroll") for (int k = 0; k < 2; ++k) dst[n][k] = *(const PG8_LAS bf16x8*)(lds + PG8_SB(b, h) + boff + n * 2048 + k * 1024); } while (0)
#define PG8_MMA(ai, bj, At, Bt) do { __builtin_amdgcn_s_setprio(1); _Pragma("unroll") for (int m = 0; m < 4; ++m) _Pragma("unroll") for (int n = 0; n < 2; ++n) _Pragma("unroll") for (int k = 0; k < 2; ++k) \
        acc[ai][bj][m][n] = __builtin_amdgcn_mfma_f32_16x16x32_bf16(Bt[n][k], At[m][k], acc[ai][bj][m][n], 0, 0, 0); __builtin_amdgcn_s_setprio(0); } while (0)
#define PG8_WAIT_V(n) asm volatile("s_waitcnt vmcnt(" #n ")" ::: "memory")
#define PG8_WAIT_L(n) asm volatile("s_waitcnt lgkmcnt(" #n ")" ::: "memory")
#define PG8_BAR __builtin_amdgcn_s_barrier()
#define PG8_SCHED __builtin_amdgcn_sched_barrier(0)
    Unit cur, nxt; int ui = 0;
    if (!S.next(0, cur)) return;
    f32x4 acc[2][2][4][2];
#pragma unroll
    for (int a = 0; a < 2; ++a)
#pragma unroll
        for (int b = 0; b < 2; ++b)
#pragma unroll
            for (int m = 0; m < 4; ++m)
#pragma unroll
                for (int n = 0; n < 2; ++n) acc[a][b][m][n] = (f32x4){0.f, 0.f, 0.f, 0.f};
    bf16x8 At[4][2], B0[2][2], B1[2][2];
    const char* cA = (const char*)g.A + (size_t)cur.pm * tstep; const char* cB = (const char*)g.Bt + (size_t)cur.pn * tstep;
    S.a_ready(cur);
    if constexpr (SP2) {
        PG8_STAGE(PG8_SB(0, 0), cB, voffB); PG8_STAGE(PG8_SB(0, 1), cB + hstep, voffB); PG8_STAGE(PG8_SA(0, 0), cA, voffA); PG8_STAGE(PG8_SA(0, 1), cA + hstep, voffA);
        if (wr == 1) PG8_BAR;
        PG8_WAIT_V(2); PG8_BAR;
        PG8_STAGE(PG8_SB(1, 0), cB + kstep, voffB); PG8_STAGE(PG8_SA(1, 0), cA + kstep, voffA); PG8_STAGE(PG8_SB(1, 1), cB + hstep + kstep, voffB);
        PG8_WAIT_V(6); PG8_BAR;
    } else {
        PG8_STAGE(PG8_SB(0, 0), cB, voffB); PG8_STAGE(PG8_SA(0, 0), cA, voffA); PG8_STAGE(PG8_SB(0, 1), cB + hstep, voffB); PG8_STAGE(PG8_SA(0, 1), cA + hstep, voffA);
        if (wr == 1) PG8_BAR;
        PG8_WAIT_V(4); PG8_BAR;
        PG8_STAGE(PG8_SB(1, 0), cB + kstep, voffB); PG8_STAGE(PG8_SA(1, 0), cA + kstep, voffA); PG8_STAGE(PG8_SB(1, 1), cB + hstep + kstep, voffB);
        PG8_WAIT_V(6); PG8_BAR;
    }
    for (;;) {
        const bool has_next = S.next(ui + 1, nxt);
        const char* nA = has_next ? (const char*)g.A + (size_t)nxt.pm * tstep : cA; const char* nB = has_next ? (const char*)g.Bt + (size_t)nxt.pn * tstep : cB;
        for (int t = 0; t < nt; t += 2) {
            const bool last = (t == nt - 2);
            const char* a1 = cA + (size_t)(t + 1) * kstep;
            const char* a2 = last ? nA : cA + (size_t)(t + 2) * kstep; const char* b2 = last ? nB : cB + (size_t)(t + 2) * kstep;
            const char* a3 = a2 + kstep; const char* b3 = b2 + kstep;
            if (last && has_next) S.a_ready(nxt);
            if constexpr (SP2) {
            PG8_LDB(B0, 0, 0); PG8_LDB(B1, 0, 1); PG8_SCHED; PG8_LDA(At, 0, 0); PG8_STAGE(PG8_SA(1, 1), a1 + hstep, voffA);
            PG8_WAIT_V(8); PG8_WAIT_L(0); PG8_BAR; PG8_MMA(0, 0, At, B0); PG8_MMA(0, 1, At, B1); PG8_BAR; PG8_SCHED;
            PG8_LDA(At, 0, 1); PG8_STAGE(PG8_SB(0, 0), b2, voffB); PG8_STAGE(PG8_SB(0, 1), b2 + hstep, voffB); PG8_STAGE(PG8_SA(0, 0), a2, voffA);
            PG8_WAIT_V(8); PG8_WAIT_L(0); PG8_BAR; PG8_MMA(1, 0, At, B0); PG8_MMA(1, 1, At, B1); PG8_BAR; PG8_SCHED;
            PG8_LDB(B0, 1, 0); PG8_LDB(B1, 1, 1); PG8_SCHED; PG8_LDA(At, 1, 0); PG8_STAGE(PG8_SA(0, 1), a2 + hstep, voffA);
            PG8_WAIT_V(8); PG8_WAIT_L(0); PG8_BAR; PG8_MMA(0, 0, At, B0); PG8_MMA(0, 1, At, B1); PG8_BAR; PG8_SCHED;
            PG8_LDA(At, 1, 1); PG8_STAGE(PG8_SB(1, 0), b3, voffB); PG8_STAGE(PG8_SB(1, 1), b3 + hstep, voffB); PG8_STAGE(PG8_SA(1, 0), a3, voffA);
            PG8_WAIT_V(8); PG8_WAIT_L(0); PG8_BAR; PG8_MMA(1, 0, At, B0); PG8_MMA(1, 1, At, B1); PG8_BAR; PG8_SCHED;
            } else {
            PG8_LDB(B0, 0, 0); PG8_SCHED; PG8_LDA(At, 0, 0); PG8_STAGE(PG8_SA(1, 1), a1 + hstep, voffA);
            PG8_WAIT_L(8); PG8_BAR; PG8_WAIT_L(0); PG8_MMA(0, 0, At, B0); PG8_BAR; PG8_SCHED;
            PG8_LDB(B1, 0, 1); PG8_STAGE(PG8_SB(0, 0), b2, voffB);
            PG8_BAR; PG8_WAIT_L(0); PG8_MMA(0, 1, At, B1); PG8_BAR;
            PG8_LDA(At, 0, 1); PG8_STAGE(PG8_SA(0, 0), a2, voffA);
            PG8_BAR; PG8_WAIT_L(0); PG8_MMA(1, 0, At, B0); PG8_BAR; PG8_SCHED;
            PG8_STAGE(PG8_SB(0, 1), b2 + hstep, voffB);
            PG8_WAIT_V(6); PG8_BAR; PG8_MMA(1, 1, At, B1); PG8_BAR;
            PG8_LDB(B0, 1, 0); PG8_SCHED; PG8_LDA(At, 1, 0); PG8_STAGE(PG8_SA(0, 1), a2 + hstep, voffA);
            PG8_WAIT_L(8); PG8_BAR; PG8_WAIT_L(0); PG8_MMA(0, 0, At, B0); PG8_BAR; PG8_SCHED;
            PG8_LDB(B1, 1, 1); PG8_STAGE(PG8_SB(1, 0), b3, voffB);
            PG8_BAR; PG8_WAIT_L(0); PG8_MMA(0, 1, At, B1); PG8_BAR;
            PG8_LDA(At, 1, 1); PG8_STAGE(PG8_SA(1, 0), a3, voffA);
            PG8_BAR; PG8_WAIT_L(0); PG8_MMA(1, 0, At, B0); PG8_BAR; PG8_SCHED;
            PG8_STAGE(PG8_SB(1, 1), b3 + hstep, voffB);
            PG8_WAIT_V(6); PG8_BAR; PG8_MMA(1, 1, At, B1); PG8_BAR;
            }
        }
        if constexpr (ALIGN_EPI) { if (wr == 0) PG8_BAR; }
        if constexpr (!Epi::AFTER_DRAIN) { E(acc, cur, wr, wc, fr, fq); S.done(cur); }
        if (!has_next) break;
#pragma unroll
        for (int a = 0; a < 2; ++a)
#pragma unroll
            for (int b = 0; b < 2; ++b)
#pragma unroll
                for (int m = 0; m < 4; ++m)
#pragma unroll
                    for (int n = 0; n < 2; ++n) acc[a][b][m][n] = (f32x4){0.f, 0.f, 0.f, 0.f};
        cur = nxt; cA = nA; cB = nB; ++ui;
        if constexpr (ALIGN_EPI) { if (wr == 1) PG8_BAR; }
    }
    PG8_WAIT_V(0);
    if constexpr (!ALIGN_EPI) { if (wr == 0) PG8_BAR; }
    PG8_BAR;
    if constexpr (Epi::AFTER_DRAIN) { E.fused(acc, cur, wr, wc, fr, fq, lds, wid, lane); S.done(cur); }
#undef PG8_SA
#undef PG8_SB
#undef PG8_STAGE
#undef PG8_LDA
#undef PG8_LDB
#undef PG8_MMA
#undef PG8_WAIT_V
#undef PG8_WAIT_L
#undef PG8_BAR
#undef PG8_SCHED
}
}

#define LAS __attribute__((address_space(3)))
typedef unsigned short bf16_t;
typedef short v8s __attribute__((ext_vector_type(8)));
typedef short v4s __attribute__((ext_vector_type(4)));
typedef float v4f __attribute__((ext_vector_type(4)));
typedef float v16f __attribute__((ext_vector_type(16)));
typedef unsigned v4u __attribute__((ext_vector_type(4)));
typedef unsigned v2u __attribute__((ext_vector_type(2)));

constexpr int DM = 2048, NB = 4, SEQ = 4096, MTOK = NB * SEQ, DFF = 8192;
constexpr int EVEN_IN = 3376, EVEN_PAD = 3584, ODD_IN = 6176, ODD_PAD = 6400;
constexpr int E_QA = 0, E_KA = 1024, E_VA = 1280, E_QB = 1536, E_KC = 2560, E_VC = 2688, E_KS = 2816, E_VS = 2944, E_KW = 3072, E_VW = 3200, E_GT = 3328;
constexpr int O_Q = 0, O_K = 2048, O_V = 4096, O_F = 6144;
constexpr float LOG2E = 1.4426950408889634f;
constexpr float C1 = 0.125f * LOG2E;
constexpr float RMS_EPS = 1e-6f;

constexpr size_t MiB = 1u << 20;
constexpr size_t WS_WUP = 16 * MiB, WS_WDN = 144 * MiB, WS_WIE = 272 * MiB, WS_WIO = 300 * MiB, WS_WOE = 350 * MiB, WS_WOO = 366 * MiB;
constexpr size_t WS_CW1 = 382 * MiB, WS_CW2 = 386 * MiB, WS_KCMP = 387 * MiB, WS_VCMP = 387 * MiB + 512 * 1024, WS_C = 388 * MiB, WS_SSP = 390 * MiB;
constexpr size_t WS_XN = 392 * MiB, WS_QKV = 456 * MiB, WS_AO = 656 * MiB, WS_H = 456 * MiB, WS_SCR = 720 * MiB, WS_END = 736 * MiB;

constexpr int KP = 144, VP = 144, TILEB = 64 * 144;
constexpr int LDS_BYTES = 160 * 1024;

struct Args { const float* in[19]; float* out; unsigned char* ws; };
__device__ __forceinline__ const unsigned char __attribute__((address_space(4)))* karg_base() {
    const unsigned char __attribute__((address_space(4)))* kp = (const unsigned char __attribute__((address_space(4)))*)__builtin_amdgcn_kernarg_segment_ptr();
    asm volatile("" : "+s"(kp)); return kp; }
__device__ __forceinline__ const float* arg_in(int i) { return *(const float* const __attribute__((address_space(4)))*)(karg_base() + 8 * i); }
__device__ __forceinline__ float* arg_out() { return *(float* const __attribute__((address_space(4)))*)(karg_base() + 8 * 19); }
__device__ __forceinline__ unsigned char* arg_ws() { return *(unsigned char* const __attribute__((address_space(4)))*)(karg_base() + 8 * 20); }

__device__ __forceinline__ unsigned pkbf(float lo, float hi) {
    typedef float f2 __attribute__((ext_vector_type(2))); typedef __bf16 b2 __attribute__((ext_vector_type(2)));
    f2 v = {lo, hi}; b2 b = __builtin_convertvector(v, b2); return __builtin_bit_cast(unsigned, b);
}
__device__ __forceinline__ float bf2f(unsigned short u) { return __uint_as_float(((unsigned)u) << 16); }
__device__ __forceinline__ float ex2(float x) { return __builtin_amdgcn_exp2f(x); }
__device__ __forceinline__ void lds_add(LAS unsigned* p, unsigned v) { (void)__hip_atomic_fetch_add(p, v, __ATOMIC_RELAXED, __HIP_MEMORY_SCOPE_WORKGROUP); }
__device__ __forceinline__ void lds_or(LAS unsigned* p, unsigned v) { (void)__hip_atomic_fetch_or(p, v, __ATOMIC_RELAXED, __HIP_MEMORY_SCOPE_WORKGROUP); }
__device__ __forceinline__ int crow(int r, int hi) { return (r & 3) + 8 * (r >> 2) + 4 * hi; }
__device__ __forceinline__ v16f mfma32(v8s a, v8s b, v16f c) { return __builtin_amdgcn_mfma_f32_32x32x16_bf16(a, b, c, 0, 0, 0); }
__device__ __forceinline__ float wave_sum(float v) {
#pragma unroll
    for (int o = 1; o < 64; o <<= 1) v += __shfl_xor(v, o);
    return v;
}

__device__ __forceinline__ void tr_load(float (&v)[32], const float* W, int K, int N, int item, int lane) {
    const int nblk = (N + 31) / 32, kb = item / nblk, nb = item - kb * nblk, k0 = 64 * kb, n0 = 32 * nb;
    const int nn = n0 + (lane & 31); const bool ok = nn < N;
    const float* p = W + (size_t)(k0 + (lane >> 5)) * N + (ok ? nn : 0);
#pragma unroll
    for (int i = 0; i < 32; ++i) { const float x = p[(size_t)(2 * i) * N]; v[i] = ok ? x : 0.f; }
}
__device__ __forceinline__ void tr_put(const float (&v)[32], LAS float* scr, int lane) {
#pragma unroll
    for (int i = 0; i < 32; ++i) scr[(2 * i + (lane >> 5)) * 33 + (lane & 31)] = v[i];
}
__device__ __forceinline__ void tr_put_gain(const float (&v)[32], LAS float* scr, int lane, const LAS float* gk) {
#pragma unroll
    for (int i = 0; i < 32; ++i) scr[(2 * i + (lane >> 5)) * 33 + (lane & 31)] = v[i] * gk[2 * i + (lane >> 5)];
}
__device__ __forceinline__ void tr_store(bf16_t* WT, int K, int N, LAS float* scr, int item, int lane) {
    const int nblk = (N + 31) / 32, kb = item / nblk, nb = item - kb * nblk, k0 = 64 * kb, n0 = 32 * nb;
    const int c = lane & 7;
#pragma unroll
    for (int j = 0; j < 4; ++j) { const int n = (lane >> 3) + 8 * j; const LAS float* s = scr + (8 * c) * 33 + n;
        v4u o; o.x = pkbf(s[0 * 33], s[1 * 33]); o.y = pkbf(s[2 * 33], s[3 * 33]); o.z = pkbf(s[4 * 33], s[5 * 33]); o.w = pkbf(s[6 * 33], s[7 * 33]);
        *(v4u*)(WT + (size_t)(n0 + n) * K + k0 + 8 * c) = o; }
}

__device__ __forceinline__ void prologue_phase(LAS unsigned char* lds) {
    const int tid = mk_ltid(), lane = tid & 63, wave = __builtin_amdgcn_readfirstlane(tid >> 6);
    LAS float* scr = (LAS float*)(lds + wave * 16384);
    const int gw = mk_bid() * 8 + wave, NGW = mk_grid() * 8;
    for (int mi = 0; mi < 24; ++mi) {
        unsigned char* ws = arg_ws();
        const float* W; int K, N; bf16_t* WT; const float* g = nullptr;
        if (mi < 4) { W = arg_in(17) + (size_t)mi * DM * DFF; K = DM; N = DFF; WT = (bf16_t*)(ws + WS_WUP) + (size_t)mi * DFF * DM; g = arg_in(3) + mi * DM; }
        else if (mi < 8) { const int L = mi - 4; W = arg_in(18) + (size_t)L * DFF * DM; K = DFF; N = DM; WT = (bf16_t*)(ws + WS_WDN) + (size_t)L * DM * DFF; }
        else if (mi < 10) { const int e = mi - 8; W = arg_in(5) + (size_t)e * DM * EVEN_IN; K = DM; N = EVEN_IN; WT = (bf16_t*)(ws + WS_WIE) + (size_t)e * EVEN_PAD * DM; g = arg_in(2) + (2 * e) * DM; }
        else if (mi < 12) { const int e = mi - 10; W = arg_in(14) + (size_t)e * DM * ODD_IN; K = DM; N = ODD_IN; WT = (bf16_t*)(ws + WS_WIO) + (size_t)e * ODD_PAD * DM; g = arg_in(2) + (2 * e + 1) * DM; }
        else if (mi < 14) { const int e = mi - 12; W = arg_in(6) + (size_t)e * DM * DM; K = DM; N = DM; WT = (bf16_t*)(ws + WS_WOE) + (size_t)e * DM * DM; }
        else if (mi < 16) { const int e = mi - 14; W = arg_in(15) + (size_t)e * DM * DM; K = DM; N = DM; WT = (bf16_t*)(ws + WS_WOO) + (size_t)e * DM * DM; }
        else if (mi < 20) { const int e = (mi - 16) & 1, kv = (mi - 16) >> 1; W = arg_in(kv ? 12 : 10) + (size_t)e * 2048 * 256; K = 2048; N = 256; WT = (bf16_t*)(ws + WS_CW1) + (size_t)(e * 2 + kv) * 256 * 2048; }
        else { const int e = (mi - 20) & 1, kv = (mi - 20) >> 1; W = arg_in(kv ? 13 : 11) + (size_t)e * 256 * 64; K = 256; N = 64; WT = (bf16_t*)(ws + WS_CW2) + (size_t)(e * 2 + kv) * 64 * 256; }
        const int nitems = (K / 64) * ((N + 31) / 32), nblk = (N + 31) / 32;
        LAS float* SG = scr + 64 * 33;
        float v[32]; float gv = 1.f;
        int it = gw;
        if (it < nitems) { tr_load(v, W, K, N, it, lane); if (g) gv = g[64 * (it / nblk) + lane]; }
        while (it < nitems) {
            if (g) { SG[lane] = gv; tr_put_gain(v, scr, lane, SG); } else tr_put(v, scr, lane);
            const int nx = it + NGW;
            if (nx < nitems) { tr_load(v, W, K, N, nx, lane); if (g) gv = g[64 * (nx / nblk) + lane]; }
            asm volatile("s_waitcnt lgkmcnt(0)" ::: "memory");
            tr_store(WT, K, N, scr, it, lane);
            asm volatile("s_waitcnt lgkmcnt(0)" ::: "memory");
            it = nx;
        }
    }
}

__device__ __forceinline__ void prep_phase(const float* X, bf16_t* XB, float* SSP) {
    const int tid = mk_ltid(), lane = tid & 63, wave = tid >> 6;
    const int gw = mk_bid() * 8 + wave, NGW = mk_grid() * 8;
    for (int m = gw; m < MTOK; m += NGW) {
        const v4f* xr = (const v4f*)(X + (size_t)m * DM) + lane;
        v2u* o = (v2u*)(XB + (size_t)m * DM) + lane;
        float s = 0.f;
#pragma unroll
        for (int j = 0; j < 8; ++j) { const v4f v = xr[64 * j]; s += (v.x * v.x + v.y * v.y) + (v.z * v.z + v.w * v.w); v2u w; w.x = pkbf(v.x, v.y); w.y = pkbf(v.z, v.w); o[64 * j] = w; }
        s = wave_sum(s);
        if (lane < 8) SSP[(size_t)lane * MTOK + m] = (lane == 0) ? s : 0.f;
    }
}
__device__ __forceinline__ void rs_table(LAS float* RL, const float* SSP, int rbase) {
    const int tid = mk_ltid();
#pragma unroll
    for (int i = 0; i < 4; ++i) { const int row = rbase + tid + 512 * i; float s = 0.f;
#pragma unroll
        for (int p = 0; p < 8; ++p) s += SSP[(size_t)p * MTOK + row];
        RL[tid + 512 * i] = 1.0f / sqrtf(s * (1.f / DM) + RMS_EPS); }
    __syncthreads();
}

__device__ __forceinline__ void final_norm_phase(const bf16_t* XB, const float* g, float* OUT) {
    const int tid = mk_ltid(), lane = tid & 63, wave = tid >> 6;
    const int gw = mk_bid() * 8 + wave, NGW = mk_grid() * 8;
    v4f gv[8];
#pragma unroll
    for (int j = 0; j < 8; ++j) gv[j] = *((const v4f*)g + lane + 64 * j);
    for (int m = gw; m < MTOK; m += NGW) {
        const v2u* xr = (const v2u*)(XB + (size_t)m * DM) + lane;
        v4f v[8]; float s = 0.f;
#pragma unroll
        for (int j = 0; j < 8; ++j) { const v2u w = xr[64 * j]; v[j] = (v4f){__uint_as_float(w.x << 16), __uint_as_float(w.x & 0xffff0000u), __uint_as_float(w.y << 16), __uint_as_float(w.y & 0xffff0000u)};
            s += (v[j].x * v[j].x + v[j].y * v[j].y) + (v[j].z * v[j].z + v[j].w * v[j].w); }
        const float r = 1.0f / sqrtf(wave_sum(s) * (1.f / DM) + RMS_EPS);
        v4f* o = (v4f*)(OUT + (size_t)m * DM) + lane;
#pragma unroll
        for (int j = 0; j < 8; ++j) o[64 * j] = v[j] * r * gv[j];
    }
}
__device__ __forceinline__ void norm_phase(const float* X, const float* g, bf16_t* XN, float* OUTF) {
    const int tid = mk_ltid(), lane = tid & 63, wave = tid >> 6;
    const int gw = mk_bid() * 8 + wave, NGW = mk_grid() * 8;
    v4f gv[8];
#pragma unroll
    for (int j = 0; j < 8; ++j) gv[j] = *((const v4f*)g + lane + 64 * j);
    for (int m = gw; m < MTOK; m += NGW) {
        const v4f* xr = (const v4f*)(X + (size_t)m * DM) + lane;
        v4f v[8]; float s = 0.f;
#pragma unroll
        for (int j = 0; j < 8; ++j) { v[j] = xr[64 * j]; s += (v[j].x * v[j].x + v[j].y * v[j].y) + (v[j].z * v[j].z + v[j].w * v[j].w); }
        const float r = 1.0f / sqrtf(wave_sum(s) * (1.f / DM) + RMS_EPS);
        if (OUTF) {
            v4f* o = (v4f*)(OUTF + (size_t)m * DM) + lane;
#pragma unroll
            for (int j = 0; j < 8; ++j) o[64 * j] = v[j] * r * gv[j];
        } else {
            v2u* o = (v2u*)(XN + (size_t)m * DM) + lane;
#pragma unroll
            for (int j = 0; j < 8; ++j) { const v4f y = v[j] * r * gv[j]; v2u w; w.x = pkbf(y.x, y.y); w.y = pkbf(y.z, y.w); o[64 * j] = w; }
        }
    }
}

constexpr int KTB = 64 * KP, VHB = 4096 + 64, VTB = 2 * VHB;
constexpr int ATT_K = 0, ATT_V = 3 * KTB, ATT_AUX = ATT_V + 3 * VTB, ATT_END = ATT_AUX + 3 * 64 * 4 + 128;
static_assert(ATT_END == 53504, "attention LDS map");

__device__ __forceinline__ void qk_tile(const LAS unsigned char* Kt, const v8s (&qf)[4], v16f& p0, v16f& p1, int r32, int hi) {
    const LAS unsigned char* kb = Kt + r32 * KP + hi * 16;
    v16f z;
#pragma unroll
    for (int r = 0; r < 16; ++r) z[r] = 0.f;
    p0 = z; p1 = z;
#pragma unroll
    for (int s = 0; s < 4; ++s) {
        const v8s a0 = *(const LAS v8s*)(kb + s * 32);
        const v8s a1 = *(const LAS v8s*)(kb + 32 * KP + s * 32);
        p0 = mfma32(a0, qf[s], p0); p1 = mfma32(a1, qf[s], p1);
    }
}
__device__ __forceinline__ v4s trrd(const LAS unsigned char* p) { return __builtin_bit_cast(v4s, __builtin_amdgcn_ds_read_tr16_b64_v4i16((LAS v4s*)p)); }
__device__ __forceinline__ void pv_tile(const LAS unsigned char* Vt, const v16f& p0, const v16f& p1, v16f (&oT)[2], int lane) {
    const int hi = lane >> 5;
    v4u w[4];
    w[0] = (v4u){pkbf(p0[0], p0[1]), pkbf(p0[2], p0[3]), pkbf(p0[4], p0[5]), pkbf(p0[6], p0[7])};
    w[1] = (v4u){pkbf(p0[8], p0[9]), pkbf(p0[10], p0[11]), pkbf(p0[12], p0[13]), pkbf(p0[14], p0[15])};
    w[2] = (v4u){pkbf(p1[0], p1[1]), pkbf(p1[2], p1[3]), pkbf(p1[4], p1[5]), pkbf(p1[6], p1[7])};
    w[3] = (v4u){pkbf(p1[8], p1[9]), pkbf(p1[10], p1[11]), pkbf(p1[12], p1[13]), pkbf(p1[14], p1[15])};
    const LAS unsigned char* vb = Vt + (4 * hi + ((lane & 15) >> 2)) * 64 + (16 * ((lane >> 4) & 1) + 4 * (lane & 3)) * 2;
#pragma unroll
    for (int dt = 0; dt < 2; ++dt)
#pragma unroll
        for (int ks = 0; ks < 4; ++ks) {
            const int kvb = 16 * (ks & 1) + 32 * (ks >> 1);
            const v4s lo = trrd(vb + dt * VHB + kvb * 64), h4 = trrd(vb + dt * VHB + (kvb + 8) * 64);
            const v8s af = (v8s){lo[0], lo[1], lo[2], lo[3], h4[0], h4[1], h4[2], h4[3]};
            oT[dt] = mfma32(af, __builtin_bit_cast(v8s, w[ks]), oT[dt]);
        }
}

__device__ __forceinline__ void k_load(const LAS unsigned char* Kt, v8s (&kf)[8], int r32, int hi) {
    const LAS unsigned char* kb = Kt + r32 * KP + hi * 16;
#pragma unroll
    for (int s = 0; s < 4; ++s) { kf[2 * s] = *(const LAS v8s*)(kb + s * 32); kf[2 * s + 1] = *(const LAS v8s*)(kb + 32 * KP + s * 32); }
}
__device__ __forceinline__ void qk_mma(const v8s (&kf)[8], const v8s (&qf)[4], v16f& p0, v16f& p1) {
    v16f z;
#pragma unroll
    for (int r = 0; r < 16; ++r) z[r] = 0.f;
    p0 = z; p1 = z;
#pragma unroll
    for (int s = 0; s < 4; ++s) { p0 = mfma32(kf[2 * s], qf[s], p0); p1 = mfma32(kf[2 * s + 1], qf[s], p1); }
}
__device__ __forceinline__ void v_load(const LAS unsigned char* Vt, v4s (&vf)[16], int lane) {
    const int hi = lane >> 5;
    const LAS unsigned char* vb = Vt + (4 * hi + ((lane & 15) >> 2)) * 64 + (16 * ((lane >> 4) & 1) + 4 * (lane & 3)) * 2;
#pragma unroll
    for (int ks = 0; ks < 4; ++ks)
#pragma unroll
        for (int dt = 0; dt < 2; ++dt) {
            const int kvb = 16 * (ks & 1) + 32 * (ks >> 1);
            vf[4 * ks + 2 * dt] = trrd(vb + dt * VHB + kvb * 64); vf[4 * ks + 2 * dt + 1] = trrd(vb + dt * VHB + (kvb + 8) * 64);
        }
}
__device__ __forceinline__ void pv_mma(const v4s (&vf)[16], const v16f& p0, const v16f& p1, v16f (&oT)[2]) {
    v4u w[4];
    w[0] = (v4u){pkbf(p0[0], p0[1]), pkbf(p0[2], p0[3]), pkbf(p0[4], p0[5]), pkbf(p0[6], p0[7])};
    w[1] = (v4u){pkbf(p0[8], p0[9]), pkbf(p0[10], p0[11]), pkbf(p0[12], p0[13]), pkbf(p0[14], p0[15])};
    w[2] = (v4u){pkbf(p1[0], p1[1]), pkbf(p1[2], p1[3]), pkbf(p1[4], p1[5]), pkbf(p1[6], p1[7])};
    w[3] = (v4u){pkbf(p1[8], p1[9]), pkbf(p1[10], p1[11]), pkbf(p1[12], p1[13]), pkbf(p1[14], p1[15])};
#pragma unroll
    for (int ks = 0; ks < 4; ++ks)
#pragma unroll
        for (int dt = 0; dt < 2; ++dt) {
            const v4s lo = vf[4 * ks + 2 * dt], h4 = vf[4 * ks + 2 * dt + 1];
            const v8s af = (v8s){lo[0], lo[1], lo[2], lo[3], h4[0], h4[1], h4[2], h4[3]};
            oT[dt] = mfma32(af, __builtin_bit_cast(v8s, w[ks]), oT[dt]);
        }
}
__device__ __forceinline__ float max3f(float a, float b, float c) { return __builtin_fmaxf(__builtin_fmaxf(a, b), c); }
__device__ __forceinline__ void softmax_step(v16f& p0, v16f& p1, v16f (&oT)[2], float& m, float& l, bool rowok) {
    float a = max3f(p0[0], p0[1], p1[0]), b = max3f(p0[2], p0[3], p1[1]); a = max3f(a, p1[2], p1[3]);
#pragma unroll
    for (int r = 4; r < 16; r += 4) { a = max3f(a, p0[r], p0[r + 1]); b = max3f(b, p0[r + 2], p0[r + 3]); a = max3f(a, p1[r], p1[r + 1]); b = max3f(b, p1[r + 2], p1[r + 3]); }
    float mx = fmaxf(a, b);
    mx = fmaxf(mx, __shfl_xor(mx, 32));
    if (!rowok) mx = -INFINITY;
    const float mn = fmaxf(m, mx);
    const float mu = (mn == -INFINITY) ? 0.f : mn;
    if (__any(mn > m)) {
        const float alpha = ex2(m - mu);
        oT[0] = oT[0] * alpha; oT[1] = oT[1] * alpha; l *= alpha;
    }
    const float mue = rowok ? mu : INFINITY;
    p0 = p0 - mue; p1 = p1 - mue;
#pragma unroll
    for (int r = 0; r < 16; ++r) { p0[r] = ex2(p0[r]); p1[r] = ex2(p1[r]); }
    const v16f s = p0 + p1;
    l += ((s[0] + s[1]) + (s[2] + s[3])) + ((s[4] + s[5]) + (s[6] + s[7])) + (((s[8] + s[9]) + (s[10] + s[11])) + ((s[12] + s[13]) + (s[14] + s[15])));
    m = mn;
}
__device__ __forceinline__ v4u ld_tile(const bf16_t* base, int row0, int pitch, int tid) { return *(const v4u*)(base + (size_t)(row0 + (tid >> 3)) * pitch + (tid & 7) * 8); }
__device__ __forceinline__ void st_k(LAS unsigned char* T, v4u v, int tid) { *(LAS v4u*)(T + (tid >> 3) * KP + (tid & 7) * 16) = v; }
__device__ __forceinline__ void st_v(LAS unsigned char* T, v4u v, int tid) { *(LAS v4u*)(T + ((tid >> 2) & 1) * VHB + (tid >> 3) * 64 + (tid & 3) * 16) = v; }
__device__ __forceinline__ void store_o(bf16_t* Orow, const v16f (&o)[2], int hi) {
#pragma unroll
    for (int dt = 0; dt < 2; ++dt)
#pragma unroll
        for (int g = 0; g < 4; ++g) { v2u w; w.x = pkbf(o[dt][4 * g], o[dt][4 * g + 1]); w.y = pkbf(o[dt][4 * g + 2], o[dt][4 * g + 3]);
            *(v2u*)(Orow + dt * 32 + 8 * g + 4 * hi) = w; }
}
__device__ __forceinline__ int rel_bucket(int n) {
    if (n < 16) return n;
    const float v = __log2f((float)n * (1.f / 16.f)) * (16.f / 6.f) + 1e-5f;
    const int b = 16 + (int)v; return b < 31 ? b : 31;
}

template <bool AUX, int VAR = 0, class Seq, class Sc>
__device__ __forceinline__ void attn_engine(LAS unsigned char* lds, const bf16_t* Kg, const bf16_t* Vg, int pitch, const float* auxg, Seq seq, const v8s (&qf)[4],
                                            v16f (&oT)[2], float& m, float& l, const Sc& sc, int tid, int lane) {
    const int r32 = lane & 31, hi = lane >> 5;
    int tc = seq.pop(); if (tc < 0) return;
    int tn = seq.pop(), tnn = (tn >= 0) ? seq.pop() : -1;
    LAS float* AUXL = (LAS float*)(lds + ATT_AUX);
    v4u kr = ld_tile(Kg, 64 * tc, pitch, tid), vr = ld_tile(Vg, 64 * tc, pitch, tid); float ar = 0.f;
    if (AUX && tid < 64) ar = auxg[64 * tc + tid];
    v4u kr2 = kr, vr2 = vr; float ar2 = 0.f;
    if (tn >= 0) { kr2 = ld_tile(Kg, 64 * tn, pitch, tid); vr2 = ld_tile(Vg, 64 * tn, pitch, tid); if (AUX && tid < 64) ar2 = auxg[64 * tn + tid]; }
    __syncthreads();
    st_k(lds + ATT_K, kr, tid); st_v(lds + ATT_V, vr, tid); if (AUX && tid < 64) AUXL[tid] = ar;
    if (tn >= 0) { st_k(lds + ATT_K + KTB, kr2, tid); st_v(lds + ATT_V + VTB, vr2, tid); if (AUX && tid < 64) AUXL[64 + tid] = ar2; }
    if (tnn >= 0) { kr = ld_tile(Kg, 64 * tnn, pitch, tid); vr = ld_tile(Vg, 64 * tnn, pitch, tid); if (AUX && tid < 64) ar = auxg[64 * tnn + tid]; }
    __syncthreads();
    v16f a0, a1, b0, b1;
    int bi = 0;
    if (sc.active(tc)) { qk_tile(lds + ATT_K, qf, a0, a1, r32, hi); sc.apply(a0, a1, tc, AUXL); }
#define ATT_STEP(C0, C1, N0, N1) { \
        __syncthreads(); \
        const int b2_ = (bi >= 1) ? bi - 1 : 2, b1_ = (bi == 2) ? 0 : bi + 1; int t3_ = -1; \
        if (tnn >= 0) { st_k(lds + ATT_K + b2_ * KTB, kr, tid); st_v(lds + ATT_V + b2_ * VTB, vr, tid); if (AUX && tid < 64) AUXL[b2_ * 64 + tid] = ar; \
            t3_ = seq.pop(); \
            if (t3_ >= 0 && VAR != 3) { kr = ld_tile(Kg, 64 * t3_, pitch, tid); vr = ld_tile(Vg, 64 * t3_, pitch, tid); if (AUX && tid < 64) ar = auxg[64 * t3_ + tid]; } } \
        const bool actn_ = (tn >= 0) && sc.active(tn), actc_ = sc.active(tc); \
        v8s kf_[8]; v4s vf_[16]; \
        if (actn_) { k_load(lds + ATT_K + b1_ * KTB, kf_, r32, hi); __builtin_amdgcn_sched_barrier(0); if (VAR != 2) qk_mma(kf_, qf, N0, N1); else { N0 = oT[0] + __builtin_bit_cast(v4f, kf_[0])[0]; N1 = oT[1] + __builtin_bit_cast(v4f, kf_[5])[1]; } } \
        __builtin_amdgcn_sched_barrier(0); \
        if (actc_) v_load(lds + ATT_V + bi * VTB, vf_, lane); \
        __builtin_amdgcn_sched_barrier(0); \
        if (actc_) { if (VAR != 1) softmax_step(C0, C1, oT, m, l, sc.rowok(tc)); if (VAR != 2) pv_mma(vf_, C0, C1, oT); else { oT[0] = oT[0] + C0 * __builtin_bit_cast(v2u, vf_[3])[0]; oT[1] = oT[1] + C1 * __builtin_bit_cast(v2u, vf_[9])[1]; } } \
        if (actn_) sc.apply(N0, N1, tn, AUXL + b1_ * 64); \
        tc = tn; tn = tnn; tnn = t3_; bi = b1_; \
        if (tc < 0) break; }
    for (;;) {
        ATT_STEP(a0, a1, b0, b1)
        ATT_STEP(b0, b1, a0, a1)
    }
#undef ATT_STEP
}
struct RangeSeq { int cur, last; __device__ __forceinline__ int pop() { const int t = cur; if (t > last) return -1; cur = t + 1; return t; } };
struct MaskSeq { unsigned long long rem; __device__ __forceinline__ int pop() { if (rem == 0ull) return -1; const int t = __builtin_ctzll(rem); rem &= rem - 1ull; return t; } };

__device__ __forceinline__ void cumsum_phase(LAS unsigned char* lds, const bf16_t* QKV, const float* fb, float* CL2) {
    const int tid = mk_ltid(), lane = tid & 63, wave = tid >> 6;
    LAS float* wtot = (LAS float*)lds;
    for (int u = mk_bid(); u < NB * 32; u += mk_grid()) {
        const int b = u >> 5, h = u & 31; const float bias = fb[h];
        float v[8]; float run = 0.f;
#pragma unroll
        for (int i = 0; i < 8; ++i) { const int t = tid * 8 + i; const float x = bf2f(QKV[(size_t)(b * SEQ + t) * ODD_PAD + O_F + h]) + bias;
            const float ls = fminf(x, 0.f) - log1pf(expf(-fabsf(x))); run += ls; v[i] = run; }
        float inc = run;
#pragma unroll
        for (int o = 1; o < 64; o <<= 1) { const float t = __shfl_up(inc, o); if (lane >= o) inc += t; }
        __syncthreads();
        if (lane == 63) wtot[wave] = inc;
        __syncthreads();
        float off = inc - run;
        for (int w2 = 0; w2 < wave; ++w2) off += wtot[w2];
        float* o = CL2 + (size_t)u * SEQ + tid * 8;
#pragma unroll
        for (int i = 0; i < 8; ++i) o[i] = (v[i] + off) * LOG2E;
    }
}

struct FoxSc {
    int qw0, qpos, hi;
    __device__ __forceinline__ bool active(int t) const { return 64 * t <= qw0 + 31; }
    __device__ __forceinline__ bool rowok(int) const { return true; }
    __device__ __forceinline__ void apply(v16f& p0, v16f& p1, int t, const LAS float* aux) const {
        const LAS float* kbp = aux + 4 * hi;
        v16f c0, c1;
#pragma unroll
        for (int g = 0; g < 4; ++g) {
            const v4f x0 = *(const LAS v4f*)(kbp + 8 * g), x1 = *(const LAS v4f*)(kbp + 32 + 8 * g);
#pragma unroll
            for (int e = 0; e < 4; ++e) { c0[4 * g + e] = x0[e]; c1[4 * g + e] = x1[e]; }
        }
        p0 = p0 * C1 - c0; p1 = p1 * C1 - c1;
        if (64 * t + 63 > qw0) {
#pragma unroll
            for (int r = 0; r < 16; ++r) { const int kv = 64 * t + crow(r, hi);
                if (kv > qpos) p0[r] = -INFINITY; if (kv + 32 > qpos) p1[r] = -INFINITY; }
        }
    }
};

template <int VAR = 0>
__device__ __forceinline__ void fox_phase(LAS unsigned char* lds, const bf16_t* QKV, const float* CL2, bf16_t* AO) {
    const int w = __builtin_amdgcn_readfirstlane(mk_ltid() >> 6);
    for (int j = mk_bid(); j < NB * 32 * 16; j += mk_grid()) {
        const int tid = mk_ltid(), lane = tid & 63, r32 = lane & 31, hi = lane >> 5;
        const int rr = j >> 7, bh = j & 127, i2 = rr >> 1; int sel = rr & 1; if (i2 & 1) sel ^= 1;
        const int qb = 15 - (2 * i2 + sel), b = bh >> 5, h = bh & 31;
        const int q0 = qb * 256, qw0 = q0 + 32 * w, qpos = qw0 + r32;
        const bf16_t* Qg = QKV + (size_t)(b * SEQ + qpos) * ODD_PAD + O_Q + h * 64 + hi * 8;
        v8s qf[4];
#pragma unroll
        for (int s = 0; s < 4; ++s) qf[s] = *(const v8s*)(Qg + s * 16);
        const bf16_t* Kg = QKV + (size_t)(b * SEQ) * ODD_PAD + O_K + h * 64;
        const bf16_t* Vg = QKV + (size_t)(b * SEQ) * ODD_PAD + O_V + h * 64;
        v16f oT[2];
#pragma unroll
        for (int r = 0; r < 16; ++r) { oT[0][r] = 0.f; oT[1][r] = 0.f; }
        float m = -INFINITY, l = 0.f;
        const FoxSc sc{qw0, qpos, hi};
        attn_engine<true, VAR>(lds, Kg, Vg, ODD_PAD, CL2 + (size_t)(b * 32 + h) * SEQ, RangeSeq{0, (q0 + 256) / 64 - 1}, qf, oT, m, l, sc, tid, lane);
        l += __shfl_xor(l, 32);
        const float inv = 1.f / l;
        oT[0] = oT[0] * inv; oT[1] = oT[1] * inv;
        store_o(AO + (size_t)(b * SEQ + qpos) * DM + h * 64, oT, hi);
    }
}

__device__ __forceinline__ void fox_scores(v16f& p0, v16f& p1, const v16f& c0, const v16f& c1, bool diag, int t, int qpos, int hi) {
    p0 = p0 * C1 - c0; p1 = p1 * C1 - c1;
    if (diag) {
#pragma unroll
        for (int r = 0; r < 16; ++r) { const int kv = 64 * t + crow(r, hi); if (kv > qpos) p0[r] = -INFINITY; if (kv + 32 > qpos) p1[r] = -INFINITY; }
    }
}
__device__ __forceinline__ void fox2_phase(LAS unsigned char* lds, const bf16_t* QKV, const float* CL2, bf16_t* AO) {
    const int w = __builtin_amdgcn_readfirstlane(mk_ltid() >> 6);
    LAS float* AUXL = (LAS float*)(lds + ATT_AUX);
    for (int j = mk_bid(); j < NB * 32 * 8; j += mk_grid()) {
        const int tid = mk_ltid(), lane = tid & 63, r32 = lane & 31, hi = lane >> 5;
        const int rr = j >> 7, bh = j & 127, i2 = rr >> 1; int sel = rr & 1; if (i2 & 1) sel ^= 1;
        const int qb = 7 - (2 * i2 + sel), b = bh >> 5, h = bh & 31;
        const int q0 = qb * 512, qw0 = q0 + 64 * w, qposA = qw0 + r32, qposB = qposA + 32;
        const bf16_t* Qg = QKV + (size_t)(b * SEQ + qposA) * ODD_PAD + O_Q + h * 64 + hi * 8;
        v8s qa[4], qb_[4];
#pragma unroll
        for (int s = 0; s < 4; ++s) { qa[s] = *(const v8s*)(Qg + s * 16); qb_[s] = *(const v8s*)(Qg + (size_t)32 * ODD_PAD + s * 16); }
        const bf16_t* Kg = QKV + (size_t)(b * SEQ) * ODD_PAD + O_K + h * 64;
        const bf16_t* Vg = QKV + (size_t)(b * SEQ) * ODD_PAD + O_V + h * 64;
        const float* cl = CL2 + (size_t)(b * 32 + h) * SEQ;
        const int nt = (q0 + 512) / 64, tw = qw0 >> 6;
        v16f oA[2], oB[2];
#pragma unroll
        for (int r = 0; r < 16; ++r) { oA[0][r] = 0.f; oA[1][r] = 0.f; oB[0][r] = 0.f; oB[1][r] = 0.f; }
        float mA = -INFINITY, lA = 0.f, mB = -INFINITY, lB = 0.f;
        v4u kr = ld_tile(Kg, 0, ODD_PAD, tid), vr = ld_tile(Vg, 0, ODD_PAD, tid); float ar = (tid < 64) ? cl[tid] : 0.f;
        v4u kr2 = ld_tile(Kg, 64, ODD_PAD, tid), vr2 = ld_tile(Vg, 64, ODD_PAD, tid); float ar2 = (tid < 64) ? cl[64 + tid] : 0.f;
        __syncthreads();
        st_k(lds + ATT_K, kr, tid); st_v(lds + ATT_V, vr, tid); if (tid < 64) AUXL[tid] = ar;
        st_k(lds + ATT_K + KTB, kr2, tid); st_v(lds + ATT_V + VTB, vr2, tid); if (tid < 64) AUXL[64 + tid] = ar2;
        kr = ld_tile(Kg, 128, ODD_PAD, tid); vr = ld_tile(Vg, 128, ODD_PAD, tid); if (tid < 64) ar = cl[128 + tid];
        int bi = 0;
#pragma unroll 1
        for (int t = 0; t < nt; ++t) {
            __syncthreads();
            const int b2 = (bi >= 1) ? bi - 1 : 2;
            if (t + 2 < nt) { st_k(lds + ATT_K + b2 * KTB, kr, tid); st_v(lds + ATT_V + b2 * VTB, vr, tid); if (tid < 64) AUXL[b2 * 64 + tid] = ar;
                if (t + 3 < nt) { kr = ld_tile(Kg, 64 * (t + 3), ODD_PAD, tid); vr = ld_tile(Vg, 64 * (t + 3), ODD_PAD, tid); if (tid < 64) ar = cl[64 * (t + 3) + tid]; } }
            if (t <= tw) {
                const bool diag = (t == tw);
                v16f a0, a1, b0, b1;
                { v8s kf[8]; k_load(lds + ATT_K + bi * KTB, kf, r32, hi); qk_mma(kf, qa, a0, a1); qk_mma(kf, qb_, b0, b1); }
                { v16f c0, c1; const LAS float* kbp = AUXL + bi * 64 + 4 * hi;
#pragma unroll
                  for (int g = 0; g < 4; ++g) { const v4f x0 = *(const LAS v4f*)(kbp + 8 * g), x1 = *(const LAS v4f*)(kbp + 32 + 8 * g);
#pragma unroll
                      for (int e = 0; e < 4; ++e) { c0[4 * g + e] = x0[e]; c1[4 * g + e] = x1[e]; } }
                  fox_scores(a0, a1, c0, c1, diag, t, qposA, hi); fox_scores(b0, b1, c0, c1, diag, t, qposB, hi); }
#ifdef FOX2_VPRE
                { v4s vf[16]; v_load(lds + ATT_V + bi * VTB, vf, lane); __builtin_amdgcn_sched_barrier(0);
                  softmax_step(a0, a1, oA, mA, lA, true); softmax_step(b0, b1, oB, mB, lB, true);
                  pv_mma(vf, a0, a1, oA); pv_mma(vf, b0, b1, oB); }
#else
                softmax_step(a0, a1, oA, mA, lA, true); softmax_step(b0, b1, oB, mB, lB, true);
                { v4s vf[16]; v_load(lds + ATT_V + bi * VTB, vf, lane); pv_mma(vf, a0, a1, oA); pv_mma(vf, b0, b1, oB); }
#endif
            }
            bi = (bi == 2) ? 0 : bi + 1;
        }
        lA += __shfl_xor(lA, 32); lB += __shfl_xor(lB, 32);
        const float ia = 1.f / lA, ib = 1.f / lB;
        oA[0] = oA[0] * ia; oA[1] = oA[1] * ia; oB[0] = oB[0] * ib; oB[1] = oB[1] * ib;
        store_o(AO + (size_t)(b * SEQ + qposA) * DM + h * 64, oA, hi);
        store_o(AO + (size_t)(b * SEQ + qposB) * DM + h * 64, oB, hi);
    }
}


__device__ __forceinline__ float gelu_tanh(float x) {
    const float u = 0.7978845608028654f * (x + 0.044715f * x * x * x);
    const float t = 1.f - 2.f / (1.f + __expf(2.f * u));
    return 0.5f * x * (1.f + t);
}
__device__ __forceinline__ void compress_unit(LAS unsigned char* lds, int u, const bf16_t* QKV, const float* pe_k, const float* pe_v,
                                              const bf16_t* CW1  , const bf16_t* CW2  , bf16_t* KCMP, bf16_t* VCMP) {
    const int tid = mk_ltid(), lane = tid & 63, w = __builtin_amdgcn_readfirstlane(tid >> 6), r32 = lane & 31, hi = lane >> 5;
    const int kv = u >> 6, b = (u >> 4) & 3, g = (u >> 3) & 1, ch = u & 7;
    const float* pe = kv ? pe_v : pe_k;
    const bf16_t* W1 = CW1 + (size_t)kv * 256 * 2048; const bf16_t* W2 = CW2 + (size_t)kv * 64 * 256;
    bf16_t* OUT = (kv ? VCMP : KCMP) + (size_t)((b * 2 + g) * 256 + ch * 32) * 64;
    const int n = ch * 32 + r32;
    const bf16_t* Ag = QKV + (size_t)(b * SEQ + 16 * n) * EVEN_PAD + (kv ? E_VC : E_KC) + g * 64 + hi * 8;
    const bf16_t* Bg = W1 + (size_t)(32 * w + r32) * 2048 + hi * 8;
    LAS bf16_t* HID = (LAS bf16_t*)lds;
    LAS float* PE = (LAS float*)(lds + 20480);
    v16f acc;
#pragma unroll
    for (int r = 0; r < 16; ++r) acc[r] = 0.f;
    __syncthreads();
    *(LAS v4f*)(PE + tid * 4) = *(const v4f*)(pe + tid * 4);
    __syncthreads();
#pragma unroll 8
    for (int st = 0; st < 128; ++st) {
        const int li = st >> 2, d0 = (st & 3) * 16;
        const v4u ar = *(const v4u*)(Ag + (size_t)li * EVEN_PAD + d0);
        const v4f pa = *(const LAS v4f*)(PE + li * 64 + d0 + hi * 8), pb = *(const LAS v4f*)(PE + li * 64 + d0 + hi * 8 + 4);
        const v8s bfr = *(const v8s*)(Bg + st * 16);
        v4u aw;
        aw.x = pkbf(__uint_as_float(ar.x << 16) + pa.x, __uint_as_float(ar.x & 0xffff0000u) + pa.y);
        aw.y = pkbf(__uint_as_float(ar.y << 16) + pa.z, __uint_as_float(ar.y & 0xffff0000u) + pa.w);
        aw.z = pkbf(__uint_as_float(ar.z << 16) + pb.x, __uint_as_float(ar.z & 0xffff0000u) + pb.y);
        aw.w = pkbf(__uint_as_float(ar.w << 16) + pb.z, __uint_as_float(ar.w & 0xffff0000u) + pb.w);
        acc = mfma32(__builtin_bit_cast(v8s, aw), bfr, acc);
    }
#pragma unroll
    for (int r = 0; r < 16; ++r) HID[crow(r, hi) * 264 + 32 * w + r32] = (bf16_t)(pkbf(gelu_tanh(acc[r]), 0.f) & 0xffffu);
    __syncthreads();
    if (w < 2) {
        v16f o;
#pragma unroll
        for (int r = 0; r < 16; ++r) o[r] = 0.f;
        const bf16_t* B2 = W2 + (size_t)(32 * w + r32) * 256 + hi * 8;
#pragma unroll
        for (int st = 0; st < 16; ++st) {
            const v8s af = *(const LAS v8s*)(HID + r32 * 264 + st * 16 + hi * 8);
            const v8s bfr = *(const v8s*)(B2 + st * 16);
            o = mfma32(af, bfr, o);
        }
#pragma unroll
        for (int r = 0; r < 16; ++r) { const int nl = crow(r, hi); const bool valid = (ch * 32 + nl) < 255;
            OUT[(size_t)nl * 64 + 32 * w + r32] = valid ? (bf16_t)(pkbf(o[r], 0.f) & 0xffffu) : (bf16_t)0; }
    }
}

template <int NEGPAD>
struct TabSc {
    const LAS float* tb;
    int qpos, hi;
    __device__ __forceinline__ void apply_tab(v16f& p0, v16f& p1, int t) const {
        const LAS float* bp = tb + (NEGPAD + qpos - 64 * t - 63 - 4 * hi);
        v16f c0, c1;
#pragma unroll
        for (int r = 0; r < 16; ++r) { c0[r] = bp[63 - ((r & 3) + 8 * (r >> 2))]; c1[r] = bp[31 - ((r & 3) + 8 * (r >> 2))]; }
        p0 = p0 * C1 + c0; p1 = p1 * C1 + c1;
    }
};
struct SwaSc : TabSc<64> {
    int qw0;
    __device__ __forceinline__ bool active(int t) const { return 64 * t + 63 >= qw0 - 127 && 64 * t <= qw0 + 31; }
    __device__ __forceinline__ bool rowok(int) const { return true; }
    __device__ __forceinline__ void apply(v16f& p0, v16f& p1, int t, const LAS float*) const { apply_tab(p0, p1, t); }
};

__device__ __forceinline__ void swa_unit(LAS unsigned char* lds, int u, const bf16_t* QKV, const float* relb, const float* sinks, bf16_t* AO) {
    const int tid = mk_ltid(), lane = tid & 63, w = __builtin_amdgcn_readfirstlane(tid >> 6), r32 = lane & 31, hi = lane >> 5;
    LAS float* TB = (LAS float*)(lds + ATT_END);
    const int qblk = u >> 4, b = (u >> 2) & 3, g = u & 3;
    const int hq = 4 * g + (w >> 1), q0 = 64 * qblk, qw0 = q0 + 32 * (w & 1), qpos = qw0 + r32;
    __syncthreads();
    for (int i = tid; i < 1024; i += 512) { const int hh = i >> 8, d = (i & 255) - 64; TB[i] = (d >= 0 && d < 128) ? relb[rel_bucket(d) * 32 + 4 * g + hh] * LOG2E : -INFINITY; }
    const bf16_t* Qg = QKV + (size_t)(b * SEQ + qpos) * EVEN_PAD + E_QA + hq * 64 + hi * 8;
    v8s qf[4];
#pragma unroll
    for (int s = 0; s < 4; ++s) qf[s] = *(const v8s*)(Qg + s * 16);
    const bf16_t* Kg = QKV + (size_t)(b * SEQ) * EVEN_PAD + E_KA + g * 64;
    const bf16_t* Vg = QKV + (size_t)(b * SEQ) * EVEN_PAD + E_VA + g * 64;
    v16f oT[2];
#pragma unroll
    for (int r = 0; r < 16; ++r) { oT[0][r] = 0.f; oT[1][r] = 0.f; }
    float m = -INFINITY, l = 0.f;
    SwaSc sc; sc.tb = TB + (w >> 1) * 256; sc.qpos = qpos; sc.hi = hi; sc.qw0 = qw0;
    attn_engine<false>(lds, Kg, Vg, EVEN_PAD, nullptr, RangeSeq{(qblk >= 2) ? qblk - 2 : 0, qblk}, qf, oT, m, l, sc, tid, lane);
    l += __shfl_xor(l, 32);
    const float sk = sinks[hq] * LOG2E;
    const float mf = fmaxf(m, sk);
    const float a = ex2(m - mf);
    const float inv = a / (l * a + ex2(sk - mf));
    oT[0] = oT[0] * inv; oT[1] = oT[1] * inv;
    store_o(AO + (size_t)(b * SEQ + qpos) * DM + hq * 64, oT, hi);
}

__device__ __forceinline__ void evenA_phase(LAS unsigned char* lds, const bf16_t* QKV, const float* relb, const float* sinks, const float* pe_k, const float* pe_v,
                                            const bf16_t* CW1, const bf16_t* CW2, bf16_t* KCMP, bf16_t* VCMP, bf16_t* AO) {
    for (int u = mk_bid(); u < 128 + 1024; u += mk_grid()) {
        if (u < 128) compress_unit(lds, u, QKV, pe_k, pe_v, CW1, CW2, KCMP, VCMP);
        else swa_unit(lds, u - 128, QKV, relb, sinks, AO);
    }
}

constexpr int NSA_TS = 1184, NSA_TW = 704;
constexpr int NSA_OFF_TS = ATT_END, NSA_OFF_TW = NSA_OFF_TS + 8 * NSA_TS * 4, NSA_OFF_IMP = NSA_OFF_TW + 8 * NSA_TW * 4, NSA_OFF_SEL = NSA_OFF_IMP + 32 * 64 * 4, NSA_OFF_UNI = NSA_OFF_SEL + 32 * 8;
static_assert(NSA_OFF_UNI + 64 <= LDS_BYTES, "NSA LDS map");

struct NsaSelSc : TabSc<64> {
    int q0; unsigned mlo, mhi;
    __device__ __forceinline__ bool active(int) const { return true; }
    __device__ __forceinline__ bool rowok(int t) const { return ((t < 32 ? (mlo >> t) : (mhi >> (t - 32))) & 1u) != 0u; }
    __device__ __forceinline__ void apply(v16f& p0, v16f& p1, int t, const LAS float*) const {
        if (q0 - (64 * t + 63) >= 1024) { const float b31 = tb[64 + 1024]; p0 = p0 * C1 + b31; p1 = p1 * C1 + b31; }
        else apply_tab(p0, p1, t);
    }
};
struct NsaWinSc : TabSc<64> {
    __device__ __forceinline__ bool active(int) const { return true; }
    __device__ __forceinline__ bool rowok(int) const { return true; }
    __device__ __forceinline__ void apply(v16f& p0, v16f& p1, int t, const LAS float*) const { apply_tab(p0, p1, t); }
};

__device__ __forceinline__ void nsa_phase(LAS unsigned char* lds, const bf16_t* QKV, const float* relb, const bf16_t* KCMP, const bf16_t* VCMP, bf16_t* AO, float* SCRG) {
    const int w = __builtin_amdgcn_readfirstlane(mk_ltid() >> 6);
    LAS unsigned char* KT = lds + ATT_K; LAS unsigned char* VT = lds + ATT_V;
    LAS float* TS = (LAS float*)(lds + NSA_OFF_TS); LAS float* TW = (LAS float*)(lds + NSA_OFF_TW); LAS unsigned* IMP = (LAS unsigned*)(lds + NSA_OFF_IMP);
    LAS unsigned* SEL = (LAS unsigned*)(lds + NSA_OFF_SEL); LAS unsigned* UNI = (LAS unsigned*)(lds + NSA_OFF_UNI);
    int cur_g = -1;
#define NSA_GATE(i) (1.f / (1.f + __expf(-bf2f(QKV[(size_t)(b * SEQ + qpos) * EVEN_PAD + E_GT + hq * 3 + (i)]))))
    for (int u = mk_bid(); u < 1024; u += mk_grid()) {
        const int qblk = 127 - (u >> 3), b = (u >> 1) & 3, g = u & 1;
        const int hq = 8 * g + w, q0 = 32 * qblk, bg = b * 2 + g;
        v8s qf[4]; v16f oT[2];
        float* SCR = SCRG + (size_t)mk_bid() * (512 * 32);
        {
            const int tid = mk_ltid(), lane = tid & 63, r32 = lane & 31, hi = lane >> 5, qpos = q0 + r32;
            __syncthreads();
            if (g != cur_g) { cur_g = g;
                for (int i = tid; i < 8 * NSA_TS; i += 512) { const int hh = i / NSA_TS, d = i - hh * NSA_TS - 64;
                    TS[i] = (d >= 0) ? relb[rel_bucket(d < 1024 ? d : 1024) * 32 + 16 + 8 * g + hh] * LOG2E : -INFINITY; }
                for (int i = tid; i < 8 * NSA_TW; i += 512) { const int hh = i / NSA_TW, d = i - hh * NSA_TW - 64;
                    TW[i] = (d >= 0 && d < 512) ? relb[rel_bucket(d) * 32 + 16 + 8 * g + hh] * LOG2E : -INFINITY; } }
            for (int i = tid; i < 32 * 64; i += 512) IMP[i] = 0u;
            if (tid < 2) UNI[tid] = 0u;
            const bf16_t* Qrow = QKV + (size_t)(b * SEQ + qpos) * EVEN_PAD;
#pragma unroll
            for (int s = 0; s < 4; ++s) qf[s] = *(const v8s*)(Qrow + E_QB + hq * 64 + hi * 8 + s * 16);
        }
        const bf16_t* Kc = KCMP + (size_t)bg * 256 * 64; const bf16_t* Vc = VCMP + (size_t)bg * 256 * 64;
        const int nct = (2 * qblk) / 64 + 1;
        float m = -INFINITY, l = 0.f;
        {
            const int tid = mk_ltid(), lane = tid & 63, r32 = lane & 31, hi = lane >> 5, qpos = q0 + r32; const LAS float* tb = TS + w * NSA_TS + 64;
            v4u kr = ld_tile(Kc, 0, 64, tid);
            for (int t = 0; t < nct; ++t) {
                const int buf = t & 1;
                st_k(KT + buf * KTB, kr, tid);
                __syncthreads();
                if (t + 1 < nct) kr = ld_tile(Kc, 64 * (t + 1), 64, tid);
                v16f p0, p1;
                qk_tile(KT + buf * KTB, qf, p0, p1, r32, hi);
                float mx = -INFINITY;
#pragma unroll
                for (int r = 0; r < 16; ++r) {
                    const int c0 = 64 * t + crow(r, hi); const int d0 = qpos - 16 * c0 - 31, d1 = d0 - 512;
                    p0[r] = p0[r] * C1 + tb[min(max(d0, -1), 1024)]; p1[r] = p1[r] * C1 + tb[min(max(d1, -1), 1024)];
                    mx = fmaxf(mx, fmaxf(p0[r], p1[r]));
                }
                mx = fmaxf(mx, __shfl_xor(mx, 32));
                const float mn = fmaxf(m, mx), mu = (mn == -INFINITY) ? 0.f : mn;
                float rs = 0.f;
#pragma unroll
                for (int r = 0; r < 16; ++r) rs += ex2(p0[r] - mu) + ex2(p1[r] - mu);
                l = l * ex2(m - mu) + rs; m = mn;
            }
        }
        l += __shfl_xor(l, 32);
        {
            const int tid = mk_ltid(), lane = tid & 63, r32 = lane & 31, hi = lane >> 5, qpos = q0 + r32; const LAS float* tb = TS + w * NSA_TS + 64;
            const float mu = (m == -INFINITY) ? 0.f : m, il = (l > 0.f) ? 1.f / l : 0.f;
            const float gt0 = NSA_GATE(0);
#pragma unroll
            for (int r = 0; r < 16; ++r) { oT[0][r] = 0.f; oT[1][r] = 0.f; }
            __syncthreads();
            v4u kr = ld_tile(Kc, 0, 64, tid), vr = ld_tile(Vc, 0, 64, tid);
            for (int t = 0; t < nct; ++t) {
                const int buf = t & 1;
                st_k(KT + buf * KTB, kr, tid); st_v(VT + buf * VTB, vr, tid);
                __syncthreads();
                if (t + 1 < nct) { kr = ld_tile(Kc, 64 * (t + 1), 64, tid); vr = ld_tile(Vc, 64 * (t + 1), 64, tid); }
                v16f p0, p1;
                qk_tile(KT + buf * KTB, qf, p0, p1, r32, hi);
#pragma unroll
                for (int r = 0; r < 16; ++r) {
                    const int c0 = 64 * t + crow(r, hi); const int d0 = qpos - 16 * c0 - 31, d1 = d0 - 512;
                    p0[r] = ex2(p0[r] * C1 + tb[min(max(d0, -1), 1024)] - mu) * il; p1[r] = ex2(p1[r] * C1 + tb[min(max(d1, -1), 1024)] - mu) * il;
                }
#pragma unroll
                for (int gq = 0; gq < 4; ++gq) {
                    const int sb0 = 16 * t + 2 * gq + hi, sb1 = sb0 + 8;
                    const unsigned a0 = (unsigned)(((p0[4 * gq] + p0[4 * gq + 1]) + (p0[4 * gq + 2] + p0[4 * gq + 3])) * 4194304.f + 0.5f);
                    const unsigned a1 = (unsigned)(((p1[4 * gq] + p1[4 * gq + 1]) + (p1[4 * gq + 2] + p1[4 * gq + 3])) * 4194304.f + 0.5f);
                    const unsigned e0 = (unsigned)(p0[4 * gq + 3] * 4194304.f + 0.5f), e1 = (unsigned)(p1[4 * gq + 3] * 4194304.f + 0.5f);
                    lds_add(IMP + r32 * 64 + sb0, a0); lds_add(IMP + r32 * 64 + sb1, a1);
                    lds_add(IMP + r32 * 64 + sb0 + 1, e0); if (sb1 + 1 < 64) lds_add(IMP + r32 * 64 + sb1 + 1, e1);
                }
                p0 = p0 * gt0; p1 = p1 * gt0;
                pv_tile(VT + buf * VTB, p0, p1, oT, lane);
            }
#pragma unroll
            for (int r = 0; r < 16; ++r) { SCR[r * 512 + tid] = oT[0][r]; SCR[(16 + r) * 512 + tid] = oT[1][r]; }
        }
        __syncthreads();
#pragma unroll 1
        for (int i = 0; i < 4; ++i) {
            const int lane = mk_ltid() & 63;
            const int qi = 4 * w + i, qp = q0 + qi, cur = qp >> 6;
            const unsigned v = IMP[qi * 64 + lane];
            const bool fut = lane > cur, forced = (lane == 0) || (lane == cur) || (lane == cur - 1);
            const unsigned key = ((fut ? 0u : (forced ? 0x3ffffffu : min(v + 1u, 0x3fffffeu))) << 6) | (unsigned)(63 - lane);
            int cnt = 0;
#pragma unroll
            for (int jj = 0; jj < 64; ++jj) { const unsigned kj = (unsigned)__builtin_amdgcn_readlane((int)key, jj); cnt += (kj > key) ? 1 : 0; }
            const unsigned long long msk = __ballot(!fut && cnt < 16);
            if (lane == 0) { SEL[2 * qi] = (unsigned)msk; SEL[2 * qi + 1] = (unsigned)(msk >> 32); lds_or(UNI, (unsigned)msk); lds_or(UNI + 1, (unsigned)(msk >> 32)); }
        }
        __syncthreads();
        {
            const int tid = mk_ltid(), lane = tid & 63, r32 = lane & 31, hi = lane >> 5, qpos = q0 + r32;
            const unsigned long long uni = ((unsigned long long)(unsigned)__builtin_amdgcn_readfirstlane((int)UNI[1]) << 32) | (unsigned)__builtin_amdgcn_readfirstlane((int)UNI[0]);
            const bf16_t* Kg = QKV + (size_t)(b * SEQ) * EVEN_PAD + E_KS + g * 64; const bf16_t* Vg = QKV + (size_t)(b * SEQ) * EVEN_PAD + E_VS + g * 64;
#pragma unroll
            for (int r = 0; r < 16; ++r) { oT[0][r] = 0.f; oT[1][r] = 0.f; }
            m = -INFINITY; l = 0.f;
            NsaSelSc sc; sc.tb = TS + w * NSA_TS; sc.qpos = qpos; sc.hi = hi; sc.q0 = q0; sc.mlo = SEL[2 * r32]; sc.mhi = SEL[2 * r32 + 1];
            attn_engine<false>(lds, Kg, Vg, EVEN_PAD, nullptr, MaskSeq{uni}, qf, oT, m, l, sc, tid, lane);
            l += __shfl_xor(l, 32);
            const float scl = (l > 0.f) ? NSA_GATE(1) / l : 0.f;
#pragma unroll
            for (int r = 0; r < 16; ++r) { SCR[r * 512 + tid] += oT[0][r] * scl; SCR[(16 + r) * 512 + tid] += oT[1][r] * scl; }
        }
        {
            const int tid = mk_ltid(), lane = tid & 63, r32 = lane & 31, hi = lane >> 5, qpos = q0 + r32;
            const bf16_t* Kg = QKV + (size_t)(b * SEQ) * EVEN_PAD + E_KW + g * 64; const bf16_t* Vg = QKV + (size_t)(b * SEQ) * EVEN_PAD + E_VW + g * 64;
#pragma unroll
            for (int r = 0; r < 16; ++r) { oT[0][r] = 0.f; oT[1][r] = 0.f; }
            m = -INFINITY; l = 0.f;
            NsaWinSc sc; sc.tb = TW + w * NSA_TW; sc.qpos = qpos; sc.hi = hi;
            attn_engine<false>(lds, Kg, Vg, EVEN_PAD, nullptr, RangeSeq{(q0 >= 511) ? ((q0 - 511) >> 6) : 0, (q0 + 31) >> 6}, qf, oT, m, l, sc, tid, lane);
            l += __shfl_xor(l, 32);
            const float scl = (l > 0.f) ? NSA_GATE(2) / l : 0.f;
#pragma unroll
            for (int r = 0; r < 16; ++r) { oT[0][r] = SCR[r * 512 + tid] + oT[0][r] * scl; oT[1][r] = SCR[(16 + r) * 512 + tid] + oT[1][r] * scl; }
            store_o(AO + (size_t)(b * SEQ + qpos) * DM + 1024 + hq * 64, oT, hi);
        }
    }
}

constexpr int N2_TS = 1216, N2_TW = 704;
constexpr int N2_OFF_TS = ATT_END, N2_OFF_TW = N2_OFF_TS + 8 * N2_TS * 4, N2_OFF_IMP = N2_OFF_TW + 8 * N2_TW * 4, N2_OFF_SEL = N2_OFF_IMP + 64 * 64 * 4, N2_OFF_UNI = N2_OFF_SEL + 64 * 8;
static_assert(N2_OFF_UNI + 64 <= LDS_BYTES - 64, "NSA2 LDS map");


__device__ __forceinline__ void k_load_half(const LAS unsigned char* Kt, int half, v8s (&kf)[4], int r32, int hi) {
    const LAS unsigned char* kb = Kt + (32 * half + r32) * KP + hi * 16;
#pragma unroll
    for (int s = 0; s < 4; ++s) kf[s] = *(const LAS v8s*)(kb + s * 32);
}
__device__ __forceinline__ void qk_half(const v8s (&kf)[4], const v8s (&qf)[4], v16f& p) {
#pragma unroll
    for (int s = 0; s < 4; ++s) p = mfma32(kf[s], qf[s], p);
}
__device__ __forceinline__ v8s scale_q(v8s q) {
    v4u u = __builtin_bit_cast(v4u, q), o;
    o.x = pkbf(__uint_as_float(u.x << 16) * C1, __uint_as_float(u.x & 0xffff0000u) * C1); o.y = pkbf(__uint_as_float(u.y << 16) * C1, __uint_as_float(u.y & 0xffff0000u) * C1);
    o.z = pkbf(__uint_as_float(u.z << 16) * C1, __uint_as_float(u.z & 0xffff0000u) * C1); o.w = pkbf(__uint_as_float(u.w << 16) * C1, __uint_as_float(u.w & 0xffff0000u) * C1);
    return __builtin_bit_cast(v8s, o);
}
__device__ __forceinline__ void v_load_half(const LAS unsigned char* Vt, int dt, v4s (&vf)[8], int lane) {
    const int hi = lane >> 5;
    const LAS unsigned char* vb = Vt + dt * VHB + (4 * hi + ((lane & 15) >> 2)) * 64 + (16 * ((lane >> 4) & 1) + 4 * (lane & 3)) * 2;
#pragma unroll
    for (int ks = 0; ks < 4; ++ks) { const int kvb = 16 * (ks & 1) + 32 * (ks >> 1); vf[2 * ks] = trrd(vb + kvb * 64); vf[2 * ks + 1] = trrd(vb + (kvb + 8) * 64); }
}
__device__ __forceinline__ void pv_half(const v4s (&vf)[8], const v4u (&w)[4], v16f& o) {
#pragma unroll
    for (int ks = 0; ks < 4; ++ks) { const v4s lo = vf[2 * ks], h4 = vf[2 * ks + 1];
        const v8s af = (v8s){lo[0], lo[1], lo[2], lo[3], h4[0], h4[1], h4[2], h4[3]};
        o = mfma32(af, __builtin_bit_cast(v8s, w[ks]), o); }
}
__device__ __forceinline__ void pack_p2(const v16f& p0, const v16f& p1, v4u (&w)[4]) {
    w[0] = (v4u){pkbf(p0[0], p0[1]), pkbf(p0[2], p0[3]), pkbf(p0[4], p0[5]), pkbf(p0[6], p0[7])};
    w[1] = (v4u){pkbf(p0[8], p0[9]), pkbf(p0[10], p0[11]), pkbf(p0[12], p0[13]), pkbf(p0[14], p0[15])};
    w[2] = (v4u){pkbf(p1[0], p1[1]), pkbf(p1[2], p1[3]), pkbf(p1[4], p1[5]), pkbf(p1[6], p1[7])};
    w[3] = (v4u){pkbf(p1[8], p1[9]), pkbf(p1[10], p1[11]), pkbf(p1[12], p1[13]), pkbf(p1[14], p1[15])};
}

__device__ __forceinline__ void softmax_half(v16f& p, v16f (&oT)[2], float& m, float& l, bool rowok) {
    float a = max3f(p[0], p[1], p[2]), b = max3f(p[3], p[4], p[5]);
    a = max3f(a, p[6], p[7]); b = max3f(b, p[8], p[9]); a = max3f(a, p[10], p[11]); b = max3f(b, p[12], p[13]); a = max3f(a, p[14], p[15]);
    float mx = fmaxf(a, b);
    mx = fmaxf(mx, __shfl_xor(mx, 32));
    if (!rowok) mx = -INFINITY;
    const float mn = fmaxf(m, mx);
    const float mu = (mn == -INFINITY) ? 0.f : mn;
    if (__any(mn > m)) { const float alpha = ex2(m - mu); oT[0] = oT[0] * alpha; oT[1] = oT[1] * alpha; l *= alpha; }
    const float mue = rowok ? mu : INFINITY;
    p = p - mue;
#pragma unroll
    for (int r = 0; r < 16; ++r) p[r] = ex2(p[r]);
    l += ((p[0] + p[1]) + (p[2] + p[3])) + ((p[4] + p[5]) + (p[6] + p[7])) + (((p[8] + p[9]) + (p[10] + p[11])) + ((p[12] + p[13]) + (p[14] + p[15])));
    m = mn;
}
__device__ __forceinline__ void v_load_khalf(const LAS unsigned char* Vt, int h, v4s (&vf)[8], int lane) {
    const int hi = lane >> 5;
    const LAS unsigned char* vb = Vt + (32 * h + 4 * hi + ((lane & 15) >> 2)) * 64 + (16 * ((lane >> 4) & 1) + 4 * (lane & 3)) * 2;
#pragma unroll
    for (int ksl = 0; ksl < 2; ++ksl)
#pragma unroll
        for (int dt = 0; dt < 2; ++dt) { vf[(ksl * 2 + dt) * 2] = trrd(vb + dt * VHB + (16 * ksl) * 64); vf[(ksl * 2 + dt) * 2 + 1] = trrd(vb + dt * VHB + (16 * ksl + 8) * 64); }
}
__device__ __forceinline__ void pv_khalf(const v4s (&vf)[8], const v16f& p, v16f (&oT)[2]) {
    v4u w[2];
    w[0] = (v4u){pkbf(p[0], p[1]), pkbf(p[2], p[3]), pkbf(p[4], p[5]), pkbf(p[6], p[7])};
    w[1] = (v4u){pkbf(p[8], p[9]), pkbf(p[10], p[11]), pkbf(p[12], p[13]), pkbf(p[14], p[15])};
#pragma unroll
    for (int ksl = 0; ksl < 2; ++ksl)
#pragma unroll
        for (int dt = 0; dt < 2; ++dt) { const v4s lo = vf[(ksl * 2 + dt) * 2], h4 = vf[(ksl * 2 + dt) * 2 + 1];
            const v8s af = (v8s){lo[0], lo[1], lo[2], lo[3], h4[0], h4[1], h4[2], h4[3]};
            oT[dt] = mfma32(af, __builtin_bit_cast(v8s, w[ksl]), oT[dt]); }
}
template <class Seq, class Sc>
__device__ __forceinline__ void attn_engine2(LAS unsigned char* lds, const bf16_t* Kg, const bf16_t* Vg, int pitch, Seq seq, const v8s (&qa)[4], const v8s (&qb)[4],
                                             v16f (&oA)[2], v16f (&oB)[2], float& mA, float& lA, float& mB, float& lB, const Sc& sc, int tid, int lane) {
    const int r32 = lane & 31, hi = lane >> 5;
    int tc = seq.pop(); if (tc < 0) return;
    int tn = seq.pop(), tnn = (tn >= 0) ? seq.pop() : -1;
    v4u kr = ld_tile(Kg, 64 * tc, pitch, tid), vr = ld_tile(Vg, 64 * tc, pitch, tid);
    __syncthreads();
    st_k(lds + ATT_K, kr, tid); st_v(lds + ATT_V, vr, tid);
    if (tn >= 0) { kr = ld_tile(Kg, 64 * tn, pitch, tid); vr = ld_tile(Vg, 64 * tn, pitch, tid); st_k(lds + ATT_K + KTB, kr, tid); st_v(lds + ATT_V + VTB, vr, tid); }
    if (tnn >= 0) { kr = ld_tile(Kg, 64 * tnn, pitch, tid); vr = ld_tile(Vg, 64 * tnn, pitch, tid); }
    int bi = 0;
#pragma unroll 1
    for (;;) {
        __syncthreads();
        const int b2 = (bi >= 1) ? bi - 1 : 2; int t3 = -1;
        if (tnn >= 0) { st_k(lds + ATT_K + b2 * KTB, kr, tid); st_v(lds + ATT_V + b2 * VTB, vr, tid);
            t3 = seq.pop();
            if (t3 >= 0) { kr = ld_tile(Kg, 64 * t3, pitch, tid); vr = ld_tile(Vg, 64 * t3, pitch, tid); } }
        const bool okA = sc.rowok(tc, 0), okB = sc.rowok(tc, 1);
#pragma unroll
        for (int h = 0; h < 2; ++h) {
            v16f a, b;
            sc.init_half(a, tc, 0, h); sc.init_half(b, tc, 1, h);
            { v8s kf[4]; k_load_half(lds + ATT_K + bi * KTB, h, kf, r32, hi); qk_half(kf, qa, a); qk_half(kf, qb, b); }
            softmax_half(a, oA, mA, lA, okA); softmax_half(b, oB, mB, lB, okB);
            { v4s vf[8]; v_load_khalf(lds + ATT_V + bi * VTB, h, vf, lane); pv_khalf(vf, a, oA); pv_khalf(vf, b, oB); }
        }
        tc = tn; tn = tnn; tnn = t3; bi = (bi == 2) ? 0 : bi + 1;
        if (tc < 0) break;
    }
}
struct Nsa2SelSc {
    const LAS float* tb; int qposA, hi, q0; unsigned mloA, mhiA, mloB, mhiB;
    __device__ __forceinline__ bool rowok(int t, int sub) const { const unsigned lo = sub ? mloB : mloA, hh = sub ? mhiB : mhiA; return ((t < 32 ? (lo >> t) : (hh >> (t - 32))) & 1u) != 0u; }
    __device__ __forceinline__ void init_half(v16f& p, int t, int sub, int h) const {
        if (q0 - (64 * t + 63) >= 1024) { const float b31 = tb[64 + 1024];
#pragma unroll
            for (int r = 0; r < 16; ++r) p[r] = b31; }
        else { const LAS float* bp = tb + (64 + qposA + 32 * sub - 64 * t - 63 - 4 * hi);
#pragma unroll
            for (int r = 0; r < 16; ++r) p[r] = bp[63 - 32 * h - ((r & 3) + 8 * (r >> 2))]; }
    }
};
struct Nsa2WinSc {
    const LAS float* tb; int qposA, hi;
    __device__ __forceinline__ bool rowok(int, int) const { return true; }
    __device__ __forceinline__ void init_half(v16f& p, int t, int sub, int h) const {
        const LAS float* bp = tb + (64 + qposA + 32 * sub - 64 * t - 63 - 4 * hi);
#pragma unroll
        for (int r = 0; r < 16; ++r) p[r] = bp[63 - 32 * h - ((r & 3) + 8 * (r >> 2))];
    }
};

__device__ __forceinline__ void nsa2_phase(LAS unsigned char* lds, const bf16_t* QKV, const float* relb, const bf16_t* KCMP, const bf16_t* VCMP, bf16_t* AO, float* SCRG) {
    const int w = __builtin_amdgcn_readfirstlane(mk_ltid() >> 6);
    LAS unsigned char* KT = lds + ATT_K; LAS unsigned char* VT = lds + ATT_V;
    LAS float* TS = (LAS float*)(lds + N2_OFF_TS); LAS float* TW = (LAS float*)(lds + N2_OFF_TW); LAS unsigned* IMP = (LAS unsigned*)(lds + N2_OFF_IMP);
    LAS unsigned* SEL = (LAS unsigned*)(lds + N2_OFF_SEL); LAS unsigned* UNI = (LAS unsigned*)(lds + N2_OFF_UNI);
    int cur_g = -1;
#define N2_LOADQ() { const bf16_t* Qrow_ = QKV + (size_t)(b * SEQ + q0 + (mk_ltid() & 31)) * EVEN_PAD + E_QB + hq * 64 + ((mk_ltid() >> 5) & 1) * 8; asm volatile("" : "+v"(Qrow_)); \
        _Pragma("unroll") for (int s = 0; s < 4; ++s) { qa[s] = scale_q(*(const v8s*)(Qrow_ + s * 16)); qb[s] = scale_q(*(const v8s*)(Qrow_ + (size_t)32 * EVEN_PAD + s * 16)); } }
#define N2_GATE(qp, i) (1.f / (1.f + __expf(-bf2f(QKV[(size_t)(b * SEQ + (qp)) * EVEN_PAD + E_GT + hq * 3 + (i)]))))
    for (int u = mk_bid(); u < 512; u += mk_grid()) {
        const int qblk = 63 - (u >> 3), b = (u >> 1) & 3, g = u & 1;
        const int hq = 8 * g + w, q0 = 64 * qblk, bg = b * 2 + g;
        v8s qa[4], qb[4]; v16f oA[2], oB[2];
        float* SCR = SCRG + (size_t)mk_bid() * (512 * 64);
        {
            const int tid = mk_ltid(), lane = tid & 63, r32 = lane & 31, hi = lane >> 5, qpos = q0 + r32;
            __syncthreads();
            if (g != cur_g) { cur_g = g;
                for (int i = tid; i < 8 * N2_TS; i += 512) { const int hh = i / N2_TS, d = i - hh * N2_TS - 64;
                    TS[i] = (d >= 0) ? relb[rel_bucket(d < 1024 ? d : 1024) * 32 + 16 + 8 * g + hh] * LOG2E : -INFINITY; }
                for (int i = tid; i < 8 * N2_TW; i += 512) { const int hh = i / N2_TW, d = i - hh * N2_TW - 64;
                    TW[i] = (d >= 0 && d < 512) ? relb[rel_bucket(d) * 32 + 16 + 8 * g + hh] * LOG2E : -INFINITY; } }
            for (int i = tid; i < 64 * 64; i += 512) IMP[i] = 0u;
            if (tid < 2) UNI[tid] = 0u;
            N2_LOADQ()
        }
        const bf16_t* Kc = KCMP + (size_t)bg * 256 * 64; const bf16_t* Vc = VCMP + (size_t)bg * 256 * 64;
        const int nct = ((q0 + 32) >> 4) / 64 + 1;
        float mA = -INFINITY, lA = 0.f, mB = -INFINITY, lB = 0.f;
#define N2_CSCORE(P0, P1, QP) { \
            _Pragma("unroll") for (int r = 0; r < 16; ++r) { const int c0_ = 64 * t + crow(r, hi); const int d0_ = (QP) - 16 * c0_ - 31, d1_ = d0_ - 512; \
                P0[r] = P0[r] + tb[min(max(d0_, -1), 1024)]; P1[r] = P1[r] + tb[min(max(d1_, -1), 1024)]; } }
#define N2_STAT(P0, P1, M, L) { float mx_ = -INFINITY; \
            _Pragma("unroll") for (int r = 0; r < 16; ++r) mx_ = fmaxf(mx_, fmaxf(P0[r], P1[r])); \
            mx_ = fmaxf(mx_, __shfl_xor(mx_, 32)); const float mn_ = fmaxf(M, mx_), mu_ = (mn_ == -INFINITY) ? 0.f : mn_; float rs_ = 0.f; \
            _Pragma("unroll") for (int r = 0; r < 16; ++r) rs_ += ex2(P0[r] - mu_) + ex2(P1[r] - mu_); \
            L = L * ex2(M - mu_) + rs_; M = mn_; }
        {
            const int tid = mk_ltid(), lane = tid & 63, r32 = lane & 31, hi = lane >> 5, qpos = q0 + r32; const LAS float* tb = TS + w * N2_TS + 64;
            v4u kr = ld_tile(Kc, 0, 64, tid);
            for (int t = 0; t < nct; ++t) {
                const int buf = t & 1;
                st_k(KT + buf * KTB, kr, tid);
                __syncthreads();
                if (t + 1 < nct) kr = ld_tile(Kc, 64 * (t + 1), 64, tid);
                { v16f a0, a1; { v8s kf[8]; k_load(KT + buf * KTB, kf, r32, hi); qk_mma(kf, qa, a0, a1); } N2_CSCORE(a0, a1, qpos) N2_STAT(a0, a1, mA, lA) }
                __builtin_amdgcn_sched_barrier(0);
                { v16f b0, b1; { v8s kf[8]; k_load(KT + buf * KTB, kf, r32, hi); qk_mma(kf, qb, b0, b1); } N2_CSCORE(b0, b1, qpos + 32) N2_STAT(b0, b1, mB, lB) }
            }
        }
        lA += __shfl_xor(lA, 32); lB += __shfl_xor(lB, 32);
        {
            const int tid = mk_ltid(), lane = tid & 63, r32 = lane & 31, hi = lane >> 5, qpos = q0 + r32; const LAS float* tb = TS + w * N2_TS + 64;
            const float muA = (mA == -INFINITY) ? 0.f : mA, ilA = (lA > 0.f) ? 1.f / lA : 0.f, muB = (mB == -INFINITY) ? 0.f : mB, ilB = (lB > 0.f) ? 1.f / lB : 0.f;
            const float gA = N2_GATE(qpos, 0), gB = N2_GATE(qpos + 32, 0);
#pragma unroll
            for (int r = 0; r < 16; ++r) { oA[0][r] = 0.f; oA[1][r] = 0.f; oB[0][r] = 0.f; oB[1][r] = 0.f; }
            __syncthreads();
            v4u kr = ld_tile(Kc, 0, 64, tid), vr = ld_tile(Vc, 0, 64, tid);
            for (int t = 0; t < nct; ++t) {
                const int buf = t & 1;
                st_k(KT + buf * KTB, kr, tid); st_v(VT + buf * VTB, vr, tid);
                __syncthreads();
                if (t + 1 < nct) { kr = ld_tile(Kc, 64 * (t + 1), 64, tid); vr = ld_tile(Vc, 64 * (t + 1), 64, tid); }
#define N2_IMP(P0, P1, MU, IL, ROW) { \
                _Pragma("unroll") for (int r = 0; r < 16; ++r) { P0[r] = ex2(P0[r] - MU) * IL; P1[r] = ex2(P1[r] - MU) * IL; } \
                _Pragma("unroll") for (int gq = 0; gq < 4; ++gq) { const int sb0 = 16 * t + 2 * gq + hi, sb1 = sb0 + 8; \
                    const unsigned x0 = (unsigned)(((P0[4 * gq] + P0[4 * gq + 1]) + (P0[4 * gq + 2] + P0[4 * gq + 3])) * 4194304.f + 0.5f); \
                    const unsigned x1 = (unsigned)(((P1[4 * gq] + P1[4 * gq + 1]) + (P1[4 * gq + 2] + P1[4 * gq + 3])) * 4194304.f + 0.5f); \
                    const unsigned e0 = (unsigned)(P0[4 * gq + 3] * 4194304.f + 0.5f), e1 = (unsigned)(P1[4 * gq + 3] * 4194304.f + 0.5f); \
                    lds_add(IMP + (ROW) * 64 + sb0, x0); lds_add(IMP + (ROW) * 64 + sb1, x1); \
                    lds_add(IMP + (ROW) * 64 + sb0 + 1, e0); if (sb1 + 1 < 64) lds_add(IMP + (ROW) * 64 + sb1 + 1, e1); } }
                { v16f a0, a1; { v8s kf[8]; k_load(KT + buf * KTB, kf, r32, hi); qk_mma(kf, qa, a0, a1); } N2_CSCORE(a0, a1, qpos) N2_IMP(a0, a1, muA, ilA, r32)
                  a0 = a0 * gA; a1 = a1 * gA; { v4s vf[16]; v_load(VT + buf * VTB, vf, lane); pv_mma(vf, a0, a1, oA); } }
                __builtin_amdgcn_sched_barrier(0);
                { v16f b0, b1; { v8s kf[8]; k_load(KT + buf * KTB, kf, r32, hi); qk_mma(kf, qb, b0, b1); } N2_CSCORE(b0, b1, qpos + 32) N2_IMP(b0, b1, muB, ilB, 32 + r32)
                  b0 = b0 * gB; b1 = b1 * gB; { v4s vf[16]; v_load(VT + buf * VTB, vf, lane); pv_mma(vf, b0, b1, oB); } }
            }
#pragma unroll
            for (int r = 0; r < 16; ++r) { SCR[r * 512 + tid] = oA[0][r]; SCR[(16 + r) * 512 + tid] = oA[1][r]; SCR[(32 + r) * 512 + tid] = oB[0][r]; SCR[(48 + r) * 512 + tid] = oB[1][r]; }
        }
        __syncthreads();
#pragma unroll 1
        for (int i = 0; i < 8; ++i) {
            const int lane = mk_ltid() & 63;
            const int qi = 8 * w + i, qp = q0 + qi, cur = qp >> 6;
            const unsigned v = IMP[qi * 64 + lane];
            const bool fut = lane > cur, forced = (lane == 0) || (lane == cur) || (lane == cur - 1);
            const unsigned key = ((fut ? 0u : (forced ? 0x3ffffffu : min(v + 1u, 0x3fffffeu))) << 6) | (unsigned)(63 - lane);
            int cnt = 0;
#pragma unroll
            for (int jj = 0; jj < 64; ++jj) { const unsigned kj = (unsigned)__builtin_amdgcn_readlane((int)key, jj); cnt += (kj > key) ? 1 : 0; }
            const unsigned long long msk = __ballot(!fut && cnt < 16);
            if (lane == 0) { SEL[2 * qi] = (unsigned)msk; SEL[2 * qi + 1] = (unsigned)(msk >> 32); lds_or(UNI, (unsigned)msk); lds_or(UNI + 1, (unsigned)(msk >> 32)); }
        }
        __syncthreads();
        {
            const int tid = mk_ltid(), lane = tid & 63, r32 = lane & 31, hi = lane >> 5, qpos = q0 + r32;
            const unsigned long long uni = ((unsigned long long)(unsigned)__builtin_amdgcn_readfirstlane((int)UNI[1]) << 32) | (unsigned)__builtin_amdgcn_readfirstlane((int)UNI[0]);
            const bf16_t* Kg = QKV + (size_t)(b * SEQ) * EVEN_PAD + E_KS + g * 64; const bf16_t* Vg = QKV + (size_t)(b * SEQ) * EVEN_PAD + E_VS + g * 64;
#pragma unroll
            for (int r = 0; r < 16; ++r) { oA[0][r] = 0.f; oA[1][r] = 0.f; oB[0][r] = 0.f; oB[1][r] = 0.f; }
            mA = -INFINITY; lA = 0.f; mB = -INFINITY; lB = 0.f;
            N2_LOADQ()
            Nsa2SelSc sc; sc.tb = TS + w * N2_TS; sc.qposA = qpos; sc.hi = hi; sc.q0 = q0; sc.mloA = SEL[2 * r32]; sc.mhiA = SEL[2 * r32 + 1]; sc.mloB = SEL[2 * (32 + r32)]; sc.mhiB = SEL[2 * (32 + r32) + 1];
            attn_engine2(lds, Kg, Vg, EVEN_PAD, MaskSeq{uni}, qa, qb, oA, oB, mA, lA, mB, lB, sc, tid, lane);
            lA += __shfl_xor(lA, 32); lB += __shfl_xor(lB, 32);
            const float sA = (lA > 0.f) ? N2_GATE(qpos, 1) / lA : 0.f, sB = (lB > 0.f) ? N2_GATE(qpos + 32, 1) / lB : 0.f;
#pragma unroll
            for (int r = 0; r < 16; ++r) { SCR[r * 512 + tid] += oA[0][r] * sA; SCR[(16 + r) * 512 + tid] += oA[1][r] * sA; SCR[(32 + r) * 512 + tid] += oB[0][r] * sB; SCR[(48 + r) * 512 + tid] += oB[1][r] * sB; }
        }
        {
            const int tid = mk_ltid(), lane = tid & 63, r32 = lane & 31, hi = lane >> 5, qpos = q0 + r32;
            const bf16_t* Kg = QKV + (size_t)(b * SEQ) * EVEN_PAD + E_KW + g * 64; const bf16_t* Vg = QKV + (size_t)(b * SEQ) * EVEN_PAD + E_VW + g * 64;
#pragma unroll
            for (int r = 0; r < 16; ++r) { oA[0][r] = 0.f; oA[1][r] = 0.f; oB[0][r] = 0.f; oB[1][r] = 0.f; }
            mA = -INFINITY; lA = 0.f; mB = -INFINITY; lB = 0.f;
            N2_LOADQ()
            Nsa2WinSc sc; sc.tb = TW + w * N2_TW; sc.qposA = qpos; sc.hi = hi;
            attn_engine2(lds, Kg, Vg, EVEN_PAD, RangeSeq{(q0 >= 511) ? ((q0 - 511) >> 6) : 0, (q0 + 63) >> 6}, qa, qb, oA, oB, mA, lA, mB, lB, sc, tid, lane);
            lA += __shfl_xor(lA, 32); lB += __shfl_xor(lB, 32);
            const float sA = (lA > 0.f) ? N2_GATE(qpos, 2) / lA : 0.f, sB = (lB > 0.f) ? N2_GATE(qpos + 32, 2) / lB : 0.f;
#pragma unroll
            for (int r = 0; r < 16; ++r) { oA[0][r] = SCR[r * 512 + tid] + oA[0][r] * sA; oA[1][r] = SCR[(16 + r) * 512 + tid] + oA[1][r] * sA;
                                           oB[0][r] = SCR[(32 + r) * 512 + tid] + oB[0][r] * sB; oB[1][r] = SCR[(48 + r) * 512 + tid] + oB[1][r] * sB; }
            store_o(AO + (size_t)(b * SEQ + qpos) * DM + 1024 + hq * 64, oA, hi);
            store_o(AO + (size_t)(b * SEQ + qpos + 32) * DM + 1024 + hq * 64, oB, hi);
        }
    }
#undef N2_GATE
#undef N2_LOADQ
#undef N2_CSCORE
#undef N2_STAT
#undef N2_IMP
}

__device__ __forceinline__ unsigned xb_ld(unsigned* p)              { return __hip_atomic_load(p, __ATOMIC_RELAXED, __HIP_MEMORY_SCOPE_AGENT); }
__device__ __forceinline__ unsigned xb_add(unsigned* p, unsigned v) { return __hip_atomic_fetch_add(p, v, __ATOMIC_RELAXED, __HIP_MEMORY_SCOPE_AGENT); }
__device__ __forceinline__ unsigned xb_xcc_id() { return (unsigned)__builtin_amdgcn_s_getreg((3 << 11) | 20) & 0xFu; }
#define XB_TMO      128
#define XB_XCNT(j)  (256  + 64 * (j))
#define XB_XSUB(j)  (1280 + 64 * (j))
#define XB_XGEN(j)  (2304 + 64 * (j))
#define XB_TOP      3328
#define XB_TOPGEN   3392
#define XCD_BAR_WORDS 3456
#define XB_SPIN_CAP (1u << 18)

#define XB_SPIN(cond, bar) do { unsigned _sp = 0; while (cond) { __builtin_amdgcn_s_sleep(1); \
    if ((++_sp & 255u) == 0u) { if (xb_ld(&(bar)[XB_TMO])) break; if (_sp > XB_SPIN_CAP) { atomicAdd(&(bar)[XB_TMO], 1u); break; } } } } while (0)

struct XcdBarrier {
    unsigned* bar; unsigned x;
    volatile LAS unsigned* st;
};

__device__ __forceinline__ XcdBarrier xcd_barrier_post(unsigned* bar, volatile LAS unsigned* st) {
    XcdBarrier b; b.bar = bar; b.x = xb_xcc_id(); b.st = st;
    if (threadIdx.x == 0) (void)xb_add(&bar[XB_XCNT(b.x)], 1u);
    return b;
}
__device__ __forceinline__ void xcd_barrier_complete(unsigned* bar, unsigned x, unsigned& nloc, unsigned& nx) {
    const unsigned G = gridDim.x * gridDim.y * gridDim.z;
    unsigned sum, cnt, mine, sp = 0u;
    for (;;) {
        sum = 0u; cnt = 0u; mine = 0u;
#pragma unroll
        for (unsigned j = 0; j < 16; ++j) { const unsigned c = xb_ld(&bar[XB_XCNT(j)]); sum += c; cnt += (c > 0u) ? 1u : 0u; mine = (j == x) ? c : mine; }
        if (sum == G) break;
        __builtin_amdgcn_s_sleep(1);
        if ((++sp & 255u) == 0u) { if (xb_ld(&bar[XB_TMO])) break; if (sp > XB_SPIN_CAP) { atomicAdd(&bar[XB_TMO], 1u); break; } }
    }
    nloc = mine > 0u ? mine : 1u; nx = cnt > 0u ? cnt : 1u;
}

__device__ __forceinline__ void xcd_barrier(const XcdBarrier& b) {
    asm volatile("s_waitcnt vmcnt(0)" ::: "memory");
    __syncthreads();
    if (threadIdx.x == 0) {
        unsigned* bar = b.bar;
        __builtin_amdgcn_s_waitcnt(0);
        unsigned nloc = b.st[0], nx = b.st[1];
        if (nloc == 0u) { xcd_barrier_complete(bar, b.x, nloc, nx); b.st[0] = nloc; b.st[1] = nx; }
        const unsigned old = xb_add(&bar[XB_XSUB(b.x)], 1u);
        const unsigned gen = old / nloc;
        if (old + 1u == (gen + 1u) * nloc) {
            __builtin_amdgcn_fence(__ATOMIC_RELEASE, "agent");
            asm volatile("s_waitcnt vmcnt(0)" ::: "memory");
            const unsigned og = xb_add(&bar[XB_TOP], 1u);
            const unsigned tg = og / nx;
            if (og + 1u == (tg + 1u) * nx) xb_add(&bar[XB_TOPGEN], 1u);
            else XB_SPIN(xb_ld(&bar[XB_TOPGEN]) == tg, bar);
            __builtin_amdgcn_fence(__ATOMIC_ACQUIRE, "agent");
            xb_add(&bar[XB_XGEN(b.x)], 1u);
            asm volatile("s_waitcnt vmcnt(0)" ::: "memory");
        } else {
            XB_SPIN(xb_ld(&bar[XB_XGEN(b.x)]) == gen, bar);
            __builtin_amdgcn_fence(__ATOMIC_ACQUIRE, "agent");
            asm volatile("s_waitcnt vmcnt(0)" ::: "memory");
        }
    }
    __syncthreads();
}

#ifndef BF_ALIGN
#define BF_ALIGN true
#endif
#ifndef RES_ALIGN
#define RES_ALIGN true
#endif
__global__ void __launch_bounds__(512, 2) fwd_mega(Args a_unused) {
    extern __shared__ __attribute__((aligned(16))) unsigned char lds_raw[];
    LAS unsigned char* lds = (LAS unsigned char*)lds_raw;
    cg::grid_group grid = cg::this_grid();
    volatile LAS unsigned* xst = (volatile LAS unsigned*)(lds + LDS_BYTES - 64);
    if (threadIdx.x < 2) xst[threadIdx.x] = 0u;
    __syncthreads();
    XcdBarrier xb = xcd_barrier_post((unsigned*)arg_ws(), xst);
#define WSP(off) (arg_ws() + (off))
#define RED_LDS ((PG8_LAS float*)(lds + 131072))
#define RL_LDS ((LAS float*)(lds + 131072 + 4096))
#define RBASE (2048 * (mk_bid() & 7))
    prologue_phase(lds);
    prep_phase(arg_in(0), (bf16_t*)WSP(WS_XN), (float*)WSP(WS_SSP));
    grid.sync();
#pragma unroll 1
    for (int L = 0; L < 4; ++L) {
        const int e = L >> 1;
        rs_table(RL_LDS, (const float*)WSP(WS_SSP), RBASE);
        if ((L & 1) == 0) {
            { pg8::Gemm gm{(const bf16_t*)WSP(WS_XN), (const bf16_t*)WSP(WS_WIE) + (size_t)e * EVEN_PAD * DM, MTOK, EVEN_PAD, DM}; pg8::StaticOrder S; S.init(MTOK, EVEN_PAD, mk_grid(), mk_bid());
              pg8::EpiBf16<0> E{(bf16_t*)WSP(WS_QKV), EVEN_PAD, (PG8_LAS const float*)RL_LDS, RBASE}; pg8::gemm_phase<pg8::EpiBf16<0>, pg8::StaticOrder, true, true>(lds, gm, S, E); }
            xcd_barrier(xb);
            evenA_phase(lds, (const bf16_t*)WSP(WS_QKV), arg_in(1), arg_in(7) + e * 16, arg_in(8) + e * 2048, arg_in(9) + e * 2048,
                        (const bf16_t*)WSP(WS_CW1) + (size_t)e * 2 * 256 * 2048, (const bf16_t*)WSP(WS_CW2) + (size_t)e * 2 * 64 * 256, (bf16_t*)WSP(WS_KCMP), (bf16_t*)WSP(WS_VCMP), (bf16_t*)WSP(WS_AO));
            xcd_barrier(xb);
            nsa_phase(lds, (const bf16_t*)WSP(WS_QKV), arg_in(1), (const bf16_t*)WSP(WS_KCMP), (const bf16_t*)WSP(WS_VCMP), (bf16_t*)WSP(WS_AO), (float*)WSP(WS_SCR));
            xcd_barrier(xb);
            { pg8::Gemm gm{(const bf16_t*)WSP(WS_AO), (const bf16_t*)WSP(WS_WOE) + (size_t)e * DM * DM, MTOK, DM, DM}; pg8::StaticOrder S; S.init(MTOK, DM, mk_grid(), mk_bid());
              pg8::EpiRes E{(const bf16_t*)WSP(WS_XN), (bf16_t*)WSP(WS_XN), DM, (float*)WSP(WS_SSP), RED_LDS}; pg8::gemm_phase<pg8::EpiRes, pg8::StaticOrder, true, true>(lds, gm, S, E); }
#ifdef DUP_OUT0
            if (L == 0) { xcd_barrier(xb);
              pg8::Gemm gm{(const bf16_t*)WSP(WS_AO), (const bf16_t*)WSP(WS_WOE) + (size_t)e * DM * DM, MTOK, DM, DM}; pg8::StaticOrder S; S.init(MTOK, DM, mk_grid(), mk_bid());
              pg8::EpiRes E{(const bf16_t*)WSP(WS_XN), (bf16_t*)WSP(WS_XN), DM, (float*)WSP(WS_SSP), RED_LDS}; pg8::gemm_phase<pg8::EpiRes, pg8::StaticOrder, true, true>(lds, gm, S, E); }
#endif
        } else {
            { pg8::Gemm gm{(const bf16_t*)WSP(WS_XN), (const bf16_t*)WSP(WS_WIO) + (size_t)e * ODD_PAD * DM, MTOK, ODD_PAD, DM}; pg8::StaticOrder S; S.init(MTOK, ODD_PAD, mk_grid(), mk_bid());
              pg8::EpiBf16<0> E{(bf16_t*)WSP(WS_QKV), ODD_PAD, (PG8_LAS const float*)RL_LDS, RBASE}; pg8::gemm_phase<pg8::EpiBf16<0>, pg8::StaticOrder, true, true>(lds, gm, S, E); }
            xcd_barrier(xb);
            cumsum_phase(lds, (const bf16_t*)WSP(WS_QKV), arg_in(16) + e * 32, (float*)WSP(WS_C));
            xcd_barrier(xb);
            fox2_phase(lds, (const bf16_t*)WSP(WS_QKV), (const float*)WSP(WS_C), (bf16_t*)WSP(WS_AO));
            xcd_barrier(xb);
            { pg8::Gemm gm{(const bf16_t*)WSP(WS_AO), (const bf16_t*)WSP(WS_WOO) + (size_t)e * DM * DM, MTOK, DM, DM}; pg8::StaticOrder S; S.init(MTOK, DM, mk_grid(), mk_bid());
              pg8::EpiRes E{(const bf16_t*)WSP(WS_XN), (bf16_t*)WSP(WS_XN), DM, (float*)WSP(WS_SSP), RED_LDS}; pg8::gemm_phase<pg8::EpiRes, pg8::StaticOrder, true, true>(lds, gm, S, E); }
        }
        xcd_barrier(xb);
        rs_table(RL_LDS, (const float*)WSP(WS_SSP), RBASE);
        { pg8::Gemm gm{(const bf16_t*)WSP(WS_XN), (const bf16_t*)WSP(WS_WUP) + (size_t)L * DFF * DM, MTOK, DFF, DM}; pg8::StaticOrder S; S.init(MTOK, DFF, mk_grid(), mk_bid());
          pg8::EpiBf16<2> E{(bf16_t*)WSP(WS_H), DFF, (PG8_LAS const float*)RL_LDS, RBASE}; pg8::gemm_phase<pg8::EpiBf16<2>, pg8::StaticOrder, true, true>(lds, gm, S, E); }
        xcd_barrier(xb);
        { pg8::Gemm gm{(const bf16_t*)WSP(WS_H), (const bf16_t*)WSP(WS_WDN) + (size_t)L * DM * DFF, MTOK, DM, DFF}; pg8::StaticOrder S; S.init(MTOK, DM, mk_grid(), mk_bid());
          pg8::EpiRes E{(const bf16_t*)WSP(WS_XN), (bf16_t*)WSP(WS_XN), DM, (float*)WSP(WS_SSP), RED_LDS}; pg8::gemm_phase<pg8::EpiRes, pg8::StaticOrder, true, true>(lds, gm, S, E); }
        xcd_barrier(xb);
    }
    final_norm_phase((const bf16_t*)WSP(WS_XN), arg_in(4), arg_out());
#undef RED_LDS
#undef RL_LDS
#undef RBASE
#undef WSP
}

extern "C" void kernel_launch(void* const* d_in, const int* in_sizes, int n_in, void* d_out, int out_size, void* d_ws, size_t ws_size, hipStream_t stream) {
    static int grid = 0;
    if (grid == 0) {
        if (n_in != 19 || out_size != MTOK * DM || ws_size < WS_END) { fprintf(stderr, "kernel_launch: unexpected shapes (n_in %d out %d ws %zu)\n", n_in, out_size, ws_size); grid = -1; return; }
        int dev = 0, cus = 0, per_cu = 0;
        (void)hipGetDevice(&dev);
        (void)hipDeviceGetAttribute(&cus, hipDeviceAttributeMultiprocessorCount, dev);
        (void)hipFuncSetAttribute((const void*)fwd_mega, hipFuncAttributeMaxDynamicSharedMemorySize, LDS_BYTES);
        (void)hipOccupancyMaxActiveBlocksPerMultiprocessor(&per_cu, (const void*)fwd_mega, 512, LDS_BYTES);
        if (per_cu < 1) per_cu = 1;
        grid = cus * per_cu;
        fprintf(stderr, "kernel_launch: grid %d (cus %d x %d)\n", grid, cus, per_cu);
    }
    if (grid < 0) return;
    if (hipMemsetAsync(d_ws, 0, 16384, stream) != hipSuccess) { fprintf(stderr, "kernel_launch: memset of the barrier words failed\n"); return; }
    Args a{};
    for (int i = 0; i < 19; ++i) a.in[i] = (const float*)d_in[i];
    a.out = (float*)d_out; a.ws = (unsigned char*)d_ws;
    void* args[] = {&a};
    hipError_t e = hipLaunchCooperativeKernel((void*)fwd_mega, dim3(grid), dim3(512), args, LDS_BYTES, stream);
    if (e != hipSuccess) fprintf(stderr, "cooperative launch failed: %s (grid %d)\n", hipGetErrorString(e), grid);
}
```

```cpp
#include <hip/hip_runtime.h>
#include <hip/hip_cooperative_groups.h>
#include <cstdio>
#include <cstdint>
#include <cmath>
namespace cg = cooperative_groups;
__device__ __forceinline__ int mk_ltid() { int t = threadIdx.x; asm volatile("" : "+v"(t)); return t; }
__device__ __forceinline__ int mk_bid() { int t = blockIdx.x; asm volatile("" : "+s"(t)); return t; }
__device__ __forceinline__ int mk_grid() { int t = gridDim.x; asm volatile("" : "+s"(t)); return t; }
namespace pg8 {
#define PG8_LAS __attribute__((address_space(3)))
typedef unsigned short bf16_t;
typedef short bf16x8 __attribute__((ext_vector_type(8)));
typedef float f32x4 __attribute__((ext_vector_type(4)));
typedef unsigned u32x4 __attribute__((ext_vector_type(4)));
constexpr int BM = 256, BK = 64, HALF = 128, HTB = HALF * BK * 2  , STAGE_BYTES = 8 * HTB, NXCD = 8, WGM = 4;

__host__ __device__ __forceinline__ int lds_byte(int r, int c) { const int st = (r >> 4) * 2 + (c >> 5), rr = r & 15, cc = c & 31, ob = rr * 64 + cc * 2; return st * 1024 + (ob ^ (((ob >> 9) & 1) << 5)); }
__host__ __device__ __forceinline__ void stage_rc(int b, int& R, int& C) { const int st = b / 1024, sb = b % 1024, swz = sb ^ (((sb >> 9) & 1) << 5); R = (st >> 1) * 16 + swz / 64; C = (st & 1) * 32 + (swz % 64) / 2; }
__host__ __device__ __forceinline__ int perm32(int rho) { const int n = rho >> 4, i = rho & 15; return 8 * (i >> 2) + 4 * n + (i & 3); }

struct Unit { int pm, pn; };
struct Gemm { const bf16_t* A; const bf16_t* Bt; int M, N, K; };

struct StaticOrder {
    int nM, nN, nwg, G, c;
    __host__ __device__ void init(int M, int N, int G_, int c_) { nM = M / BM; nN = N / BM; nwg = nM * nN; G = G_; c = c_; }
    __host__ __device__ bool next(int i, Unit& u) const {
        const long L = (long)i * G + c; if (L >= nwg) return false;
        int wgid = (int)L; { const int q = nwg / NXCD, r = nwg % NXCD, xcd = wgid % NXCD, off = wgid / NXCD; wgid = (xcd < r ? xcd * (q + 1) : r * (q + 1) + (xcd - r) * q) + off; }
        const int nig = WGM * nN, gid = wgid / nig, fm = gid * WGM, gsz = (nM - fm) < WGM ? (nM - fm) : WGM;
        u.pm = fm + ((wgid % nig) % gsz); u.pn = (wgid % nig) / gsz; return true;
    }
    __device__ __forceinline__ void a_ready(const Unit&) const {}
    __device__ __forceinline__ void done(const Unit&) const {}
};

__device__ __forceinline__ unsigned cvt_pk_bf16(float lo, float hi) { unsigned r; asm volatile("v_cvt_pk_bf16_f32 %0, %1, %2" : "=v"(r) : "v"(lo), "v"(hi)); return r; }
typedef float f32x2 __attribute__((ext_vector_type(2)));
template <int ACT  > struct EpiBf16 {
    static constexpr bool PERM = true, AFTER_DRAIN = false;
    bf16_t* O; int ldc; PG8_LAS const float* rl; int rbase;
    __device__ __forceinline__ void operator()(const f32x4 (&acc)[2][2][4][2], const Unit& u, int wr, int wc, int fr, int fq) const {
        const int row0 = u.pm * BM + wr * 64 + fr; const int col0 = u.pn * BM + wc * 32 + 8 * fq;
        float rs[2][4];
#pragma unroll
        for (int ai = 0; ai < 2; ++ai)
#pragma unroll
            for (int m = 0; m < 4; ++m) rs[ai][m] = rl[row0 + ai * HALF + m * 16 - rbase];
#pragma unroll
        for (int ai = 0; ai < 2; ++ai)
#pragma unroll
            for (int m = 0; m < 4; ++m) { bf16_t* rowp = O + (size_t)(row0 + ai * HALF + m * 16) * ldc + col0;
#pragma unroll
                for (int bj = 0; bj < 2; ++bj) { f32x4 v0 = acc[ai][bj][m][0] * rs[ai][m], v1 = acc[ai][bj][m][1] * rs[ai][m];
                    if (ACT == 2) {
#pragma unroll
                        for (int e = 0; e < 4; ++e) { float a = v0[e] > 0.f ? v0[e] : 0.f; v0[e] = a * a; float b = v1[e] > 0.f ? v1[e] : 0.f; v1[e] = b * b; } }
                    u32x4 w; w.x = cvt_pk_bf16(v0[0], v0[1]); w.y = cvt_pk_bf16(v0[2], v0[3]); w.z = cvt_pk_bf16(v1[0], v1[1]); w.w = cvt_pk_bf16(v1[2], v1[3]);
                    *(u32x4*)(rowp + bj * HALF) = w; } }
    }
};
struct EpiRes {
    static constexpr bool PERM = false, AFTER_DRAIN = false;
    const bf16_t* base; bf16_t* xb; int ldc; float* ssp; PG8_LAS float* red;
    __device__ __forceinline__ void operator()(const f32x4 (&acc)[2][2][4][2], const Unit& u, int wr, int wc, int fr, int fq) const {
        typedef unsigned u32x2_ __attribute__((ext_vector_type(2)));
        const int row0 = u.pm * BM + wr * 64 + fr; const int col0 = u.pn * BM + wc * 32 + 4 * fq;
#pragma unroll
        for (int ai = 0; ai < 2; ++ai)
#pragma unroll
            for (int m = 0; m < 4; ++m) { const size_t off = (size_t)(row0 + ai * HALF + m * 16) * ldc + col0; float q = 0.f;
                u32x2_ bv[2][2];
#pragma unroll
                for (int bj = 0; bj < 2; ++bj)
#pragma unroll
                    for (int n = 0; n < 2; ++n) bv[bj][n] = *(const u32x2_*)(base + off + bj * HALF + n * 16);
#pragma unroll
                for (int bj = 0; bj < 2; ++bj)
#pragma unroll
                    for (int n = 0; n < 2; ++n) { const u32x2_ bb = bv[bj][n]; f32x4 v = acc[ai][bj][m][n];
                        v[0] += __uint_as_float(bb.x << 16); v[1] += __uint_as_float(bb.x & 0xffff0000u); v[2] += __uint_as_float(bb.y << 16); v[3] += __uint_as_float(bb.y & 0xffff0000u);
                        u32x2_ w; w.x = cvt_pk_bf16(v[0], v[1]); w.y = cvt_pk_bf16(v[2], v[3]);
                        *(u32x2_*)(xb + off + bj * HALF + n * 16) = w;
                        q += (v[0] * v[0] + v[1] * v[1]) + (v[2] * v[2] + v[3] * v[3]); }
                q += __shfl_xor(q, 16); q += __shfl_xor(q, 32);
                if (fq == 0) red[wc * 256 + ai * HALF + wr * 64 + m * 16 + fr] = q; }
        asm volatile("s_waitcnt lgkmcnt(0)" ::: "memory"); __builtin_amdgcn_s_barrier(); asm volatile("" ::: "memory");
        const int t = threadIdx.x;
        if (t < 256) ssp[(size_t)u.pn * 16384 + u.pm * BM + t] = (red[t] + red[256 + t]) + (red[512 + t] + red[768 + t]);
    }
};
template <class Epi, class Sched, bool ALIGN_EPI = false, bool SP2 = false>
__device__ __forceinline__ void gemm_phase(PG8_LAS unsigned char* lds, const Gemm g, const Sched& S, const Epi& E) {
    const int tid = mk_ltid(), wid = __builtin_amdgcn_readfirstlane(tid >> 6), lane = tid & 63, wr = wid >> 2, wc = wid & 3, fr = lane & 15, fq = lane >> 4;
    const int K = g.K, nt = K / BK;
    unsigned voffA[2], voffB[2];
#pragma unroll
    for (int i = 0; i < 2; ++i) { int R, C; stage_rc(tid * 16 + i * 8192, R, C); const int Rb = Epi::PERM ? ((R & ~31) + perm32(R & 31)) : R;
        voffA[i] = (unsigned)(R * K + C) * 2u; voffB[i] = (unsigned)(Rb * K + C) * 2u; }
    const size_t kstep = (size_t)(BK * 2);
    const size_t hstep = (size_t)HALF * K * 2;
    const size_t tstep = 2 * hstep;
    const unsigned ldsw = (unsigned)wid * 1024u;
    const int aoff = lds_byte(wr * 64 + fr, fq * 8), boff = lds_byte(wc * 32 + fr, fq * 8);
#define PG8_SA(b, h) (((b) * 2 + (h)) * HTB)
#define PG8_SB(b, h) ((4 + (b) * 2 + (h)) * HTB)
#define PG8_STAGE(bufoff, gbase, voff) do { _Pragma("unroll") for (int _i = 0; _i < 2; ++_i) \
        __builtin_amdgcn_global_load_lds((const unsigned*)((const char*)(gbase) + (voff)[_i]), (PG8_LAS unsigned*)(lds + (bufoff) + ldsw + _i * 8192), 16, 0, 0); } while (0)
#define PG8_LDA(dst, b, h) do { _Pragma("unroll") for (int m = 0; m < 4; ++m) _Pragma("unroll") for (int k = 0; k < 2; ++k) dst[m][k] = *(const PG8_LAS bf16x8*)(lds + PG8_SA(b, h) + aoff + m * 2048 + k * 1024); } while (0)
#define PG8_LDB(dst, b, h) do { _Pragma("unroll") for (int n = 0; n < 2; ++n) _Pragma("unroll") for (int k = 0; k < 2; ++k) dst[n][k] = *(const PG8_LAS bf16x8*)(lds + PG8_SB(b, h) + boff + n * 2048 + k * 1024); } while (0)
#define PG8_MMA(ai, bj, At, Bt) do { __builtin_amdgcn_s_setprio(1); _Pragma("unroll") for (int m = 0; m < 4; ++m) _Pragma("unroll") for (int n = 0; n < 2; ++n) _Pragma("unroll") for (int k = 0; k < 2; ++k) \
        acc[ai][bj][m][n] = __builtin_amdgcn_mfma_f32_16x16x32_bf16(Bt[n][k], At[m][k], acc[ai][bj][m][n], 0, 0, 0); __builtin_amdgcn_s_setprio(0); } while (0)
#define PG8_WAIT_V(n) asm volatile("s_waitcnt vmcnt(" #n ")" ::: "memory")
#define PG8_WAIT_L(n) asm volatile("s_waitcnt lgkmcnt(" #n ")" ::: "memory")
#define PG8_BAR __builtin_amdgcn_s_barrier()
#define PG8_SCHED __builtin_amdgcn_sched_barrier(0)
    Unit cur, nxt; int ui = 0;
    if (!S.next(0, cur)) return;
    f32x4 acc[2][2][4][2];
#pragma unroll
    for (int a = 0; a < 2; ++a)
#pragma unroll
        for (int b = 0; b < 2; ++b)
#pragma unroll
            for (int m = 0; m < 4; ++m)
#pragma unroll
                for (int n = 0; n < 2; ++n) acc[a][b][m][n] = (f32x4){0.f, 0.f, 0.f, 0.f};
    bf16x8 At[4][2], B0[2][2], B1[2][2];
    const char* cA = (const char*)g.A + (size_t)cur.pm * tstep; const char* cB = (const char*)g.Bt + (size_t)cur.pn * tstep;
    S.a_ready(cur);
    if constexpr (SP2) {
        PG8_STAGE(PG8_SB(0, 0), cB, voffB); PG8_STAGE(PG8_SB(0, 1), cB + hstep, voffB); PG8_STAGE(PG8_SA(0, 0), cA, voffA); PG8_STAGE(PG8_SA(0, 1), cA + hstep, voffA);
        if (wr == 1) PG8_BAR;
        PG8_WAIT_V(2); PG8_BAR;
        PG8_STAGE(PG8_SB(1, 0), cB + kstep, voffB); PG8_STAGE(PG8_SA(1, 0), cA + kstep, voffA); PG8_STAGE(PG8_SB(1, 1), cB + hstep + kstep, voffB);
        PG8_WAIT_V(6); PG8_BAR;
    } else {
        PG8_STAGE(PG8_SB(0, 0), cB, voffB); PG8_STAGE(PG8_SA(0, 0), cA, voffA); PG8_STAGE(PG8_SB(0, 1), cB + hstep, voffB); PG8_STAGE(PG8_SA(0, 1), cA + hstep, voffA);
        if (wr == 1) PG8_BAR;
        PG8_WAIT_V(4); PG8_BAR;
        PG8_STAGE(PG8_SB(1, 0), cB + kstep, voffB); PG8_STAGE(PG8_SA(1, 0), cA + kstep, voffA); PG8_STAGE(PG8_SB(1, 1), cB + hstep + kstep, voffB);
        PG8_WAIT_V(6); PG8_BAR;
    }
    for (;;) {
        const bool has_next = S.next(ui + 1, nxt);
        const char* nA = has_next ? (const char*)g.A + (size_t)nxt.pm * tstep : cA; const char* nB = has_next ? (const char*)g.Bt + (size_t)nxt.pn * tstep : cB;
        for (int t = 0; t < nt; t += 2) {
            const bool last = (t == nt - 2);
            const char* a1 = cA + (size_t)(t + 1) * kstep;
            const char* a2 = last ? nA : cA + (size_t)(t + 2) * kstep; const char* b2 = last ? nB : cB + (size_t)(t + 2) * kstep;
            const char* a3 = a2 + kstep; const char* b3 = b2 + kstep;
            if (last && has_next) S.a_ready(nxt);
            if constexpr (SP2) {
            PG8_LDB(B0, 0, 0); PG8_LDB(B1, 0, 1); PG8_SCHED; PG8_LDA(At, 0, 0); PG8_STAGE(PG8_SA(1, 1), a1 + hstep, voffA);
            PG8_WAIT_V(8); PG8_WAIT_L(0); PG8_BAR; PG8_MMA(0, 0, At, B0); PG8_MMA(0, 1, At, B1); PG8_BAR; PG8_SCHED;
            PG8_LDA(At, 0, 1); PG8_STAGE(PG8_SB(0, 0), b2, voffB); PG8_STAGE(PG8_SB(0, 1), b2 + hstep, voffB); PG8_STAGE(PG8_SA(0, 0), a2, voffA);
            PG8_WAIT_V(8); PG8_WAIT_L(0); PG8_BAR; PG8_MMA(1, 0, At, B0); PG8_MMA(1, 1, At, B1); PG8_BAR; PG8_SCHED;
            PG8_LDB(B0, 1, 0); PG8_LDB(B1, 1, 1); PG8_SCHED; PG8_LDA(At, 1, 0); PG8_STAGE(PG8_SA(0, 1), a2 + hstep, voffA);
            PG8_WAIT_V(8); PG8_WAIT_L(0); PG8_BAR; PG8_MMA(0, 0, At, B0); PG8_MMA(0, 1, At, B1); PG8_BAR; PG8_SCHED;
            PG8_LDA(At, 1, 1); PG8_STAGE(PG8_SB(1, 0), b3, voffB); PG8_STAGE(PG8_SB(1, 1), b3 + hstep, voffB); PG8_STAGE(PG8_SA(1, 0), a3, voffA);
            PG8_WAIT_V(8); PG8_WAIT_L(0); PG8_BAR; PG8_MMA(1, 0, At, B0); PG8_MMA(1, 1, At, B1); PG8_BAR; PG8_SCHED;
            } else {
            PG8_LDB(B0, 0, 0); PG8_SCHED; PG8_LDA(At, 0, 0); PG8_STAGE(PG8_SA(1, 1), a1 + hstep, voffA);
            PG8_WAIT_L(8); PG8_BAR; PG8_WAIT_L(0); PG8_MMA(0, 0, At, B0); PG8_BAR; PG8_SCHED;
            PG8_LDB(B1, 0, 1); PG8_STAGE(PG8_SB(0, 0), b2, voffB);
            PG8_BAR; PG8_WAIT_L(0); PG8_MMA(0, 1, At, B1); PG8_BAR;
            PG8_LDA(At, 0, 1); PG8_STAGE(PG8_SA(0, 0), a2, voffA);
            PG8_BAR; PG8_WAIT_L(0); PG8_MMA(1, 0, At, B0); PG8_BAR; PG8_SCHED;
            PG8_STAGE(PG8_SB(0, 1), b2 + hstep, voffB);
            PG8_WAIT_V(6); PG8_BAR; PG8_MMA(1, 1, At, B1); PG8_BAR;
            PG8_LDB(B0, 1, 0); PG8_SCHED; PG8_LDA(At, 1, 0); PG8_STAGE(PG8_SA(0, 1), a2 + hstep, voffA);
            PG8_WAIT_L(8); PG8_BAR; PG8_WAIT_L(0); PG8_MMA(0, 0, At, B0); PG8_BAR; PG8_SCHED;
            PG8_LDB(B1, 1, 1); PG8_STAGE(PG8_SB(1, 0), b3, voffB);
            PG8_BAR; PG8_WAIT_L(0); PG8_MMA(0, 1, At, B1); PG8_BAR;
            PG8_LDA(At, 1, 1); PG8_STAGE(PG8_SA(1, 0), a3, voffA);
            PG8_BAR; PG8_WAIT_L(0); PG8_MMA(1, 0, At, B0); PG8_BAR; PG8_SCHED;
            PG8_STAGE(PG8_SB(1, 1), b3 + hstep, voffB);
            PG8_WAIT_V(6); PG8_BAR; PG8_MMA(1, 1, At, B1); PG8_BAR;
            }
        }
        if constexpr (ALIGN_EPI) { if (wr == 0) PG8_BAR; }
        if constexpr (!Epi::AFTER_DRAIN) { E(acc, cur, wr, wc, fr, fq); S.done(cur); }
        if (!has_next) break;
#pragma unroll
        for (int a = 0; a < 2; ++a)
#pragma unroll
            for (int b = 0; b < 2; ++b)
#pragma unroll
                for (int m = 0; m < 4; ++m)
#pragma unroll
                    for (int n = 0; n < 2; ++n) acc[a][b][m][n] = (f32x4){0.f, 0.f, 0.f, 0.f};
        cur = nxt; cA = nA; cB = nB; ++ui;
        if constexpr (ALIGN_EPI) { if (wr == 1) PG8_BAR; }
    }
    PG8_WAIT_V(0);
    if constexpr (!ALIGN_EPI) { if (wr == 0) PG8_BAR; }
    PG8_BAR;
    if constexpr (Epi::AFTER_DRAIN) { E.fused(acc, cur, wr, wc, fr, fq, lds, wid, lane); S.done(cur); }
#undef PG8_SA
#undef PG8_SB
#undef PG8_STAGE
#undef PG8_LDA
#undef PG8_LDB
#undef PG8_MMA
#undef PG8_WAIT_V
#undef PG8_WAIT_L
#undef PG8_BAR
#undef PG8_SCHED
}
}

#define LAS __attribute__((address_space(3)))
typedef unsigned short bf16_t;
typedef short v8s __attribute__((ext_vector_type(8)));
typedef short v4s __attribute__((ext_vector_type(4)));
typedef float v4f __attribute__((ext_vector_type(4)));
typedef float v16f __attribute__((ext_vector_type(16)));
typedef unsigned v4u __attribute__((ext_vector_type(4)));
typedef unsigned v2u __attribute__((ext_vector_type(2)));

constexpr int DM = 2048, NB = 4, SEQ = 4096, MTOK = NB * SEQ, DFF = 8192;
constexpr int EVEN_IN = 3376, EVEN_PAD = 3584, ODD_IN = 6176, ODD_PAD = 6400;
constexpr int E_QA = 0, E_KA = 1024, E_VA = 1280, E_QB = 1536, E_KC = 2560, E_VC = 2688, E_KS = 2816, E_VS = 2944, E_KW = 3072, E_VW = 3200, E_GT = 3328;
constexpr int O_Q = 0, O_K = 2048, O_V = 4096, O_F = 6144;
constexpr float LOG2E = 1.4426950408889634f;
constexpr float C1 = 0.125f * LOG2E;
constexpr float RMS_EPS = 1e-6f;

constexpr size_t MiB = 1u << 20;
constexpr size_t WS_WUP = 16 * MiB, WS_WDN = 144 * MiB, WS_WIE = 272 * MiB, WS_WIO = 300 * MiB, WS_WOE = 350 * MiB, WS_WOO = 366 * MiB;
constexpr size_t WS_CW1 = 382 * MiB, WS_CW2 = 386 * MiB, WS_KCMP = 387 * MiB, WS_VCMP = 387 * MiB + 512 * 1024, WS_C = 388 * MiB, WS_SSP = 390 * MiB;
constexpr size_t WS_XN = 392 * MiB, WS_QKV = 456 * MiB, WS_AO = 656 * MiB, WS_H = 456 * MiB, WS_SCR = 720 * MiB, WS_END = 736 * MiB;

constexpr int KP = 144, VP = 144, TILEB = 64 * 144;
constexpr int LDS_BYTES = 160 * 1024;

struct Args { const float* in[19]; float* out; unsigned char* ws; };
__device__ __forceinline__ const unsigned char __attribute__((address_space(4)))* karg_base() {
    const unsigned char __attribute__((address_space(4)))* kp = (const unsigned char __attribute__((address_space(4)))*)__builtin_amdgcn_kernarg_segment_ptr();
    asm volatile("" : "+s"(kp)); return kp; }
__device__ __forceinline__ const float* arg_in(int i) { return *(const float* const __attribute__((address_space(4)))*)(karg_base() + 8 * i); }
__device__ __forceinline__ float* arg_out() { return *(float* const __attribute__((address_space(4)))*)(karg_base() + 8 * 19); }
__device__ __forceinline__ unsigned char* arg_ws() { return *(unsigned char* const __attribute__((address_space(4)))*)(karg_base() + 8 * 20); }

__device__ __forceinline__ unsigned pkbf(float lo, float hi) {
    typedef float f2 __attribute__((ext_vector_type(2))); typedef __bf16 b2 __attribute__((ext_vector_type(2)));
    f2 v = {lo, hi}; b2 b = __builtin_convertvector(v, b2); return __builtin_bit_cast(unsigned, b);
}
__device__ __forceinline__ float bf2f(unsigned short u) { return __uint_as_float(((unsigned)u) << 16); }
__device__ __forceinline__ float ex2(float x) { return __builtin_amdgcn_exp2f(x); }
__device__ __forceinline__ void lds_add(LAS unsigned* p, unsigned v) { (void)__hip_atomic_fetch_add(p, v, __ATOMIC_RELAXED, __HIP_MEMORY_SCOPE_WORKGROUP); }
__device__ __forceinline__ void lds_or(LAS unsigned* p, unsigned v) { (void)__hip_atomic_fetch_or(p, v, __ATOMIC_RELAXED, __HIP_MEMORY_SCOPE_WORKGROUP); }
__device__ __forceinline__ int crow(int r, int hi) { return (r & 3) + 8 * (r >> 2) + 4 * hi; }
__device__ __forceinline__ v16f mfma32(v8s a, v8s b, v16f c) { return __builtin_amdgcn_mfma_f32_32x32x16_bf16(a, b, c, 0, 0, 0); }
__device__ __forceinline__ float wave_sum(float v) {
#pragma unroll
    for (int o = 1; o < 64; o <<= 1) v += __shfl_xor(v, o);
    return v;
}

__device__ __forceinline__ void tr_load(float (&v)[32], const float* W, int K, int N, int item, int lane) {
    const int nblk = (N + 31) / 32, kb = item / nblk, nb = item - kb * nblk, k0 = 64 * kb, n0 = 32 * nb;
    const int nn = n0 + (lane & 31); const bool ok = nn < N;
    const float* p = W + (size_t)(k0 + (lane >> 5)) * N + (ok ? nn : 0);
#pragma unroll
    for (int i = 0; i < 32; ++i) { const float x = p[(size_t)(2 * i) * N]; v[i] = ok ? x : 0.f; }
}
__device__ __forceinline__ void tr_put(const float (&v)[32], LAS float* scr, int lane) {
#pragma unroll
    for (int i = 0; i < 32; ++i) scr[(2 * i + (lane >> 5)) * 33 + (lane & 31)] = v[i];
}
__device__ __forceinline__ void tr_put_gain(const float (&v)[32], LAS float* scr, int lane, const LAS float* gk) {
#pragma unroll
    for (int i = 0; i < 32; ++i) scr[(2 * i + (lane >> 5)) * 33 + (lane & 31)] = v[i] * gk[2 * i + (lane >> 5)];
}
__device__ __forceinline__ void tr_store(bf16_t* WT, int K, int N, LAS float* scr, int item, int lane) {
    const int nblk = (N + 31) / 32, kb = item / nblk, nb = item - kb * nblk, k0 = 64 * kb, n0 = 32 * nb;
    const int c = lane & 7;
#pragma unroll
    for (int j = 0; j < 4; ++j) { const int n = (lane >> 3) + 8 * j; const LAS float* s = scr + (8 * c) * 33 + n;
        v4u o; o.x = pkbf(s[0 * 33], s[1 * 33]); o.y = pkbf(s[2 * 33], s[3 * 33]); o.z = pkbf(s[4 * 33], s[5 * 33]); o.w = pkbf(s[6 * 33], s[7 * 33]);
        *(v4u*)(WT + (size_t)(n0 + n) * K + k0 + 8 * c) = o; }
}

__device__ __forceinline__ void prologue_phase(LAS unsigned char* lds) {
    const int tid = mk_ltid(), lane = tid & 63, wave = __builtin_amdgcn_readfirstlane(tid >> 6);
    LAS float* scr = (LAS float*)(lds + wave * 16384);
    const int gw = mk_bid() * 8 + wave, NGW = mk_grid() * 8;
    for (int mi = 0; mi < 24; ++mi) {
        unsigned char* ws = arg_ws();
        const float* W; int K, N; bf16_t* WT; const float* g = nullptr;
        if (mi < 4) { W = arg_in(17) + (size_t)mi * DM * DFF; K = DM; N = DFF; WT = (bf16_t*)(ws + WS_WUP) + (size_t)mi * DFF * DM; g = arg_in(3) + mi * DM; }
        else if (mi < 8) { const int L = mi - 4; W = arg_in(18) + (size_t)L * DFF * DM; K = DFF; N = DM; WT = (bf16_t*)(ws + WS_WDN) + (size_t)L * DM * DFF; }
        else if (mi < 10) { const int e = mi - 8; W = arg_in(5) + (size_t)e * DM * EVEN_IN; K = DM; N = EVEN_IN; WT = (bf16_t*)(ws + WS_WIE) + (size_t)e * EVEN_PAD * DM; g = arg_in(2) + (2 * e) * DM; }
        else if (mi < 12) { const int e = mi - 10; W = arg_in(14) + (size_t)e * DM * ODD_IN; K = DM; N = ODD_IN; WT = (bf16_t*)(ws + WS_WIO) + (size_t)e * ODD_PAD * DM; g = arg_in(2) + (2 * e + 1) * DM; }
        else if (mi < 14) { const int e = mi - 12; W = arg_in(6) + (size_t)e * DM * DM; K = DM; N = DM; WT = (bf16_t*)(ws + WS_WOE) + (size_t)e * DM * DM; }
        else if (mi < 16) { const int e = mi - 14; W = arg_in(15) + (size_t)e * DM * DM; K = DM; N = DM; WT = (bf16_t*)(ws + WS_WOO) + (size_t)e * DM * DM; }
        else if (mi < 20) { const int e = (mi - 16) & 1, kv = (mi - 16) >> 1; W = arg_in(kv ? 12 : 10) + (size_t)e * 2048 * 256; K = 2048; N = 256; WT = (bf16_t*)(ws + WS_CW1) + (size_t)(e * 2 + kv) * 256 * 2048; }
        else { const int e = (mi - 20) & 1, kv = (mi - 20) >> 1; W = arg_in(kv ? 13 : 11) + (size_t)e * 256 * 64; K = 256; N = 64; WT = (bf16_t*)(ws + WS_CW2) + (size_t)(e * 2 + kv) * 64 * 256; }
        const int nitems = (K / 64) * ((N + 31) / 32), nblk = (N + 31) / 32;
        LAS float* SG = scr + 64 * 33;
        float v[32]; float gv = 1.f;
        int it = gw;
        if (it < nitems) { tr_load(v, W, K, N, it, lane); if (g) gv = g[64 * (it / nblk) + lane]; }
        while (it < nitems) {
            if (g) { SG[lane] = gv; tr_put_gain(v, scr, lane, SG); } else tr_put(v, scr, lane);
            const int nx = it + NGW;
            if (nx < nitems) { tr_load(v, W, K, N, nx, lane); if (g) gv = g[64 * (nx / nblk) + lane]; }
            asm volatile("s_waitcnt lgkmcnt(0)" ::: "memory");
            tr_store(WT, K, N, scr, it, lane);
            asm volatile("s_waitcnt lgkmcnt(0)" ::: "memory");
            it = nx;
        }
    }
}

__device__ __forceinline__ void prep_phase(const float* X, bf16_t* XB, float* SSP) {
    const int tid = mk_ltid(), lane = tid & 63, wave = tid >> 6;
    const int gw = mk_bid() * 8 + wave, NGW = mk_grid() * 8;
    for (int m = gw; m < MTOK; m += NGW) {
        const v4f* xr = (const v4f*)(X + (size_t)m * DM) + lane;
        v2u* o = (v2u*)(XB + (size_t)m * DM) + lane;
        float s = 0.f;
#pragma unroll
        for (int j = 0; j < 8; ++j) { const v4f v = xr[64 * j]; s += (v.x * v.x + v.y * v.y) + (v.z * v.z + v.w * v.w); v2u w; w.x = pkbf(v.x, v.y); w.y = pkbf(v.z, v.w); o[64 * j] = w; }
        s = wave_sum(s);
        if (lane < 8) SSP[(size_t)lane * MTOK + m] = (lane == 0) ? s : 0.f;
    }
}
__device__ __forceinline__ void rs_table(LAS float* RL, const float* SSP, int rbase) {
    const int tid = mk_ltid();
#pragma unroll
    for (int i = 0; i < 4; ++i) { const int row = rbase + tid + 512 * i; float s = 0.f;
#pragma unroll
        for (int p = 0; p < 8; ++p) s += SSP[(size_t)p * MTOK + row];
        RL[tid + 512 * i] = 1.0f / sqrtf(s * (1.f / DM) + RMS_EPS); }
    __syncthreads();
}

__device__ __forceinline__ void final_norm_phase(const bf16_t* XB, const float* g, float* OUT) {
    const int tid = mk_ltid(), lane = tid & 63, wave = tid >> 6;
    const int gw = mk_bid() * 8 + wave, NGW = mk_grid() * 8;
    v4f gv[8];
#pragma unroll
    for (int j = 0; j < 8; ++j) gv[j] = *((const v4f*)g + lane + 64 * j);
    for (int m = gw; m < MTOK; m += NGW) {
        const v2u* xr = (const v2u*)(XB + (size_t)m * DM) + lane;
        v4f v[8]; float s = 0.f;
#pragma unroll
        for (int j = 0; j < 8; ++j) { const v2u w = xr[64 * j]; v[j] = (v4f){__uint_as_float(w.x << 16), __uint_as_float(w.x & 0xffff0000u), __uint_as_float(w.y << 16), __uint_as_float(w.y & 0xffff0000u)};
            s += (v[j].x * v[j].x + v[j].y * v[j].y) + (v[j].z * v[j].z + v[j].w * v[j].w); }
        const float r = 1.0f / sqrtf(wave_sum(s) * (1.f / DM) + RMS_EPS);
        v4f* o = (v4f*)(OUT + (size_t)m * DM) + lane;
#pragma unroll
        for (int j = 0; j < 8; ++j) o[64 * j] = v[j] * r * gv[j];
    }
}
__device__ __forceinline__ void norm_phase(const float* X, const float* g, bf16_t* XN, float* OUTF) {
    const int tid = mk_ltid(), lane = tid & 63, wave = tid >> 6;
    const int gw = mk_bid() * 8 + wave, NGW = mk_grid() * 8;
    v4f gv[8];
#pragma unroll
    for (int j = 0; j < 8; ++j) gv[j] = *((const v4f*)g + lane + 64 * j);
    for (int m = gw; m < MTOK; m += NGW) {
        const v4f* xr = (const v4f*)(X + (size_t)m * DM) + lane;
        v4f v[8]; float s = 0.f;
#pragma unroll
        for (int j = 0; j < 8; ++j) { v[j] = xr[64 * j]; s += (v[j].x * v[j].x + v[j].y * v[j].y) + (v[j].z * v[j].z + v[j].w * v[j].w); }
        const float r = 1.0f / sqrtf(wave_sum(s) * (1.f / DM) + RMS_EPS);
        if (OUTF) {
            v4f* o = (v4f*)(OUTF + (size_t)m * DM) + lane;
#pragma unroll
            for (int j = 0; j < 8; ++j) o[64 * j] = v[j] * r * gv[j];
        } else {
            v2u* o = (v2u*)(XN + (size_t)m * DM) + lane;
#pragma unroll
            for (int j = 0; j < 8; ++j) { const v4f y = v[j] * r * gv[j]; v2u w; w.x = pkbf(y.x, y.y); w.y = pkbf(y.z, y.w); o[64 * j] = w; }
        }
    }
}

constexpr int KTB = 64 * KP, VHB = 4096 + 64, VTB = 2 * VHB;
constexpr int ATT_K = 0, ATT_V = 3 * KTB, ATT_AUX = ATT_V + 3 * VTB, ATT_END = ATT_AUX + 3 * 64 * 4 + 128;
static_assert(ATT_END == 53504, "attention LDS map");

__device__ __forceinline__ void qk_tile(const LAS unsigned char* Kt, const v8s (&qf)[4], v16f& p0, v16f& p1, int r32, int hi) {
    const LAS unsigned char* kb = Kt + r32 * KP + hi * 16;
    v16f z;
#pragma unroll
    for (int r = 0; r < 16; ++r) z[r] = 0.f;
    p0 = z; p1 = z;
#pragma unroll
    for (int s = 0; s < 4; ++s) {
        const v8s a0 = *(const LAS v8s*)(kb + s * 32);
        const v8s a1 = *(const LAS v8s*)(kb + 32 * KP + s * 32);
        p0 = mfma32(a0, qf[s], p0); p1 = mfma32(a1, qf[s], p1);
    }
}
__device__ __forceinline__ v4s trrd(const LAS unsigned char* p) { return __builtin_bit_cast(v4s, __builtin_amdgcn_ds_read_tr16_b64_v4i16((LAS v4s*)p)); }
__device__ __forceinline__ void pv_tile(const LAS unsigned char* Vt, const v16f& p0, const v16f& p1, v16f (&oT)[2], int lane) {
    const int hi = lane >> 5;
    v4u w[4];
    w[0] = (v4u){pkbf(p0[0], p0[1]), pkbf(p0[2], p0[3]), pkbf(p0[4], p0[5]), pkbf(p0[6], p0[7])};
    w[1] = (v4u){pkbf(p0[8], p0[9]), pkbf(p0[10], p0[11]), pkbf(p0[12], p0[13]), pkbf(p0[14], p0[15])};
    w[2] = (v4u){pkbf(p1[0], p1[1]), pkbf(p1[2], p1[3]), pkbf(p1[4], p1[5]), pkbf(p1[6], p1[7])};
    w[3] = (v4u){pkbf(p1[8], p1[9]), pkbf(p1[10], p1[11]), pkbf(p1[12], p1[13]), pkbf(p1[14], p1[15])};
    const LAS unsigned char* vb = Vt + (4 * hi + ((lane & 15) >> 2)) * 64 + (16 * ((lane >> 4) & 1) + 4 * (lane & 3)) * 2;
#pragma unroll
    for (int dt = 0; dt < 2; ++dt)
#pragma unroll
        for (int ks = 0; ks < 4; ++ks) {
            const int kvb = 16 * (ks & 1) + 32 * (ks >> 1);
            const v4s lo = trrd(vb + dt * VHB + kvb * 64), h4 = trrd(vb + dt * VHB + (kvb + 8) * 64);
            const v8s af = (v8s){lo[0], lo[1], lo[2], lo[3], h4[0], h4[1], h4[2], h4[3]};
            oT[dt] = mfma32(af, __builtin_bit_cast(v8s, w[ks]), oT[dt]);
        }
}

__device__ __forceinline__ void k_load(const LAS unsigned char* Kt, v8s (&kf)[8], int r32, int hi) {
    const LAS unsigned char* kb = Kt + r32 * KP + hi * 16;
#pragma unroll
    for (int s = 0; s < 4; ++s) { kf[2 * s] = *(const LAS v8s*)(kb + s * 32); kf[2 * s + 1] = *(const LAS v8s*)(kb + 32 * KP + s * 32); }
}
__device__ __forceinline__ void qk_mma(const v8s (&kf)[8], const v8s (&qf)[4], v16f& p0, v16f& p1) {
    v16f z;
#pragma unroll
    for (int r = 0; r < 16; ++r) z[r] = 0.f;
    p0 = z; p1 = z;
#pragma unroll
    for (int s = 0; s < 4; ++s) { p0 = mfma32(kf[2 * s], qf[s], p0); p1 = mfma32(kf[2 * s + 1], qf[s], p1); }
}
__device__ __forceinline__ void v_load(const LAS unsigned char* Vt, v4s (&vf)[16], int lane) {
    const int hi = lane >> 5;
    const LAS unsigned char* vb = Vt + (4 * hi + ((lane & 15) >> 2)) * 64 + (16 * ((lane >> 4) & 1) + 4 * (lane & 3)) * 2;
#pragma unroll
    for (int ks = 0; ks < 4; ++ks)
#pragma unroll
        for (int dt = 0; dt < 2; ++dt) {
            const int kvb = 16 * (ks & 1) + 32 * (ks >> 1);
            vf[4 * ks + 2 * dt] = trrd(vb + dt * VHB + kvb * 64); vf[4 * ks + 2 * dt + 1] = trrd(vb + dt * VHB + (kvb + 8) * 64);
        }
}
__device__ __forceinline__ void pv_mma(const v4s (&vf)[16], const v16f& p0, const v16f& p1, v16f (&oT)[2]) {
    v4u w[4];
    w[0] = (v4u){pkbf(p0[0], p0[1]), pkbf(p0[2], p0[3]), pkbf(p0[4], p0[5]), pkbf(p0[6], p0[7])};
    w[1] = (v4u){pkbf(p0[8], p0[9]), pkbf(p0[10], p0[11]), pkbf(p0[12], p0[13]), pkbf(p0[14], p0[15])};
    w[2] = (v4u){pkbf(p1[0], p1[1]), pkbf(p1[2], p1[3]), pkbf(p1[4], p1[5]), pkbf(p1[6], p1[7])};
    w[3] = (v4u){pkbf(p1[8], p1[9]), pkbf(p1[10], p1[11]), pkbf(p1[12], p1[13]), pkbf(p1[14], p1[15])};
#pragma unroll
    for (int ks = 0; ks < 4; ++ks)
#pragma unroll
        for (int dt = 0; dt < 2; ++dt) {
            const v4s lo = vf[4 * ks + 2 * dt], h4 = vf[4 * ks + 2 * dt + 1];
            const v8s af = (v8s){lo[0], lo[1], lo[2], lo[3], h4[0], h4[1], h4[2], h4[3]};
            oT[dt] = mfma32(af, __builtin_bit_cast(v8s, w[ks]), oT[dt]);
        }
}
__device__ __forceinline__ float max3f(float a, float b, float c) { return __builtin_fmaxf(__builtin_fmaxf(a, b), c); }
__device__ __forceinline__ void softmax_step(v16f& p0, v16f& p1, v16f (&oT)[2], float& m, float& l, bool rowok) {
    float a = max3f(p0[0], p0[1], p1[0]), b = max3f(p0[2], p0[3], p1[1]); a = max3f(a, p1[2], p1[3]);
#pragma unroll
    for (int r = 4; r < 16; r += 4) { a = max3f(a, p0[r], p0[r + 1]); b = max3f(b, p0[r + 2], p0[r + 3]); a = max3f(a, p1[r], p1[r + 1]); b = max3f(b, p1[r + 2], p1[r + 3]); }
    float mx = fmaxf(a, b);
    mx = fmaxf(mx, __shfl_xor(mx, 32));
    if (!rowok) mx = -INFINITY;
    const float mn = fmaxf(m, mx);
    const float mu = (mn == -INFINITY) ? 0.f : mn;
    if (__any(mn > m)) {
        const float alpha = ex2(m - mu);
        oT[0] = oT[0] * alpha; oT[1] = oT[1] * alpha; l *= alpha;
    }
    const float mue = rowok ? mu : INFINITY;
    p0 = p0 - mue; p1 = p1 - mue;
#pragma unroll
    for (int r = 0; r < 16; ++r) { p0[r] = ex2(p0[r]); p1[r] = ex2(p1[r]); }
    const v16f s = p0 + p1;
    l += ((s[0] + s[1]) + (s[2] + s[3])) + ((s[4] + s[5]) + (s[6] + s[7])) + (((s[8] + s[9]) + (s[10] + s[11])) + ((s[12] + s[13]) + (s[14] + s[15])));
    m = mn;
}
__device__ __forceinline__ v4u ld_tile(const bf16_t* base, int row0, int pitch, int tid) { return *(const v4u*)(base + (size_t)(row0 + (tid >> 3)) * pitch + (tid & 7) * 8); }
__device__ __forceinline__ void st_k(LAS unsigned char* T, v4u v, int tid) { *(LAS v4u*)(T + (tid >> 3) * KP + (tid & 7) * 16) = v; }
__device__ __forceinline__ void st_v(LAS unsigned char* T, v4u v, int tid) { *(LAS v4u*)(T + ((tid >> 2) & 1) * VHB + (tid >> 3) * 64 + (tid & 3) * 16) = v; }
__device__ __forceinline__ void store_o(bf16_t* Orow, const v16f (&o)[2], int hi) {
#pragma unroll
    for (int dt = 0; dt < 2; ++dt)
#pragma unroll
        for (int g = 0; g < 4; ++g) { v2u w; w.x = pkbf(o[dt][4 * g], o[dt][4 * g + 1]); w.y = pkbf(o[dt][4 * g + 2], o[dt][4 * g + 3]);
            *(v2u*)(Orow + dt * 32 + 8 * g + 4 * hi) = w; }
}
__device__ __forceinline__ int rel_bucket(int n) {
    if (n < 16) return n;
    const float v = __log2f((float)n * (1.f / 16.f)) * (16.f / 6.f) + 1e-5f;
    const int b = 16 + (int)v; return b < 31 ? b : 31;
}

template <bool AUX, int VAR = 0, class Seq, class Sc>
__device__ __forceinline__ void attn_engine(LAS unsigned char* lds, const bf16_t* Kg, const bf16_t* Vg, int pitch, const float* auxg, Seq seq, const v8s (&qf)[4],
                                            v16f (&oT)[2], float& m, float& l, const Sc& sc, int tid, int lane) {
    const int r32 = lane & 31, hi = lane >> 5;
    int tc = seq.pop(); if (tc < 0) return;
    int tn = seq.pop(), tnn = (tn >= 0) ? seq.pop() : -1;
    LAS float* AUXL = (LAS float*)(lds + ATT_AUX);
    v4u kr = ld_tile(Kg, 64 * tc, pitch, tid), vr = ld_tile(Vg, 64 * tc, pitch, tid); float ar = 0.f;
    if (AUX && tid < 64) ar = auxg[64 * tc + tid];
    v4u kr2 = kr, vr2 = vr; float ar2 = 0.f;
    if (tn >= 0) { kr2 = ld_tile(Kg, 64 * tn, pitch, tid); vr2 = ld_tile(Vg, 64 * tn, pitch, tid); if (AUX && tid < 64) ar2 = auxg[64 * tn + tid]; }
    __syncthreads();
    st_k(lds + ATT_K, kr, tid); st_v(lds + ATT_V, vr, tid); if (AUX && tid < 64) AUXL[tid] = ar;
    if (tn >= 0) { st_k(lds + ATT_K + KTB, kr2, tid); st_v(lds + ATT_V + VTB, vr2, tid); if (AUX && tid < 64) AUXL[64 + tid] = ar2; }
    if (tnn >= 0) { kr = ld_tile(Kg, 64 * tnn, pitch, tid); vr = ld_tile(Vg, 64 * tnn, pitch, tid); if (AUX && tid < 64) ar = auxg[64 * tnn + tid]; }
    __syncthreads();
    v16f a0, a1, b0, b1;
    int bi = 0;
    if (sc.active(tc)) { qk_tile(lds + ATT_K, qf, a0, a1, r32, hi); sc.apply(a0, a1, tc, AUXL); }
#define ATT_STEP(C0, C1, N0, N1) { \
        __syncthreads(); \
        const int b2_ = (bi >= 1) ? bi - 1 : 2, b1_ = (bi == 2) ? 0 : bi + 1; int t3_ = -1; \
        if (tnn >= 0) { st_k(lds + ATT_K + b2_ * KTB, kr, tid); st_v(lds + ATT_V + b2_ * VTB, vr, tid); if (AUX && tid < 64) AUXL[b2_ * 64 + tid] = ar; \
            t3_ = seq.pop(); \
            if (t3_ >= 0 && VAR != 3) { kr = ld_tile(Kg, 64 * t3_, pitch, tid); vr = ld_tile(Vg, 64 * t3_, pitch, tid); if (AUX && tid < 64) ar = auxg[64 * t3_ + tid]; } } \
        const bool actn_ = (tn >= 0) && sc.active(tn), actc_ = sc.active(tc); \
        v8s kf_[8]; v4s vf_[16]; \
        if (actn_) { k_load(lds + ATT_K + b1_ * KTB, kf_, r32, hi); __builtin_amdgcn_sched_barrier(0); if (VAR != 2) qk_mma(kf_, qf, N0, N1); else { N0 = oT[0] + __builtin_bit_cast(v4f, kf_[0])[0]; N1 = oT[1] + __builtin_bit_cast(v4f, kf_[5])[1]; } } \
        __builtin_amdgcn_sched_barrier(0); \
        if (actc_) v_load(lds + ATT_V + bi * VTB, vf_, lane); \
        __builtin_amdgcn_sched_barrier(0); \
        if (actc_) { if (VAR != 1) softmax_step(C0, C1, oT, m, l, sc.rowok(tc)); if (VAR != 2) pv_mma(vf_, C0, C1, oT); else { oT[0] = oT[0] + C0 * __builtin_bit_cast(v2u, vf_[3])[0]; oT[1] = oT[1] + C1 * __builtin_bit_cast(v2u, vf_[9])[1]; } } \
        if (actn_) sc.apply(N0, N1, tn, AUXL + b1_ * 64); \
        tc = tn; tn = tnn; tnn = t3_; bi = b1_; \
        if (tc < 0) break; }
    for (;;) {
        ATT_STEP(a0, a1, b0, b1)
        ATT_STEP(b0, b1, a0, a1)
    }
#undef ATT_STEP
}
struct RangeSeq { int cur, last; __device__ __forceinline__ int pop() { const int t = cur; if (t > last) return -1; cur = t + 1; return t; } };
struct MaskSeq { unsigned long long rem; __device__ __forceinline__ int pop() { if (rem == 0ull) return -1; const int t = __builtin_ctzll(rem); rem &= rem - 1ull; return t; } };

__device__ __forceinline__ void cumsum_phase(LAS unsigned char* lds, const bf16_t* QKV, const float* fb, float* CL2) {
    const int tid = mk_ltid(), lane = tid & 63, wave = tid >> 6;
    LAS float* wtot = (LAS float*)lds;
    for (int u = mk_bid(); u < NB * 32; u += mk_grid()) {
        const int b = u >> 5, h = u & 31; const float bias = fb[h];
        float v[8]; float run = 0.f;
#pragma unroll
        for (int i = 0; i < 8; ++i) { const int t = tid * 8 + i; const float x = bf2f(QKV[(size_t)(b * SEQ + t) * ODD_PAD + O_F + h]) + bias;
            const float ls = fminf(x, 0.f) - log1pf(expf(-fabsf(x))); run += ls; v[i] = run; }
        float inc = run;
#pragma unroll
        for (int o = 1; o < 64; o <<= 1) { const float t = __shfl_up(inc, o); if (lane >= o) inc += t; }
        __syncthreads();
        if (lane == 63) wtot[wave] = inc;
        __syncthreads();
        float off = inc - run;
        for (int w2 = 0; w2 < wave; ++w2) off += wtot[w2];
        float* o = CL2 + (size_t)u * SEQ + tid * 8;
#pragma unroll
        for (int i = 0; i < 8; ++i) o[i] = (v[i] + off) * LOG2E;
    }
}

struct FoxSc {
    int qw0, qpos, hi;
    __device__ __forceinline__ bool active(int t) const { return 64 * t <= qw0 + 31; }
    __device__ __forceinline__ bool rowok(int) const { return true; }
    __device__ __forceinline__ void apply(v16f& p0, v16f& p1, int t, const LAS float* aux) const {
        const LAS float* kbp = aux + 4 * hi;
        v16f c0, c1;
#pragma unroll
        for (int g = 0; g < 4; ++g) {
            const v4f x0 = *(const LAS v4f*)(kbp + 8 * g), x1 = *(const LAS v4f*)(kbp + 32 + 8 * g);
#pragma unroll
            for (int e = 0; e < 4; ++e) { c0[4 * g + e] = x0[e]; c1[4 * g + e] = x1[e]; }
        }
        p0 = p0 * C1 - c0; p1 = p1 * C1 - c1;
        if (64 * t + 63 > qw0) {
#pragma unroll
            for (int r = 0; r < 16; ++r) { const int kv = 64 * t + crow(r, hi);
                if (kv > qpos) p0[r] = -INFINITY; if (kv + 32 > qpos) p1[r] = -INFINITY; }
        }
    }
};

template <int VAR = 0>
__device__ __forceinline__ void fox_phase(LAS unsigned char* lds, const bf16_t* QKV, const float* CL2, bf16_t* AO) {
    const int w = __builtin_amdgcn_readfirstlane(mk_ltid() >> 6);
    for (int j = mk_bid(); j < NB * 32 * 16; j += mk_grid()) {
        const int tid = mk_ltid(), lane = tid & 63, r32 = lane & 31, hi = lane >> 5;
        const int rr = j >> 7, bh = j & 127, i2 = rr >> 1; int sel = rr & 1; if (i2 & 1) sel ^= 1;
        const int qb = 15 - (2 * i2 + sel), b = bh >> 5, h = bh & 31;
        const int q0 = qb * 256, qw0 = q0 + 32 * w, qpos = qw0 + r32;
        const bf16_t* Qg = QKV + (size_t)(b * SEQ + qpos) * ODD_PAD + O_Q + h * 64 + hi * 8;
        v8s qf[4];
#pragma unroll
        for (int s = 0; s < 4; ++s) qf[s] = *(const v8s*)(Qg + s * 16);
        const bf16_t* Kg = QKV + (size_t)(b * SEQ) * ODD_PAD + O_K + h * 64;
        const bf16_t* Vg = QKV + (size_t)(b * SEQ) * ODD_PAD + O_V + h * 64;
        v16f oT[2];
#pragma unroll
        for (int r = 0; r < 16; ++r) { oT[0][r] = 0.f; oT[1][r] = 0.f; }
        float m = -INFINITY, l = 0.f;
        const FoxSc sc{qw0, qpos, hi};
        attn_engine<true, VAR>(lds, Kg, Vg, ODD_PAD, CL2 + (size_t)(b * 32 + h) * SEQ, RangeSeq{0, (q0 + 256) / 64 - 1}, qf, oT, m, l, sc, tid, lane);
        l += __shfl_xor(l, 32);
        const float inv = 1.f / l;
        oT[0] = oT[0] * inv; oT[1] = oT[1] * inv;
        store_o(AO + (size_t)(b * SEQ + qpos) * DM + h * 64, oT, hi);
    }
}

__device__ __forceinline__ void fox_scores(v16f& p0, v16f& p1, const v16f& c0, const v16f& c1, bool diag, int t, int qpos, int hi) {
    p0 = p0 * C1 - c0; p1 = p1 * C1 - c1;
    if (diag) {
#pragma unroll
        for (int r = 0; r < 16; ++r) { const int kv = 64 * t + crow(r, hi); if (kv > qpos) p0[r] = -INFINITY; if (kv + 32 > qpos) p1[r] = -INFINITY; }
    }
}
__device__ __forceinline__ void fox2_phase(LAS unsigned char* lds, const bf16_t* QKV, const float* CL2, bf16_t* AO) {
    const int w = __builtin_amdgcn_readfirstlane(mk_ltid() >> 6);
    LAS float* AUXL = (LAS float*)(lds + ATT_AUX);
    for (int j = mk_bid(); j < NB * 32 * 8; j += mk_grid()) {
        const int tid = mk_ltid(), lane = tid & 63, r32 = lane & 31, hi = lane >> 5;
        const int rr = j >> 7, bh = j & 127, i2 = rr >> 1; int sel = rr & 1; if (i2 & 1) sel ^= 1;
        const int qb = 7 - (2 * i2 + sel), b = bh >> 5, h = bh & 31;
        const int q0 = qb * 512, qw0 = q0 + 64 * w, qposA = qw0 + r32, qposB = qposA + 32;
        const bf16_t* Qg = QKV + (size_t)(b * SEQ + qposA) * ODD_PAD + O_Q + h * 64 + hi * 8;
        v8s qa[4], qb_[4];
#pragma unroll
        for (int s = 0; s < 4; ++s) { qa[s] = *(const v8s*)(Qg + s * 16); qb_[s] = *(const v8s*)(Qg + (size_t)32 * ODD_PAD + s * 16); }
        const bf16_t* Kg = QKV + (size_t)(b * SEQ) * ODD_PAD + O_K + h * 64;
        const bf16_t* Vg = QKV + (size_t)(b * SEQ) * ODD_PAD + O_V + h * 64;
        const float* cl = CL2 + (size_t)(b * 32 + h) * SEQ;
        const int nt = (q0 + 512) / 64, tw = qw0 >> 6;
        v16f oA[2], oB[2];
#pragma unroll
        for (int r = 0; r < 16; ++r) { oA[0][r] = 0.f; oA[1][r] = 0.f; oB[0][r] = 0.f; oB[1][r] = 0.f; }
        float mA = -INFINITY, lA = 0.f, mB = -INFINITY, lB = 0.f;
        v4u kr = ld_tile(Kg, 0, ODD_PAD, tid), vr = ld_tile(Vg, 0, ODD_PAD, tid); float ar = (tid < 64) ? cl[tid] : 0.f;
        v4u kr2 = ld_tile(Kg, 64, ODD_PAD, tid), vr2 = ld_tile(Vg, 64, ODD_PAD, tid); float ar2 = (tid < 64) ? cl[64 + tid] : 0.f;
        __syncthreads();
        st_k(lds + ATT_K, kr, tid); st_v(lds + ATT_V, vr, tid); if (tid < 64) AUXL[tid] = ar;
        st_k(lds + ATT_K + KTB, kr2, tid); st_v(lds + ATT_V + VTB, vr2, tid); if (tid < 64) AUXL[64 + tid] = ar2;
        kr = ld_tile(Kg, 128, ODD_PAD, tid); vr = ld_tile(Vg, 128, ODD_PAD, tid); if (tid < 64) ar = cl[128 + tid];
        int bi = 0;
#pragma unroll 1
        for (int t = 0; t < nt; ++t) {
            __syncthreads();
            const int b2 = (bi >= 1) ? bi - 1 : 2;
            if (t + 2 < nt) { st_k(lds + ATT_K + b2 * KTB, kr, tid); st_v(lds + ATT_V + b2 * VTB, vr, tid); if (tid < 64) AUXL[b2 * 64 + tid] = ar;
                if (t + 3 < nt) { kr = ld_tile(Kg, 64 * (t + 3), ODD_PAD, tid); vr = ld_tile(Vg, 64 * (t + 3), ODD_PAD, tid); if (tid < 64) ar = cl[64 * (t + 3) + tid]; } }
            if (t <= tw) {
                const bool diag = (t == tw);
                v16f a0, a1, b0, b1;
                { v8s kf[8]; k_load(lds + ATT_K + bi * KTB, kf, r32, hi); qk_mma(kf, qa, a0, a1); qk_mma(kf, qb_, b0, b1); }
                { v16f c0, c1; const LAS float* kbp = AUXL + bi * 64 + 4 * hi;
#pragma unroll
                  for (int g = 0; g < 4; ++g) { const v4f x0 = *(const LAS v4f*)(kbp + 8 * g), x1 = *(const LAS v4f*)(kbp + 32 + 8 * g);
#pragma unroll
                      for (int e = 0; e < 4; ++e) { c0[4 * g + e] = x0[e]; c1[4 * g + e] = x1[e]; } }
                  fox_scores(a0, a1, c0, c1, diag, t, qposA, hi); fox_scores(b0, b1, c0, c1, diag, t, qposB, hi); }
#ifdef FOX2_VPRE
                { v4s vf[16]; v_load(lds + ATT_V + bi * VTB, vf, lane); __builtin_amdgcn_sched_barrier(0);
                  softmax_step(a0, a1, oA, mA, lA, true); softmax_step(b0, b1, oB, mB, lB, true);
                  pv_mma(vf, a0, a1, oA); pv_mma(vf, b0, b1, oB); }
#else
                softmax_step(a0, a1, oA, mA, lA, true); softmax_step(b0, b1, oB, mB, lB, true);
                { v4s vf[16]; v_load(lds + ATT_V + bi * VTB, vf, lane); pv_mma(vf, a0, a1, oA); pv_mma(vf, b0, b1, oB); }
#endif
            }
            bi = (bi == 2) ? 0 : bi + 1;
        }
        lA += __shfl_xor(lA, 32); lB += __shfl_xor(lB, 32);
        const float ia = 1.f / lA, ib = 1.f / lB;
        oA[0] = oA[0] * ia; oA[1] = oA[1] * ia; oB[0] = oB[0] * ib; oB[1] = oB[1] * ib;
        store_o(AO + (size_t)(b * SEQ + qposA) * DM + h * 64, oA, hi);
        store_o(AO + (size_t)(b * SEQ + qposB) * DM + h * 64, oB, hi);
    }
}


__device__ __forceinline__ float gelu_tanh(float x) {
    const float u = 0.7978845608028654f * (x + 0.044715f * x * x * x);
    const float t = 1.f - 2.f / (1.f + __expf(2.f * u));
    return 0.5f * x * (1.f + t);
}
__device__ __forceinline__ void compress_unit(LAS unsigned char* lds, int u, const bf16_t* QKV, const float* pe_k, const float* pe_v,
                                              const bf16_t* CW1  , const bf16_t* CW2  , bf16_t* KCMP, bf16_t* VCMP) {
    const int tid = mk_ltid(), lane = tid & 63, w = __builtin_amdgcn_readfirstlane(tid >> 6), r32 = lane & 31, hi = lane >> 5;
    const int kv = u >> 6, b = (u >> 4) & 3, g = (u >> 3) & 1, ch = u & 7;
    const float* pe = kv ? pe_v : pe_k;
    const bf16_t* W1 = CW1 + (size_t)kv * 256 * 2048; const bf16_t* W2 = CW2 + (size_t)kv * 64 * 256;
    bf16_t* OUT = (kv ? VCMP : KCMP) + (size_t)((b * 2 + g) * 256 + ch * 32) * 64;
    const int n = ch * 32 + r32;
    const bf16_t* Ag = QKV + (size_t)(b * SEQ + 16 * n) * EVEN_PAD + (kv ? E_VC : E_KC) + g * 64 + hi * 8;
    const bf16_t* Bg = W1 + (size_t)(32 * w + r32) * 2048 + hi * 8;
    LAS bf16_t* HID = (LAS bf16_t*)lds;
    LAS float* PE = (LAS float*)(lds + 20480);
    v16f acc;
#pragma unroll
    for (int r = 0; r < 16; ++r) acc[r] = 0.f;
    __syncthreads();
    *(LAS v4f*)(PE + tid * 4) = *(const v4f*)(pe + tid * 4);
    __syncthreads();
#pragma unroll 8
    for (int st = 0; st < 128; ++st) {
        const int li = st >> 2, d0 = (st & 3) * 16;
        const v4u ar = *(const v4u*)(Ag + (size_t)li * EVEN_PAD + d0);
        const v4f pa = *(const LAS v4f*)(PE + li * 64 + d0 + hi * 8), pb = *(const LAS v4f*)(PE + li * 64 + d0 + hi * 8 + 4);
        const v8s bfr = *(const v8s*)(Bg + st * 16);
        v4u aw;
        aw.x = pkbf(__uint_as_float(ar.x << 16) + pa.x, __uint_as_float(ar.x & 0xffff0000u) + pa.y);
        aw.y = pkbf(__uint_as_float(ar.y << 16) + pa.z, __uint_as_float(ar.y & 0xffff0000u) + pa.w);
        aw.z = pkbf(__uint_as_float(ar.z << 16) + pb.x, __uint_as_float(ar.z & 0xffff0000u) + pb.y);
        aw.w = pkbf(__uint_as_float(ar.w << 16) + pb.z, __uint_as_float(ar.w & 0xffff0000u) + pb.w);
        acc = mfma32(__builtin_bit_cast(v8s, aw), bfr, acc);
    }
#pragma unroll
    for (int r = 0; r < 16; ++r) HID[crow(r, hi) * 264 + 32 * w + r32] = (bf16_t)(pkbf(gelu_tanh(acc[r]), 0.f) & 0xffffu);
    __syncthreads();
    if (w < 2) {
        v16f o;
#pragma unroll
        for (int r = 0; r < 16; ++r) o[r] = 0.f;
        const bf16_t* B2 = W2 + (size_t)(32 * w + r32) * 256 + hi * 8;
#pragma unroll
        for (int st = 0; st < 16; ++st) {
            const v8s af = *(const LAS v8s*)(HID + r32 * 264 + st * 16 + hi * 8);
            const v8s bfr = *(const v8s*)(B2 + st * 16);
            o = mfma32(af, bfr, o);
        }
#pragma unroll
        for (int r = 0; r < 16; ++r) { const int nl = crow(r, hi); const bool valid = (ch * 32 + nl) < 255;
            OUT[(size_t)nl * 64 + 32 * w + r32] = valid ? (bf16_t)(pkbf(o[r], 0.f) & 0xffffu) : (bf16_t)0; }
    }
}

template <int NEGPAD>
struct TabSc {
    const LAS float* tb;
    int qpos, hi;
    __device__ __forceinline__ void apply_tab(v16f& p0, v16f& p1, int t) const {
        const LAS float* bp = tb + (NEGPAD + qpos - 64 * t - 63 - 4 * hi);
        v16f c0, c1;
#pragma unroll
        for (int r = 0; r < 16; ++r) { c0[r] = bp[63 - ((r & 3) + 8 * (r >> 2))]; c1[r] = bp[31 - ((r & 3) + 8 * (r >> 2))]; }
        p0 = p0 * C1 + c0; p1 = p1 * C1 + c1;
    }
};
struct SwaSc : TabSc<64> {
    int qw0;
    __device__ __forceinline__ bool active(int t) const { return 64 * t + 63 >= qw0 - 127 && 64 * t <= qw0 + 31; }
    __device__ __forceinline__ bool rowok(int) const { return true; }
    __device__ __forceinline__ void apply(v16f& p0, v16f& p1, int t, const LAS float*) const { apply_tab(p0, p1, t); }
};

__device__ __forceinline__ void swa_unit(LAS unsigned char* lds, int u, const bf16_t* QKV, const float* relb, const float* sinks, bf16_t* AO) {
    const int tid = mk_ltid(), lane = tid & 63, w = __builtin_amdgcn_readfirstlane(tid >> 6), r32 = lane & 31, hi = lane >> 5;
    LAS float* TB = (LAS float*)(lds + ATT_END);
    const int qblk = u >> 4, b = (u >> 2) & 3, g = u & 3;
    const int hq = 4 * g + (w >> 1), q0 = 64 * qblk, qw0 = q0 + 32 * (w & 1), qpos = qw0 + r32;
    __syncthreads();
    for (int i = tid; i < 1024; i += 512) { const int hh = i >> 8, d = (i & 255) - 64; TB[i] = (d >= 0 && d < 128) ? relb[rel_bucket(d) * 32 + 4 * g + hh] * LOG2E : -INFINITY; }
    const bf16_t* Qg = QKV + (size_t)(b * SEQ + qpos) * EVEN_PAD + E_QA + hq * 64 + hi * 8;
    v8s qf[4];
#pragma unroll
    for (int s = 0; s < 4; ++s) qf[s] = *(const v8s*)(Qg + s * 16);
    const bf16_t* Kg = QKV + (size_t)(b * SEQ) * EVEN_PAD + E_KA + g * 64;
    const bf16_t* Vg = QKV + (size_t)(b * SEQ) * EVEN_PAD + E_VA + g * 64;
    v16f oT[2];
#pragma unroll
    for (int r = 0; r < 16; ++r) { oT[0][r] = 0.f; oT[1][r] = 0.f; }
    float m = -INFINITY, l = 0.f;
    SwaSc sc; sc.tb = TB + (w >> 1) * 256; sc.qpos = qpos; sc.hi = hi; sc.qw0 = qw0;
    attn_engine<false>(lds, Kg, Vg, EVEN_PAD, nullptr, RangeSeq{(qblk >= 2) ? qblk - 2 : 0, qblk}, qf, oT, m, l, sc, tid, lane);
    l += __shfl_xor(l, 32);
    const float sk = sinks[hq] * LOG2E;
    const float mf = fmaxf(m, sk);
    const float a = ex2(m - mf);
    const float inv = a / (l * a + ex2(sk - mf));
    oT[0] = oT[0] * inv; oT[1] = oT[1] * inv;
    store_o(AO + (size_t)(b * SEQ + qpos) * DM + hq * 64, oT, hi);
}

__device__ __forceinline__ void evenA_phase(LAS unsigned char* lds, const bf16_t* QKV, const float* relb, const float* sinks, const float* pe_k, const float* pe_v,
                                            const bf16_t* CW1, const bf16_t* CW2, bf16_t* KCMP, bf16_t* VCMP, bf16_t* AO) {
    for (int u = mk_bid(); u < 128 + 1024; u += mk_grid()) {
        if (u < 128) compress_unit(lds, u, QKV, pe_k, pe_v, CW1, CW2, KCMP, VCMP);
        else swa_unit(lds, u - 128, QKV, relb, sinks, AO);
    }
}

constexpr int NSA_TS = 1184, NSA_TW = 704;
constexpr int NSA_OFF_TS = ATT_END, NSA_OFF_TW = NSA_OFF_TS + 8 * NSA_TS * 4, NSA_OFF_IMP = NSA_OFF_TW + 8 * NSA_TW * 4, NSA_OFF_SEL = NSA_OFF_IMP + 32 * 64 * 4, NSA_OFF_UNI = NSA_OFF_SEL + 32 * 8;
static_assert(NSA_OFF_UNI + 64 <= LDS_BYTES, "NSA LDS map");

struct NsaSelSc : TabSc<64> {
    int q0; unsigned mlo, mhi;
    __device__ __forceinline__ bool active(int) const { return true; }
    __device__ __forceinline__ bool rowok(int t) const { return ((t < 32 ? (mlo >> t) : (mhi >> (t - 32))) & 1u) != 0u; }
    __device__ __forceinline__ void apply(v16f& p0, v16f& p1, int t, const LAS float*) const {
        if (q0 - (64 * t + 63) >= 1024) { const float b31 = tb[64 + 1024]; p0 = p0 * C1 + b31; p1 = p1 * C1 + b31; }
        else apply_tab(p0, p1, t);
    }
};
struct NsaWinSc : TabSc<64> {
    __device__ __forceinline__ bool active(int) const { return true; }
    __device__ __forceinline__ bool rowok(int) const { return true; }
    __device__ __forceinline__ void apply(v16f& p0, v16f& p1, int t, const LAS float*) const { apply_tab(p0, p1, t); }
};

__device__ __forceinline__ void nsa_phase(LAS unsigned char* lds, const bf16_t* QKV, const float* relb, const bf16_t* KCMP, const bf16_t* VCMP, bf16_t* AO, float* SCRG) {
    const int w = __builtin_amdgcn_readfirstlane(mk_ltid() >> 6);
    LAS unsigned char* KT = lds + ATT_K; LAS unsigned char* VT = lds + ATT_V;
    LAS float* TS = (LAS float*)(lds + NSA_OFF_TS); LAS float* TW = (LAS float*)(lds + NSA_OFF_TW); LAS unsigned* IMP = (LAS unsigned*)(lds + NSA_OFF_IMP);
    LAS unsigned* SEL = (LAS unsigned*)(lds + NSA_OFF_SEL); LAS unsigned* UNI = (LAS unsigned*)(lds + NSA_OFF_UNI);
    int cur_g = -1;
#define NSA_GATE(i) (1.f / (1.f + __expf(-bf2f(QKV[(size_t)(b * SEQ + qpos) * EVEN_PAD + E_GT + hq * 3 + (i)]))))
    for (int u = mk_bid(); u < 1024; u += mk_grid()) {
        const int qblk = 127 - (u >> 3), b = (u >> 1) & 3, g = u & 1;
        const int hq = 8 * g + w, q0 = 32 * qblk, bg = b * 2 + g;
        v8s qf[4]; v16f oT[2];
        float* SCR = SCRG + (size_t)mk_bid() * (512 * 32);
        {
            const int tid = mk_ltid(), lane = tid & 63, r32 = lane & 31, hi = lane >> 5, qpos = q0 + r32;
            __syncthreads();
            if (g != cur_g) { cur_g = g;
                for (int i = tid; i < 8 * NSA_TS; i += 512) { const int hh = i / NSA_TS, d = i - hh * NSA_TS - 64;
                    TS[i] = (d >= 0) ? relb[rel_bucket(d < 1024 ? d : 1024) * 32 + 16 + 8 * g + hh] * LOG2E : -INFINITY; }
                for (int i = tid; i < 8 * NSA_TW; i += 512) { const int hh = i / NSA_TW, d = i - hh * NSA_TW - 64;
                    TW[i] = (d >= 0 && d < 512) ? relb[rel_bucket(d) * 32 + 16 + 8 * g + hh] * LOG2E : -INFINITY; } }
            for (int i = tid; i < 32 * 64; i += 512) IMP[i] = 0u;
            if (tid < 2) UNI[tid] = 0u;
            const bf16_t* Qrow = QKV + (size_t)(b * SEQ + qpos) * EVEN_PAD;
#pragma unroll
            for (int s = 0; s < 4; ++s) qf[s] = *(const v8s*)(Qrow + E_QB + hq * 64 + hi * 8 + s * 16);
        }
        const bf16_t* Kc = KCMP + (size_t)bg * 256 * 64; const bf16_t* Vc = VCMP + (size_t)bg * 256 * 64;
        const int nct = (2 * qblk) / 64 + 1;
        float m = -INFINITY, l = 0.f;
        {
            const int tid = mk_ltid(), lane = tid & 63, r32 = lane & 31, hi = lane >> 5, qpos = q0 + r32; const LAS float* tb = TS + w * NSA_TS + 64;
            v4u kr = ld_tile(Kc, 0, 64, tid);
            for (int t = 0; t < nct; ++t) {
                const int buf = t & 1;
                st_k(KT + buf * KTB, kr, tid);
                __syncthreads();
                if (t + 1 < nct) kr = ld_tile(Kc, 64 * (t + 1), 64, tid);
                v16f p0, p1;
                qk_tile(KT + buf * KTB, qf, p0, p1, r32, hi);
                float mx = -INFINITY;
#pragma unroll
                for (int r = 0; r < 16; ++r) {
                    const int c0 = 64 * t + crow(r, hi); const int d0 = qpos - 16 * c0 - 31, d1 = d0 - 512;
                    p0[r] = p0[r] * C1 + tb[min(max(d0, -1), 1024)]; p1[r] = p1[r] * C1 + tb[min(max(d1, -1), 1024)];
                    mx = fmaxf(mx, fmaxf(p0[r], p1[r]));
                }
                mx = fmaxf(mx, __shfl_xor(mx, 32));
                const float mn = fmaxf(m, mx), mu = (mn == -INFINITY) ? 0.f : mn;
                float rs = 0.f;
#pragma unroll
                for (int r = 0; r < 16; ++r) rs += ex2(p0[r] - mu) + ex2(p1[r] - mu);
                l = l * ex2(m - mu) + rs; m = mn;
            }
        }
        l += __shfl_xor(l, 32);
        {
            const int tid = mk_ltid(), lane = tid & 63, r32 = lane & 31, hi = lane >> 5, qpos = q0 + r32; const LAS float* tb = TS + w * NSA_TS + 64;
            const float mu = (m == -INFINITY) ? 0.f : m, il = (l > 0.f) ? 1.f / l : 0.f;
            const float gt0 = NSA_GATE(0);
#pragma unroll
            for (int r = 0; r < 16; ++r) { oT[0][r] = 0.f; oT[1][r] = 0.f; }
            __syncthreads();
            v4u kr = ld_tile(Kc, 0, 64, tid), vr = ld_tile(Vc, 0, 64, tid);
            for (int t = 0; t < nct; ++t) {
                const int buf = t & 1;
                st_k(KT + buf * KTB, kr, tid); st_v(VT + buf * VTB, vr, tid);
                __syncthreads();
                if (t + 1 < nct) { kr = ld_tile(Kc, 64 * (t + 1), 64, tid); vr = ld_tile(Vc, 64 * (t + 1), 64, tid); }
                v16f p0, p1;
                qk_tile(KT + buf * KTB, qf, p0, p1, r32, hi);
#pragma unroll
                for (int r = 0; r < 16; ++r) {
                    const int c0 = 64 * t + crow(r, hi); const int d0 = qpos - 16 * c0 - 31, d1 = d0 - 512;
                    p0[r] = ex2(p0[r] * C1 + tb[min(max(d0, -1), 1024)] - mu) * il; p1[r] = ex2(p1[r] * C1 + tb[min(max(d1, -1), 1024)] - mu) * il;
                }
#pragma unroll
                for (int gq = 0; gq < 4; ++gq) {
                    const int sb0 = 16 * t + 2 * gq + hi, sb1 = sb0 + 8;
                    const unsigned a0 = (unsigned)(((p0[4 * gq] + p0[4 * gq + 1]) + (p0[4 * gq + 2] + p0[4 * gq + 3])) * 4194304.f + 0.5f);
                    const unsigned a1 = (unsigned)(((p1[4 * gq] + p1[4 * gq + 1]) + (p1[4 * gq + 2] + p1[4 * gq + 3])) * 4194304.f + 0.5f);
                    const unsigned e0 = (unsigned)(p0[4 * gq + 3] * 4194304.f + 0.5f), e1 = (unsigned)(p1[4 * gq + 3] * 4194304.f + 0.5f);
                    lds_add(IMP + r32 * 64 + sb0, a0); lds_add(IMP + r32 * 64 + sb1, a1);
                    lds_add(IMP + r32 * 64 + sb0 + 1, e0); if (sb1 + 1 < 64) lds_add(IMP + r32 * 64 + sb1 + 1, e1);
                }
                p0 = p0 * gt0; p1 = p1 * gt0;
                pv_tile(VT + buf * VTB, p0, p1, oT, lane);
            }
#pragma unroll
            for (int r = 0; r < 16; ++r) { SCR[r * 512 + tid] = oT[0][r]; SCR[(16 + r) * 512 + tid] = oT[1][r]; }
        }
        __syncthreads();
#pragma unroll 1
        for (int i = 0; i < 4; ++i) {
            const int lane = mk_ltid() & 63;
            const int qi = 4 * w + i, qp = q0 + qi, cur = qp >> 6;
            const unsigned v = IMP[qi * 64 + lane];
            const bool fut = lane > cur, forced = (lane == 0) || (lane == cur) || (lane == cur - 1);
            const unsigned key = ((fut ? 0u : (forced ? 0x3ffffffu : min(v + 1u, 0x3fffffeu))) << 6) | (unsigned)(63 - lane);
            int cnt = 0;
#pragma unroll
            for (int jj = 0; jj < 64; ++jj) { const unsigned kj = (unsigned)__builtin_amdgcn_readlane((int)key, jj); cnt += (kj > key) ? 1 : 0; }
            const unsigned long long msk = __ballot(!fut && cnt < 16);
            if (lane == 0) { SEL[2 * qi] = (unsigned)msk; SEL[2 * qi + 1] = (unsigned)(msk >> 32); lds_or(UNI, (unsigned)msk); lds_or(UNI + 1, (unsigned)(msk >> 32)); }
        }
        __syncthreads();
        {
            const int tid = mk_ltid(), lane = tid & 63, r32 = lane & 31, hi = lane >> 5, qpos = q0 + r32;
            const unsigned long long uni = ((unsigned long long)(unsigned)__builtin_amdgcn_readfirstlane((int)UNI[1]) << 32) | (unsigned)__builtin_amdgcn_readfirstlane((int)UNI[0]);
            const bf16_t* Kg = QKV + (size_t)(b * SEQ) * EVEN_PAD + E_KS + g * 64; const bf16_t* Vg = QKV + (size_t)(b * SEQ) * EVEN_PAD + E_VS + g * 64;
#pragma unroll
            for (int r = 0; r < 16; ++r) { oT[0][r] = 0.f; oT[1][r] = 0.f; }
            m = -INFINITY; l = 0.f;
            NsaSelSc sc; sc.tb = TS + w * NSA_TS; sc.qpos = qpos; sc.hi = hi; sc.q0 = q0; sc.mlo = SEL[2 * r32]; sc.mhi = SEL[2 * r32 + 1];
            attn_engine<false>(lds, Kg, Vg, EVEN_PAD, nullptr, MaskSeq{uni}, qf, oT, m, l, sc, tid, lane);
            l += __shfl_xor(l, 32);
            const float scl = (l > 0.f) ? NSA_GATE(1) / l : 0.f;
#pragma unroll
            for (int r = 0; r < 16; ++r) { SCR[r * 512 + tid] += oT[0][r] * scl; SCR[(16 + r) * 512 + tid] += oT[1][r] * scl; }
        }
        {
            const int tid = mk_ltid(), lane = tid & 63, r32 = lane & 31, hi = lane >> 5, qpos = q0 + r32;
            const bf16_t* Kg = QKV + (size_t)(b * SEQ) * EVEN_PAD + E_KW + g * 64; const bf16_t* Vg = QKV + (size_t)(b * SEQ) * EVEN_PAD + E_VW + g * 64;
#pragma unroll
            for (int r = 0; r < 16; ++r) { oT[0][r] = 0.f; oT[1][r] = 0.f; }
            m = -INFINITY; l = 0.f;
            NsaWinSc sc; sc.tb = TW + w * NSA_TW; sc.qpos = qpos; sc.hi = hi;
            attn_engine<false>(lds, Kg, Vg, EVEN_PAD, nullptr, RangeSeq{(q0 >= 511) ? ((q0 - 511) >> 6) : 0, (q0 + 31) >> 6}, qf, oT, m, l, sc, tid, lane);
            l += __shfl_xor(l, 32);
            const float scl = (l > 0.f) ? NSA_GATE(2) / l : 0.f;
#pragma unroll
            for (int r = 0; r < 16; ++r) { oT[0][r] = SCR[r * 512 + tid] + oT[0][r] * scl; oT[1][r] = SCR[(16 + r) * 512 + tid] + oT[1][r] * scl; }
            store_o(AO + (size_t)(b * SEQ + qpos) * DM + 1024 + hq * 64, oT, hi);
        }
    }
}

constexpr int N2_TS = 1216, N2_TW = 704;
constexpr int N2_OFF_TS = ATT_END, N2_OFF_TW = N2_OFF_TS + 8 * N2_TS * 4, N2_OFF_IMP = N2_OFF_TW + 8 * N2_TW * 4, N2_OFF_SEL = N2_OFF_IMP + 64 * 64 * 4, N2_OFF_UNI = N2_OFF_SEL + 64 * 8;
static_assert(N2_OFF_UNI + 64 <= LDS_BYTES - 64, "NSA2 LDS map");


__device__ __forceinline__ void k_load_half(const LAS unsigned char* Kt, int half, v8s (&kf)[4], int r32, int hi) {
    const LAS unsigned char* kb = Kt + (32 * half + r32) * KP + hi * 16;
#pragma unroll
    for (int s = 0; s < 4; ++s) kf[s] = *(const LAS v8s*)(kb + s * 32);
}
__device__ __forceinline__ void qk_half(const v8s (&kf)[4], const v8s (&qf)[4], v16f& p) {
#pragma unroll
    for (int s = 0; s < 4; ++s) p = mfma32(kf[s], qf[s], p);
}
__device__ __forceinline__ v8s scale_q(v8s q) {
    v4u u = __builtin_bit_cast(v4u, q), o;
    o.x = pkbf(__uint_as_float(u.x << 16) * C1, __uint_as_float(u.x & 0xffff0000u) * C1); o.y = pkbf(__uint_as_float(u.y << 16) * C1, __uint_as_float(u.y & 0xffff0000u) * C1);
    o.z = pkbf(__uint_as_float(u.z << 16) * C1, __uint_as_float(u.z & 0xffff0000u) * C1); o.w = pkbf(__uint_as_float(u.w << 16) * C1, __uint_as_float(u.w & 0xffff0000u) * C1);
    return __builtin_bit_cast(v8s, o);
}
__device__ __forceinline__ void v_load_half(const LAS unsigned char* Vt, int dt, v4s (&vf)[8], int lane) {
    const int hi = lane >> 5;
    const LAS unsigned char* vb = Vt + dt * VHB + (4 * hi + ((lane & 15) >> 2)) * 64 + (16 * ((lane >> 4) & 1) + 4 * (lane & 3)) * 2;
#pragma unroll
    for (int ks = 0; ks < 4; ++ks) { const int kvb = 16 * (ks & 1) + 32 * (ks >> 1); vf[2 * ks] = trrd(vb + kvb * 64); vf[2 * ks + 1] = trrd(vb + (kvb + 8) * 64); }
}
__device__ __forceinline__ void pv_half(const v4s (&vf)[8], const v4u (&w)[4], v16f& o) {
#pragma unroll
    for (int ks = 0; ks < 4; ++ks) { const v4s lo = vf[2 * ks], h4 = vf[2 * ks + 1];
        const v8s af = (v8s){lo[0], lo[1], lo[2], lo[3], h4[0], h4[1], h4[2], h4[3]};
        o = mfma32(af, __builtin_bit_cast(v8s, w[ks]), o); }
}
__device__ __forceinline__ void pack_p2(const v16f& p0, const v16f& p1, v4u (&w)[4]) {
    w[0] = (v4u){pkbf(p0[0], p0[1]), pkbf(p0[2], p0[3]), pkbf(p0[4], p0[5]), pkbf(p0[6], p0[7])};
    w[1] = (v4u){pkbf(p0[8], p0[9]), pkbf(p0[10], p0[11]), pkbf(p0[12], p0[13]), pkbf(p0[14], p0[15])};
    w[2] = (v4u){pkbf(p1[0], p1[1]), pkbf(p1[2], p1[3]), pkbf(p1[4], p1[5]), pkbf(p1[6], p1[7])};
    w[3] = (v4u){pkbf(p1[8], p1[9]), pkbf(p1[10], p1[11]), pkbf(p1[12], p1[13]), pkbf(p1[14], p1[15])};
}

__device__ __forceinline__ void softmax_half(v16f& p, v16f (&oT)[2], float& m, float& l, bool rowok) {
    float a = max3f(p[0], p[1], p[2]), b = max3f(p[3], p[4], p[5]);
    a = max3f(a, p[6], p[7]); b = max3f(b, p[8], p[9]); a = max3f(a, p[10], p[11]); b = max3f(b, p[12], p[13]); a = max3f(a, p[14], p[15]);
    float mx = fmaxf(a, b);
    mx = fmaxf(mx, __shfl_xor(mx, 32));
    if (!rowok) mx = -INFINITY;
    const float mn = fmaxf(m, mx);
    const float mu = (mn == -INFINITY) ? 0.f : mn;
    if (__any(mn > m)) { const float alpha = ex2(m - mu); oT[0] = oT[0] * alpha; oT[1] = oT[1] * alpha; l *= alpha; }
    const float mue = rowok ? mu : INFINITY;
    p = p - mue;
#pragma unroll
    for (int r = 0; r < 16; ++r) p[r] = ex2(p[r]);
    l += ((p[0] + p[1]) + (p[2] + p[3])) + ((p[4] + p[5]) + (p[6] + p[7])) + (((p[8] + p[9]) + (p[10] + p[11])) + ((p[12] + p[13]) + (p[14] + p[15])));
    m = mn;
}
__device__ __forceinline__ void v_load_khalf(const LAS unsigned char* Vt, int h, v4s (&vf)[8], int lane) {
    const int hi = lane >> 5;
    const LAS unsigned char* vb = Vt + (32 * h + 4 * hi + ((lane & 15) >> 2)) * 64 + (16 * ((lane >> 4) & 1) + 4 * (lane & 3)) * 2;
#pragma unroll
    for (int ksl = 0; ksl < 2; ++ksl)
#pragma unroll
        for (int dt = 0; dt < 2; ++dt) { vf[(ksl * 2 + dt) * 2] = trrd(vb + dt * VHB + (16 * ksl) * 64); vf[(ksl * 2 + dt) * 2 + 1] = trrd(vb + dt * VHB + (16 * ksl + 8) * 64); }
}
__device__ __forceinline__ void pv_khalf(const v4s (&vf)[8], const v16f& p, v16f (&oT)[2]) {
    v4u w[2];
    w[0] = (v4u){pkbf(p[0], p[1]), pkbf(p[2], p[3]), pkbf(p[4], p[5]), pkbf(p[6], p[7])};
    w[1] = (v4u){pkbf(p[8], p[9]), pkbf(p[10], p[11]), pkbf(p[12], p[13]), pkbf(p[14], p[15])};
#pragma unroll
    for (int ksl = 0; ksl < 2; ++ksl)
#pragma unroll
        for (int dt = 0; dt < 2; ++dt) { const v4s lo = vf[(ksl * 2 + dt) * 2], h4 = vf[(ksl * 2 + dt) * 2 + 1];
            const v8s af = (v8s){lo[0], lo[1], lo[2], lo[3], h4[0], h4[1], h4[2], h4[3]};
            oT[dt] = mfma32(af, __builtin_bit_cast(v8s, w[ksl]), oT[dt]); }
}
template <class Seq, class Sc>
__device__ __forceinline__ void attn_engine2(LAS unsigned char* lds, const bf16_t* Kg, const bf16_t* Vg, int pitch, Seq seq, const v8s (&qa)[4], const v8s (&qb)[4],
                                             v16f (&oA)[2], v16f (&oB)[2], float& mA, float& lA, float& mB, float& lB, const Sc& sc, int tid, int lane) {
    const int r32 = lane & 31, hi = lane >> 5;
    int tc = seq.pop(); if (tc < 0) return;
    int tn = seq.pop(), tnn = (tn >= 0) ? seq.pop() : -1;
    v4u kr = ld_tile(Kg, 64 * tc, pitch, tid), vr = ld_tile(Vg, 64 * tc, pitch, tid);
    __syncthreads();
    st_k(lds + ATT_K, kr, tid); st_v(lds + ATT_V, vr, tid);
    if (tn >= 0) { kr = ld_tile(Kg, 64 * tn, pitch, tid); vr = ld_tile(Vg, 64 * tn, pitch, tid); st_k(lds + ATT_K + KTB, kr, tid); st_v(lds + ATT_V + VTB, vr, tid); }
    if (tnn >= 0) { kr = ld_tile(Kg, 64 * tnn, pitch, tid); vr = ld_tile(Vg, 64 * tnn, pitch, tid); }
    int bi = 0;
#pragma unroll 1
    for (;;) {
        __syncthreads();
        const int b2 = (bi >= 1) ? bi - 1 : 2; int t3 = -1;
        if (tnn >= 0) { st_k(lds + ATT_K + b2 * KTB, kr, tid); st_v(lds + ATT_V + b2 * VTB, vr, tid);
            t3 = seq.pop();
            if (t3 >= 0) { kr = ld_tile(Kg, 64 * t3, pitch, tid); vr = ld_tile(Vg, 64 * t3, pitch, tid); } }
        const bool okA = sc.rowok(tc, 0), okB = sc.rowok(tc, 1);
#pragma unroll
        for (int h = 0; h < 2; ++h) {
            v16f a, b;
            sc.init_half(a, tc, 0, h); sc.init_half(b, tc, 1, h);
            { v8s kf[4]; k_load_half(lds + ATT_K + bi * KTB, h, kf, r32, hi); qk_half(kf, qa, a); qk_half(kf, qb, b); }
            softmax_half(a, oA, mA, lA, okA); softmax_half(b, oB, mB, lB, okB);
            { v4s vf[8]; v_load_khalf(lds + ATT_V + bi * VTB, h, vf, lane); pv_khalf(vf, a, oA); pv_khalf(vf, b, oB); }
        }
        tc = tn; tn = tnn; tnn = t3; bi = (bi == 2) ? 0 : bi + 1;
        if (tc < 0) break;
    }
}
struct Nsa2SelSc {
    const LAS float* tb; int qposA, hi, q0; unsigned mloA, mhiA, mloB, mhiB;
    __device__ __forceinline__ bool rowok(int t, int sub) const { const unsigned lo = sub ? mloB : mloA, hh = sub ? mhiB : mhiA; return ((t < 32 ? (lo >> t) : (hh >> (t - 32))) & 1u) != 0u; }
    __device__ __forceinline__ void init_half(v16f& p, int t, int sub, int h) const {
        if (q0 - (64 * t + 63) >= 1024) { const float b31 = tb[64 + 1024];
#pragma unroll
            for (int r = 0; r < 16; ++r) p[r] = b31; }
        else { const LAS float* bp = tb + (64 + qposA + 32 * sub - 64 * t - 63 - 4 * hi);
#pragma unroll
            for (int r = 0; r < 16; ++r) p[r] = bp[63 - 32 * h - ((r & 3) + 8 * (r >> 2))]; }
    }
};
struct Nsa2WinSc {
    const LAS float* tb; int qposA, hi;
    __device__ __forceinline__ bool rowok(int, int) const { return true; }
    __device__ __forceinline__ void init_half(v16f& p, int t, int sub, int h) const {
        const LAS float* bp = tb + (64 + qposA + 32 * sub - 64 * t - 63 - 4 * hi);
#pragma unroll
        for (int r = 0; r < 16; ++r) p[r] = bp[63 - 32 * h - ((r & 3) + 8 * (r >> 2))];
    }
};

__device__ __forceinline__ void nsa2_phase(LAS unsigned char* lds, const bf16_t* QKV, const float* relb, const bf16_t* KCMP, const bf16_t* VCMP, bf16_t* AO, float* SCRG) {
    const int w = __builtin_amdgcn_readfirstlane(mk_ltid() >> 6);
    LAS unsigned char* KT = lds + ATT_K; LAS unsigned char* VT = lds + ATT_V;
    LAS float* TS = (LAS float*)(lds + N2_OFF_TS); LAS float* TW = (LAS float*)(lds + N2_OFF_TW); LAS unsigned* IMP = (LAS unsigned*)(lds + N2_OFF_IMP);
    LAS unsigned* SEL = (LAS unsigned*)(lds + N2_OFF_SEL); LAS unsigned* UNI = (LAS unsigned*)(lds + N2_OFF_UNI);
    int cur_g = -1;
#define N2_LOADQ() { const bf16_t* Qrow_ = QKV + (size_t)(b * SEQ + q0 + (mk_ltid() & 31)) * EVEN_PAD + E_QB + hq * 64 + ((mk_ltid() >> 5) & 1) * 8; asm volatile("" : "+v"(Qrow_)); \
        _Pragma("unroll") for (int s = 0; s < 4; ++s) { qa[s] = scale_q(*(const v8s*)(Qrow_ + s * 16)); qb[s] = scale_q(*(const v8s*)(Qrow_ + (size_t)32 * EVEN_PAD + s * 16)); } }
#define N2_GATE(qp, i) (1.f / (1.f + __expf(-bf2f(QKV[(size_t)(b * SEQ + (qp)) * EVEN_PAD + E_GT + hq * 3 + (i)]))))
    for (int u = mk_bid(); u < 512; u += mk_grid()) {
        const int qblk = 63 - (u >> 3), b = (u >> 1) & 3, g = u & 1;
        const int hq = 8 * g + w, q0 = 64 * qblk, bg = b * 2 + g;
        v8s qa[4], qb[4]; v16f oA[2], oB[2];
        float* SCR = SCRG + (size_t)mk_bid() * (512 * 64);
        {
            const int tid = mk_ltid(), lane = tid & 63, r32 = lane & 31, hi = lane >> 5, qpos = q0 + r32;
            __syncthreads();
            if (g != cur_g) { cur_g = g;
                for (int i = tid; i < 8 * N2_TS; i += 512) { const int hh = i / N2_TS, d = i - hh * N2_TS - 64;
                    TS[i] = (d >= 0) ? relb[rel_bucket(d < 1024 ? d : 1024) * 32 + 16 + 8 * g + hh] * LOG2E : -INFINITY; }
                for (int i = tid; i < 8 * N2_TW; i += 512) { const int hh = i / N2_TW, d = i - hh * N2_TW - 64;
                    TW[i] = (d >= 0 && d < 512) ? relb[rel_bucket(d) * 32 + 16 + 8 * g + hh] * LOG2E : -INFINITY; } }
            for (int i = tid; i < 64 * 64; i += 512) IMP[i] = 0u;
            if (tid < 2) UNI[tid] = 0u;
            N2_LOADQ()
        }
        const bf16_t* Kc = KCMP + (size_t)bg * 256 * 64; const bf16_t* Vc = VCMP + (size_t)bg * 256 * 64;
        const int nct = ((q0 + 32) >> 4) / 64 + 1;
        float mA = -INFINITY, lA = 0.f, mB = -INFINITY, lB = 0.f;
#define N2_CSCORE(P0, P1, QP) { \
            _Pragma("unroll") for (int r = 0; r < 16; ++r) { const int c0_ = 64 * t + crow(r, hi); const int d0_ = (QP) - 16 * c0_ - 31, d1_ = d0_ - 512; \
                P0[r] = P0[r] + tb[min(max(d0_, -1), 1024)]; P1[r] = P1[r] + tb[min(max(d1_, -1), 1024)]; } }
#define N2_STAT(P0, P1, M, L) { float mx_ = -INFINITY; \
            _Pragma("unroll") for (int r = 0; r < 16; ++r) mx_ = fmaxf(mx_, fmaxf(P0[r], P1[r])); \
            mx_ = fmaxf(mx_, __shfl_xor(mx_, 32)); const float mn_ = fmaxf(M, mx_), mu_ = (mn_ == -INFINITY) ? 0.f : mn_; float rs_ = 0.f; \
            _Pragma("unroll") for (int r = 0; r < 16; ++r) rs_ += ex2(P0[r] - mu_) + ex2(P1[r] - mu_); \
            L = L * ex2(M - mu_) + rs_; M = mn_; }
        {
            const int tid = mk_ltid(), lane = tid & 63, r32 = lane & 31, hi = lane >> 5, qpos = q0 + r32; const LAS float* tb = TS + w * N2_TS + 64;
            v4u kr = ld_tile(Kc, 0, 64, tid);
            for (int t = 0; t < nct; ++t) {
                const int buf = t & 1;
                st_k(KT + buf * KTB, kr, tid);
                __syncthreads();
                if (t + 1 < nct) kr = ld_tile(Kc, 64 * (t + 1), 64, tid);
                { v16f a0, a1; { v8s kf[8]; k_load(KT + buf * KTB, kf, r32, hi); qk_mma(kf, qa, a0, a1); } N2_CSCORE(a0, a1, qpos) N2_STAT(a0, a1, mA, lA) }
                __builtin_amdgcn_sched_barrier(0);
                { v16f b0, b1; { v8s kf[8]; k_load(KT + buf * KTB, kf, r32, hi); qk_mma(kf, qb, b0, b1); } N2_CSCORE(b0, b1, qpos + 32) N2_STAT(b0, b1, mB, lB) }
            }
        }
        lA += __shfl_xor(lA, 32); lB += __shfl_xor(lB, 32);
        {
            const int tid = mk_ltid(), lane = tid & 63, r32 = lane & 31, hi = lane >> 5, qpos = q0 + r32; const LAS float* tb = TS + w * N2_TS + 64;
            const float muA = (mA == -INFINITY) ? 0.f : mA, ilA = (lA > 0.f) ? 1.f / lA : 0.f, muB = (mB == -INFINITY) ? 0.f : mB, ilB = (lB > 0.f) ? 1.f / lB : 0.f;
            const float gA = N2_GATE(qpos, 0), gB = N2_GATE(qpos + 32, 0);
#pragma unroll
            for (int r = 0; r < 16; ++r) { oA[0][r] = 0.f; oA[1][r] = 0.f; oB[0][r] = 0.f; oB[1][r] = 0.f; }
            __syncthreads();
            v4u kr = ld_tile(Kc, 0, 64, tid), vr = ld_tile(Vc, 0, 64, tid);
            for (int t = 0; t < nct; ++t) {
                const int buf = t & 1;
                st_k(KT + buf * KTB, kr, tid); st_v(VT + buf * VTB, vr, tid);
                __syncthreads();
                if (t + 1 < nct) { kr = ld_tile(Kc, 64 * (t + 1), 64, tid); vr = ld_tile(Vc, 64 * (t + 1), 64, tid); }
#define N2_IMP(P0, P1, MU, IL, ROW) { \
                _Pragma("unroll") for (int r = 0; r < 16; ++r) { P0[r] = ex2(P0[r] - MU) * IL; P1[r] = ex2(P1[r] - MU) * IL; } \
                _Pragma("unroll") for (int gq = 0; gq < 4; ++gq) { const int sb0 = 16 * t + 2 * gq + hi, sb1 = sb0 + 8; \
                    const unsigned x0 = (unsigned)(((P0[4 * gq] + P0[4 * gq + 1]) + (P0[4 * gq + 2] + P0[4 * gq + 3])) * 4194304.f + 0.5f); \
                    const unsigned x1 = (unsigned)(((P1[4 * gq] + P1[4 * gq + 1]) + (P1[4 * gq + 2] + P1[4 * gq + 3])) * 4194304.f + 0.5f); \
                    const unsigned e0 = (unsigned)(P0[4 * gq + 3] * 4194304.f + 0.5f), e1 = (unsigned)(P1[4 * gq + 3] * 4194304.f + 0.5f); \
                    lds_add(IMP + (ROW) * 64 + sb0, x0); lds_add(IMP + (ROW) * 64 + sb1, x1); \
                    lds_add(IMP + (ROW) * 64 + sb0 + 1, e0); if (sb1 + 1 < 64) lds_add(IMP + (ROW) * 64 + sb1 + 1, e1); } }
                { v16f a0, a1; { v8s kf[8]; k_load(KT + buf * KTB, kf, r32, hi); qk_mma(kf, qa, a0, a1); } N2_CSCORE(a0, a1, qpos) N2_IMP(a0, a1, muA, ilA, r32)
                  a0 = a0 * gA; a1 = a1 * gA; { v4s vf[16]; v_load(VT + buf * VTB, vf, lane); pv_mma(vf, a0, a1, oA); } }
                __builtin_amdgcn_sched_barrier(0);
                { v16f b0, b1; { v8s kf[8]; k_load(KT + buf * KTB, kf, r32, hi); qk_mma(kf, qb, b0, b1); } N2_CSCORE(b0, b1, qpos + 32) N2_IMP(b0, b1, muB, ilB, 32 + r32)
                  b0 = b0 * gB; b1 = b1 * gB; { v4s vf[16]; v_load(VT + buf * VTB, vf, lane); pv_mma(vf, b0, b1, oB); } }
            }
#pragma unroll
            for (int r = 0; r < 16; ++r) { SCR[r * 512 + tid] = oA[0][r]; SCR[(16 + r) * 512 + tid] = oA[1][r]; SCR[(32 + r) * 512 + tid] = oB[0][r]; SCR[(48 + r) * 512 + tid] = oB[1][r]; }
        }
        __syncthreads();
#pragma unroll 1
        for (int i = 0; i < 8; ++i) {
            const int lane = mk_ltid() & 63;
            const int qi = 8 * w + i, qp = q0 + qi, cur = qp >> 6;
            const unsigned v = IMP[qi * 64 + lane];
            const bool fut = lane > cur, forced = (lane == 0) || (lane == cur) || (lane == cur - 1);
            const unsigned key = ((fut ? 0u : (forced ? 0x3ffffffu : min(v + 1u, 0x3fffffeu))) << 6) | (unsigned)(63 - lane);
            int cnt = 0;
#pragma unroll
            for (int jj = 0; jj < 64; ++jj) { const unsigned kj = (unsigned)__builtin_amdgcn_readlane((int)key, jj); cnt += (kj > key) ? 1 : 0; }
            const unsigned long long msk = __ballot(!fut && cnt < 16);
            if (lane == 0) { SEL[2 * qi] = (unsigned)msk; SEL[2 * qi + 1] = (unsigned)(msk >> 32); lds_or(UNI, (unsigned)msk); lds_or(UNI + 1, (unsigned)(msk >> 32)); }
        }
        __syncthreads();
        {
            const int tid = mk_ltid(), lane = tid & 63, r32 = lane & 31, hi = lane >> 5, qpos = q0 + r32;
            const unsigned long long uni = ((unsigned long long)(unsigned)__builtin_amdgcn_readfirstlane((int)UNI[1]) << 32) | (unsigned)__builtin_amdgcn_readfirstlane((int)UNI[0]);
            const bf16_t* Kg = QKV + (size_t)(b * SEQ) * EVEN_PAD + E_KS + g * 64; const bf16_t* Vg = QKV + (size_t)(b * SEQ) * EVEN_PAD + E_VS + g * 64;
#pragma unroll
            for (int r = 0; r < 16; ++r) { oA[0][r] = 0.f; oA[1][r] = 0.f; oB[0][r] = 0.f; oB[1][r] = 0.f; }
            mA = -INFINITY; lA = 0.f; mB = -INFINITY; lB = 0.f;
            N2_LOADQ()
            Nsa2SelSc sc; sc.tb = TS + w * N2_TS; sc.qposA = qpos; sc.hi = hi; sc.q0 = q0; sc.mloA = SEL[2 * r32]; sc.mhiA = SEL[2 * r32 + 1]; sc.mloB = SEL[2 * (32 + r32)]; sc.mhiB = SEL[2 * (32 + r32) + 1];
            attn_engine2(lds, Kg, Vg, EVEN_PAD, MaskSeq{uni}, qa, qb, oA, oB, mA, lA, mB, lB, sc, tid, lane);
            lA += __shfl_xor(lA, 32); lB += __shfl_xor(lB, 32);
            const float sA = (lA > 0.f) ? N2_GATE(qpos, 1) / lA : 0.f, sB = (lB > 0.f) ? N2_GATE(qpos + 32, 1) / lB : 0.f;
#pragma unroll
            for (int r = 0; r < 16; ++r) { SCR[r * 512 + tid] += oA[0][r] * sA; SCR[(16 + r) * 512 + tid] += oA[1][r] * sA; SCR[(32 + r) * 512 + tid] += oB[0][r] * sB; SCR[(48 + r) * 512 + tid] += oB[1][r] * sB; }
        }
        {
            const int tid = mk_ltid(), lane = tid & 63, r32 = lane & 31, hi = lane >> 5, qpos = q0 + r32;
            const bf16_t* Kg = QKV + (size_t)(b * SEQ) * EVEN_PAD + E_KW + g * 64; const bf16_t* Vg = QKV + (size_t)(b * SEQ) * EVEN_PAD + E_VW + g * 64;
#pragma unroll
            for (int r = 0; r < 16; ++r) { oA[0][r] = 0.f; oA[1][r] = 0.f; oB[0][r] = 0.f; oB[1][r] = 0.f; }
            mA = -INFINITY; lA = 0.f; mB = -INFINITY; lB = 0.f;
            N2_LOADQ()
            Nsa2WinSc sc; sc.tb = TW + w * N2_TW; sc.qposA = qpos; sc.hi = hi;
            attn_engine2(lds, Kg, Vg, EVEN_PAD, RangeSeq{(q0 >= 511) ? ((q0 - 511) >> 6) : 0, (q0 + 63) >> 6}, qa, qb, oA, oB, mA, lA, mB, lB, sc, tid, lane);
            lA += __shfl_xor(lA, 32); lB += __shfl_xor(lB, 32);
            const float sA = (lA > 0.f) ? N2_GATE(qpos, 2) / lA : 0.f, sB = (lB > 0.f) ? N2_GATE(qpos + 32, 2) / lB : 0.f;
#pragma unroll
            for (int r = 0; r < 16; ++r) { oA[0][r] = SCR[r * 512 + tid] + oA[0][r] * sA; oA[1][r] = SCR[(16 + r) * 512 + tid] + oA[1][r] * sA;
                                           oB[0][r] = SCR[(32 + r) * 512 + tid] + oB[0][r] * sB; oB[1][r] = SCR[(48 + r) * 512 + tid] + oB[1][r] * sB; }
            store_o(AO + (size_t)(b * SEQ + qpos) * DM + 1024 + hq * 64, oA, hi);
            store_o(AO + (size_t)(b * SEQ + qpos + 32) * DM + 1024 + hq * 64, oB, hi);
        }
    }
#undef N2_GATE
#undef N2_LOADQ
#undef N2_CSCORE
#undef N2_STAT
#undef N2_IMP
}

__device__ __forceinline__ unsigned xb_ld(unsigned* p)              { return __hip_atomic_load(p, __ATOMIC_RELAXED, __HIP_MEMORY_SCOPE_AGENT); }
__device__ __forceinline__ unsigned xb_add(unsigned* p, unsigned v) { return __hip_atomic_fetch_add(p, v, __ATOMIC_RELAXED, __HIP_MEMORY_SCOPE_AGENT); }
__device__ __forceinline__ unsigned xb_xcc_id() { return (unsigned)__builtin_amdgcn_s_getreg((3 << 11) | 20) & 0xFu; }
#define XB_TMO      128
#define XB_XCNT(j)  (256  + 64 * (j))
#define XB_XSUB(j)  (1280 + 64 * (j))
#define XB_XGEN(j)  (2304 + 64 * (j))
#define XB_TOP      3328
#define XB_TOPGEN   3392
#define XCD_BAR_WORDS 3456
#define XB_SPIN_CAP (1u << 18)

#define XB_SPIN(cond, bar) do { unsigned _sp = 0; while (cond) { __builtin_amdgcn_s_sleep(1); \
    if ((++_sp & 255u) == 0u) { if (xb_ld(&(bar)[XB_TMO])) break; if (_sp > XB_SPIN_CAP) { atomicAdd(&(bar)[XB_TMO], 1u); break; } } } } while (0)

struct XcdBarrier {
    unsigned* bar; unsigned x;
    volatile LAS unsigned* st;
};

__device__ __forceinline__ XcdBarrier xcd_barrier_post(unsigned* bar, volatile LAS unsigned* st) {
    XcdBarrier b; b.bar = bar; b.x = xb_xcc_id(); b.st = st;
    if (threadIdx.x == 0) (void)xb_add(&bar[XB_XCNT(b.x)], 1u);
    return b;
}
__device__ __forceinline__ void xcd_barrier_complete(unsigned* bar, unsigned x, unsigned& nloc, unsigned& nx) {
    const unsigned G = gridDim.x * gridDim.y * gridDim.z;
    unsigned sum, cnt, mine, sp = 0u;
    for (;;) {
        sum = 0u; cnt = 0u; mine = 0u;
#pragma unroll
        for (unsigned j = 0; j < 16; ++j) { const unsigned c = xb_ld(&bar[XB_XCNT(j)]); sum += c; cnt += (c > 0u) ? 1u : 0u; mine = (j == x) ? c : mine; }
        if (sum == G) break;
        __builtin_amdgcn_s_sleep(1);
        if ((++sp & 255u) == 0u) { if (xb_ld(&bar[XB_TMO])) break; if (sp > XB_SPIN_CAP) { atomicAdd(&bar[XB_TMO], 1u); break; } }
    }
    nloc = mine > 0u ? mine : 1u; nx = cnt > 0u ? cnt : 1u;
}

__device__ __forceinline__ void xcd_barrier(const XcdBarrier& b) {
    asm volatile("s_waitcnt vmcnt(0)" ::: "memory");
    __syncthreads();
    if (threadIdx.x == 0) {
        unsigned* bar = b.bar;
        __builtin_amdgcn_s_waitcnt(0);
        unsigned nloc = b.st[0], nx = b.st[1];
        if (nloc == 0u) { xcd_barrier_complete(bar, b.x, nloc, nx); b.st[0] = nloc; b.st[1] = nx; }
        const unsigned old = xb_add(&bar[XB_XSUB(b.x)], 1u);
        const unsigned gen = old / nloc;
        if (old + 1u == (gen + 1u) * nloc) {
            __builtin_amdgcn_fence(__ATOMIC_RELEASE, "agent");
            asm volatile("s_waitcnt vmcnt(0)" ::: "memory");
            const unsigned og = xb_add(&bar[XB_TOP], 1u);
            const unsigned tg = og / nx;
            if (og + 1u == (tg + 1u) * nx) xb_add(&bar[XB_TOPGEN], 1u);
            else XB_SPIN(xb_ld(&bar[XB_TOPGEN]) == tg, bar);
            __builtin_amdgcn_fence(__ATOMIC_ACQUIRE, "agent");
            xb_add(&bar[XB_XGEN(b.x)], 1u);
            asm volatile("s_waitcnt vmcnt(0)" ::: "memory");
        } else {
            XB_SPIN(xb_ld(&bar[XB_XGEN(b.x)]) == gen, bar);
            __builtin_amdgcn_fence(__ATOMIC_ACQUIRE, "agent");
            asm volatile("s_waitcnt vmcnt(0)" ::: "memory");
        }
    }
    __syncthreads();
}

#ifndef BF_ALIGN
#define BF_ALIGN true
#endif
#ifndef RES_ALIGN
#define RES_ALIGN true
#endif
__global__ void __launch_bounds__(512, 2) fwd_mega(Args a_unused) {
    extern __shared__ __attribute__((aligned(16))) unsigned char lds_raw[];
    LAS unsigned char* lds = (LAS unsigned char*)lds_raw;
    cg::grid_group grid = cg::this_grid();
    volatile LAS unsigned* xst = (volatile LAS unsigned*)(lds + LDS_BYTES - 64);
    if (threadIdx.x < 2) xst[threadIdx.x] = 0u;
    __syncthreads();
    XcdBarrier xb = xcd_barrier_post((unsigned*)arg_ws(), xst);
#define WSP(off) (arg_ws() + (off))
#define RED_LDS ((PG8_LAS float*)(lds + 131072))
#define RL_LDS ((LAS float*)(lds + 131072 + 4096))
#define RBASE (2048 * (mk_bid() & 7))
    prologue_phase(lds);
    prep_phase(arg_in(0), (bf16_t*)WSP(WS_XN), (float*)WSP(WS_SSP));
    grid.sync();
#pragma unroll 1
    for (int L = 0; L < 4; ++L) {
        const int e = L >> 1;
        rs_table(RL_LDS, (const float*)WSP(WS_SSP), RBASE);
        if ((L & 1) == 0) {
            { pg8::Gemm gm{(const bf16_t*)WSP(WS_XN), (const bf16_t*)WSP(WS_WIE) + (size_t)e * EVEN_PAD * DM, MTOK, EVEN_PAD, DM}; pg8::StaticOrder S; S.init(MTOK, EVEN_PAD, mk_grid(), mk_bid());
              pg8::EpiBf16<0> E{(bf16_t*)WSP(WS_QKV), EVEN_PAD, (PG8_LAS const float*)RL_LDS, RBASE}; pg8::gemm_phase<pg8::EpiBf16<0>, pg8::StaticOrder, true, true>(lds, gm, S, E); }
            xcd_barrier(xb);
            evenA_phase(lds, (const bf16_t*)WSP(WS_QKV), arg_in(1), arg_in(7) + e * 16, arg_in(8) + e * 2048, arg_in(9) + e * 2048,
                        (const bf16_t*)WSP(WS_CW1) + (size_t)e * 2 * 256 * 2048, (const bf16_t*)WSP(WS_CW2) + (size_t)e * 2 * 64 * 256, (bf16_t*)WSP(WS_KCMP), (bf16_t*)WSP(WS_VCMP), (bf16_t*)WSP(WS_AO));
            xcd_barrier(xb);
            nsa_phase(lds, (const bf16_t*)WSP(WS_QKV), arg_in(1), (const bf16_t*)WSP(WS_KCMP), (const bf16_t*)WSP(WS_VCMP), (bf16_t*)WSP(WS_AO), (float*)WSP(WS_SCR));
            xcd_barrier(xb);
            { pg8::Gemm gm{(const bf16_t*)WSP(WS_AO), (const bf16_t*)WSP(WS_WOE) + (size_t)e * DM * DM, MTOK, DM, DM}; pg8::StaticOrder S; S.init(MTOK, DM, mk_grid(), mk_bid());
              pg8::EpiRes E{(const bf16_t*)WSP(WS_XN), (bf16_t*)WSP(WS_XN), DM, (float*)WSP(WS_SSP), RED_LDS}; pg8::gemm_phase<pg8::EpiRes, pg8::StaticOrder, true, true>(lds, gm, S, E); }
#ifdef DUP_OUT0
            if (L == 0) { xcd_barrier(xb);
              pg8::Gemm gm{(const bf16_t*)WSP(WS_AO), (const bf16_t*)WSP(WS_WOE) + (size_t)e * DM * DM, MTOK, DM, DM}; pg8::StaticOrder S; S.init(MTOK, DM, mk_grid(), mk_bid());
              pg8::EpiRes E{(const bf16_t*)WSP(WS_XN), (bf16_t*)WSP(WS_XN), DM, (float*)WSP(WS_SSP), RED_LDS}; pg8::gemm_phase<pg8::EpiRes, pg8::StaticOrder, true, true>(lds, gm, S, E); }
#endif
        } else {
            { pg8::Gemm gm{(const bf16_t*)WSP(WS_XN), (const bf16_t*)WSP(WS_WIO) + (size_t)e * ODD_PAD * DM, MTOK, ODD_PAD, DM}; pg8::StaticOrder S; S.init(MTOK, ODD_PAD, mk_grid(), mk_bid());
              pg8::EpiBf16<0> E{(bf16_t*)WSP(WS_QKV), ODD_PAD, (PG8_LAS const float*)RL_LDS, RBASE}; pg8::gemm_phase<pg8::EpiBf16<0>, pg8::StaticOrder, true, true>(lds, gm, S, E); }
            xcd_barrier(xb);
            cumsum_phase(lds, (const bf16_t*)WSP(WS_QKV), arg_in(16) + e * 32, (float*)WSP(WS_C));
            xcd_barrier(xb);
            fox2_phase(lds, (const bf16_t*)WSP(WS_QKV), (const float*)WSP(WS_C), (bf16_t*)WSP(WS_AO));
            xcd_barrier(xb);
            { pg8::Gemm gm{(const bf16_t*)WSP(WS_AO), (const bf16_t*)WSP(WS_WOO) + (size_t)e * DM * DM, MTOK, DM, DM}; pg8::StaticOrder S; S.init(MTOK, DM, mk_grid(), mk_bid());
              pg8::EpiRes E{(const bf16_t*)WSP(WS_XN), (bf16_t*)WSP(WS_XN), DM, (float*)WSP(WS_SSP), RED_LDS}; pg8::gemm_phase<pg8::EpiRes, pg8::StaticOrder, true, true>(lds, gm, S, E); }
        }
        xcd_barrier(xb);
        rs_table(RL_LDS, (const float*)WSP(WS_SSP), RBASE);
        { pg8::Gemm gm{(const bf16_t*)WSP(WS_XN), (const bf16_t*)WSP(WS_WUP) + (size_t)L * DFF * DM, MTOK, DFF, DM}; pg8::StaticOrder S; S.init(MTOK, DFF, mk_grid(), mk_bid());
          pg8::EpiBf16<2> E{(bf16_t*)WSP(WS_H), DFF, (PG8_LAS const float*)RL_LDS, RBASE}; pg8::gemm_phase<pg8::EpiBf16<2>, pg8::StaticOrder, true, true>(lds, gm, S, E); }
        xcd_barrier(xb);
        { pg8::Gemm gm{(const bf16_t*)WSP(WS_H), (const bf16_t*)WSP(WS_WDN) + (size_t)L * DM * DFF, MTOK, DM, DFF}; pg8::StaticOrder S; S.init(MTOK, DM, mk_grid(), mk_bid());
          pg8::EpiRes E{(const bf16_t*)WSP(WS_XN), (bf16_t*)WSP(WS_XN), DM, (float*)WSP(WS_SSP), RED_LDS}; pg8::gemm_phase<pg8::EpiRes, pg8::StaticOrder, true, true>(lds, gm, S, E); }
        xcd_barrier(xb);
    }
    final_norm_phase((const bf16_t*)WSP(WS_XN), arg_in(4), arg_out());
#undef RED_LDS
#undef RL_LDS
#undef RBASE
#undef WSP
}

extern "C" void kernel_launch(void* const* d_in, const int* in_sizes, int n_in, void* d_out, int out_size, void* d_ws, size_t ws_size, hipStream_t stream) {
    static int grid = 0;
    if (grid == 0) {
        if (n_in != 19 || out_size != MTOK * DM || ws_size < WS_END) { fprintf(stderr, "kernel_launch: unexpected shapes (n_in %d out %d ws %zu)\n", n_in, out_size, ws_size); grid = -1; return; }
        int dev = 0, cus = 0, per_cu = 0;
        (void)hipGetDevice(&dev);
        (void)hipDeviceGetAttribute(&cus, hipDeviceAttributeMultiprocessorCount, dev);
        (void)hipFuncSetAttribute((const void*)fwd_mega, hipFuncAttributeMaxDynamicSharedMemorySize, LDS_BYTES);
        (void)hipOccupancyMaxActiveBlocksPerMultiprocessor(&per_cu, (const void*)fwd_mega, 512, LDS_BYTES);
        if (per_cu < 1) per_cu = 1;
        grid = cus * per_cu;
        fprintf(stderr, "kernel_launch: grid %d (cus %d x %d)\n", grid, cus, per_cu);
    }
    if (grid < 0) return;
    if (hipMemsetAsync(d_ws, 0, 16384, stream) != hipSuccess) { fprintf(stderr, "kernel_launch: memset of the barrier words failed\n"); return; }
    Args a{};
    for (int i = 0; i < 19; ++i) a.in[i] = (const float*)d_in[i];
    a.out = (float*)d_out; a.ws = (unsigned char*)d_ws;
    void* args[] = {&a};
    hipError_t e = hipLaunchCooperativeKernel((void*)fwd_mega, dim3(grid), dim3(512), args, LDS_BYTES, stream);
    if (e != hipSuccess) fprintf(stderr, "cooperative launch failed: %s (grid %d)\n", hipGetErrorString(e), grid);
}
```

```cpp
#include <hip/hip_runtime.h>
#include <hip/hip_cooperative_groups.h>
#include <cstdio>
#include <cstdint>
#include <cmath>
namespace cg = cooperative_groups;
__device__ __forceinline__ int mk_ltid() { int t = threadIdx.x; asm volatile("" : "+v"(t)); return t; }
__device__ __forceinline__ int mk_bid() { int t = blockIdx.x; asm volatile("" : "+s"(t)); return t; }
__device__ __forceinline__ int mk_grid() { int t = gridDim.x; asm volatile("" : "+s"(t)); return t; }
namespace pg8 {
#define PG8_LAS __attribute__((address_space(3)))
typedef unsigned short bf16_t;
typedef short bf16x8 __attribute__((ext_vector_type(8)));
typedef float f32x4 __attribute__((ext_vector_type(4)));
typedef unsigned u32x4 __attribute__((ext_vector_type(4)));
constexpr int BM = 256, BK = 64, HALF = 128, HTB = HALF * BK * 2  , STAGE_BYTES = 8 * HTB, NXCD = 8, WGM = 4;

__host__ __device__ __forceinline__ int lds_byte(int r, int c) { const int st = (r >> 4) * 2 + (c >> 5), rr = r & 15, cc = c & 31, ob = rr * 64 + cc * 2; return st * 1024 + (ob ^ (((ob >> 9) & 1) << 5)); }
__host__ __device__ __forceinline__ void stage_rc(int b, int& R, int& C) { const int st = b / 1024, sb = b % 1024, swz = sb ^ (((sb >> 9) & 1) << 5); R = (st >> 1) * 16 + swz / 64; C = (st & 1) * 32 + (swz % 64) / 2; }
__host__ __device__ __forceinline__ int perm32(int rho) { const int n = rho >> 4, i = rho & 15; return 8 * (i >> 2) + 4 * n + (i & 3); }

struct Unit { int pm, pn; };
struct Gemm { const bf16_t* A; const bf16_t* Bt; int M, N, K; };

struct StaticOrder {
    int nM, nN, nwg, G, c;
    __host__ __device__ void init(int M, int N, int G_, int c_) { nM = M / BM; nN = N / BM; nwg = nM * nN; G = G_; c = c_; }
    __host__ __device__ bool next(int i, Unit& u) const {
        const long L = (long)i * G + c; if (L >= nwg) return false;
        int wgid = (int)L; { const int q = nwg / NXCD, r = nwg % NXCD, xcd = wgid % NXCD, off = wgid / NXCD; wgid = (xcd < r ? xcd * (q + 1) : r * (q + 1) + (xcd - r) * q) + off; }
        const int nig = WGM * nN, gid = wgid / nig, fm = gid * WGM, gsz = (nM - fm) < WGM ? (nM - fm) : WGM;
        u.pm = fm + ((wgid % nig) % gsz); u.pn = (wgid % nig) / gsz; return true;
    }
    __device__ __forceinline__ void a_ready(const Unit&) const {}
    __device__ __forceinline__ void done(const Unit&) const {}
};

__device__ __forceinline__ unsigned cvt_pk_bf16(float lo, float hi) { unsigned r; asm volatile("v_cvt_pk_bf16_f32 %0, %1, %2" : "=v"(r) : "v"(lo), "v"(hi)); return r; }
typedef float f32x2 __attribute__((ext_vector_type(2)));
template <int ACT  > struct EpiBf16 {
    static constexpr bool PERM = true, AFTER_DRAIN = false;
    bf16_t* O; int ldc; PG8_LAS const float* rl; int rbase;
    __device__ __forceinline__ void operator()(const f32x4 (&acc)[2][2][4][2], const Unit& u, int wr, int wc, int fr, int fq) const {
        const int row0 = u.pm * BM + wr * 64 + fr; const int col0 = u.pn * BM + wc * 32 + 8 * fq;
        float rs[2][4];
#pragma unroll
        for (int ai = 0; ai < 2; ++ai)
#pragma unroll
            for (int m = 0; m < 4; ++m) rs[ai][m] = rl[row0 + ai * HALF + m * 16 - rbase];
#pragma unroll
        for (int ai = 0; ai < 2; ++ai)
#pragma unroll
            for (int m = 0; m < 4; ++m) { bf16_t* rowp = O + (size_t)(row0 + ai * HALF + m * 16) * ldc + col0;
#pragma unroll
                for (int bj = 0; bj < 2; ++bj) { f32x4 v0 = acc[ai][bj][m][0] * rs[ai][m], v1 = acc[ai][bj][m][1] * rs[ai][m];
                    if (ACT == 2) {
#pragma unroll
                        for (int e = 0; e < 4; ++e) { float a = v0[e] > 0.f ? v0[e] : 0.f; v0[e] = a * a; float b = v1[e] > 0.f ? v1[e] : 0.f; v1[e] = b * b; } }
                    u32x4 w; w.x = cvt_pk_bf16(v0[0], v0[1]); w.y = cvt_pk_bf16(v0[2], v0[3]); w.z = cvt_pk_bf16(v1[0], v1[1]); w.w = cvt_pk_bf16(v1[2], v1[3]);
                    *(u32x4*)(rowp + bj * HALF) = w; } }
    }
};
struct EpiRes {
    static constexpr bool PERM = false, AFTER_DRAIN = false;
    const bf16_t* base; bf16_t* xb; int ldc; float* ssp; PG8_LAS float* red;
    __device__ __forceinline__ void operator()(const f32x4 (&acc)[2][2][4][2], const Unit& u, int wr, int wc, int fr, int fq) const {
        typedef unsigned u32x2_ __attribute__((ext_vector_type(2)));
        const int row0 = u.pm * BM + wr * 64 + fr; const int col0 = u.pn * BM + wc * 32 + 4 * fq;
#pragma unroll
        for (int ai = 0; ai < 2; ++ai)
#pragma unroll
            for (int m = 0; m < 4; ++m) { const size_t off = (size_t)(row0 + ai * HALF + m * 16) * ldc + col0; float q = 0.f;
                u32x2_ bv[2][2];
#pragma unroll
                for (int bj = 0; bj < 2; ++bj)
#pragma unroll
                    for (int n = 0; n < 2; ++n) bv[bj][n] = *(const u32x2_*)(base + off + bj * HALF + n * 16);
#pragma unroll
                for (int bj = 0; bj < 2; ++bj)
#pragma unroll
                    for (int n = 0; n < 2; ++n) { const u32x2_ bb = bv[bj][n]; f32x4 v = acc[ai][bj][m][n];
                        v[0] += __uint_as_float(bb.x << 16); v[1] += __uint_as_float(bb.x & 0xffff0000u); v[2] += __uint_as_float(bb.y << 16); v[3] += __uint_as_float(bb.y & 0xffff0000u);
                        u32x2_ w; w.x = cvt_pk_bf16(v[0], v[1]); w.y = cvt_pk_bf16(v[2], v[3]);
                        *(u32x2_*)(xb + off + bj * HALF + n * 16) = w;
                        q += (v[0] * v[0] + v[1] * v[1]) + (v[2] * v[2] + v[3] * v[3]); }
                q += __shfl_xor(q, 16); q += __shfl_xor(q, 32);
                if (fq == 0) red[wc * 256 + ai * HALF + wr * 64 + m * 16 + fr] = q; }
        asm volatile("s_waitcnt lgkmcnt(0)" ::: "memory"); __builtin_amdgcn_s_barrier(); asm volatile("" ::: "memory");
        const int t = threadIdx.x;
        if (t < 256) ssp[(size_t)u.pn * 16384 + u.pm * BM + t] = (red[t] + red[256 + t]) + (red[512 + t] + red[768 + t]);
    }
};
template <class Epi, class Sched, bool ALIGN_EPI = false, bool SP2 = false>
__device__ __forceinline__ void gemm_phase(PG8_LAS unsigned char* lds, const Gemm g, const Sched& S, const Epi& E) {
    const int tid = mk_ltid(), wid = __builtin_amdgcn_readfirstlane(tid >> 6), lane = tid & 63, wr = wid >> 2, wc = wid & 3, fr = lane & 15, fq = lane >> 4;
    const int K = g.K, nt = K / BK;
    unsigned voffA[2], voffB[2];
#pragma unroll
    for (int i = 0; i < 2; ++i) { int R, C; stage_rc(tid * 16 + i * 8192, R, C); const int Rb = Epi::PERM ? ((R & ~31) + perm32(R & 31)) : R;
        voffA[i] = (unsigned)(R * K + C) * 2u; voffB[i] = (unsigned)(Rb * K + C) * 2u; }
    const size_t kstep = (size_t)(BK * 2);
    const size_t hstep = (size_t)HALF * K * 2;
    const size_t tstep = 2 * hstep;
    const unsigned ldsw = (unsigned)wid * 1024u;
    const int aoff = lds_byte(wr * 64 + fr, fq * 8), boff = lds_byte(wc * 32 + fr, fq * 8);
#define PG8_SA(b, h) (((b) * 2 + (h)) * HTB)
#define PG8_SB(b, h) ((4 + (b) * 2 + (h)) * HTB)
#define PG8_STAGE(bufoff, gbase, voff) do { _Pragma("unroll") for (int _i = 0; _i < 2; ++_i) \
        __builtin_amdgcn_global_load_lds((const unsigned*)((const char*)(gbase) + (voff)[_i]), (PG8_LAS unsigned*)(lds + (bufoff) + ldsw + _i * 8192), 16, 0, 0); } while (0)
#define PG8_LDA(dst, b, h) do { _Pragma("unroll") for (int m = 0; m < 4; ++m) _Pragma("unroll") for (int k = 0; k < 2; ++k) dst[m][k] = *(const PG8_LAS bf16x8*)(lds + PG8_SA(b, h) + aoff + m * 2048 + k * 1024); } while (0)
#define PG8_LDB(dst, b, h) do { _Pragma("unroll") for (int n = 0; n < 2; ++n) _Pragma("unroll") for (int k = 0; k < 2; ++k) dst[n][k] = *(const PG8_LAS bf16x8*)(lds + PG8_SB(b, h) + boff + n * 2048 + k * 1024); } while (0)
#define PG8_MMA(ai, bj, At, Bt) do { __builtin_amdgcn_s_setprio(1); _Pragma("unroll") for (int m = 0; m < 4; ++m) _Pragma("unroll") for (int n = 0; n < 2; ++n) _Pragma("unroll") for (int k = 0; k < 2; ++k) \
        acc[ai][bj][m][n] = __builtin_amdgcn_mfma_f32_16x16x32_bf16(Bt[n][k], At[m][k], acc[ai][bj][m][n], 0, 0, 0); __builtin_amdgcn_s_setprio(0); } while (0)
#define PG8_WAIT_V(n) asm volatile("s_waitcnt vmcnt(" #n ")" ::: "memory")
#define PG8_WAIT_L(n) asm volatile("s_waitcnt lgkmcnt(" #n ")" ::: "memory")
#define PG8_BAR __builtin_amdgcn_s_barrier()
#define PG8_SCHED __builtin_amdgcn_sched_barrier(0)
    Unit cur, nxt; int ui = 0;
    if (!S.next(0, cur)) return;
    f32x4 acc[2][2][4][2];
#pragma unroll
    for (int a = 0; a < 2; ++a)
#pragma unroll
        for (int b = 0; b < 2; ++b)
#pragma unroll
            for (int m = 0; m < 4; ++m)
#pragma unroll
                for (int n = 0; n < 2; ++n) acc[a][b][m][n] = (f32x4){0.f, 0.f, 0.f, 0.f};
    bf16x8 At[4][2], B0[2][2], B1[2][2];
    const char* cA = (const char*)g.A + (size_t)cur.pm * tstep; const char* cB = (const char*)g.Bt + (size_t)cur.pn * tstep;
    S.a_ready(cur);
    if constexpr (SP2) {
        PG8_STAGE(PG8_SB(0, 0), cB, voffB); PG8_STAGE(PG8_SB(0, 1), cB + hstep, voffB); PG8_STAGE(PG8_SA(0, 0), cA, voffA); PG8_STAGE(PG8_SA(0, 1), cA + hstep, voffA);
        if (wr == 1) PG8_BAR;
        PG8_WAIT_V(2); PG8_BAR;
        PG8_STAGE(PG8_SB(1, 0), cB + kstep, voffB); PG8_STAGE(PG8_SA(1, 0), cA + kstep, voffA); PG8_STAGE(PG8_SB(1, 1), cB + hstep + kstep, voffB);
        PG8_WAIT_V(6); PG8_BAR;
    } else {
        PG8_STAGE(PG8_SB(0, 0), cB, voffB); PG8_STAGE(PG8_SA(0, 0), cA, voffA); PG8_STAGE(PG8_SB(0, 1), cB + hstep, voffB); PG8_STAGE(PG8_SA(0, 1), cA + hstep, voffA);
        if (wr == 1) PG8_BAR;
        PG8_WAIT_V(4); PG8_BAR;
        PG8_STAGE(PG8_SB(1, 0), cB + kstep, voffB); PG8_STAGE(PG8_SA(1, 0), cA + kstep, voffA); PG8_STAGE(PG8_SB(1, 1), cB + hstep + kstep, voffB);
        PG8_WAIT_V(6); PG8_BAR;
    }
    for (;;) {
        const bool has_next = S.next(ui + 1, nxt);
        const char* nA = has_next ? (const char*)g.A + (size_t)nxt.pm * tstep : cA; const char* nB = has_next ? (const char*)g.Bt + (size_t)nxt.pn * tstep : cB;
        for (int t = 0; t < nt; t += 2) {
            const bool last = (t == nt - 2);
            const char* a1 = cA + (size_t)(t + 1) * kstep;
            const char* a2 = last ? nA : cA + (size_t)(t + 2) * kstep; const char* b2 = last ? nB : cB + (size_t)(t + 2) * kstep;
            const char* a3 = a2 + kstep; const char* b3 = b2 + kstep;
            if (last && has_next) S.a_ready(nxt);
            if constexpr (SP2) {
            PG8_LDB(B0, 0, 0); PG8_LDB(B1, 0, 1); PG8_SCHED; PG8_LDA(At, 0, 0); PG8_STAGE(PG8_SA(1, 1), a1 + hstep, voffA);
            PG8_WAIT_V(8); PG8_WAIT_L(0); PG8_BAR; PG8_MMA(0, 0, At, B0); PG8_MMA(0, 1, At, B1); PG8_BAR; PG8_SCHED;
            PG8_LDA(At, 0, 1); PG8_STAGE(PG8_SB(0, 0), b2, voffB); PG8_STAGE(PG8_SB(0, 1), b2 + hstep, voffB); PG8_STAGE(PG8_SA(0, 0), a2, voffA);
            PG8_WAIT_V(8); PG8_WAIT_L(0); PG8_BAR; PG8_MMA(1, 0, At, B0); PG8_MMA(1, 1, At, B1); PG8_BAR; PG8_SCHED;
            PG8_LDB(B0, 1, 0); PG8_LDB(B1, 1, 1); PG8_SCHED; PG8_LDA(At, 1, 0); PG8_STAGE(PG8_SA(0, 1), a2 + hstep, voffA);
            PG8_WAIT_V(8); PG8_WAIT_L(0); PG8_BAR; PG8_MMA(0, 0, At, B0); PG8_MMA(0, 1, At, B1); PG8_BAR; PG8_SCHED;
            PG8_LDA(At, 1, 1); PG8_STAGE(PG8_SB(1, 0), b3, voffB); PG8_STAGE(PG8_SB(1, 1), b3 + hstep, voffB); PG8_STAGE(PG8_SA(1, 0), a3, voffA);
            PG8_WAIT_V(8); PG8_WAIT_L(0); PG8_BAR; PG8_MMA(1, 0, At, B0); PG8_MMA(1, 1, At, B1); PG8_BAR; PG8_SCHED;
            } else {
            PG8_LDB(B0, 0, 0); PG8_SCHED; PG8_LDA(At, 0, 0); PG8_STAGE(PG8_SA(1, 1), a1 + hstep, voffA);
            PG8_WAIT_L(8); PG8_BAR; PG8_WAIT_L(0); PG8_MMA(0, 0, At, B0); PG8_BAR; PG8_SCHED;
            PG8_LDB(B1, 0, 1); PG8_STAGE(PG8_SB(0, 0), b2, voffB);
            PG8_BAR; PG8_WAIT_L(0); PG8_MMA(0, 1, At, B1); PG8_BAR;
            PG8_LDA(At, 0, 1); PG8_STAGE(PG8_SA(0, 0), a2, voffA);
            PG8_BAR; PG8_WAIT_L(0); PG8_MMA(1, 0, At, B0); PG8_BAR; PG8_SCHED;
            PG8_STAGE(PG8_SB(0, 1), b2 + hstep, voffB);
            PG8_WAIT_V(6); PG8_BAR; PG8_MMA(1, 1, At, B1); PG8_BAR;
            PG8_LDB(B0, 1, 0); PG8_SCHED; PG8_LDA(At, 1, 0); PG8_STAGE(PG8_SA(0, 1), a2 + hstep, voffA);
            PG8_WAIT_L(8); PG8_BAR; PG8_WAIT_L(0); PG8_MMA(0, 0, At, B0); PG8_BAR; PG8_SCHED;
            PG8_LDB(B1, 1, 1); PG8_STAGE(PG8_SB(1, 0), b3, voffB);
            PG8_BAR; PG8_WAIT_L(0); PG8_MMA(0, 1, At, B1); PG8_BAR;
            PG8_LDA(At, 1, 1); PG8_STAGE(PG8_SA(1, 0), a3, voffA);
            PG8_BAR; PG8_WAIT_L(0); PG8_MMA(1, 0, At, B0); PG8_BAR; PG8_SCHED;
            PG8_STAGE(PG8_SB(1, 1), b3 + hstep, voffB);
            PG8_WAIT_V(6); PG8_BAR; PG8_MMA(1, 1, At, B1); PG8_BAR;
            }
        }
        if constexpr (ALIGN_EPI) { if (wr == 0) PG8_BAR; }
        if constexpr (!Epi::AFTER_DRAIN) { E(acc, cur, wr, wc, fr, fq); S.done(cur); }
        if (!has_next) break;
#pragma unroll
        for (int a = 0; a < 2; ++a)
#pragma unroll
            for (int b = 0; b < 2; ++b)
#pragma unroll
                for (int m = 0; m < 4; ++m)
#pragma unroll
                    for (int n = 0; n < 2; ++n) acc[a][b][m][n] = (f32x4){0.f, 0.f, 0.f, 0.f};
        cur = nxt; cA = nA; cB = nB; ++ui;
        if constexpr (ALIGN_EPI) { if (wr == 1) PG8_BAR; }
    }
    PG8_WAIT_V(0);
    if constexpr (!ALIGN_EPI) { if (wr == 0) PG8_BAR; }
    PG8_BAR;
    if constexpr (Epi::AFTER_DRAIN) { E.fused(acc, cur, wr, wc, fr, fq, lds, wid, lane); S.done(cur); }
#undef PG8_SA
#undef PG8_SB
#undef PG8_STAGE
#undef PG8_LDA
#undef PG8_LDB
#undef PG8_MMA
#undef PG8_WAIT_V
#undef PG8_WAIT_L
#undef PG8_BAR
#undef PG8_SCHED
}
}

#define LAS __attribute__((address_space(3)))
typedef unsigned short bf16_t;
typedef short v8s __attribute__((ext_vector_type(8)));
typedef short v4s __attribute__((ext_vector_type(4)));
typedef float v4f __attribute__((ext_vector_type(4)));
typedef float v16f __attribute__((ext_vector_type(16)));
typedef unsigned v4u __attribute__((ext_vector_type(4)));
typedef unsigned v2u __attribute__((ext_vector_type(2)));

constexpr int DM = 2048, NB = 4, SEQ = 4096, MTOK = NB * SEQ, DFF = 8192;
constexpr int EVEN_IN = 3376, EVEN_PAD = 3584, ODD_IN = 6176, ODD_PAD = 6400;
constexpr int E_QA = 0, E_KA = 1024, E_VA = 1280, E_QB = 1536, E_KC = 2560, E_VC = 2688, E_KS = 2816, E_VS = 2944, E_KW = 3072, E_VW = 3200, E_GT = 3328;
constexpr int O_Q = 0, O_K = 2048, O_V = 4096, O_F = 6144;
constexpr float LOG2E = 1.4426950408889634f;
constexpr float C1 = 0.125f * LOG2E;
constexpr float RMS_EPS = 1e-6f;

constexpr size_t MiB = 1u << 20;
constexpr size_t WS_WUP = 16 * MiB, WS_WDN = 144 * MiB, WS_WIE = 272 * MiB, WS_WIO = 300 * MiB, WS_WOE = 350 * MiB, WS_WOO = 366 * MiB;
constexpr size_t WS_CW1 = 382 * MiB, WS_CW2 = 386 * MiB, WS_KCMP = 387 * MiB, WS_VCMP = 387 * MiB + 512 * 1024, WS_C = 388 * MiB, WS_SSP = 390 * MiB;
constexpr size_t WS_XN = 392 * MiB, WS_QKV = 456 * MiB, WS_AO = 656 * MiB, WS_H = 456 * MiB, WS_SCR = 720 * MiB, WS_END = 736 * MiB;

constexpr int KP = 144, VP = 144, TILEB = 64 * 144;
constexpr int LDS_BYTES = 160 * 1024;

struct Args { const float* in[19]; float* out; unsigned char* ws; };
__device__ __forceinline__ const unsigned char __attribute__((address_space(4)))* karg_base() {
    const unsigned char __attribute__((address_space(4)))* kp = (const unsigned char __attribute__((address_space(4)))*)__builtin_amdgcn_kernarg_segment_ptr();
    asm volatile("" : "+s"(kp)); return kp; }
__device__ __forceinline__ const float* arg_in(int i) { return *(const float* const __attribute__((address_space(4)))*)(karg_base() + 8 * i); }
__device__ __forceinline__ float* arg_out() { return *(float* const __attribute__((address_space(4)))*)(karg_base() + 8 * 19); }
__device__ __forceinline__ unsigned char* arg_ws() { return *(unsigned char* const __attribute__((address_space(4)))*)(karg_base() + 8 * 20); }

__device__ __forceinline__ unsigned pkbf(float lo, float hi) {
    typedef float f2 __attribute__((ext_vector_type(2))); typedef __bf16 b2 __attribute__((ext_vector_type(2)));
    f2 v = {lo, hi}; b2 b = __builtin_convertvector(v, b2); return __builtin_bit_cast(unsigned, b);
}
__device__ __forceinline__ float bf2f(unsigned short u) { return __uint_as_float(((unsigned)u) << 16); }
__device__ __forceinline__ float ex2(float x) { return __builtin_amdgcn_exp2f(x); }
__device__ __forceinline__ void lds_add(LAS unsigned* p, unsigned v) { (void)__hip_atomic_fetch_add(p, v, __ATOMIC_RELAXED, __HIP_MEMORY_SCOPE_WORKGROUP); }
__device__ __forceinline__ void lds_or(LAS unsigned* p, unsigned v) { (void)__hip_atomic_fetch_or(p, v, __ATOMIC_RELAXED, __HIP_MEMORY_SCOPE_WORKGROUP); }
__device__ __forceinline__ int crow(int r, int hi) { return (r & 3) + 8 * (r >> 2) + 4 * hi; }
__device__ __forceinline__ v16f mfma32(v8s a, v8s b, v16f c) { return __builtin_amdgcn_mfma_f32_32x32x16_bf16(a, b, c, 0, 0, 0); }
__device__ __forceinline__ float wave_sum(float v) {
#pragma unroll
    for (int o = 1; o < 64; o <<= 1) v += __shfl_xor(v, o);
    return v;
}

__device__ __forceinline__ void tr_load(float (&v)[32], const float* W, int K, int N, int item, int lane) {
    const int nblk = (N + 31) / 32, kb = item / nblk, nb = item - kb * nblk, k0 = 64 * kb, n0 = 32 * nb;
    const int nn = n0 + (lane & 31); const bool ok = nn < N;
    const float* p = W + (size_t)(k0 + (lane >> 5)) * N + (ok ? nn : 0);
#pragma unroll
    for (int i = 0; i < 32; ++i) { const float x = p[(size_t)(2 * i) * N]; v[i] = ok ? x : 0.f; }
}
__device__ __forceinline__ void tr_put(const float (&v)[32], LAS float* scr, int lane) {
#pragma unroll
    for (int i = 0; i < 32; ++i) scr[(2 * i + (lane >> 5)) * 33 + (lane & 31)] = v[i];
}
__device__ __forceinline__ void tr_put_gain(const float (&v)[32], LAS float* scr, int lane, const LAS float* gk) {
#pragma unroll
    for (int i = 0; i < 32; ++i) scr[(2 * i + (lane >> 5)) * 33 + (lane & 31)] = v[i] * gk[2 * i + (lane >> 5)];
}
__device__ __forceinline__ void tr_store(bf16_t* WT, int K, int N, LAS float* scr, int item, int lane) {
    const int nblk = (N + 31) / 32, kb = item / nblk, nb = item - kb * nblk, k0 = 64 * kb, n0 = 32 * nb;
    const int c = lane & 7;
#pragma unroll
    for (int j = 0; j < 4; ++j) { const int n = (lane >> 3) + 8 * j; const LAS float* s = scr + (8 * c) * 33 + n;
        v4u o; o.x = pkbf(s[0 * 33], s[1 * 33]); o.y = pkbf(s[2 * 33], s[3 * 33]); o.z = pkbf(s[4 * 33], s[5 * 33]); o.w = pkbf(s[6 * 33], s[7 * 33]);
        *(v4u*)(WT + (size_t)(n0 + n) * K + k0 + 8 * c) = o; }
}

__device__ __forceinline__ void prologue_phase(LAS unsigned char* lds) {
    const int tid = mk_ltid(), lane = tid & 63, wave = __builtin_amdgcn_readfirstlane(tid >> 6);
    LAS float* scr = (LAS float*)(lds + wave * 16384);
    const int gw = mk_bid() * 8 + wave, NGW = mk_grid() * 8;
    for (int mi = 0; mi < 24; ++mi) {
        unsigned char* ws = arg_ws();
        const float* W; int K, N; bf16_t* WT; const float* g = nullptr;
        if (mi < 4) { W = arg_in(17) + (size_t)mi * DM * DFF; K = DM; N = DFF; WT = (bf16_t*)(ws + WS_WUP) + (size_t)mi * DFF * DM; g = arg_in(3) + mi * DM; }
        else if (mi < 8) { const int L = mi - 4; W = arg_in(18) + (size_t)L * DFF * DM; K = DFF; N = DM; WT = (bf16_t*)(ws + WS_WDN) + (size_t)L * DM * DFF; }
        else if (mi < 10) { const int e = mi - 8; W = arg_in(5) + (size_t)e * DM * EVEN_IN; K = DM; N = EVEN_IN; WT = (bf16_t*)(ws + WS_WIE) + (size_t)e * EVEN_PAD * DM; g = arg_in(2) + (2 * e) * DM; }
        else if (mi < 12) { const int e = mi - 10; W = arg_in(14) + (size_t)e * DM * ODD_IN; K = DM; N = ODD_IN; WT = (bf16_t*)(ws + WS_WIO) + (size_t)e * ODD_PAD * DM; g = arg_in(2) + (2 * e + 1) * DM; }
        else if (mi < 14) { const int e = mi - 12; W = arg_in(6) + (size_t)e * DM * DM; K = DM; N = DM; WT = (bf16_t*)(ws + WS_WOE) + (size_t)e * DM * DM; }
        else if (mi < 16) { const int e = mi - 14; W = arg_in(15) + (size_t)e * DM * DM; K = DM; N = DM; WT = (bf16_t*)(ws + WS_WOO) + (size_t)e * DM * DM; }
        else if (mi < 20) { const int e = (mi - 16) & 1, kv = (mi - 16) >> 1; W = arg_in(kv ? 12 : 10) + (size_t)e * 2048 * 256; K = 2048; N = 256; WT = (bf16_t*)(ws + WS_CW1) + (size_t)(e * 2 + kv) * 256 * 2048; }
        else { const int e = (mi - 20) & 1, kv = (mi - 20) >> 1; W = arg_in(kv ? 13 : 11) + (size_t)e * 256 * 64; K = 256; N = 64; WT = (bf16_t*)(ws + WS_CW2) + (size_t)(e * 2 + kv) * 64 * 256; }
        const int nitems = (K / 64) * ((N + 31) / 32), nblk = (N + 31) / 32;
        LAS float* SG = scr + 64 * 33;
        float v[32]; float gv = 1.f;
        int it = gw;
        if (it < nitems) { tr_load(v, W, K, N, it, lane); if (g) gv = g[64 * (it / nblk) + lane]; }
        while (it < nitems) {
            if (g) { SG[lane] = gv; tr_put_gain(v, scr, lane, SG); } else tr_put(v, scr, lane);
            const int nx = it + NGW;
            if (nx < nitems) { tr_load(v, W, K, N, nx, lane); if (g) gv = g[64 * (nx / nblk) + lane]; }
            asm volatile("s_waitcnt lgkmcnt(0)" ::: "memory");
            tr_store(WT, K, N, scr, it, lane);
            asm volatile("s_waitcnt lgkmcnt(0)" ::: "memory");
            it = nx;
        }
    }
}

__device__ __forceinline__ void prep_phase(const float* X, bf16_t* XB, float* SSP) {
    const int tid = mk_ltid(), lane = tid & 63, wave = tid >> 6;
    const int gw = mk_bid() * 8 + wave, NGW = mk_grid() * 8;
    for (int m = gw; m < MTOK; m += NGW) {
        const v4f* xr = (const v4f*)(X + (size_t)m * DM) + lane;
        v2u* o = (v2u*)(XB + (size_t)m * DM) + lane;
        float s = 0.f;
#pragma unroll
        for (int j = 0; j < 8; ++j) { const v4f v = xr[64 * j]; s += (v.x * v.x + v.y * v.y) + (v.z * v.z + v.w * v.w); v2u w; w.x = pkbf(v.x, v.y); w.y = pkbf(v.z, v.w); o[64 * j] = w; }
        s = wave_sum(s);
        if (lane < 8) SSP[(size_t)lane * MTOK + m] = (lane == 0) ? s : 0.f;
    }
}
__device__ __forceinline__ void rs_table(LAS float* RL, const float* SSP, int rbase) {
    const int tid = mk_ltid();
#pragma unroll
    for (int i = 0; i < 4; ++i) { const int row = rbase + tid + 512 * i; float s = 0.f;
#pragma unroll
        for (int p = 0; p < 8; ++p) s += SSP[(size_t)p * MTOK + row];
        RL[tid + 512 * i] = 1.0f / sqrtf(s * (1.f / DM) + RMS_EPS); }
    __syncthreads();
}

__device__ __forceinline__ void final_norm_phase(const bf16_t* XB, const float* g, float* OUT) {
    const int tid = mk_ltid(), lane = tid & 63, wave = tid >> 6;
    const int gw = mk_bid() * 8 + wave, NGW = mk_grid() * 8;
    v4f gv[8];
#pragma unroll
    for (int j = 0; j < 8; ++j) gv[j] = *((const v4f*)g + lane + 64 * j);
    for (int m = gw; m < MTOK; m += NGW) {
        const v2u* xr = (const v2u*)(XB + (size_t)m * DM) + lane;
        v4f v[8]; float s = 0.f;
#pragma unroll
        for (int j = 0; j < 8; ++j) { const v2u w = xr[64 * j]; v[j] = (v4f){__uint_as_float(w.x << 16), __uint_as_float(w.x & 0xffff0000u), __uint_as_float(w.y << 16), __uint_as_float(w.y & 0xffff0000u)};
            s += (v[j].x * v[j].x + v[j].y * v[j].y) + (v[j].z * v[j].z + v[j].w * v[j].w); }
        const float r = 1.0f / sqrtf(wave_sum(s) * (1.f / DM) + RMS_EPS);
        v4f* o = (v4f*)(OUT + (size_t)m * DM) + lane;
#pragma unroll
        for (int j = 0; j < 8; ++j) o[64 * j] = v[j] * r * gv[j];
    }
}
__device__ __forceinline__ void norm_phase(const float* X, const float* g, bf16_t* XN, float* OUTF) {
    const int tid = mk_ltid(), lane = tid & 63, wave = tid >> 6;
    const int gw = mk_bid() * 8 + wave, NGW = mk_grid() * 8;
    v4f gv[8];
#pragma unroll
    for (int j = 0; j < 8; ++j) gv[j] = *((const v4f*)g + lane + 64 * j);
    for (int m = gw; m < MTOK; m += NGW) {
        const v4f* xr = (const v4f*)(X + (size_t)m * DM) + lane;
        v4f v[8]; float s = 0.f;
#pragma unroll
        for (int j = 0; j < 8; ++j) { v[j] = xr[64 * j]; s += (v[j].x * v[j].x + v[j].y * v[j].y) + (v[j].z * v[j].z + v[j].w * v[j].w); }
        const float r = 1.0f / sqrtf(wave_sum(s) * (1.f / DM) + RMS_EPS);
        if (OUTF) {
            v4f* o = (v4f*)(OUTF + (size_t)m * DM) + lane;
#pragma unroll
            for (int j = 0; j < 8; ++j) o[64 * j] = v[j] * r * gv[j];
        } else {
            v2u* o = (v2u*)(XN + (size_t)m * DM) + lane;
#pragma unroll
            for (int j = 0; j < 8; ++j) { const v4f y = v[j] * r * gv[j]; v2u w; w.x = pkbf(y.x, y.y); w.y = pkbf(y.z, y.w); o[64 * j] = w; }
        }
    }
}

constexpr int KTB = 64 * KP, VHB = 4096 + 64, VTB = 2 * VHB;
constexpr int ATT_K = 0, ATT_V = 3 * KTB, ATT_AUX = ATT_V + 3 * VTB, ATT_END = ATT_AUX + 3 * 64 * 4 + 128;
static_assert(ATT_END == 53504, "attention LDS map");

__device__ __forceinline__ void qk_tile(const LAS unsigned char* Kt, const v8s (&qf)[4], v16f& p0, v16f& p1, int r32, int hi) {
    const LAS unsigned char* kb = Kt + r32 * KP + hi * 16;
    v16f z;
#pragma unroll
    for (int r = 0; r < 16; ++r) z[r] = 0.f;
    p0 = z; p1 = z;
#pragma unroll
    for (int s = 0; s < 4; ++s) {
        const v8s a0 = *(const LAS v8s*)(kb + s * 32);
        const v8s a1 = *(const LAS v8s*)(kb + 32 * KP + s * 32);
        p0 = mfma32(a0, qf[s], p0); p1 = mfma32(a1, qf[s], p1);
    }
}
__device__ __forceinline__ v4s trrd(const LAS unsigned char* p) { return __builtin_bit_cast(v4s, __builtin_amdgcn_ds_read_tr16_b64_v4i16((LAS v4s*)p)); }
__device__ __forceinline__ void pv_tile(const LAS unsigned char* Vt, const v16f& p0, const v16f& p1, v16f (&oT)[2], int lane) {
    const int hi = lane >> 5;
    v4u w[4];
    w[0] = (v4u){pkbf(p0[0], p0[1]), pkbf(p0[2], p0[3]), pkbf(p0[4], p0[5]), pkbf(p0[6], p0[7])};
    w[1] = (v4u){pkbf(p0[8], p0[9]), pkbf(p0[10], p0[11]), pkbf(p0[12], p0[13]), pkbf(p0[14], p0[15])};
    w[2] = (v4u){pkbf(p1[0], p1[1]), pkbf(p1[2], p1[3]), pkbf(p1[4], p1[5]), pkbf(p1[6], p1[7])};
    w[3] = (v4u){pkbf(p1[8], p1[9]), pkbf(p1[10], p1[11]), pkbf(p1[12], p1[13]), pkbf(p1[14], p1[15])};
    const LAS unsigned char* vb = Vt + (4 * hi + ((lane & 15) >> 2)) * 64 + (16 * ((lane >> 4) & 1) + 4 * (lane & 3)) * 2;
#pragma unroll
    for (int dt = 0; dt < 2; ++dt)
#pragma unroll
        for (int ks = 0; ks < 4; ++ks) {
            const int kvb = 16 * (ks & 1) + 32 * (ks >> 1);
            const v4s lo = trrd(vb + dt * VHB + kvb * 64), h4 = trrd(vb + dt * VHB + (kvb + 8) * 64);
            const v8s af = (v8s){lo[0], lo[1], lo[2], lo[3], h4[0], h4[1], h4[2], h4[3]};
            oT[dt] = mfma32(af, __builtin_bit_cast(v8s, w[ks]), oT[dt]);
        }
}

__device__ __forceinline__ void k_load(const LAS unsigned char* Kt, v8s (&kf)[8], int r32, int hi) {
    const LAS unsigned char* kb = Kt + r32 * KP + hi * 16;
#pragma unroll
    for (int s = 0; s < 4; ++s) { kf[2 * s] = *(const LAS v8s*)(kb + s * 32); kf[2 * s + 1] = *(const LAS v8s*)(kb + 32 * KP + s * 32); }
}
__device__ __forceinline__ void qk_mma(const v8s (&kf)[8], const v8s (&qf)[4], v16f& p0, v16f& p1) {
    v16f z;
#pragma unroll
    for (int r = 0; r < 16; ++r) z[r] = 0.f;
    p0 = z; p1 = z;
#pragma unroll
    for (int s = 0; s < 4; ++s) { p0 = mfma32(kf[2 * s], qf[s], p0); p1 = mfma32(kf[2 * s + 1], qf[s], p1); }
}
__device__ __forceinline__ void v_load(const LAS unsigned char* Vt, v4s (&vf)[16], int lane) {
    const int hi = lane >> 5;
    const LAS unsigned char* vb = Vt + (4 * hi + ((lane & 15) >> 2)) * 64 + (16 * ((lane >> 4) & 1) + 4 * (lane & 3)) * 2;
#pragma unroll
    for (int ks = 0; ks < 4; ++ks)
#pragma unroll
        for (int dt = 0; dt < 2; ++dt) {
            const int kvb = 16 * (ks & 1) + 32 * (ks >> 1);
            vf[4 * ks + 2 * dt] = trrd(vb + dt * VHB + kvb * 64); vf[4 * ks + 2 * dt + 1] = trrd(vb + dt * VHB + (kvb + 8) * 64);
        }
}
__device__ __forceinline__ void pv_mma(const v4s (&vf)[16], const v16f& p0, const v16f& p1, v16f (&oT)[2]) {
    v4u w[4];
    w[0] = (v4u){pkbf(p0[0], p0[1]), pkbf(p0[2], p0[3]), pkbf(p0[4], p0[5]), pkbf(p0[6], p0[7])};
    w[1] = (v4u){pkbf(p0[8], p0[9]), pkbf(p0[10], p0[11]), pkbf(p0[12], p0[13]), pkbf(p0[14], p0[15])};
    w[2] = (v4u){pkbf(p1[0], p1[1]), pkbf(p1[2], p1[3]), pkbf(p1[4], p1[5]), pkbf(p1[6], p1[7])};
    w[3] = (v4u){pkbf(p1[8], p1[9]), pkbf(p1[10], p1[11]), pkbf(p1[12], p1[13]), pkbf(p1[14], p1[15])};
#pragma unroll
    for (int ks = 0; ks < 4; ++ks)
#pragma unroll
        for (int dt = 0; dt < 2; ++dt) {
            const v4s lo = vf[4 * ks + 2 * dt], h4 = vf[4 * ks + 2 * dt + 1];
            const v8s af = (v8s){lo[0], lo[1], lo[2], lo[3], h4[0], h4[1], h4[2], h4[3]};
            oT[dt] = mfma32(af, __builtin_bit_cast(v8s, w[ks]), oT[dt]);
        }
}
__device__ __forceinline__ float max3f(float a, float b, float c) { return __builtin_fmaxf(__builtin_fmaxf(a, b), c); }
__device__ __forceinline__ void softmax_step(v16f& p0, v16f& p1, v16f (&oT)[2], float& m, float& l, bool rowok) {
    float a = max3f(p0[0], p0[1], p1[0]), b = max3f(p0[2], p0[3], p1[1]); a = max3f(a, p1[2], p1[3]);
#pragma unroll
    for (int r = 4; r < 16; r += 4) { a = max3f(a, p0[r], p0[r + 1]); b = max3f(b, p0[r + 2], p0[r + 3]); a = max3f(a, p1[r], p1[r + 1]); b = max3f(b, p1[r + 2], p1[r + 3]); }
    float mx = fmaxf(a, b);
    mx = fmaxf(mx, __shfl_xor(mx, 32));
    if (!rowok) mx = -INFINITY;
    const float mn = fmaxf(m, mx);
    const float mu = (mn == -INFINITY) ? 0.f : mn;
    if (__any(mn > m)) {
        const float alpha = ex2(m - mu);
        oT[0] = oT[0] * alpha; oT[1] = oT[1] * alpha; l *= alpha;
    }
    const float mue = rowok ? mu : INFINITY;
    p0 = p0 - mue; p1 = p1 - mue;
#pragma unroll
    for (int r = 0; r < 16; ++r) { p0[r] = ex2(p0[r]); p1[r] = ex2(p1[r]); }
    const v16f s = p0 + p1;
    l += ((s[0] + s[1]) + (s[2] + s[3])) + ((s[4] + s[5]) + (s[6] + s[7])) + (((s[8] + s[9]) + (s[10] + s[11])) + ((s[12] + s[13]) + (s[14] + s[15])));
    m = mn;
}
__device__ __forceinline__ v4u ld_tile(const bf16_t* base, int row0, int pitch, int tid) { return *(const v4u*)(base + (size_t)(row0 + (tid >> 3)) * pitch + (tid & 7) * 8); }
__device__ __forceinline__ void st_k(LAS unsigned char* T, v4u v, int tid) { *(LAS v4u*)(T + (tid >> 3) * KP + (tid & 7) * 16) = v; }
__device__ __forceinline__ void st_v(LAS unsigned char* T, v4u v, int tid) { *(LAS v4u*)(T + ((tid >> 2) & 1) * VHB + (tid >> 3) * 64 + (tid & 3) * 16) = v; }
__device__ __forceinline__ void store_o(bf16_t* Orow, const v16f (&o)[2], int hi) {
#pragma unroll
    for (int dt = 0; dt < 2; ++dt)
#pragma unroll
        for (int g = 0; g < 4; ++g) { v2u w; w.x = pkbf(o[dt][4 * g], o[dt][4 * g + 1]); w.y = pkbf(o[dt][4 * g + 2], o[dt][4 * g + 3]);
            *(v2u*)(Orow + dt * 32 + 8 * g + 4 * hi) = w; }
}
__device__ __forceinline__ int rel_bucket(int n) {
    if (n < 16) return n;
    const float v = __log2f((float)n * (1.f / 16.f)) * (16.f / 6.f) + 1e-5f;
    const int b = 16 + (int)v; return b < 31 ? b : 31;
}

template <bool AUX, int VAR = 0, class Seq, class Sc>
__device__ __forceinline__ void attn_engine(LAS unsigned char* lds, const bf16_t* Kg, const bf16_t* Vg, int pitch, const float* auxg, Seq seq, const v8s (&qf)[4],
                                            v16f (&oT)[2], float& m, float& l, const Sc& sc, int tid, int lane) {
    const int r32 = lane & 31, hi = lane >> 5;
    int tc = seq.pop(); if (tc < 0) return;
    int tn = seq.pop(), tnn = (tn >= 0) ? seq.pop() : -1;
    LAS float* AUXL = (LAS float*)(lds + ATT_AUX);
    v4u kr = ld_tile(Kg, 64 * tc, pitch, tid), vr = ld_tile(Vg, 64 * tc, pitch, tid); float ar = 0.f;
    if (AUX && tid < 64) ar = auxg[64 * tc + tid];
    v4u kr2 = kr, vr2 = vr; float ar2 = 0.f;
    if (tn >= 0) { kr2 = ld_tile(Kg, 64 * tn, pitch, tid); vr2 = ld_tile(Vg, 64 * tn, pitch, tid); if (AUX && tid < 64) ar2 = auxg[64 * tn + tid]; }
    __syncthreads();
    st_k(lds + ATT_K, kr, tid); st_v(lds + ATT_V, vr, tid); if (AUX && tid < 64) AUXL[tid] = ar;
    if (tn >= 0) { st_k(lds + ATT_K + KTB, kr2, tid); st_v(lds + ATT_V + VTB, vr2, tid); if (AUX && tid < 64) AUXL[64 + tid] = ar2; }
    if (tnn >= 0) { kr = ld_tile(Kg, 64 * tnn, pitch, tid); vr = ld_tile(Vg, 64 * tnn, pitch, tid); if (AUX && tid < 64) ar = auxg[64 * tnn + tid]; }
    __syncthreads();
    v16f a0, a1, b0, b1;
    int bi = 0;
    if (sc.active(tc)) { qk_tile(lds + ATT_K, qf, a0, a1, r32, hi); sc.apply(a0, a1, tc, AUXL); }
#define ATT_STEP(C0, C1, N0, N1) { \
        __syncthreads(); \
        const int b2_ = (bi >= 1) ? bi - 1 : 2, b1_ = (bi == 2) ? 0 : bi + 1; int t3_ = -1; \
        if (tnn >= 0) { st_k(lds + ATT_K + b2_ * KTB, kr, tid); st_v(lds + ATT_V + b2_ * VTB, vr, tid); if (AUX && tid < 64) AUXL[b2_ * 64 + tid] = ar; \
            t3_ = seq.pop(); \
            if (t3_ >= 0 && VAR != 3) { kr = ld_tile(Kg, 64 * t3_, pitch, tid); vr = ld_tile(Vg, 64 * t3_, pitch, tid); if (AUX && tid < 64) ar = auxg[64 * t3_ + tid]; } } \
        const bool actn_ = (tn >= 0) && sc.active(tn), actc_ = sc.active(tc); \
        v8s kf_[8]; v4s vf_[16]; \
        if (actn_) { k_load(lds + ATT_K + b1_ * KTB, kf_, r32, hi); __builtin_amdgcn_sched_barrier(0); if (VAR != 2) qk_mma(kf_, qf, N0, N1); else { N0 = oT[0] + __builtin_bit_cast(v4f, kf_[0])[0]; N1 = oT[1] + __builtin_bit_cast(v4f, kf_[5])[1]; } } \
        __builtin_amdgcn_sched_barrier(0); \
        if (actc_) v_load(lds + ATT_V + bi * VTB, vf_, lane); \
        __builtin_amdgcn_sched_barrier(0); \
        if (actc_) { if (VAR != 1) softmax_step(C0, C1, oT, m, l, sc.rowok(tc)); if (VAR != 2) pv_mma(vf_, C0, C1, oT); else { oT[0] = oT[0] + C0 * __builtin_bit_cast(v2u, vf_[3])[0]; oT[1] = oT[1] + C1 * __builtin_bit_cast(v2u, vf_[9])[1]; } } \
        if (actn_) sc.apply(N0, N1, tn, AUXL + b1_ * 64); \
        tc = tn; tn = tnn; tnn = t3_; bi = b1_; \
        if (tc < 0) break; }
    for (;;) {
        ATT_STEP(a0, a1, b0, b1)
        ATT_STEP(b0, b1, a0, a1)
    }
#undef ATT_STEP
}
struct RangeSeq { int cur, last; __device__ __forceinline__ int pop() { const int t = cur; if (t > last) return -1; cur = t + 1; return t; } };
struct MaskSeq { unsigned long long rem; __device__ __forceinline__ int pop() { if (rem == 0ull) return -1; const int t = __builtin_ctzll(rem); rem &= rem - 1ull; return t; } };

__device__ __forceinline__ void cumsum_phase(LAS unsigned char* lds, const bf16_t* QKV, const float* fb, float* CL2) {
    const int tid = mk_ltid(), lane = tid & 63, wave = tid >> 6;
    LAS float* wtot = (LAS float*)lds;
    for (int u = mk_bid(); u < NB * 32; u += mk_grid()) {
        const int b = u >> 5, h = u & 31; const float bias = fb[h];
        float v[8]; float run = 0.f;
#pragma unroll
        for (int i = 0; i < 8; ++i) { const int t = tid * 8 + i; const float x = bf2f(QKV[(size_t)(b * SEQ + t) * ODD_PAD + O_F + h]) + bias;
            const float ls = fminf(x, 0.f) - log1pf(expf(-fabsf(x))); run += ls; v[i] = run; }
        float inc = run;
#pragma unroll
        for (int o = 1; o < 64; o <<= 1) { const float t = __shfl_up(inc, o); if (lane >= o) inc += t; }
        __syncthreads();
        if (lane == 63) wtot[wave] = inc;
        __syncthreads();
        float off = inc - run;
        for (int w2 = 0; w2 < wave; ++w2) off += wtot[w2];
        float* o = CL2 + (size_t)u * SEQ + tid * 8;
#pragma unroll
        for (int i = 0; i < 8; ++i) o[i] = (v[i] + off) * LOG2E;
    }
}

struct FoxSc {
    int qw0, qpos, hi;
    __device__ __forceinline__ bool active(int t) const { return 64 * t <= qw0 + 31; }
    __device__ __forceinline__ bool rowok(int) const { return true; }
    __device__ __forceinline__ void apply(v16f& p0, v16f& p1, int t, const LAS float* aux) const {
        const LAS float* kbp = aux + 4 * hi;
        v16f c0, c1;
#pragma unroll
        for (int g = 0; g < 4; ++g) {
            const v4f x0 = *(const LAS v4f*)(kbp + 8 * g), x1 = *(const LAS v4f*)(kbp + 32 + 8 * g);
#pragma unroll
            for (int e = 0; e < 4; ++e) { c0[4 * g + e] = x0[e]; c1[4 * g + e] = x1[e]; }
        }
        p0 = p0 * C1 - c0; p1 = p1 * C1 - c1;
        if (64 * t + 63 > qw0) {
#pragma unroll
            for (int r = 0; r < 16; ++r) { const int kv = 64 * t + crow(r, hi);
                if (kv > qpos) p0[r] = -INFINITY; if (kv + 32 > qpos) p1[r] = -INFINITY; }
        }
    }
};

template <int VAR = 0>
__device__ __forceinline__ void fox_phase(LAS unsigned char* lds, const bf16_t* QKV, const float* CL2, bf16_t* AO) {
    const int w = __builtin_amdgcn_readfirstlane(mk_ltid() >> 6);
    for (int j = mk_bid(); j < NB * 32 * 16; j += mk_grid()) {
        const int tid = mk_ltid(), lane = tid & 63, r32 = lane & 31, hi = lane >> 5;
        const int rr = j >> 7, bh = j & 127, i2 = rr >> 1; int sel = rr & 1; if (i2 & 1) sel ^= 1;
        const int qb = 15 - (2 * i2 + sel), b = bh >> 5, h = bh & 31;
        const int q0 = qb * 256, qw0 = q0 + 32 * w, qpos = qw0 + r32;
        const bf16_t* Qg = QKV + (size_t)(b * SEQ + qpos) * ODD_PAD + O_Q + h * 64 + hi * 8;
        v8s qf[4];
#pragma unroll
        for (int s = 0; s < 4; ++s) qf[s] = *(const v8s*)(Qg + s * 16);
        const bf16_t* Kg = QKV + (size_t)(b * SEQ) * ODD_PAD + O_K + h * 64;
        const bf16_t* Vg = QKV + (size_t)(b * SEQ) * ODD_PAD + O_V + h * 64;
        v16f oT[2];
#pragma unroll
        for (int r = 0; r < 16; ++r) { oT[0][r] = 0.f; oT[1][r] = 0.f; }
        float m = -INFINITY, l = 0.f;
        const FoxSc sc{qw0, qpos, hi};
        attn_engine<true, VAR>(lds, Kg, Vg, ODD_PAD, CL2 + (size_t)(b * 32 + h) * SEQ, RangeSeq{0, (q0 + 256) / 64 - 1}, qf, oT, m, l, sc, tid, lane);
        l += __shfl_xor(l, 32);
        const float inv = 1.f / l;
        oT[0] = oT[0] * inv; oT[1] = oT[1] * inv;
        store_o(AO + (size_t)(b * SEQ + qpos) * DM + h * 64, oT, hi);
    }
}

__device__ __forceinline__ void fox_scores(v16f& p0, v16f& p1, const v16f& c0, const v16f& c1, bool diag, int t, int qpos, int hi) {
    p0 = p0 * C1 - c0; p1 = p1 * C1 - c1;
    if (diag) {
#pragma unroll
        for (int r = 0; r < 16; ++r) { const int kv = 64 * t + crow(r, hi); if (kv > qpos) p0[r] = -INFINITY; if (kv + 32 > qpos) p1[r] = -INFINITY; }
    }
}
__device__ __forceinline__ void fox2_phase(LAS unsigned char* lds, const bf16_t* QKV, const float* CL2, bf16_t* AO) {
    const int w = __builtin_amdgcn_readfirstlane(mk_ltid() >> 6);
    LAS float* AUXL = (LAS float*)(lds + ATT_AUX);
    for (int j = mk_bid(); j < NB * 32 * 8; j += mk_grid()) {
        const int tid = mk_ltid(), lane = tid & 63, r32 = lane & 31, hi = lane >> 5;
        const int rr = j >> 7, bh = j & 127, i2 = rr >> 1; int sel = rr & 1; if (i2 & 1) sel ^= 1;
        const int qb = 7 - (2 * i2 + sel), b = bh >> 5, h = bh & 31;
        const int q0 = qb * 512, qw0 = q0 + 64 * w, qposA = qw0 + r32, qposB = qposA + 32;
        const bf16_t* Qg = QKV + (size_t)(b * SEQ + qposA) * ODD_PAD + O_Q + h * 64 + hi * 8;
        v8s qa[4], qb_[4];
#pragma unroll
        for (int s = 0; s < 4; ++s) { qa[s] = *(const v8s*)(Qg + s * 16); qb_[s] = *(const v8s*)(Qg + (size_t)32 * ODD_PAD + s * 16); }
        const bf16_t* Kg = QKV + (size_t)(b * SEQ) * ODD_PAD + O_K + h * 64;
        const bf16_t* Vg = QKV + (size_t)(b * SEQ) * ODD_PAD + O_V + h * 64;
        const float* cl = CL2 + (size_t)(b * 32 + h) * SEQ;
        const int nt = (q0 + 512) / 64, tw = qw0 >> 6;
        v16f oA[2], oB[2];
#pragma unroll
        for (int r = 0; r < 16; ++r) { oA[0][r] = 0.f; oA[1][r] = 0.f; oB[0][r] = 0.f; oB[1][r] = 0.f; }
        float mA = -INFINITY, lA = 0.f, mB = -INFINITY, lB = 0.f;
        v4u kr = ld_tile(Kg, 0, ODD_PAD, tid), vr = ld_tile(Vg, 0, ODD_PAD, tid); float ar = (tid < 64) ? cl[tid] : 0.f;
        v4u kr2 = ld_tile(Kg, 64, ODD_PAD, tid), vr2 = ld_tile(Vg, 64, ODD_PAD, tid); float ar2 = (tid < 64) ? cl[64 + tid] : 0.f;
        __syncthreads();
        st_k(lds + ATT_K, kr, tid); st_v(lds + ATT_V, vr, tid); if (tid < 64) AUXL[tid] = ar;
        st_k(lds + ATT_K + KTB, kr2, tid); st_v(lds + ATT_V + VTB, vr2, tid); if (tid < 64) AUXL[64 + tid] = ar2;
        kr = ld_tile(Kg, 128, ODD_PAD, tid); vr = ld_tile(Vg, 128, ODD_PAD, tid); if (tid < 64) ar = cl[128 + tid];
        int bi = 0;
#pragma unroll 1
        for (int t = 0; t < nt; ++t) {
            __syncthreads();
            const int b2 = (bi >= 1) ? bi - 1 : 2;
            if (t + 2 < nt) { st_k(lds + ATT_K + b2 * KTB, kr, tid); st_v(lds + ATT_V + b2 * VTB, vr, tid); if (tid < 64) AUXL[b2 * 64 + tid] = ar;
                if (t + 3 < nt) { kr = ld_tile(Kg, 64 * (t + 3), ODD_PAD, tid); vr = ld_tile(Vg, 64 * (t + 3), ODD_PAD, tid); if (tid < 64) ar = cl[64 * (t + 3) + tid]; } }
            if (t <= tw) {
                const bool diag = (t == tw);
                v16f a0, a1, b0, b1;
                { v8s kf[8]; k_load(lds + ATT_K + bi * KTB, kf, r32, hi); qk_mma(kf, qa, a0, a1); qk_mma(kf, qb_, b0, b1); }
                { v16f c0, c1; const LAS float* kbp = AUXL + bi * 64 + 4 * hi;
#pragma unroll
                  for (int g = 0; g < 4; ++g) { const v4f x0 = *(const LAS v4f*)(kbp + 8 * g), x1 = *(const LAS v4f*)(kbp + 32 + 8 * g);
#pragma unroll
                      for (int e = 0; e < 4; ++e) { c0[4 * g + e] = x0[e]; c1[4 * g + e] = x1[e]; } }
                  fox_scores(a0, a1, c0, c1, diag, t, qposA, hi); fox_scores(b0, b1, c0, c1, diag, t, qposB, hi); }
#ifdef FOX2_VPRE
                { v4s vf[16]; v_load(lds + ATT_V + bi * VTB, vf, lane); __builtin_amdgcn_sched_barrier(0);
                  softmax_step(a0, a1, oA, mA, lA, true); softmax_step(b0, b1, oB, mB, lB, true);
                  pv_mma(vf, a0, a1, oA); pv_mma(vf, b0, b1, oB); }
#else
                softmax_step(a0, a1, oA, mA, lA, true); softmax_step(b0, b1, oB, mB, lB, true);
                { v4s vf[16]; v_load(lds + ATT_V + bi * VTB, vf, lane); pv_mma(vf, a0, a1, oA); pv_mma(vf, b0, b1, oB); }
#endif
            }
            bi = (bi == 2) ? 0 : bi + 1;
        }
        lA += __shfl_xor(lA, 32); lB += __shfl_xor(lB, 32);
        const float ia = 1.f / lA, ib = 1.f / lB;
        oA[0] = oA[0] * ia; oA[1] = oA[1] * ia; oB[0] = oB[0] * ib; oB[1] = oB[1] * ib;
        store_o(AO + (size_t)(b * SEQ + qposA) * DM + h * 64, oA, hi);
        store_o(AO + (size_t)(b * SEQ + qposB) * DM + h * 64, oB, hi);
    }
}


__device__ __forceinline__ float gelu_tanh(float x) {
    const float u = 0.7978845608028654f * (x + 0.044715f * x * x * x);
    const float t = 1.f - 2.f / (1.f + __expf(2.f * u));
    return 0.5f * x * (1.f + t);
}
__device__ __forceinline__ void compress_unit(LAS unsigned char* lds, int u, const bf16_t* QKV, const float* pe_k, const float* pe_v,
                                              const bf16_t* CW1  , const bf16_t* CW2  , bf16_t* KCMP, bf16_t* VCMP) {
    const int tid = mk_ltid(), lane = tid & 63, w = __builtin_amdgcn_readfirstlane(tid >> 6), r32 = lane & 31, hi = lane >> 5;
    const int kv = u >> 6, b = (u >> 4) & 3, g = (u >> 3) & 1, ch = u & 7;
    const float* pe = kv ? pe_v : pe_k;
    const bf16_t* W1 = CW1 + (size_t)kv * 256 * 2048; const bf16_t* W2 = CW2 + (size_t)kv * 64 * 256;
    bf16_t* OUT = (kv ? VCMP : KCMP) + (size_t)((b * 2 + g) * 256 + ch * 32) * 64;
    const int n = ch * 32 + r32;
    const bf16_t* Ag = QKV + (size_t)(b * SEQ + 16 * n) * EVEN_PAD + (kv ? E_VC : E_KC) + g * 64 + hi * 8;
    const bf16_t* Bg = W1 + (size_t)(32 * w + r32) * 2048 + hi * 8;
    LAS bf16_t* HID = (LAS bf16_t*)lds;
    LAS float* PE = (LAS float*)(lds + 20480);
    v16f acc;
#pragma unroll
    for (int r = 0; r < 16; ++r) acc[r] = 0.f;
    __syncthreads();
    *(LAS v4f*)(PE + tid * 4) = *(const v4f*)(pe + tid * 4);
    __syncthreads();
#pragma unroll 8
    for (int st = 0; st < 128; ++st) {
        const int li = st >> 2, d0 = (st & 3) * 16;
        const v4u ar = *(const v4u*)(Ag + (size_t)li * EVEN_PAD + d0);
        const v4f pa = *(const LAS v4f*)(PE + li * 64 + d0 + hi * 8), pb = *(const LAS v4f*)(PE + li * 64 + d0 + hi * 8 + 4);
        const v8s bfr = *(const v8s*)(Bg + st * 16);
        v4u aw;
        aw.x = pkbf(__uint_as_float(ar.x << 16) + pa.x, __uint_as_float(ar.x & 0xffff0000u) + pa.y);
        aw.y = pkbf(__uint_as_float(ar.y << 16) + pa.z, __uint_as_float(ar.y & 0xffff0000u) + pa.w);
        aw.z = pkbf(__uint_as_float(ar.z << 16) + pb.x, __uint_as_float(ar.z & 0xffff0000u) + pb.y);
        aw.w = pkbf(__uint_as_float(ar.w << 16) + pb.z, __uint_as_float(ar.w & 0xffff0000u) + pb.w);
        acc = mfma32(__builtin_bit_cast(v8s, aw), bfr, acc);
    }
#pragma unroll
    for (int r = 0; r < 16; ++r) HID[crow(r, hi) * 264 + 32 * w + r32] = (bf16_t)(pkbf(gelu_tanh(acc[r]), 0.f) & 0xffffu);
    __syncthreads();
    if (w < 2) {
        v16f o;
#pragma unroll
        for (int r = 0; r < 16; ++r) o[r] = 0.f;
        const bf16_t* B2 = W2 + (size_t)(32 * w + r32) * 256 + hi * 8;
#pragma unroll
        for (int st = 0; st < 16; ++st) {
            const v8s af = *(const LAS v8s*)(HID + r32 * 264 + st * 16 + hi * 8);
            const v8s bfr = *(const v8s*)(B2 + st * 16);
            o = mfma32(af, bfr, o);
        }
#pragma unroll
        for (int r = 0; r < 16; ++r) { const int nl = crow(r, hi); const bool valid = (ch * 32 + nl) < 255;
            OUT[(size_t)nl * 64 + 32 * w + r32] = valid ? (bf16_t)(pkbf(o[r], 0.f) & 0xffffu) : (bf16_t)0; }
    }
}

template <int NEGPAD>
struct TabSc {
    const LAS float* tb;
    int qpos, hi;
    __device__ __forceinline__ void apply_tab(v16f& p0, v16f& p1, int t) const {
        const LAS float* bp = tb + (NEGPAD + qpos - 64 * t - 63 - 4 * hi);
        v16f c0, c1;
#pragma unroll
        for (int r = 0; r < 16; ++r) { c0[r] = bp[63 - ((r & 3) + 8 * (r >> 2))]; c1[r] = bp[31 - ((r & 3) + 8 * (r >> 2))]; }
        p0 = p0 * C1 + c0; p1 = p1 * C1 + c1;
    }
};
struct SwaSc : TabSc<64> {
    int qw0;
    __device__ __forceinline__ bool active(int t) const { return 64 * t + 63 >= qw0 - 127 && 64 * t <= qw0 + 31; }
    __device__ __forceinline__ bool rowok(int) const { return true; }
    __device__ __forceinline__ void apply(v16f& p0, v16f& p1, int t, const LAS float*) const { apply_tab(p0, p1, t); }
};

__device__ __forceinline__ void swa_unit(LAS unsigned char* lds, int u, const bf16_t* QKV, const float* relb, const float* sinks, bf16_t* AO) {
    const int tid = mk_ltid(), lane = tid & 63, w = __builtin_amdgcn_readfirstlane(tid >> 6), r32 = lane & 31, hi = lane >> 5;
    LAS float* TB = (LAS float*)(lds + ATT_END);
    const int qblk = u >> 4, b = (u >> 2) & 3, g = u & 3;
    const int hq = 4 * g + (w >> 1), q0 = 64 * qblk, qw0 = q0 + 32 * (w & 1), qpos = qw0 + r32;
    __syncthreads();
    for (int i = tid; i < 1024; i += 512) { const int hh = i >> 8, d = (i & 255) - 64; TB[i] = (d >= 0 && d < 128) ? relb[rel_bucket(d) * 32 + 4 * g + hh] * LOG2E : -INFINITY; }
    const bf16_t* Qg = QKV + (size_t)(b * SEQ + qpos) * EVEN_PAD + E_QA + hq * 64 + hi * 8;
    v8s qf[4];
#pragma unroll
    for (int s = 0; s < 4; ++s) qf[s] = *(const v8s*)(Qg + s * 16);
    const bf16_t* Kg = QKV + (size_t)(b * SEQ) * EVEN_PAD + E_KA + g * 64;
    const bf16_t* Vg = QKV + (size_t)(b * SEQ) * EVEN_PAD + E_VA + g * 64;
    v16f oT[2];
#pragma unroll
    for (int r = 0; r < 16; ++r) { oT[0][r] = 0.f; oT[1][r] = 0.f; }
    float m = -INFINITY, l = 0.f;
    SwaSc sc; sc.tb = TB + (w >> 1) * 256; sc.qpos = qpos; sc.hi = hi; sc.qw0 = qw0;
    attn_engine<false>(lds, Kg, Vg, EVEN_PAD, nullptr, RangeSeq{(qblk >= 2) ? qblk - 2 : 0, qblk}, qf, oT, m, l, sc, tid, lane);
    l += __shfl_xor(l, 32);
    const float sk = sinks[hq] * LOG2E;
    const float mf = fmaxf(m, sk);
    const float a = ex2(m - mf);
    const float inv = a / (l * a + ex2(sk - mf));
    oT[0] = oT[0] * inv; oT[1] = oT[1] * inv;
    store_o(AO + (size_t)(b * SEQ + qpos) * DM + hq * 64, oT, hi);
}

__device__ __forceinline__ void evenA_phase(LAS unsigned char* lds, const bf16_t* QKV, const float* relb, const float* sinks, const float* pe_k, const float* pe_v,
                                            const bf16_t* CW1, const bf16_t* CW2, bf16_t* KCMP, bf16_t* VCMP, bf16_t* AO) {
    for (int u = mk_bid(); u < 128 + 1024; u += mk_grid()) {
        if (u < 128) compress_unit(lds, u, QKV, pe_k, pe_v, CW1, CW2, KCMP, VCMP);
        else swa_unit(lds, u - 128, QKV, relb, sinks, AO);
    }
}

constexpr int NSA_TS = 1184, NSA_TW = 704;
constexpr int NSA_OFF_TS = ATT_END, NSA_OFF_TW = NSA_OFF_TS + 8 * NSA_TS * 4, NSA_OFF_IMP = NSA_OFF_TW + 8 * NSA_TW * 4, NSA_OFF_SEL = NSA_OFF_IMP + 32 * 64 * 4, NSA_OFF_UNI = NSA_OFF_SEL + 32 * 8;
static_assert(NSA_OFF_UNI + 64 <= LDS_BYTES, "NSA LDS map");

struct NsaSelSc : TabSc<64> {
    int q0; unsigned mlo, mhi;
    __device__ __forceinline__ bool active(int) const { return true; }
    __device__ __forceinline__ bool rowok(int t) const { return ((t < 32 ? (mlo >> t) : (mhi >> (t - 32))) & 1u) != 0u; }
    __device__ __forceinline__ void apply(v16f& p0, v16f& p1, int t, const LAS float*) const {
        if (q0 - (64 * t + 63) >= 1024) { const float b31 = tb[64 + 1024]; p0 = p0 * C1 + b31; p1 = p1 * C1 + b31; }
        else apply_tab(p0, p1, t);
    }
};
struct NsaWinSc : TabSc<64> {
    __device__ __forceinline__ bool active(int) const { return true; }
    __device__ __forceinline__ bool rowok(int) const { return true; }
    __device__ __forceinline__ void apply(v16f& p0, v16f& p1, int t, const LAS float*) const { apply_tab(p0, p1, t); }
};

__device__ __forceinline__ void nsa_phase(LAS unsigned char* lds, const bf16_t* QKV, const float* relb, const bf16_t* KCMP, const bf16_t* VCMP, bf16_t* AO, float* SCRG, unsigned* CTR) {
    const int w = __builtin_amdgcn_readfirstlane(mk_ltid() >> 6);
    LAS unsigned char* KT = lds + ATT_K; LAS unsigned char* VT = lds + ATT_V;
    LAS float* TS = (LAS float*)(lds + NSA_OFF_TS); LAS float* TW = (LAS float*)(lds + NSA_OFF_TW); LAS unsigned* IMP = (LAS unsigned*)(lds + NSA_OFF_IMP);
    LAS unsigned* SEL = (LAS unsigned*)(lds + NSA_OFF_SEL); LAS unsigned* UNI = (LAS unsigned*)(lds + NSA_OFF_UNI);
    int cur_g = -1;
#define NSA_GATE(i) (1.f / (1.f + __expf(-bf2f(QKV[(size_t)(b * SEQ + qpos) * EVEN_PAD + E_GT + hq * 3 + (i)]))))
    LAS unsigned* UCUR = (LAS unsigned*)(lds + NSA_OFF_UNI + 16);
    for (;;) {
        const int g = mk_bid() & 1;
        __syncthreads();
        if (mk_ltid() == 0) UCUR[0] = __hip_atomic_fetch_add(CTR + 64 * g, 1u, __ATOMIC_RELAXED, __HIP_MEMORY_SCOPE_AGENT);
        __syncthreads();
        const int u = (int)__builtin_amdgcn_readfirstlane((int)UCUR[0]);
        if (u >= 512) break;
        const int qblk = 127 - (u >> 2), b = u & 3;
        const int hq = 8 * g + w, q0 = 32 * qblk, bg = b * 2 + g;
        v8s qf[4]; v16f oT[2];
        float* SCR = SCRG + (size_t)mk_bid() * (512 * 32);
        {
            const int tid = mk_ltid(), lane = tid & 63, r32 = lane & 31, hi = lane >> 5, qpos = q0 + r32;
            __syncthreads();
            if (g != cur_g) { cur_g = g;
                for (int i = tid; i < 8 * NSA_TS; i += 512) { const int hh = i / NSA_TS, d = i - hh * NSA_TS - 64;
                    TS[i] = (d >= 0) ? relb[rel_bucket(d < 1024 ? d : 1024) * 32 + 16 + 8 * g + hh] * LOG2E : -INFINITY; }
                for (int i = tid; i < 8 * NSA_TW; i += 512) { const int hh = i / NSA_TW, d = i - hh * NSA_TW - 64;
                    TW[i] = (d >= 0 && d < 512) ? relb[rel_bucket(d) * 32 + 16 + 8 * g + hh] * LOG2E : -INFINITY; } }
            for (int i = tid; i < 32 * 64; i += 512) IMP[i] = 0u;
            if (tid < 2) UNI[tid] = 0u;
            const bf16_t* Qrow = QKV + (size_t)(b * SEQ + qpos) * EVEN_PAD;
#pragma unroll
            for (int s = 0; s < 4; ++s) qf[s] = *(const v8s*)(Qrow + E_QB + hq * 64 + hi * 8 + s * 16);
        }
        const bf16_t* Kc = KCMP + (size_t)bg * 256 * 64; const bf16_t* Vc = VCMP + (size_t)bg * 256 * 64;
        const int nct = (2 * qblk) / 64 + 1;
        float m = -INFINITY, l = 0.f;
        {
            const int tid = mk_ltid(), lane = tid & 63, r32 = lane & 31, hi = lane >> 5, qpos = q0 + r32; const LAS float* tb = TS + w * NSA_TS + 64;
            v4u kr = ld_tile(Kc, 0, 64, tid);
            for (int t = 0; t < nct; ++t) {
                const int buf = t & 1;
                st_k(KT + buf * KTB, kr, tid);
                __syncthreads();
                if (t + 1 < nct) kr = ld_tile(Kc, 64 * (t + 1), 64, tid);
                v16f p0, p1;
                qk_tile(KT + buf * KTB, qf, p0, p1, r32, hi);
                float mx = -INFINITY;
#pragma unroll
                for (int r = 0; r < 16; ++r) {
                    const int c0 = 64 * t + crow(r, hi); const int d0 = qpos - 16 * c0 - 31, d1 = d0 - 512;
                    p0[r] = p0[r] * C1 + tb[min(max(d0, -1), 1024)]; p1[r] = p1[r] * C1 + tb[min(max(d1, -1), 1024)];
                    mx = fmaxf(mx, fmaxf(p0[r], p1[r]));
                }
                mx = fmaxf(mx, __shfl_xor(mx, 32));
                const float mn = fmaxf(m, mx), mu = (mn == -INFINITY) ? 0.f : mn;
                float rs = 0.f;
#pragma unroll
                for (int r = 0; r < 16; ++r) rs += ex2(p0[r] - mu) + ex2(p1[r] - mu);
                l = l * ex2(m - mu) + rs; m = mn;
            }
        }
        l += __shfl_xor(l, 32);
        {
            const int tid = mk_ltid(), lane = tid & 63, r32 = lane & 31, hi = lane >> 5, qpos = q0 + r32; const LAS float* tb = TS + w * NSA_TS + 64;
            const float mu = (m == -INFINITY) ? 0.f : m, il = (l > 0.f) ? 1.f / l : 0.f;
            const float gt0 = NSA_GATE(0);
#pragma unroll
            for (int r = 0; r < 16; ++r) { oT[0][r] = 0.f; oT[1][r] = 0.f; }
            __syncthreads();
            v4u kr = ld_tile(Kc, 0, 64, tid), vr = ld_tile(Vc, 0, 64, tid);
            for (int t = 0; t < nct; ++t) {
                const int buf = t & 1;
                st_k(KT + buf * KTB, kr, tid); st_v(VT + buf * VTB, vr, tid);
                __syncthreads();
                if (t + 1 < nct) { kr = ld_tile(Kc, 64 * (t + 1), 64, tid); vr = ld_tile(Vc, 64 * (t + 1), 64, tid); }
                v16f p0, p1;
                qk_tile(KT + buf * KTB, qf, p0, p1, r32, hi);
#pragma unroll
                for (int r = 0; r < 16; ++r) {
                    const int c0 = 64 * t + crow(r, hi); const int d0 = qpos - 16 * c0 - 31, d1 = d0 - 512;
                    p0[r] = ex2(p0[r] * C1 + tb[min(max(d0, -1), 1024)] - mu) * il; p1[r] = ex2(p1[r] * C1 + tb[min(max(d1, -1), 1024)] - mu) * il;
                }
#pragma unroll
                for (int gq = 0; gq < 4; ++gq) {
                    const int sb0 = 16 * t + 2 * gq + hi, sb1 = sb0 + 8;
                    const unsigned a0 = (unsigned)(((p0[4 * gq] + p0[4 * gq + 1]) + (p0[4 * gq + 2] + p0[4 * gq + 3])) * 4194304.f + 0.5f);
                    const unsigned a1 = (unsigned)(((p1[4 * gq] + p1[4 * gq + 1]) + (p1[4 * gq + 2] + p1[4 * gq + 3])) * 4194304.f + 0.5f);
                    const unsigned e0 = (unsigned)(p0[4 * gq + 3] * 4194304.f + 0.5f), e1 = (unsigned)(p1[4 * gq + 3] * 4194304.f + 0.5f);
                    lds_add(IMP + r32 * 64 + sb0, a0); lds_add(IMP + r32 * 64 + sb1, a1);
                    lds_add(IMP + r32 * 64 + sb0 + 1, e0); if (sb1 + 1 < 64) lds_add(IMP + r32 * 64 + sb1 + 1, e1);
                }
                p0 = p0 * gt0; p1 = p1 * gt0;
                pv_tile(VT + buf * VTB, p0, p1, oT, lane);
            }
#pragma unroll
            for (int r = 0; r < 16; ++r) { SCR[r * 512 + tid] = oT[0][r]; SCR[(16 + r) * 512 + tid] = oT[1][r]; }
        }
        __syncthreads();
#pragma unroll 1
        for (int i = 0; i < 4; ++i) {
            const int lane = mk_ltid() & 63;
            const int qi = 4 * w + i, qp = q0 + qi, cur = qp >> 6;
            const unsigned v = IMP[qi * 64 + lane];
            const bool fut = lane > cur, forced = (lane == 0) || (lane == cur) || (lane == cur - 1);
            const unsigned key = ((fut ? 0u : (forced ? 0x3ffffffu : min(v + 1u, 0x3fffffeu))) << 6) | (unsigned)(63 - lane);
            int cnt = 0;
#pragma unroll
            for (int jj = 0; jj < 64; ++jj) { const unsigned kj = (unsigned)__builtin_amdgcn_readlane((int)key, jj); cnt += (kj > key) ? 1 : 0; }
            const unsigned long long msk = __ballot(!fut && cnt < 16);
            if (lane == 0) { SEL[2 * qi] = (unsigned)msk; SEL[2 * qi + 1] = (unsigned)(msk >> 32); lds_or(UNI, (unsigned)msk); lds_or(UNI + 1, (unsigned)(msk >> 32)); }
        }
        __syncthreads();
        {
            const int tid = mk_ltid(), lane = tid & 63, r32 = lane & 31, hi = lane >> 5, qpos = q0 + r32;
            const unsigned long long uni = ((unsigned long long)(unsigned)__builtin_amdgcn_readfirstlane((int)UNI[1]) << 32) | (unsigned)__builtin_amdgcn_readfirstlane((int)UNI[0]);
            const bf16_t* Kg = QKV + (size_t)(b * SEQ) * EVEN_PAD + E_KS + g * 64; const bf16_t* Vg = QKV + (size_t)(b * SEQ) * EVEN_PAD + E_VS + g * 64;
#pragma unroll
            for (int r = 0; r < 16; ++r) { oT[0][r] = 0.f; oT[1][r] = 0.f; }
            m = -INFINITY; l = 0.f;
            NsaSelSc sc; sc.tb = TS + w * NSA_TS; sc.qpos = qpos; sc.hi = hi; sc.q0 = q0; sc.mlo = SEL[2 * r32]; sc.mhi = SEL[2 * r32 + 1];
            attn_engine<false>(lds, Kg, Vg, EVEN_PAD, nullptr, MaskSeq{uni}, qf, oT, m, l, sc, tid, lane);
            l += __shfl_xor(l, 32);
            const float scl = (l > 0.f) ? NSA_GATE(1) / l : 0.f;
#pragma unroll
            for (int r = 0; r < 16; ++r) { SCR[r * 512 + tid] += oT[0][r] * scl; SCR[(16 + r) * 512 + tid] += oT[1][r] * scl; }
        }
        {
            const int tid = mk_ltid(), lane = tid & 63, r32 = lane & 31, hi = lane >> 5, qpos = q0 + r32;
            const bf16_t* Kg = QKV + (size_t)(b * SEQ) * EVEN_PAD + E_KW + g * 64; const bf16_t* Vg = QKV + (size_t)(b * SEQ) * EVEN_PAD + E_VW + g * 64;
#pragma unroll
            for (int r = 0; r < 16; ++r) { oT[0][r] = 0.f; oT[1][r] = 0.f; }
            m = -INFINITY; l = 0.f;
            NsaWinSc sc; sc.tb = TW + w * NSA_TW; sc.qpos = qpos; sc.hi = hi;
            attn_engine<false>(lds, Kg, Vg, EVEN_PAD, nullptr, RangeSeq{(q0 >= 511) ? ((q0 - 511) >> 6) : 0, (q0 + 31) >> 6}, qf, oT, m, l, sc, tid, lane);
            l += __shfl_xor(l, 32);
            const float scl = (l > 0.f) ? NSA_GATE(2) / l : 0.f;
#pragma unroll
            for (int r = 0; r < 16; ++r) { oT[0][r] = SCR[r * 512 + tid] + oT[0][r] * scl; oT[1][r] = SCR[(16 + r) * 512 + tid] + oT[1][r] * scl; }
            store_o(AO + (size_t)(b * SEQ + qpos) * DM + 1024 + hq * 64, oT, hi);
        }
    }
}

constexpr int N2_TS = 1216, N2_TW = 704;
constexpr int N2_OFF_TS = ATT_END, N2_OFF_TW = N2_OFF_TS + 8 * N2_TS * 4, N2_OFF_IMP = N2_OFF_TW + 8 * N2_TW * 4, N2_OFF_SEL = N2_OFF_IMP + 64 * 64 * 4, N2_OFF_UNI = N2_OFF_SEL + 64 * 8;
static_assert(N2_OFF_UNI + 64 <= LDS_BYTES - 64, "NSA2 LDS map");


__device__ __forceinline__ void k_load_half(const LAS unsigned char* Kt, int half, v8s (&kf)[4], int r32, int hi) {
    const LAS unsigned char* kb = Kt + (32 * half + r32) * KP + hi * 16;
#pragma unroll
    for (int s = 0; s < 4; ++s) kf[s] = *(const LAS v8s*)(kb + s * 32);
}
__device__ __forceinline__ void qk_half(const v8s (&kf)[4], const v8s (&qf)[4], v16f& p) {
#pragma unroll
    for (int s = 0; s < 4; ++s) p = mfma32(kf[s], qf[s], p);
}
__device__ __forceinline__ v8s scale_q(v8s q) {
    v4u u = __builtin_bit_cast(v4u, q), o;
    o.x = pkbf(__uint_as_float(u.x << 16) * C1, __uint_as_float(u.x & 0xffff0000u) * C1); o.y = pkbf(__uint_as_float(u.y << 16) * C1, __uint_as_float(u.y & 0xffff0000u) * C1);
    o.z = pkbf(__uint_as_float(u.z << 16) * C1, __uint_as_float(u.z & 0xffff0000u) * C1); o.w = pkbf(__uint_as_float(u.w << 16) * C1, __uint_as_float(u.w & 0xffff0000u) * C1);
    return __builtin_bit_cast(v8s, o);
}
__device__ __forceinline__ void v_load_half(const LAS unsigned char* Vt, int dt, v4s (&vf)[8], int lane) {
    const int hi = lane >> 5;
    const LAS unsigned char* vb = Vt + dt * VHB + (4 * hi + ((lane & 15) >> 2)) * 64 + (16 * ((lane >> 4) & 1) + 4 * (lane & 3)) * 2;
#pragma unroll
    for (int ks = 0; ks < 4; ++ks) { const int kvb = 16 * (ks & 1) + 32 * (ks >> 1); vf[2 * ks] = trrd(vb + kvb * 64); vf[2 * ks + 1] = trrd(vb + (kvb + 8) * 64); }
}
__device__ __forceinline__ void pv_half(const v4s (&vf)[8], const v4u (&w)[4], v16f& o) {
#pragma unroll
    for (int ks = 0; ks < 4; ++ks) { const v4s lo = vf[2 * ks], h4 = vf[2 * ks + 1];
        const v8s af = (v8s){lo[0], lo[1], lo[2], lo[3], h4[0], h4[1], h4[2], h4[3]};
        o = mfma32(af, __builtin_bit_cast(v8s, w[ks]), o); }
}
__device__ __forceinline__ void pack_p2(const v16f& p0, const v16f& p1, v4u (&w)[4]) {
    w[0] = (v4u){pkbf(p0[0], p0[1]), pkbf(p0[2], p0[3]), pkbf(p0[4], p0[5]), pkbf(p0[6], p0[7])};
    w[1] = (v4u){pkbf(p0[8], p0[9]), pkbf(p0[10], p0[11]), pkbf(p0[12], p0[13]), pkbf(p0[14], p0[15])};
    w[2] = (v4u){pkbf(p1[0], p1[1]), pkbf(p1[2], p1[3]), pkbf(p1[4], p1[5]), pkbf(p1[6], p1[7])};
    w[3] = (v4u){pkbf(p1[8], p1[9]), pkbf(p1[10], p1[11]), pkbf(p1[12], p1[13]), pkbf(p1[14], p1[15])};
}

__device__ __forceinline__ void softmax_half(v16f& p, v16f (&oT)[2], float& m, float& l, bool rowok) {
    float a = max3f(p[0], p[1], p[2]), b = max3f(p[3], p[4], p[5]);
    a = max3f(a, p[6], p[7]); b = max3f(b, p[8], p[9]); a = max3f(a, p[10], p[11]); b = max3f(b, p[12], p[13]); a = max3f(a, p[14], p[15]);
    float mx = fmaxf(a, b);
    mx = fmaxf(mx, __shfl_xor(mx, 32));
    if (!rowok) mx = -INFINITY;
    const float mn = fmaxf(m, mx);
    const float mu = (mn == -INFINITY) ? 0.f : mn;
    if (__any(mn > m)) { const float alpha = ex2(m - mu); oT[0] = oT[0] * alpha; oT[1] = oT[1] * alpha; l *= alpha; }
    const float mue = rowok ? mu : INFINITY;
    p = p - mue;
#pragma unroll
    for (int r = 0; r < 16; ++r) p[r] = ex2(p[r]);
    l += ((p[0] + p[1]) + (p[2] + p[3])) + ((p[4] + p[5]) + (p[6] + p[7])) + (((p[8] + p[9]) + (p[10] + p[11])) + ((p[12] + p[13]) + (p[14] + p[15])));
    m = mn;
}
__device__ __forceinline__ void v_load_khalf(const LAS unsigned char* Vt, int h, v4s (&vf)[8], int lane) {
    const int hi = lane >> 5;
    const LAS unsigned char* vb = Vt + (32 * h + 4 * hi + ((lane & 15) >> 2)) * 64 + (16 * ((lane >> 4) & 1) + 4 * (lane & 3)) * 2;
#pragma unroll
    for (int ksl = 0; ksl < 2; ++ksl)
#pragma unroll
        for (int dt = 0; dt < 2; ++dt) { vf[(ksl * 2 + dt) * 2] = trrd(vb + dt * VHB + (16 * ksl) * 64); vf[(ksl * 2 + dt) * 2 + 1] = trrd(vb + dt * VHB + (16 * ksl + 8) * 64); }
}
__device__ __forceinline__ void pv_khalf(const v4s (&vf)[8], const v16f& p, v16f (&oT)[2]) {
    v4u w[2];
    w[0] = (v4u){pkbf(p[0], p[1]), pkbf(p[2], p[3]), pkbf(p[4], p[5]), pkbf(p[6], p[7])};
    w[1] = (v4u){pkbf(p[8], p[9]), pkbf(p[10], p[11]), pkbf(p[12], p[13]), pkbf(p[14], p[15])};
#pragma unroll
    for (int ksl = 0; ksl < 2; ++ksl)
#pragma unroll
        for (int dt = 0; dt < 2; ++dt) { const v4s lo = vf[(ksl * 2 + dt) * 2], h4 = vf[(ksl * 2 + dt) * 2 + 1];
            const v8s af = (v8s){lo[0], lo[1], lo[2], lo[3], h4[0], h4[1], h4[2], h4[3]};
            oT[dt] = mfma32(af, __builtin_bit_cast(v8s, w[ksl]), oT[dt]); }
}
template <class Seq, class Sc>
__device__ __forceinline__ void attn_engine2(LAS unsigned char* lds, const bf16_t* Kg, const bf16_t* Vg, int pitch, Seq seq, const v8s (&qa)[4], const v8s (&qb)[4],
                                             v16f (&oA)[2], v16f (&oB)[2], float& mA, float& lA, float& mB, float& lB, const Sc& sc, int tid, int lane) {
    const int r32 = lane & 31, hi = lane >> 5;
    int tc = seq.pop(); if (tc < 0) return;
    int tn = seq.pop(), tnn = (tn >= 0) ? seq.pop() : -1;
    v4u kr = ld_tile(Kg, 64 * tc, pitch, tid), vr = ld_tile(Vg, 64 * tc, pitch, tid);
    __syncthreads();
    st_k(lds + ATT_K, kr, tid); st_v(lds + ATT_V, vr, tid);
    if (tn >= 0) { kr = ld_tile(Kg, 64 * tn, pitch, tid); vr = ld_tile(Vg, 64 * tn, pitch, tid); st_k(lds + ATT_K + KTB, kr, tid); st_v(lds + ATT_V + VTB, vr, tid); }
    if (tnn >= 0) { kr = ld_tile(Kg, 64 * tnn, pitch, tid); vr = ld_tile(Vg, 64 * tnn, pitch, tid); }
    int bi = 0;
#pragma unroll 1
    for (;;) {
        __syncthreads();
        const int b2 = (bi >= 1) ? bi - 1 : 2; int t3 = -1;
        if (tnn >= 0) { st_k(lds + ATT_K + b2 * KTB, kr, tid); st_v(lds + ATT_V + b2 * VTB, vr, tid);
            t3 = seq.pop();
            if (t3 >= 0) { kr = ld_tile(Kg, 64 * t3, pitch, tid); vr = ld_tile(Vg, 64 * t3, pitch, tid); } }
        const bool okA = sc.rowok(tc, 0), okB = sc.rowok(tc, 1);
#pragma unroll
        for (int h = 0; h < 2; ++h) {
            v16f a, b;
            sc.init_half(a, tc, 0, h); sc.init_half(b, tc, 1, h);
            { v8s kf[4]; k_load_half(lds + ATT_K + bi * KTB, h, kf, r32, hi); qk_half(kf, qa, a); qk_half(kf, qb, b); }
            softmax_half(a, oA, mA, lA, okA); softmax_half(b, oB, mB, lB, okB);
            { v4s vf[8]; v_load_khalf(lds + ATT_V + bi * VTB, h, vf, lane); pv_khalf(vf, a, oA); pv_khalf(vf, b, oB); }
        }
        tc = tn; tn = tnn; tnn = t3; bi = (bi == 2) ? 0 : bi + 1;
        if (tc < 0) break;
    }
}
struct Nsa2SelSc {
    const LAS float* tb; int qposA, hi, q0; unsigned mloA, mhiA, mloB, mhiB;
    __device__ __forceinline__ bool rowok(int t, int sub) const { const unsigned lo = sub ? mloB : mloA, hh = sub ? mhiB : mhiA; return ((t < 32 ? (lo >> t) : (hh >> (t - 32))) & 1u) != 0u; }
    __device__ __forceinline__ void init_half(v16f& p, int t, int sub, int h) const {
        if (q0 - (64 * t + 63) >= 1024) { const float b31 = tb[64 + 1024];
#pragma unroll
            for (int r = 0; r < 16; ++r) p[r] = b31; }
        else { const LAS float* bp = tb + (64 + qposA + 32 * sub - 64 * t - 63 - 4 * hi);
#pragma unroll
            for (int r = 0; r < 16; ++r) p[r] = bp[63 - 32 * h - ((r & 3) + 8 * (r >> 2))]; }
    }
};
struct Nsa2WinSc {
    const LAS float* tb; int qposA, hi;
    __device__ __forceinline__ bool rowok(int, int) const { return true; }
    __device__ __forceinline__ void init_half(v16f& p, int t, int sub, int h) const {
        const LAS float* bp = tb + (64 + qposA + 32 * sub - 64 * t - 63 - 4 * hi);
#pragma unroll
        for (int r = 0; r < 16; ++r) p[r] = bp[63 - 32 * h - ((r & 3) + 8 * (r >> 2))];
    }
};

__device__ __forceinline__ void nsa2_phase(LAS unsigned char* lds, const bf16_t* QKV, const float* relb, const bf16_t* KCMP, const bf16_t* VCMP, bf16_t* AO, float* SCRG) {
    const int w = __builtin_amdgcn_readfirstlane(mk_ltid() >> 6);
    LAS unsigned char* KT = lds + ATT_K; LAS unsigned char* VT = lds + ATT_V;
    LAS float* TS = (LAS float*)(lds + N2_OFF_TS); LAS float* TW = (LAS float*)(lds + N2_OFF_TW); LAS unsigned* IMP = (LAS unsigned*)(lds + N2_OFF_IMP);
    LAS unsigned* SEL = (LAS unsigned*)(lds + N2_OFF_SEL); LAS unsigned* UNI = (LAS unsigned*)(lds + N2_OFF_UNI);
    int cur_g = -1;
#define N2_LOADQ() { const bf16_t* Qrow_ = QKV + (size_t)(b * SEQ + q0 + (mk_ltid() & 31)) * EVEN_PAD + E_QB + hq * 64 + ((mk_ltid() >> 5) & 1) * 8; asm volatile("" : "+v"(Qrow_)); \
        _Pragma("unroll") for (int s = 0; s < 4; ++s) { qa[s] = scale_q(*(const v8s*)(Qrow_ + s * 16)); qb[s] = scale_q(*(const v8s*)(Qrow_ + (size_t)32 * EVEN_PAD + s * 16)); } }
#define N2_GATE(qp, i) (1.f / (1.f + __expf(-bf2f(QKV[(size_t)(b * SEQ + (qp)) * EVEN_PAD + E_GT + hq * 3 + (i)]))))
    for (int u = mk_bid(); u < 512; u += mk_grid()) {
        const int qblk = 63 - (u >> 3), b = (u >> 1) & 3, g = u & 1;
        const int hq = 8 * g + w, q0 = 64 * qblk, bg = b * 2 + g;
        v8s qa[4], qb[4]; v16f oA[2], oB[2];
        float* SCR = SCRG + (size_t)mk_bid() * (512 * 64);
        {
            const int tid = mk_ltid(), lane = tid & 63, r32 = lane & 31, hi = lane >> 5, qpos = q0 + r32;
            __syncthreads();
            if (g != cur_g) { cur_g = g;
                for (int i = tid; i < 8 * N2_TS; i += 512) { const int hh = i / N2_TS, d = i - hh * N2_TS - 64;
                    TS[i] = (d >= 0) ? relb[rel_bucket(d < 1024 ? d : 1024) * 32 + 16 + 8 * g + hh] * LOG2E : -INFINITY; }
                for (int i = tid; i < 8 * N2_TW; i += 512) { const int hh = i / N2_TW, d = i - hh * N2_TW - 64;
                    TW[i] = (d >= 0 && d < 512) ? relb[rel_bucket(d) * 32 + 16 + 8 * g + hh] * LOG2E : -INFINITY; } }
            for (int i = tid; i < 64 * 64; i += 512) IMP[i] = 0u;
            if (tid < 2) UNI[tid] = 0u;
            N2_LOADQ()
        }
        const bf16_t* Kc = KCMP + (size_t)bg * 256 * 64; const bf16_t* Vc = VCMP + (size_t)bg * 256 * 64;
        const int nct = ((q0 + 32) >> 4) / 64 + 1;
        float mA = -INFINITY, lA = 0.f, mB = -INFINITY, lB = 0.f;
#define N2_CSCORE(P0, P1, QP) { \
            _Pragma("unroll") for (int r = 0; r < 16; ++r) { const int c0_ = 64 * t + crow(r, hi); const int d0_ = (QP) - 16 * c0_ - 31, d1_ = d0_ - 512; \
                P0[r] = P0[r] + tb[min(max(d0_, -1), 1024)]; P1[r] = P1[r] + tb[min(max(d1_, -1), 1024)]; } }
#define N2_STAT(P0, P1, M, L) { float mx_ = -INFINITY; \
            _Pragma("unroll") for (int r = 0; r < 16; ++r) mx_ = fmaxf(mx_, fmaxf(P0[r], P1[r])); \
            mx_ = fmaxf(mx_, __shfl_xor(mx_, 32)); const float mn_ = fmaxf(M, mx_), mu_ = (mn_ == -INFINITY) ? 0.f : mn_; float rs_ = 0.f; \
            _Pragma("unroll") for (int r = 0; r < 16; ++r) rs_ += ex2(P0[r] - mu_) + ex2(P1[r] - mu_); \
            L = L * ex2(M - mu_) + rs_; M = mn_; }
        {
            const int tid = mk_ltid(), lane = tid & 63, r32 = lane & 31, hi = lane >> 5, qpos = q0 + r32; const LAS float* tb = TS + w * N2_TS + 64;
            v4u kr = ld_tile(Kc, 0, 64, tid);
            for (int t = 0; t < nct; ++t) {
                const int buf = t & 1;
                st_k(KT + buf * KTB, kr, tid);
                __syncthreads();
                if (t + 1 < nct) kr = ld_tile(Kc, 64 * (t + 1), 64, tid);
                { v16f a0, a1; { v8s kf[8]; k_load(KT + buf * KTB, kf, r32, hi); qk_mma(kf, qa, a0, a1); } N2_CSCORE(a0, a1, qpos) N2_STAT(a0, a1, mA, lA) }
                __builtin_amdgcn_sched_barrier(0);
                { v16f b0, b1; { v8s kf[8]; k_load(KT + buf * KTB, kf, r32, hi); qk_mma(kf, qb, b0, b1); } N2_CSCORE(b0, b1, qpos + 32) N2_STAT(b0, b1, mB, lB) }
            }
        }
        lA += __shfl_xor(lA, 32); lB += __shfl_xor(lB, 32);
        {
            const int tid = mk_ltid(), lane = tid & 63, r32 = lane & 31, hi = lane >> 5, qpos = q0 + r32; const LAS float* tb = TS + w * N2_TS + 64;
            const float muA = (mA == -INFINITY) ? 0.f : mA, ilA = (lA > 0.f) ? 1.f / lA : 0.f, muB = (mB == -INFINITY) ? 0.f : mB, ilB = (lB > 0.f) ? 1.f / lB : 0.f;
            const float gA = N2_GATE(qpos, 0), gB = N2_GATE(qpos + 32, 0);
#pragma unroll
            for (int r = 0; r < 16; ++r) { oA[0][r] = 0.f; oA[1][r] = 0.f; oB[0][r] = 0.f; oB[1][r] = 0.f; }
            __syncthreads();
            v4u kr = ld_tile(Kc, 0, 64, tid), vr = ld_tile(Vc, 0, 64, tid);
            for (int t = 0; t < nct; ++t) {
                const int buf = t & 1;
                st_k(KT + buf * KTB, kr, tid); st_v(VT + buf * VTB, vr, tid);
                __syncthreads();
                if (t + 1 < nct) { kr = ld_tile(Kc, 64 * (t + 1), 64, tid); vr = ld_tile(Vc, 64 * (t + 1), 64, tid); }
#define N2_IMP(P0, P1, MU, IL, ROW) { \
                _Pragma("unroll") for (int r = 0; r < 16; ++r) { P0[r] = ex2(P0[r] - MU) * IL; P1[r] = ex2(P1[r] - MU) * IL; } \
                _Pragma("unroll") for (int gq = 0; gq < 4; ++gq) { const int sb0 = 16 * t + 2 * gq + hi, sb1 = sb0 + 8; \
                    const unsigned x0 = (unsigned)(((P0[4 * gq] + P0[4 * gq + 1]) + (P0[4 * gq + 2] + P0[4 * gq + 3])) * 4194304.f + 0.5f); \
                    const unsigned x1 = (unsigned)(((P1[4 * gq] + P1[4 * gq + 1]) + (P1[4 * gq + 2] + P1[4 * gq + 3])) * 4194304.f + 0.5f); \
                    const unsigned e0 = (unsigned)(P0[4 * gq + 3] * 4194304.f + 0.5f), e1 = (unsigned)(P1[4 * gq + 3] * 4194304.f + 0.5f); \
                    lds_add(IMP + (ROW) * 64 + sb0, x0); lds_add(IMP + (ROW) * 64 + sb1, x1); \
                    lds_add(IMP + (ROW) * 64 + sb0 + 1, e0); if (sb1 + 1 < 64) lds_add(IMP + (ROW) * 64 + sb1 + 1, e1); } }
                { v16f a0, a1; { v8s kf[8]; k_load(KT + buf * KTB, kf, r32, hi); qk_mma(kf, qa, a0, a1); } N2_CSCORE(a0, a1, qpos) N2_IMP(a0, a1, muA, ilA, r32)
                  a0 = a0 * gA; a1 = a1 * gA; { v4s vf[16]; v_load(VT + buf * VTB, vf, lane); pv_mma(vf, a0, a1, oA); } }
                __builtin_amdgcn_sched_barrier(0);
                { v16f b0, b1; { v8s kf[8]; k_load(KT + buf * KTB, kf, r32, hi); qk_mma(kf, qb, b0, b1); } N2_CSCORE(b0, b1, qpos + 32) N2_IMP(b0, b1, muB, ilB, 32 + r32)
                  b0 = b0 * gB; b1 = b1 * gB; { v4s vf[16]; v_load(VT + buf * VTB, vf, lane); pv_mma(vf, b0, b1, oB); } }
            }
#pragma unroll
            for (int r = 0; r < 16; ++r) { SCR[r * 512 + tid] = oA[0][r]; SCR[(16 + r) * 512 + tid] = oA[1][r]; SCR[(32 + r) * 512 + tid] = oB[0][r]; SCR[(48 + r) * 512 + tid] = oB[1][r]; }
        }
        __syncthreads();
#pragma unroll 1
        for (int i = 0; i < 8; ++i) {
            const int lane = mk_ltid() & 63;
            const int qi = 8 * w + i, qp = q0 + qi, cur = qp >> 6;
            const unsigned v = IMP[qi * 64 + lane];
            const bool fut = lane > cur, forced = (lane == 0) || (lane == cur) || (lane == cur - 1);
            const unsigned key = ((fut ? 0u : (forced ? 0x3ffffffu : min(v + 1u, 0x3fffffeu))) << 6) | (unsigned)(63 - lane);
            int cnt = 0;
#pragma unroll
            for (int jj = 0; jj < 64; ++jj) { const unsigned kj = (unsigned)__builtin_amdgcn_readlane((int)key, jj); cnt += (kj > key) ? 1 : 0; }
            const unsigned long long msk = __ballot(!fut && cnt < 16);
            if (lane == 0) { SEL[2 * qi] = (unsigned)msk; SEL[2 * qi + 1] = (unsigned)(msk >> 32); lds_or(UNI, (unsigned)msk); lds_or(UNI + 1, (unsigned)(msk >> 32)); }
        }
        __syncthreads();
        {
            const int tid = mk_ltid(), lane = tid & 63, r32 = lane & 31, hi = lane >> 5, qpos = q0 + r32;
            const unsigned long long uni = ((unsigned long long)(unsigned)__builtin_amdgcn_readfirstlane((int)UNI[1]) << 32) | (unsigned)__builtin_amdgcn_readfirstlane((int)UNI[0]);
            const bf16_t* Kg = QKV + (size_t)(b * SEQ) * EVEN_PAD + E_KS + g * 64; const bf16_t* Vg = QKV + (size_t)(b * SEQ) * EVEN_PAD + E_VS + g * 64;
#pragma unroll
            for (int r = 0; r < 16; ++r) { oA[0][r] = 0.f; oA[1][r] = 0.f; oB[0][r] = 0.f; oB[1][r] = 0.f; }
            mA = -INFINITY; lA = 0.f; mB = -INFINITY; lB = 0.f;
            N2_LOADQ()
            Nsa2SelSc sc; sc.tb = TS + w * N2_TS; sc.qposA = qpos; sc.hi = hi; sc.q0 = q0; sc.mloA = SEL[2 * r32]; sc.mhiA = SEL[2 * r32 + 1]; sc.mloB = SEL[2 * (32 + r32)]; sc.mhiB = SEL[2 * (32 + r32) + 1];
            attn_engine2(lds, Kg, Vg, EVEN_PAD, MaskSeq{uni}, qa, qb, oA, oB, mA, lA, mB, lB, sc, tid, lane);
            lA += __shfl_xor(lA, 32); lB += __shfl_xor(lB, 32);
            const float sA = (lA > 0.f) ? N2_GATE(qpos, 1) / lA : 0.f, sB = (lB > 0.f) ? N2_GATE(qpos + 32, 1) / lB : 0.f;
#pragma unroll
            for (int r = 0; r < 16; ++r) { SCR[r * 512 + tid] += oA[0][r] * sA; SCR[(16 + r) * 512 + tid] += oA[1][r] * sA; SCR[(32 + r) * 512 + tid] += oB[0][r] * sB; SCR[(48 + r) * 512 + tid] += oB[1][r] * sB; }
        }
        {
            const int tid = mk_ltid(), lane = tid & 63, r32 = lane & 31, hi = lane >> 5, qpos = q0 + r32;
            const bf16_t* Kg = QKV + (size_t)(b * SEQ) * EVEN_PAD + E_KW + g * 64; const bf16_t* Vg = QKV + (size_t)(b * SEQ) * EVEN_PAD + E_VW + g * 64;
#pragma unroll
            for (int r = 0; r < 16; ++r) { oA[0][r] = 0.f; oA[1][r] = 0.f; oB[0][r] = 0.f; oB[1][r] = 0.f; }
            mA = -INFINITY; lA = 0.f; mB = -INFINITY; lB = 0.f;
            N2_LOADQ()
            Nsa2WinSc sc; sc.tb = TW + w * N2_TW; sc.qposA = qpos; sc.hi = hi;
            attn_engine2(lds, Kg, Vg, EVEN_PAD, RangeSeq{(q0 >= 511) ? ((q0 - 511) >> 6) : 0, (q0 + 63) >> 6}, qa, qb, oA, oB, mA, lA, mB, lB, sc, tid, lane);
            lA += __shfl_xor(lA, 32); lB += __shfl_xor(lB, 32);
            const float sA = (lA > 0.f) ? N2_GATE(qpos, 2) / lA : 0.f, sB = (lB > 0.f) ? N2_GATE(qpos + 32, 2) / lB : 0.f;
#pragma unroll
            for (int r = 0; r < 16; ++r) { oA[0][r] = SCR[r * 512 + tid] + oA[0][r] * sA; oA[1][r] = SCR[(16 + r) * 512 + tid] + oA[1][r] * sA;
                                           oB[0][r] = SCR[(32 + r) * 512 + tid] + oB[0][r] * sB; oB[1][r] = SCR[(48 + r) * 512 + tid] + oB[1][r] * sB; }
            store_o(AO + (size_t)(b * SEQ + qpos) * DM + 1024 + hq * 64, oA, hi);
            store_o(AO + (size_t)(b * SEQ + qpos + 32) * DM + 1024 + hq * 64, oB, hi);
        }
    }
#undef N2_GATE
#undef N2_LOADQ
#undef N2_CSCORE
#undef N2_STAT
#undef N2_IMP
}

__device__ __forceinline__ unsigned xb_ld(unsigned* p)              { return __hip_atomic_load(p, __ATOMIC_RELAXED, __HIP_MEMORY_SCOPE_AGENT); }
__device__ __forceinline__ unsigned xb_add(unsigned* p, unsigned v) { return __hip_atomic_fetch_add(p, v, __ATOMIC_RELAXED, __HIP_MEMORY_SCOPE_AGENT); }
__device__ __forceinline__ unsigned xb_xcc_id() { return (unsigned)__builtin_amdgcn_s_getreg((3 << 11) | 20) & 0xFu; }
#define XB_TMO      128
#define XB_XCNT(j)  (256  + 64 * (j))
#define XB_XSUB(j)  (1280 + 64 * (j))
#define XB_XGEN(j)  (2304 + 64 * (j))
#define XB_TOP      3328
#define XB_TOPGEN   3392
#define XCD_BAR_WORDS 3456
#define XB_SPIN_CAP (1u << 18)

#define XB_SPIN(cond, bar) do { unsigned _sp = 0; while (cond) { __builtin_amdgcn_s_sleep(1); \
    if ((++_sp & 255u) == 0u) { if (xb_ld(&(bar)[XB_TMO])) break; if (_sp > XB_SPIN_CAP) { atomicAdd(&(bar)[XB_TMO], 1u); break; } } } } while (0)

struct XcdBarrier {
    unsigned* bar; unsigned x;
    volatile LAS unsigned* st;
};

__device__ __forceinline__ XcdBarrier xcd_barrier_post(unsigned* bar, volatile LAS unsigned* st) {
    XcdBarrier b; b.bar = bar; b.x = xb_xcc_id(); b.st = st;
    if (threadIdx.x == 0) (void)xb_add(&bar[XB_XCNT(b.x)], 1u);
    return b;
}
__device__ __forceinline__ void xcd_barrier_complete(unsigned* bar, unsigned x, unsigned& nloc, unsigned& nx) {
    const unsigned G = gridDim.x * gridDim.y * gridDim.z;
    unsigned sum, cnt, mine, sp = 0u;
    for (;;) {
        sum = 0u; cnt = 0u; mine = 0u;
#pragma unroll
        for (unsigned j = 0; j < 16; ++j) { const unsigned c = xb_ld(&bar[XB_XCNT(j)]); sum += c; cnt += (c > 0u) ? 1u : 0u; mine = (j == x) ? c : mine; }
        if (sum == G) break;
        __builtin_amdgcn_s_sleep(1);
        if ((++sp & 255u) == 0u) { if (xb_ld(&bar[XB_TMO])) break; if (sp > XB_SPIN_CAP) { atomicAdd(&bar[XB_TMO], 1u); break; } }
    }
    nloc = mine > 0u ? mine : 1u; nx = cnt > 0u ? cnt : 1u;
}

__device__ __forceinline__ void xcd_barrier(const XcdBarrier& b) {
    asm volatile("s_waitcnt vmcnt(0)" ::: "memory");
    __syncthreads();
    if (threadIdx.x == 0) {
        unsigned* bar = b.bar;
        __builtin_amdgcn_s_waitcnt(0);
        unsigned nloc = b.st[0], nx = b.st[1];
        if (nloc == 0u) { xcd_barrier_complete(bar, b.x, nloc, nx); b.st[0] = nloc; b.st[1] = nx; }
        const unsigned old = xb_add(&bar[XB_XSUB(b.x)], 1u);
        const unsigned gen = old / nloc;
        if (old + 1u == (gen + 1u) * nloc) {
            __builtin_amdgcn_fence(__ATOMIC_RELEASE, "agent");
            asm volatile("s_waitcnt vmcnt(0)" ::: "memory");
            const unsigned og = xb_add(&bar[XB_TOP], 1u);
            const unsigned tg = og / nx;
            if (og + 1u == (tg + 1u) * nx) xb_add(&bar[XB_TOPGEN], 1u);
            else XB_SPIN(xb_ld(&bar[XB_TOPGEN]) == tg, bar);
            __builtin_amdgcn_fence(__ATOMIC_ACQUIRE, "agent");
            xb_add(&bar[XB_XGEN(b.x)], 1u);
            asm volatile("s_waitcnt vmcnt(0)" ::: "memory");
        } else {
            XB_SPIN(xb_ld(&bar[XB_XGEN(b.x)]) == gen, bar);
            __builtin_amdgcn_fence(__ATOMIC_ACQUIRE, "agent");
            asm volatile("s_waitcnt vmcnt(0)" ::: "memory");
        }
    }
    __syncthreads();
}

#ifndef BF_ALIGN
#define BF_ALIGN true
#endif
#ifndef RES_ALIGN
#define RES_ALIGN true
#endif
__global__ void __launch_bounds__(512, 2) fwd_mega(Args a_unused) {
    extern __shared__ __attribute__((aligned(16))) unsigned char lds_raw[];
    LAS unsigned char* lds = (LAS unsigned char*)lds_raw;
    cg::grid_group grid = cg::this_grid();
    volatile LAS unsigned* xst = (volatile LAS unsigned*)(lds + LDS_BYTES - 64);
    if (threadIdx.x < 2) xst[threadIdx.x] = 0u;
    __syncthreads();
    XcdBarrier xb = xcd_barrier_post((unsigned*)arg_ws(), xst);
#define WSP(off) (arg_ws() + (off))
#define RED_LDS ((PG8_LAS float*)(lds + 131072))
#define RL_LDS ((LAS float*)(lds + 131072 + 4096))
#define RBASE (2048 * (mk_bid() & 7))
    prologue_phase(lds);
    prep_phase(arg_in(0), (bf16_t*)WSP(WS_XN), (float*)WSP(WS_SSP));
    grid.sync();
#pragma unroll 1
    for (int L = 0; L < 4; ++L) {
        const int e = L >> 1;
        rs_table(RL_LDS, (const float*)WSP(WS_SSP), RBASE);
        if ((L & 1) == 0) {
            { pg8::Gemm gm{(const bf16_t*)WSP(WS_XN), (const bf16_t*)WSP(WS_WIE) + (size_t)e * EVEN_PAD * DM, MTOK, EVEN_PAD, DM}; pg8::StaticOrder S; S.init(MTOK, EVEN_PAD, mk_grid(), mk_bid());
              pg8::EpiBf16<0> E{(bf16_t*)WSP(WS_QKV), EVEN_PAD, (PG8_LAS const float*)RL_LDS, RBASE}; pg8::gemm_phase<pg8::EpiBf16<0>, pg8::StaticOrder, true, true>(lds, gm, S, E); }
            xcd_barrier(xb);
            evenA_phase(lds, (const bf16_t*)WSP(WS_QKV), arg_in(1), arg_in(7) + e * 16, arg_in(8) + e * 2048, arg_in(9) + e * 2048,
                        (const bf16_t*)WSP(WS_CW1) + (size_t)e * 2 * 256 * 2048, (const bf16_t*)WSP(WS_CW2) + (size_t)e * 2 * 64 * 256, (bf16_t*)WSP(WS_KCMP), (bf16_t*)WSP(WS_VCMP), (bf16_t*)WSP(WS_AO));
            xcd_barrier(xb);
            nsa_phase(lds, (const bf16_t*)WSP(WS_QKV), arg_in(1), (const bf16_t*)WSP(WS_KCMP), (const bf16_t*)WSP(WS_VCMP), (bf16_t*)WSP(WS_AO), (float*)WSP(WS_SCR), (unsigned*)arg_ws() + 3600 + 128 * e);
            xcd_barrier(xb);
            { pg8::Gemm gm{(const bf16_t*)WSP(WS_AO), (const bf16_t*)WSP(WS_WOE) + (size_t)e * DM * DM, MTOK, DM, DM}; pg8::StaticOrder S; S.init(MTOK, DM, mk_grid(), mk_bid());
              pg8::EpiRes E{(const bf16_t*)WSP(WS_XN), (bf16_t*)WSP(WS_XN), DM, (float*)WSP(WS_SSP), RED_LDS}; pg8::gemm_phase<pg8::EpiRes, pg8::StaticOrder, true, true>(lds, gm, S, E); }
#ifdef DUP_OUT0
            if (L == 0) { xcd_barrier(xb);
              pg8::Gemm gm{(const bf16_t*)WSP(WS_AO), (const bf16_t*)WSP(WS_WOE) + (size_t)e * DM * DM, MTOK, DM, DM}; pg8::StaticOrder S; S.init(MTOK, DM, mk_grid(), mk_bid());
              pg8::EpiRes E{(const bf16_t*)WSP(WS_XN), (bf16_t*)WSP(WS_XN), DM, (float*)WSP(WS_SSP), RED_LDS}; pg8::gemm_phase<pg8::EpiRes, pg8::StaticOrder, true, true>(lds, gm, S, E); }
#endif
        } else {
            { pg8::Gemm gm{(const bf16_t*)WSP(WS_XN), (const bf16_t*)WSP(WS_WIO) + (size_t)e * ODD_PAD * DM, MTOK, ODD_PAD, DM}; pg8::StaticOrder S; S.init(MTOK, ODD_PAD, mk_grid(), mk_bid());
              pg8::EpiBf16<0> E{(bf16_t*)WSP(WS_QKV), ODD_PAD, (PG8_LAS const float*)RL_LDS, RBASE}; pg8::gemm_phase<pg8::EpiBf16<0>, pg8::StaticOrder, true, true>(lds, gm, S, E); }
            xcd_barrier(xb);
            cumsum_phase(lds, (const bf16_t*)WSP(WS_QKV), arg_in(16) + e * 32, (float*)WSP(WS_C));
            xcd_barrier(xb);
            fox2_phase(lds, (const bf16_t*)WSP(WS_QKV), (const float*)WSP(WS_C), (bf16_t*)WSP(WS_AO));
            xcd_barrier(xb);
            { pg8::Gemm gm{(const bf16_t*)WSP(WS_AO), (const bf16_t*)WSP(WS_WOO) + (size_t)e * DM * DM, MTOK, DM, DM}; pg8::StaticOrder S; S.init(MTOK, DM, mk_grid(), mk_bid());
              pg8::EpiRes E{(const bf16_t*)WSP(WS_XN), (bf16_t*)WSP(WS_XN), DM, (float*)WSP(WS_SSP), RED_LDS}; pg8::gemm_phase<pg8::EpiRes, pg8::StaticOrder, true, true>(lds, gm, S, E); }
        }
        xcd_barrier(xb);
        rs_table(RL_LDS, (const float*)WSP(WS_SSP), RBASE);
        { pg8::Gemm gm{(const bf16_t*)WSP(WS_XN), (const bf16_t*)WSP(WS_WUP) + (size_t)L * DFF * DM, MTOK, DFF, DM}; pg8::StaticOrder S; S.init(MTOK, DFF, mk_grid(), mk_bid());
          pg8::EpiBf16<2> E{(bf16_t*)WSP(WS_H), DFF, (PG8_LAS const float*)RL_LDS, RBASE}; pg8::gemm_phase<pg8::EpiBf16<2>, pg8::StaticOrder, true, true>(lds, gm, S, E); }
        xcd_barrier(xb);
        { pg8::Gemm gm{(const bf16_t*)WSP(WS_H), (const bf16_t*)WSP(WS_WDN) + (size_t)L * DM * DFF, MTOK, DM, DFF}; pg8::StaticOrder S; S.init(MTOK, DM, mk_grid(), mk_bid());
          pg8::EpiRes E{(const bf16_t*)WSP(WS_XN), (bf16_t*)WSP(WS_XN), DM, (float*)WSP(WS_SSP), RED_LDS}; pg8::gemm_phase<pg8::EpiRes, pg8::StaticOrder, true, true>(lds, gm, S, E); }
        xcd_barrier(xb);
    }
    final_norm_phase((const bf16_t*)WSP(WS_XN), arg_in(4), arg_out());
#undef RED_LDS
#undef RL_LDS
#undef RBASE
#undef WSP
}

extern "C" void kernel_launch(void* const* d_in, const int* in_sizes, int n_in, void* d_out, int out_size, void* d_ws, size_t ws_size, hipStream_t stream) {
    static int grid = 0;
    if (grid == 0) {
        if (n_in != 19 || out_size != MTOK * DM || ws_size < WS_END) { fprintf(stderr, "kernel_launch: unexpected shapes (n_in %d out %d ws %zu)\n", n_in, out_size, ws_size); grid = -1; return; }
        int dev = 0, cus = 0, per_cu = 0;
        (void)hipGetDevice(&dev);
        (void)hipDeviceGetAttribute(&cus, hipDeviceAttributeMultiprocessorCount, dev);
        (void)hipFuncSetAttribute((const void*)fwd_mega, hipFuncAttributeMaxDynamicSharedMemorySize, LDS_BYTES);
        (void)hipOccupancyMaxActiveBlocksPerMultiprocessor(&per_cu, (const void*)fwd_mega, 512, LDS_BYTES);
        if (per_cu < 1) per_cu = 1;
        grid = cus * per_cu;
        fprintf(stderr, "kernel_launch: grid %d (cus %d x %d)\n", grid, cus, per_cu);
    }
    if (grid < 0) return;
    if (hipMemsetAsync(d_ws, 0, 16384, stream) != hipSuccess) { fprintf(stderr, "kernel_launch: memset of the barrier words failed\n"); return; }
    Args a{};
    for (int i = 0; i < 19; ++i) a.in[i] = (const float*)d_in[i];
    a.out = (float*)d_out; a.ws = (unsigned char*)d_ws;
    void* args[] = {&a};
    hipError_t e = hipLaunchCooperativeKernel((void*)fwd_mega, dim3(grid), dim3(512), args, LDS_BYTES, stream);
    if (e != hipSuccess) fprintf(stderr, "cooperative launch failed: %s (grid %d)\n", hipGetErrorString(e), grid);
}
```

```cpp
#include <hip/hip_runtime.h>
#include <hip/hip_cooperative_groups.h>
#include <cstdio>
#include <cstdint>
#include <cmath>
namespace cg = cooperative_groups;
__device__ __forceinline__ int mk_ltid() { int t = threadIdx.x; asm volatile("" : "+v"(t)); return t; }
__device__ __forceinline__ int mk_bid() { int t = blockIdx.x; asm volatile("" : "+s"(t)); return t; }
__device__ __forceinline__ int mk_grid() { int t = gridDim.x; asm volatile("" : "+s"(t)); return t; }
namespace pg8 {
#define PG8_LAS __attribute__((address_space(3)))
typedef unsigned short bf16_t;
typedef short bf16x8 __attribute__((ext_vector_type(8)));
typedef float f32x4 __attribute__((ext_vector_type(4)));
typedef unsigned u32x4 __attribute__((ext_vector_type(4)));
constexpr int BM = 256, BK = 64, HALF = 128, HTB = HALF * BK * 2  , STAGE_BYTES = 8 * HTB, NXCD = 8, WGM = 4;

__host__ __device__ __forceinline__ int lds_byte(int r, int c) { const int st = (r >> 4) * 2 + (c >> 5), rr = r & 15, cc = c & 31, ob = rr * 64 + cc * 2; return st * 1024 + (ob ^ (((ob >> 9) & 1) << 5)); }
__host__ __device__ __forceinline__ void stage_rc(int b, int& R, int& C) { const int st = b / 1024, sb = b % 1024, swz = sb ^ (((sb >> 9) & 1) << 5); R = (st >> 1) * 16 + swz / 64; C = (st & 1) * 32 + (swz % 64) / 2; }
__host__ __device__ __forceinline__ int perm32(int rho) { const int n = rho >> 4, i = rho & 15; return 8 * (i >> 2) + 4 * n + (i & 3); }

struct Unit { int pm, pn; };
struct Gemm { const bf16_t* A; const bf16_t* Bt; int M, N, K; };

struct StaticOrder {
    int nM, nN, nwg, G, c;
    __host__ __device__ void init(int M, int N, int G_, int c_) { nM = M / BM; nN = N / BM; nwg = nM * nN; G = G_; c = c_; }
    __host__ __device__ bool next(int i, Unit& u) const {
        const long L = (long)i * G + c; if (L >= nwg) return false;
        int wgid = (int)L; { const int q = nwg / NXCD, r = nwg % NXCD, xcd = wgid % NXCD, off = wgid / NXCD; wgid = (xcd < r ? xcd * (q + 1) : r * (q + 1) + (xcd - r) * q) + off; }
        const int nig = WGM * nN, gid = wgid / nig, fm = gid * WGM, gsz = (nM - fm) < WGM ? (nM - fm) : WGM;
        u.pm = fm + ((wgid % nig) % gsz); u.pn = (wgid % nig) / gsz; return true;
    }
    __device__ __forceinline__ void a_ready(const Unit&) const {}
    __device__ __forceinline__ void done(const Unit&) const {}
};

__device__ __forceinline__ unsigned cvt_pk_bf16(float lo, float hi) { unsigned r; asm volatile("v_cvt_pk_bf16_f32 %0, %1, %2" : "=v"(r) : "v"(lo), "v"(hi)); return r; }
typedef float f32x2 __attribute__((ext_vector_type(2)));
template <int ACT  > struct EpiBf16 {
    static constexpr bool PERM = true, AFTER_DRAIN = false;
    bf16_t* O; int ldc; PG8_LAS const float* rl; int rbase;
    __device__ __forceinline__ void operator()(const f32x4 (&acc)[2][2][4][2], const Unit& u, int wr, int wc, int fr, int fq) const {
        const int row0 = u.pm * BM + wr * 64 + fr; const int col0 = u.pn * BM + wc * 32 + 8 * fq;
        float rs[2][4];
#pragma unroll
        for (int ai = 0; ai < 2; ++ai)
#pragma unroll
            for (int m = 0; m < 4; ++m) rs[ai][m] = rl[row0 + ai * HALF + m * 16 - rbase];
#pragma unroll
        for (int ai = 0; ai < 2; ++ai)
#pragma unroll
            for (int m = 0; m < 4; ++m) { bf16_t* rowp = O + (size_t)(row0 + ai * HALF + m * 16) * ldc + col0;
#pragma unroll
                for (int bj = 0; bj < 2; ++bj) { f32x4 v0 = acc[ai][bj][m][0] * rs[ai][m], v1 = acc[ai][bj][m][1] * rs[ai][m];
                    if (ACT == 2) {
#pragma unroll
                        for (int e = 0; e < 4; ++e) { float a = v0[e] > 0.f ? v0[e] : 0.f; v0[e] = a * a; float b = v1[e] > 0.f ? v1[e] : 0.f; v1[e] = b * b; } }
                    u32x4 w; w.x = cvt_pk_bf16(v0[0], v0[1]); w.y = cvt_pk_bf16(v0[2], v0[3]); w.z = cvt_pk_bf16(v1[0], v1[1]); w.w = cvt_pk_bf16(v1[2], v1[3]);
                    *(u32x4*)(rowp + bj * HALF) = w; } }
    }
};
struct EpiRes {
    static constexpr bool PERM = false, AFTER_DRAIN = false;
    const bf16_t* base; bf16_t* xb; int ldc; float* ssp; PG8_LAS float* red;
    __device__ __forceinline__ void operator()(const f32x4 (&acc)[2][2][4][2], const Unit& u, int wr, int wc, int fr, int fq) const {
        typedef unsigned u32x2_ __attribute__((ext_vector_type(2)));
        const int row0 = u.pm * BM + wr * 64 + fr; const int col0 = u.pn * BM + wc * 32 + 4 * fq;
#pragma unroll
        for (int ai = 0; ai < 2; ++ai)
#pragma unroll
            for (int m = 0; m < 4; ++m) { const size_t off = (size_t)(row0 + ai * HALF + m * 16) * ldc + col0; float q = 0.f;
                u32x2_ bv[2][2];
#pragma unroll
                for (int bj = 0; bj < 2; ++bj)
#pragma unroll
                    for (int n = 0; n < 2; ++n) bv[bj][n] = *(const u32x2_*)(base + off + bj * HALF + n * 16);
#pragma unroll
                for (int bj = 0; bj < 2; ++bj)
#pragma unroll
                    for (int n = 0; n < 2; ++n) { const u32x2_ bb = bv[bj][n]; f32x4 v = acc[ai][bj][m][n];
                        v[0] += __uint_as_float(bb.x << 16); v[1] += __uint_as_float(bb.x & 0xffff0000u); v[2] += __uint_as_float(bb.y << 16); v[3] += __uint_as_float(bb.y & 0xffff0000u);
                        u32x2_ w; w.x = cvt_pk_bf16(v[0], v[1]); w.y = cvt_pk_bf16(v[2], v[3]);
                        *(u32x2_*)(xb + off + bj * HALF + n * 16) = w;
                        q += (v[0] * v[0] + v[1] * v[1]) + (v[2] * v[2] + v[3] * v[3]); }
                q += __shfl_xor(q, 16); q += __shfl_xor(q, 32);
                if (fq == 0) red[wc * 256 + ai * HALF + wr * 64 + m * 16 + fr] = q; }
        asm volatile("s_waitcnt lgkmcnt(0)" ::: "memory"); __builtin_amdgcn_s_barrier(); asm volatile("" ::: "memory");
        const int t = threadIdx.x;
        if (t < 256) ssp[(size_t)u.pn * 16384 + u.pm * BM + t] = (red[t] + red[256 + t]) + (red[512 + t] + red[768 + t]);
    }
};
template <class Epi, class Sched, bool ALIGN_EPI = false, bool SP2 = false>
__device__ __forceinline__ void gemm_phase(PG8_LAS unsigned char* lds, const Gemm g, const Sched& S, const Epi& E) {
    const int tid = mk_ltid(), wid = __builtin_amdgcn_readfirstlane(tid >> 6), lane = tid & 63, wr = wid >> 2, wc = wid & 3, fr = lane & 15, fq = lane >> 4;
    const int K = g.K, nt = K / BK;
    unsigned voffA[2], voffB[2];
#pragma unroll
    for (int i = 0; i < 2; ++i) { int R, C; stage_rc(tid * 16 + i * 8192, R, C); const int Rb = Epi::PERM ? ((R & ~31) + perm32(R & 31)) : R;
        voffA[i] = (unsigned)(R * K + C) * 2u; voffB[i] = (unsigned)(Rb * K + C) * 2u; }
    const size_t kstep = (size_t)(BK * 2);
    const size_t hstep = (size_t)HALF * K * 2;
    const size_t tstep = 2 * hstep;
    const unsigned ldsw = (unsigned)wid * 1024u;
    const int aoff = lds_byte(wr * 64 + fr, fq * 8), boff = lds_byte(wc * 32 + fr, fq * 8);
#define PG8_SA(b, h) (((b) * 2 + (h)) * HTB)
#define PG8_SB(b, h) ((4 + (b) * 2 + (h)) * HTB)
#define PG8_STAGE(bufoff, gbase, voff) do { _Pragma("unroll") for (int _i = 0; _i < 2; ++_i) \
        __builtin_amdgcn_global_load_lds((const unsigned*)((const char*)(gbase) + (voff)[_i]), (PG8_LAS unsigned*)(lds + (bufoff) + ldsw + _i * 8192), 16, 0, 0); } while (0)
#define PG8_LDA(dst, b, h) do { _Pragma("unroll") for (int m = 0; m < 4; ++m) _Pragma("unroll") for (int k = 0; k < 2; ++k) dst[m][k] = *(const PG8_LAS bf16x8*)(lds + PG8_SA(b, h) + aoff + m * 2048 + k * 1024); } while (0)
#define PG8_LDB(dst, b, h) do { _Pragma("unroll") for (int n = 0; n < 2; ++n) _Pragma("unroll") for (int k = 0; k < 2; ++k) dst[n][k] = *(const PG8_LAS bf16x8*)(lds + PG8_SB(b, h) + boff + n * 2048 + k * 1024); } while (0)
#define PG8_MMA(ai, bj, At, Bt) do { __builtin_amdgcn_s_setprio(1); _Pragma("unroll") for (int m = 0; m < 4; ++m) _Pragma("unroll") for (int n = 0; n < 2; ++n) _Pragma("unroll") for (int k = 0; k < 2; ++k) \
        acc[ai][bj][m][n] = __builtin_amdgcn_mfma_f32_16x16x32_bf16(Bt[n][k], At[m][k], acc[ai][bj][m][n], 0, 0, 0); __builtin_amdgcn_s_setprio(0); } while (0)
#define PG8_WAIT_V(n) asm volatile("s_waitcnt vmcnt(" #n ")" ::: "memory")
#define PG8_WAIT_L(n) asm volatile("s_waitcnt lgkmcnt(" #n ")" ::: "memory")
#define PG8_BAR __builtin_amdgcn_s_barrier()
#define PG8_SCHED __builtin_amdgcn_sched_barrier(0)
    Unit cur, nxt; int ui = 0;
    if (!S.next(0, cur)) return;
    f32x4 acc[2][2][4][2];
#pragma unroll
    for (int a = 0; a < 2; ++a)
#pragma unroll
        for (int b = 0; b < 2; ++b)
#pragma unroll
            for (int m = 0; m < 4; ++m)
#pragma unroll
                for (int n = 0; n < 2; ++n) acc[a][b][m][n] = (f32x4){0.f, 0.f, 0.f, 0.f};
    bf16x8 At[4][2], B0[2][2], B1[2][2];
    const char* cA = (const char*)g.A + (size_t)cur.pm * tstep; const char* cB = (const char*)g.Bt + (size_t)cur.pn * tstep;
    S.a_ready(cur);
    if constexpr (SP2) {
        PG8_STAGE(PG8_SB(0, 0), cB, voffB); PG8_STAGE(PG8_SB(0, 1), cB + hstep, voffB); PG8_STAGE(PG8_SA(0, 0), cA, voffA); PG8_STAGE(PG8_SA(0, 1), cA + hstep, voffA);
        if (wr == 1) PG8_BAR;
        PG8_WAIT_V(2); PG8_BAR;
        PG8_STAGE(PG8_SB(1, 0), cB + kstep, voffB); PG8_STAGE(PG8_SA(1, 0), cA + kstep, voffA); PG8_STAGE(PG8_SB(1, 1), cB + hstep + kstep, voffB);
        PG8_WAIT_V(6); PG8_BAR;
    } else {
        PG8_STAGE(PG8_SB(0, 0), cB, voffB); PG8_STAGE(PG8_SA(0, 0), cA, voffA); PG8_STAGE(PG8_SB(0, 1), cB + hstep, voffB); PG8_STAGE(PG8_SA(0, 1), cA + hstep, voffA);
        if (wr == 1) PG8_BAR;
        PG8_WAIT_V(4); PG8_BAR;
        PG8_STAGE(PG8_SB(1, 0), cB + kstep, voffB); PG8_STAGE(PG8_SA(1, 0), cA + kstep, voffA); PG8_STAGE(PG8_SB(1, 1), cB + hstep + kstep, voffB);
        PG8_WAIT_V(6); PG8_BAR;
    }
    for (;;) {
        const bool has_next = S.next(ui + 1, nxt);
        const char* nA = has_next ? (const char*)g.A + (size_t)nxt.pm * tstep : cA; const char* nB = has_next ? (const char*)g.Bt + (size_t)nxt.pn * tstep : cB;
        for (int t = 0; t < nt; t += 2) {
            const bool last = (t == nt - 2);
            const char* a1 = cA + (size_t)(t + 1) * kstep;
            const char* a2 = last ? nA : cA + (size_t)(t + 2) * kstep; const char* b2 = last ? nB : cB + (size_t)(t + 2) * kstep;
            const char* a3 = a2 + kstep; const char* b3 = b2 + kstep;
            if (last && has_next) S.a_ready(nxt);
            if constexpr (SP2) {
            PG8_LDB(B0, 0, 0); PG8_LDB(B1, 0, 1); PG8_SCHED; PG8_LDA(At, 0, 0); PG8_STAGE(PG8_SA(1, 1), a1 + hstep, voffA);
            PG8_WAIT_V(8); PG8_WAIT_L(0); PG8_BAR; PG8_MMA(0, 0, At, B0); PG8_MMA(0, 1, At, B1); PG8_BAR; PG8_SCHED;
            PG8_LDA(At, 0, 1); PG8_STAGE(PG8_SB(0, 0), b2, voffB); PG8_STAGE(PG8_SB(0, 1), b2 + hstep, voffB); PG8_STAGE(PG8_SA(0, 0), a2, voffA);
            PG8_WAIT_V(8); PG8_WAIT_L(0); PG8_BAR; PG8_MMA(1, 0, At, B0); PG8_MMA(1, 1, At, B1); PG8_BAR; PG8_SCHED;
            PG8_LDB(B0, 1, 0); PG8_LDB(B1, 1, 1); PG8_SCHED; PG8_LDA(At, 1, 0); PG8_STAGE(PG8_SA(0, 1), a2 + hstep, voffA);
            PG8_WAIT_V(8); PG8_WAIT_L(0); PG8_BAR; PG8_MMA(0, 0, At, B0); PG8_MMA(0, 1, At, B1); PG8_BAR; PG8_SCHED;
            PG8_LDA(At, 1, 1); PG8_STAGE(PG8_SB(1, 0), b3, voffB); PG8_STAGE(PG8_SB(1, 1), b3 + hstep, voffB); PG8_STAGE(PG8_SA(1, 0), a3, voffA);
            PG8_WAIT_V(8); PG8_WAIT_L(0); PG8_BAR; PG8_MMA(1, 0, At, B0); PG8_MMA(1, 1, At, B1); PG8_BAR; PG8_SCHED;
            } else {
            PG8_LDB(B0, 0, 0); PG8_SCHED; PG8_LDA(At, 0, 0); PG8_STAGE(PG8_SA(1, 1), a1 + hstep, voffA);
            PG8_WAIT_L(8); PG8_BAR; PG8_WAIT_L(0); PG8_MMA(0, 0, At, B0); PG8_BAR; PG8_SCHED;
            PG8_LDB(B1, 0, 1); PG8_STAGE(PG8_SB(0, 0), b2, voffB);
            PG8_BAR; PG8_WAIT_L(0); PG8_MMA(0, 1, At, B1); PG8_BAR;
            PG8_LDA(At, 0, 1); PG8_STAGE(PG8_SA(0, 0), a2, voffA);
            PG8_BAR; PG8_WAIT_L(0); PG8_MMA(1, 0, At, B0); PG8_BAR; PG8_SCHED;
            PG8_STAGE(PG8_SB(0, 1), b2 + hstep, voffB);
            PG8_WAIT_V(6); PG8_BAR; PG8_MMA(1, 1, At, B1); PG8_BAR;
            PG8_LDB(B0, 1, 0); PG8_SCHED; PG8_LDA(At, 1, 0); PG8_STAGE(PG8_SA(0, 1), a2 + hstep, voffA);
            PG8_WAIT_L(8); PG8_BAR; PG8_WAIT_L(0); PG8_MMA(0, 0, At, B0); PG8_BAR; PG8_SCHED;
            PG8_LDB(B1, 1, 1); PG8_STAGE(PG8_SB(1, 0), b3, voffB);
            PG8_BAR; PG8_WAIT_L(0); PG8_MMA(0, 1, At, B1); PG8_BAR;
            PG8_LDA(At, 1, 1); PG8_STAGE(PG8_SA(1, 0), a3, voffA);
            PG8_BAR; PG8_WAIT_L(0); PG8_MMA(1, 0, At, B0); PG8_BAR; PG8_SCHED;
            PG8_STAGE(PG8_SB(1, 1), b3 + hstep, voffB);
            PG8_WAIT_V(6); PG8_BAR; PG8_MMA(1, 1, At, B1); PG8_BAR;
            }
        }
        if constexpr (ALIGN_EPI) { if (wr == 0) PG8_BAR; }
        if constexpr (!Epi::AFTER_DRAIN) { E(acc, cur, wr, wc, fr, fq); S.done(cur); }
        if (!has_next) break;
#pragma unroll
        for (int a = 0; a < 2; ++a)
#pragma unroll
            for (int b = 0; b < 2; ++b)
#pragma unroll
                for (int m = 0; m < 4; ++m)
#pragma unroll
                    for (int n = 0; n < 2; ++n) acc[a][b][m][n] = (f32x4){0.f, 0.f, 0.f, 0.f};
        cur = nxt; cA = nA; cB = nB; ++ui;
        if constexpr (ALIGN_EPI) { if (wr == 1) PG8_BAR; }
    }
    PG8_WAIT_V(0);
    if constexpr (!ALIGN_EPI) { if (wr == 0) PG8_BAR; }
    PG8_BAR;
    if constexpr (Epi::AFTER_DRAIN) { E.fused(acc, cur, wr, wc, fr, fq, lds, wid, lane); S.done(cur); }
#undef PG8_SA
#undef PG8_SB
#undef PG8_STAGE
#undef PG8_LDA
#undef PG8_LDB
#undef PG8_MMA
#undef PG8_WAIT_V
#undef PG8_WAIT_L
#undef PG8_BAR
#undef PG8_SCHED
}
}

#define LAS __attribute__((address_space(3)))
typedef unsigned short bf16_t;
typedef short v8s __attribute__((ext_vector_type(8)));
typedef short v4s __attribute__((ext_vector_type(4)));
typedef float v4f __attribute__((ext_vector_type(4)));
typedef float v16f __attribute__((ext_vector_type(16)));
typedef unsigned v4u __attribute__((ext_vector_type(4)));
typedef unsigned v2u __attribute__((ext_vector_type(2)));

constexpr int DM = 2048, NB = 4, SEQ = 4096, MTOK = NB * SEQ, DFF = 8192;
constexpr int EVEN_IN = 3376, EVEN_PAD = 3584, ODD_IN = 6176, ODD_PAD = 6400;
constexpr int E_QA = 0, E_KA = 1024, E_VA = 1280, E_QB = 1536, E_KC = 2560, E_VC = 2688, E_KS = 2816, E_VS = 2944, E_KW = 3072, E_VW = 3200, E_GT = 3328;
constexpr int O_Q = 0, O_K = 2048, O_V = 4096, O_F = 6144;
constexpr float LOG2E = 1.4426950408889634f;
constexpr float C1 = 0.125f * LOG2E;
constexpr float RMS_EPS = 1e-6f;

constexpr size_t MiB = 1u << 20;
constexpr size_t WS_WUP = 16 * MiB, WS_WDN = 144 * MiB, WS_WIE = 272 * MiB, WS_WIO = 300 * MiB, WS_WOE = 350 * MiB, WS_WOO = 366 * MiB;
constexpr size_t WS_CW1 = 382 * MiB, WS_CW2 = 386 * MiB, WS_KCMP = 387 * MiB, WS_VCMP = 387 * MiB + 512 * 1024, WS_C = 388 * MiB, WS_SSP = 390 * MiB;
constexpr size_t WS_XN = 392 * MiB, WS_QKV = 456 * MiB, WS_AO = 656 * MiB, WS_H = 456 * MiB, WS_SCR = 720 * MiB, WS_END = 736 * MiB;

constexpr int KP = 144, VP = 144, TILEB = 64 * 144;
constexpr int LDS_BYTES = 160 * 1024;

struct Args { const float* in[19]; float* out; unsigned char* ws; };
__device__ __forceinline__ const unsigned char __attribute__((address_space(4)))* karg_base() {
    const unsigned char __attribute__((address_space(4)))* kp = (const unsigned char __attribute__((address_space(4)))*)__builtin_amdgcn_kernarg_segment_ptr();
    asm volatile("" : "+s"(kp)); return kp; }
__device__ __forceinline__ const float* arg_in(int i) { return *(const float* const __attribute__((address_space(4)))*)(karg_base() + 8 * i); }
__device__ __forceinline__ float* arg_out() { return *(float* const __attribute__((address_space(4)))*)(karg_base() + 8 * 19); }
__device__ __forceinline__ unsigned char* arg_ws() { return *(unsigned char* const __attribute__((address_space(4)))*)(karg_base() + 8 * 20); }

__device__ __forceinline__ unsigned pkbf(float lo, float hi) {
    typedef float f2 __attribute__((ext_vector_type(2))); typedef __bf16 b2 __attribute__((ext_vector_type(2)));
    f2 v = {lo, hi}; b2 b = __builtin_convertvector(v, b2); return __builtin_bit_cast(unsigned, b);
}
__device__ __forceinline__ float bf2f(unsigned short u) { return __uint_as_float(((unsigned)u) << 16); }
__device__ __forceinline__ float ex2(float x) { return __builtin_amdgcn_exp2f(x); }
__device__ __forceinline__ void lds_add(LAS unsigned* p, unsigned v) { (void)__hip_atomic_fetch_add(p, v, __ATOMIC_RELAXED, __HIP_MEMORY_SCOPE_WORKGROUP); }
__device__ __forceinline__ void lds_or(LAS unsigned* p, unsigned v) { (void)__hip_atomic_fetch_or(p, v, __ATOMIC_RELAXED, __HIP_MEMORY_SCOPE_WORKGROUP); }
__device__ __forceinline__ int crow(int r, int hi) { return (r & 3) + 8 * (r >> 2) + 4 * hi; }
__device__ __forceinline__ v16f mfma32(v8s a, v8s b, v16f c) { return __builtin_amdgcn_mfma_f32_32x32x16_bf16(a, b, c, 0, 0, 0); }
__device__ __forceinline__ float wave_sum(float v) {
#pragma unroll
    for (int o = 1; o < 64; o <<= 1) v += __shfl_xor(v, o);
    return v;
}

__device__ __forceinline__ void tr_load(float (&v)[32], const float* W, int K, int N, int item, int lane) {
    const int nblk = (N + 31) / 32, kb = item / nblk, nb = item - kb * nblk, k0 = 64 * kb, n0 = 32 * nb;
    const int nn = n0 + (lane & 31); const bool ok = nn < N;
    const float* p = W + (size_t)(k0 + (lane >> 5)) * N + (ok ? nn : 0);
#pragma unroll
    for (int i = 0; i < 32; ++i) { const float x = p[(size_t)(2 * i) * N]; v[i] = ok ? x : 0.f; }
}
__device__ __forceinline__ void tr_put(const float (&v)[32], LAS float* scr, int lane) {
#pragma unroll
    for (int i = 0; i < 32; ++i) scr[(2 * i + (lane >> 5)) * 33 + (lane & 31)] = v[i];
}
__device__ __forceinline__ void tr_put_gain(const float (&v)[32], LAS float* scr, int lane, const LAS float* gk) {
#pragma unroll
    for (int i = 0; i < 32; ++i) scr[(2 * i + (lane >> 5)) * 33 + (lane & 31)] = v[i] * gk[2 * i + (lane >> 5)];
}
__device__ __forceinline__ void tr_store(bf16_t* WT, int K, int N, LAS float* scr, int item, int lane) {
    const int nblk = (N + 31) / 32, kb = item / nblk, nb = item - kb * nblk, k0 = 64 * kb, n0 = 32 * nb;
    const int c = lane & 7;
#pragma unroll
    for (int j = 0; j < 4; ++j) { const int n = (lane >> 3) + 8 * j; const LAS float* s = scr + (8 * c) * 33 + n;
        v4u o; o.x = pkbf(s[0 * 33], s[1 * 33]); o.y = pkbf(s[2 * 33], s[3 * 33]); o.z = pkbf(s[4 * 33], s[5 * 33]); o.w = pkbf(s[6 * 33], s[7 * 33]);
        *(v4u*)(WT + (size_t)(n0 + n) * K + k0 + 8 * c) = o; }
}

__device__ __forceinline__ void prologue_phase(LAS unsigned char* lds) {
    const int tid = mk_ltid(), lane = tid & 63, wave = __builtin_amdgcn_readfirstlane(tid >> 6);
    LAS float* scr = (LAS float*)(lds + wave * 16384);
    const int gw = mk_bid() * 8 + wave, NGW = mk_grid() * 8;
    for (int mi = 0; mi < 24; ++mi) {
        unsigned char* ws = arg_ws();
        const float* W; int K, N; bf16_t* WT; const float* g = nullptr;
        if (mi < 4) { W = arg_in(17) + (size_t)mi * DM * DFF; K = DM; N = DFF; WT = (bf16_t*)(ws + WS_WUP) + (size_t)mi * DFF * DM; g = arg_in(3) + mi * DM; }
        else if (mi < 8) { const int L = mi - 4; W = arg_in(18) + (size_t)L * DFF * DM; K = DFF; N = DM; WT = (bf16_t*)(ws + WS_WDN) + (size_t)L * DM * DFF; }
        else if (mi < 10) { const int e = mi - 8; W = arg_in(5) + (size_t)e * DM * EVEN_IN; K = DM; N = EVEN_IN; WT = (bf16_t*)(ws + WS_WIE) + (size_t)e * EVEN_PAD * DM; g = arg_in(2) + (2 * e) * DM; }
        else if (mi < 12) { const int e = mi - 10; W = arg_in(14) + (size_t)e * DM * ODD_IN; K = DM; N = ODD_IN; WT = (bf16_t*)(ws + WS_WIO) + (size_t)e * ODD_PAD * DM; g = arg_in(2) + (2 * e + 1) * DM; }
        else if (mi < 14) { const int e = mi - 12; W = arg_in(6) + (size_t)e * DM * DM; K = DM; N = DM; WT = (bf16_t*)(ws + WS_WOE) + (size_t)e * DM * DM; }
        else if (mi < 16) { const int e = mi - 14; W = arg_in(15) + (size_t)e * DM * DM; K = DM; N = DM; WT = (bf16_t*)(ws + WS_WOO) + (size_t)e * DM * DM; }
        else if (mi < 20) { const int e = (mi - 16) & 1, kv = (mi - 16) >> 1; W = arg_in(kv ? 12 : 10) + (size_t)e * 2048 * 256; K = 2048; N = 256; WT = (bf16_t*)(ws + WS_CW1) + (size_t)(e * 2 + kv) * 256 * 2048; }
        else { const int e = (mi - 20) & 1, kv = (mi - 20) >> 1; W = arg_in(kv ? 13 : 11) + (size_t)e * 256 * 64; K = 256; N = 64; WT = (bf16_t*)(ws + WS_CW2) + (size_t)(e * 2 + kv) * 64 * 256; }
        const int nitems = (K / 64) * ((N + 31) / 32), nblk = (N + 31) / 32;
        LAS float* SG = scr + 64 * 33;
        float v[32]; float gv = 1.f;
        int it = gw;
        if (it < nitems) { tr_load(v, W, K, N, it, lane); if (g) gv = g[64 * (it / nblk) + lane]; }
        while (it < nitems) {
            if (g) { SG[lane] = gv; tr_put_gain(v, scr, lane, SG); } else tr_put(v, scr, lane);
            const int nx = it + NGW;
            if (nx < nitems) { tr_load(v, W, K, N, nx, lane); if (g) gv = g[64 * (nx / nblk) + lane]; }
            asm volatile("s_waitcnt lgkmcnt(0)" ::: "memory");
            tr_store(WT, K, N, scr, it, lane);
            asm volatile("s_waitcnt lgkmcnt(0)" ::: "memory");
            it = nx;
        }
    }
}

__device__ __forceinline__ void prep_phase(const float* X, bf16_t* XB, float* SSP) {
    const int tid = mk_ltid(), lane = tid & 63, wave = tid >> 6;
    const int gw = mk_bid() * 8 + wave, NGW = mk_grid() * 8;
    for (int m = gw; m < MTOK; m += NGW) {
        const v4f* xr = (const v4f*)(X + (size_t)m * DM) + lane;
        v2u* o = (v2u*)(XB + (size_t)m * DM) + lane;
        float s = 0.f;
#pragma unroll
        for (int j = 0; j < 8; ++j) { const v4f v = xr[64 * j]; s += (v.x * v.x + v.y * v.y) + (v.z * v.z + v.w * v.w); v2u w; w.x = pkbf(v.x, v.y); w.y = pkbf(v.z, v.w); o[64 * j] = w; }
        s = wave_sum(s);
        if (lane < 8) SSP[(size_t)lane * MTOK + m] = (lane == 0) ? s : 0.f;
    }
}
__device__ __forceinline__ void rs_table(LAS float* RL, const float* SSP, int rbase) {
    const int tid = mk_ltid();
#pragma unroll
    for (int i = 0; i < 4; ++i) { const int row = rbase + tid + 512 * i; float s = 0.f;
#pragma unroll
        for (int p = 0; p < 8; ++p) s += SSP[(size_t)p * MTOK + row];
        RL[tid + 512 * i] = 1.0f / sqrtf(s * (1.f / DM) + RMS_EPS); }
    __syncthreads();
}

__device__ __forceinline__ void final_norm_phase(const bf16_t* XB, const float* g, float* OUT) {
    const int tid = mk_ltid(), lane = tid & 63, wave = tid >> 6;
    const int gw = mk_bid() * 8 + wave, NGW = mk_grid() * 8;
    v4f gv[8];
#pragma unroll
    for (int j = 0; j < 8; ++j) gv[j] = *((const v4f*)g + lane + 64 * j);
    for (int m = gw; m < MTOK; m += NGW) {
        const v2u* xr = (const v2u*)(XB + (size_t)m * DM) + lane;
        v4f v[8]; float s = 0.f;
#pragma unroll
        for (int j = 0; j < 8; ++j) { const v2u w = xr[64 * j]; v[j] = (v4f){__uint_as_float(w.x << 16), __uint_as_float(w.x & 0xffff0000u), __uint_as_float(w.y << 16), __uint_as_float(w.y & 0xffff0000u)};
            s += (v[j].x * v[j].x + v[j].y * v[j].y) + (v[j].z * v[j].z + v[j].w * v[j].w); }
        const float r = 1.0f / sqrtf(wave_sum(s) * (1.f / DM) + RMS_EPS);
        v4f* o = (v4f*)(OUT + (size_t)m * DM) + lane;
#pragma unroll
        for (int j = 0; j < 8; ++j) o[64 * j] = v[j] * r * gv[j];
    }
}
__device__ __forceinline__ void norm_phase(const float* X, const float* g, bf16_t* XN, float* OUTF) {
    const int tid = mk_ltid(), lane = tid & 63, wave = tid >> 6;
    const int gw = mk_bid() * 8 + wave, NGW = mk_grid() * 8;
    v4f gv[8];
#pragma unroll
    for (int j = 0; j < 8; ++j) gv[j] = *((const v4f*)g + lane + 64 * j);
    for (int m = gw; m < MTOK; m += NGW) {
        const v4f* xr = (const v4f*)(X + (size_t)m * DM) + lane;
        v4f v[8]; float s = 0.f;
#pragma unroll
        for (int j = 0; j < 8; ++j) { v[j] = xr[64 * j]; s += (v[j].x * v[j].x + v[j].y * v[j].y) + (v[j].z * v[j].z + v[j].w * v[j].w); }
        const float r = 1.0f / sqrtf(wave_sum(s) * (1.f / DM) + RMS_EPS);
        if (OUTF) {
            v4f* o = (v4f*)(OUTF + (size_t)m * DM) + lane;
#pragma unroll
            for (int j = 0; j < 8; ++j) o[64 * j] = v[j] * r * gv[j];
        } else {
            v2u* o = (v2u*)(XN + (size_t)m * DM) + lane;
#pragma unroll
            for (int j = 0; j < 8; ++j) { const v4f y = v[j] * r * gv[j]; v2u w; w.x = pkbf(y.x, y.y); w.y = pkbf(y.z, y.w); o[64 * j] = w; }
        }
    }
}

constexpr int KTB = 64 * KP, VHB = 4096 + 64, VTB = 2 * VHB;
constexpr int ATT_K = 0, ATT_V = 3 * KTB, ATT_AUX = ATT_V + 3 * VTB, ATT_END = ATT_AUX + 3 * 64 * 4 + 128;
static_assert(ATT_END == 53504, "attention LDS map");

__device__ __forceinline__ void qk_tile(const LAS unsigned char* Kt, const v8s (&qf)[4], v16f& p0, v16f& p1, int r32, int hi) {
    const LAS unsigned char* kb = Kt + r32 * KP + hi * 16;
    v16f z;
#pragma unroll
    for (int r = 0; r < 16; ++r) z[r] = 0.f;
    p0 = z; p1 = z;
#pragma unroll
    for (int s = 0; s < 4; ++s) {
        const v8s a0 = *(const LAS v8s*)(kb + s * 32);
        const v8s a1 = *(const LAS v8s*)(kb + 32 * KP + s * 32);
        p0 = mfma32(a0, qf[s], p0); p1 = mfma32(a1, qf[s], p1);
    }
}
__device__ __forceinline__ v4s trrd(const LAS unsigned char* p) { return __builtin_bit_cast(v4s, __builtin_amdgcn_ds_read_tr16_b64_v4i16((LAS v4s*)p)); }
__device__ __forceinline__ void pv_tile(const LAS unsigned char* Vt, const v16f& p0, const v16f& p1, v16f (&oT)[2], int lane) {
    const int hi = lane >> 5;
    v4u w[4];
    w[0] = (v4u){pkbf(p0[0], p0[1]), pkbf(p0[2], p0[3]), pkbf(p0[4], p0[5]), pkbf(p0[6], p0[7])};
    w[1] = (v4u){pkbf(p0[8], p0[9]), pkbf(p0[10], p0[11]), pkbf(p0[12], p0[13]), pkbf(p0[14], p0[15])};
    w[2] = (v4u){pkbf(p1[0], p1[1]), pkbf(p1[2], p1[3]), pkbf(p1[4], p1[5]), pkbf(p1[6], p1[7])};
    w[3] = (v4u){pkbf(p1[8], p1[9]), pkbf(p1[10], p1[11]), pkbf(p1[12], p1[13]), pkbf(p1[14], p1[15])};
    const LAS unsigned char* vb = Vt + (4 * hi + ((lane & 15) >> 2)) * 64 + (16 * ((lane >> 4) & 1) + 4 * (lane & 3)) * 2;
#pragma unroll
    for (int dt = 0; dt < 2; ++dt)
#pragma unroll
        for (int ks = 0; ks < 4; ++ks) {
            const int kvb = 16 * (ks & 1) + 32 * (ks >> 1);
            const v4s lo = trrd(vb + dt * VHB + kvb * 64), h4 = trrd(vb + dt * VHB + (kvb + 8) * 64);
            const v8s af = (v8s){lo[0], lo[1], lo[2], lo[3], h4[0], h4[1], h4[2], h4[3]};
            oT[dt] = mfma32(af, __builtin_bit_cast(v8s, w[ks]), oT[dt]);
        }
}

__device__ __forceinline__ void k_load(const LAS unsigned char* Kt, v8s (&kf)[8], int r32, int hi) {
    const LAS unsigned char* kb = Kt + r32 * KP + hi * 16;
#pragma unroll
    for (int s = 0; s < 4; ++s) { kf[2 * s] = *(const LAS v8s*)(kb + s * 32); kf[2 * s + 1] = *(const LAS v8s*)(kb + 32 * KP + s * 32); }
}
__device__ __forceinline__ void qk_mma(const v8s (&kf)[8], const v8s (&qf)[4], v16f& p0, v16f& p1) {
    v16f z;
#pragma unroll
    for (int r = 0; r < 16; ++r) z[r] = 0.f;
    p0 = z; p1 = z;
#pragma unroll
    for (int s = 0; s < 4; ++s) { p0 = mfma32(kf[2 * s], qf[s], p0); p1 = mfma32(kf[2 * s + 1], qf[s], p1); }
}
__device__ __forceinline__ void v_load(const LAS unsigned char* Vt, v4s (&vf)[16], int lane) {
    const int hi = lane >> 5;
    const LAS unsigned char* vb = Vt + (4 * hi + ((lane & 15) >> 2)) * 64 + (16 * ((lane >> 4) & 1) + 4 * (lane & 3)) * 2;
#pragma unroll
    for (int ks = 0; ks < 4; ++ks)
#pragma unroll
        for (int dt = 0; dt < 2; ++dt) {
            const int kvb = 16 * (ks & 1) + 32 * (ks >> 1);
            vf[4 * ks + 2 * dt] = trrd(vb + dt * VHB + kvb * 64); vf[4 * ks + 2 * dt + 1] = trrd(vb + dt * VHB + (kvb + 8) * 64);
        }
}
__device__ __forceinline__ void pv_mma(const v4s (&vf)[16], const v16f& p0, const v16f& p1, v16f (&oT)[2]) {
    v4u w[4];
    w[0] = (v4u){pkbf(p0[0], p0[1]), pkbf(p0[2], p0[3]), pkbf(p0[4], p0[5]), pkbf(p0[6], p0[7])};
    w[1] = (v4u){pkbf(p0[8], p0[9]), pkbf(p0[10], p0[11]), pkbf(p0[12], p0[13]), pkbf(p0[14], p0[15])};
    w[2] = (v4u){pkbf(p1[0], p1[1]), pkbf(p1[2], p1[3]), pkbf(p1[4], p1[5]), pkbf(p1[6], p1[7])};
    w[3] = (v4u){pkbf(p1[8], p1[9]), pkbf(p1[10], p1[11]), pkbf(p1[12], p1[13]), pkbf(p1[14], p1[15])};
#pragma unroll
    for (int ks = 0; ks < 4; ++ks)
#pragma unroll
        for (int dt = 0; dt < 2; ++dt) {
            const v4s lo = vf[4 * ks + 2 * dt], h4 = vf[4 * ks + 2 * dt + 1];
            const v8s af = (v8s){lo[0], lo[1], lo[2], lo[3], h4[0], h4[1], h4[2], h4[3]};
            oT[dt] = mfma32(af, __builtin_bit_cast(v8s, w[ks]), oT[dt]);
        }
}
#ifndef SM_THR
#define SM_THR 16.0f
#endif
__device__ __forceinline__ float max3f(float a, float b, float c) { return __builtin_fmaxf(__builtin_fmaxf(a, b), c); }
__device__ __forceinline__ float xhalf_max(float v) {
    const auto rr = __builtin_amdgcn_permlane32_swap(__float_as_uint(v), __float_as_uint(v), false, false);
    return __builtin_fmaxf(__uint_as_float(rr[0]), __uint_as_float(rr[1]));
}
__device__ __forceinline__ void softmax_step(v16f& p0, v16f& p1, v16f (&oT)[2], float& m, float& l, bool rowok) {
    float a = max3f(p0[0], p0[1], p1[0]), b = max3f(p0[2], p0[3], p1[1]); a = max3f(a, p1[2], p1[3]);
#pragma unroll
    for (int r = 4; r < 16; r += 4) { a = max3f(a, p0[r], p0[r + 1]); b = max3f(b, p0[r + 2], p0[r + 3]); a = max3f(a, p1[r], p1[r + 1]); b = max3f(b, p1[r + 2], p1[r + 3]); }
    float mx = fmaxf(a, b);
    mx = xhalf_max(mx);
    if (!rowok) mx = -INFINITY;
    float mn = m;
    if (__any(mx > m + SM_THR)) {
        mn = fmaxf(m, mx);
        const float mu_ = (mn == -INFINITY) ? 0.f : mn;
        const float alpha = ex2(m - mu_);
        oT[0] = oT[0] * alpha; oT[1] = oT[1] * alpha; l *= alpha;
    }
    const float mu = (mn == -INFINITY) ? 0.f : mn;
    const float mue = rowok ? mu : INFINITY;
    p0 = p0 - mue; p1 = p1 - mue;
#pragma unroll
    for (int r = 0; r < 16; ++r) { p0[r] = ex2(p0[r]); p1[r] = ex2(p1[r]); }
    const v16f s = p0 + p1;
    l += ((s[0] + s[1]) + (s[2] + s[3])) + ((s[4] + s[5]) + (s[6] + s[7])) + (((s[8] + s[9]) + (s[10] + s[11])) + ((s[12] + s[13]) + (s[14] + s[15])));
    m = mn;
}
__device__ __forceinline__ v4u ld_tile(const bf16_t* base, int row0, int pitch, int tid) { return *(const v4u*)(base + (size_t)(row0 + (tid >> 3)) * pitch + (tid & 7) * 8); }
__device__ __forceinline__ void st_k(LAS unsigned char* T, v4u v, int tid) { *(LAS v4u*)(T + (tid >> 3) * KP + (tid & 7) * 16) = v; }
__device__ __forceinline__ void st_v(LAS unsigned char* T, v4u v, int tid) { *(LAS v4u*)(T + ((tid >> 2) & 1) * VHB + (tid >> 3) * 64 + (tid & 3) * 16) = v; }
__device__ __forceinline__ void store_o(bf16_t* Orow, const v16f (&o)[2], int hi) {
#pragma unroll
    for (int dt = 0; dt < 2; ++dt)
#pragma unroll
        for (int g = 0; g < 4; ++g) { v2u w; w.x = pkbf(o[dt][4 * g], o[dt][4 * g + 1]); w.y = pkbf(o[dt][4 * g + 2], o[dt][4 * g + 3]);
            *(v2u*)(Orow + dt * 32 + 8 * g + 4 * hi) = w; }
}
__device__ __forceinline__ int rel_bucket(int n) {
    if (n < 16) return n;
    const float v = __log2f((float)n * (1.f / 16.f)) * (16.f / 6.f) + 1e-5f;
    const int b = 16 + (int)v; return b < 31 ? b : 31;
}

template <bool AUX, int VAR = 0, class Seq, class Sc>
__device__ __forceinline__ void attn_engine(LAS unsigned char* lds, const bf16_t* Kg, const bf16_t* Vg, int pitch, const float* auxg, Seq seq, const v8s (&qf)[4],
                                            v16f (&oT)[2], float& m, float& l, const Sc& sc, int tid, int lane) {
    const int r32 = lane & 31, hi = lane >> 5;
    int tc = seq.pop(); if (tc < 0) return;
    int tn = seq.pop(), tnn = (tn >= 0) ? seq.pop() : -1;
    LAS float* AUXL = (LAS float*)(lds + ATT_AUX);
    v4u kr = ld_tile(Kg, 64 * tc, pitch, tid), vr = ld_tile(Vg, 64 * tc, pitch, tid); float ar = 0.f;
    if (AUX && tid < 64) ar = auxg[64 * tc + tid];
    v4u kr2 = kr, vr2 = vr; float ar2 = 0.f;
    if (tn >= 0) { kr2 = ld_tile(Kg, 64 * tn, pitch, tid); vr2 = ld_tile(Vg, 64 * tn, pitch, tid); if (AUX && tid < 64) ar2 = auxg[64 * tn + tid]; }
    __syncthreads();
    st_k(lds + ATT_K, kr, tid); st_v(lds + ATT_V, vr, tid); if (AUX && tid < 64) AUXL[tid] = ar;
    if (tn >= 0) { st_k(lds + ATT_K + KTB, kr2, tid); st_v(lds + ATT_V + VTB, vr2, tid); if (AUX && tid < 64) AUXL[64 + tid] = ar2; }
    if (tnn >= 0) { kr = ld_tile(Kg, 64 * tnn, pitch, tid); vr = ld_tile(Vg, 64 * tnn, pitch, tid); if (AUX && tid < 64) ar = auxg[64 * tnn + tid]; }
    __syncthreads();
    v16f a0, a1, b0, b1;
    int bi = 0;
    if (sc.active(tc)) { qk_tile(lds + ATT_K, qf, a0, a1, r32, hi); sc.apply(a0, a1, tc, AUXL); }
#define ATT_STEP(C0, C1, N0, N1) { \
        __syncthreads(); \
        const int b2_ = (bi >= 1) ? bi - 1 : 2, b1_ = (bi == 2) ? 0 : bi + 1; int t3_ = -1; \
        if (tnn >= 0) { st_k(lds + ATT_K + b2_ * KTB, kr, tid); st_v(lds + ATT_V + b2_ * VTB, vr, tid); if (AUX && tid < 64) AUXL[b2_ * 64 + tid] = ar; \
            t3_ = seq.pop(); \
            if (t3_ >= 0 && VAR != 3) { kr = ld_tile(Kg, 64 * t3_, pitch, tid); vr = ld_tile(Vg, 64 * t3_, pitch, tid); if (AUX && tid < 64) ar = auxg[64 * t3_ + tid]; } } \
        const bool actn_ = (tn >= 0) && sc.active(tn), actc_ = sc.active(tc); \
        v8s kf_[8]; v4s vf_[16]; \
        if (actn_) { k_load(lds + ATT_K + b1_ * KTB, kf_, r32, hi); __builtin_amdgcn_sched_barrier(0); if (VAR != 2) qk_mma(kf_, qf, N0, N1); else { N0 = oT[0] + __builtin_bit_cast(v4f, kf_[0])[0]; N1 = oT[1] + __builtin_bit_cast(v4f, kf_[5])[1]; } } \
        __builtin_amdgcn_sched_barrier(0); \
        if (actc_) v_load(lds + ATT_V + bi * VTB, vf_, lane); \
        __builtin_amdgcn_sched_barrier(0); \
        if (actc_) { if (VAR != 1) softmax_step(C0, C1, oT, m, l, sc.rowok(tc)); if (VAR != 2) pv_mma(vf_, C0, C1, oT); else { oT[0] = oT[0] + C0 * __builtin_bit_cast(v2u, vf_[3])[0]; oT[1] = oT[1] + C1 * __builtin_bit_cast(v2u, vf_[9])[1]; } } \
        if (actn_) sc.apply(N0, N1, tn, AUXL + b1_ * 64); \
        tc = tn; tn = tnn; tnn = t3_; bi = b1_; \
        if (tc < 0) break; }
    for (;;) {
        ATT_STEP(a0, a1, b0, b1)
        ATT_STEP(b0, b1, a0, a1)
    }
#undef ATT_STEP
}
struct RangeSeq { int cur, last; __device__ __forceinline__ int pop() { const int t = cur; if (t > last) return -1; cur = t + 1; return t; } };
struct MaskSeq { unsigned long long rem; __device__ __forceinline__ int pop() { if (rem == 0ull) return -1; const int t = __builtin_ctzll(rem); rem &= rem - 1ull; return t; } };

__device__ __forceinline__ void cumsum_phase(LAS unsigned char* lds, const bf16_t* QKV, const float* fb, float* CL2) {
    const int tid = mk_ltid(), lane = tid & 63, wave = tid >> 6;
    LAS float* wtot = (LAS float*)lds;
    for (int u = mk_bid(); u < NB * 32; u += mk_grid()) {
        const int b = u >> 5, h = u & 31; const float bias = fb[h];
        float v[8]; float run = 0.f;
#pragma unroll
        for (int i = 0; i < 8; ++i) { const int t = tid * 8 + i; const float x = bf2f(QKV[(size_t)(b * SEQ + t) * ODD_PAD + O_F + h]) + bias;
            const float ls = fminf(x, 0.f) - log1pf(expf(-fabsf(x))); run += ls; v[i] = run; }
        float inc = run;
#pragma unroll
        for (int o = 1; o < 64; o <<= 1) { const float t = __shfl_up(inc, o); if (lane >= o) inc += t; }
        __syncthreads();
        if (lane == 63) wtot[wave] = inc;
        __syncthreads();
        float off = inc - run;
        for (int w2 = 0; w2 < wave; ++w2) off += wtot[w2];
        float* o = CL2 + (size_t)u * SEQ + tid * 8;
#pragma unroll
        for (int i = 0; i < 8; ++i) o[i] = (v[i] + off) * LOG2E;
    }
}

struct FoxSc {
    int qw0, qpos, hi;
    __device__ __forceinline__ bool active(int t) const { return 64 * t <= qw0 + 31; }
    __device__ __forceinline__ bool rowok(int) const { return true; }
    __device__ __forceinline__ void apply(v16f& p0, v16f& p1, int t, const LAS float* aux) const {
        const LAS float* kbp = aux + 4 * hi;
        v16f c0, c1;
#pragma unroll
        for (int g = 0; g < 4; ++g) {
            const v4f x0 = *(const LAS v4f*)(kbp + 8 * g), x1 = *(const LAS v4f*)(kbp + 32 + 8 * g);
#pragma unroll
            for (int e = 0; e < 4; ++e) { c0[4 * g + e] = x0[e]; c1[4 * g + e] = x1[e]; }
        }
        p0 = p0 * C1 - c0; p1 = p1 * C1 - c1;
        if (64 * t + 63 > qw0) {
#pragma unroll
            for (int r = 0; r < 16; ++r) { const int kv = 64 * t + crow(r, hi);
                if (kv > qpos) p0[r] = -INFINITY; if (kv + 32 > qpos) p1[r] = -INFINITY; }
        }
    }
};

template <int VAR = 0>
__device__ __forceinline__ void fox_phase(LAS unsigned char* lds, const bf16_t* QKV, const float* CL2, bf16_t* AO) {
    const int w = __builtin_amdgcn_readfirstlane(mk_ltid() >> 6);
    for (int j = mk_bid(); j < NB * 32 * 16; j += mk_grid()) {
        const int tid = mk_ltid(), lane = tid & 63, r32 = lane & 31, hi = lane >> 5;
        const int rr = j >> 7, bh = j & 127, i2 = rr >> 1; int sel = rr & 1; if (i2 & 1) sel ^= 1;
        const int qb = 15 - (2 * i2 + sel), b = bh >> 5, h = bh & 31;
        const int q0 = qb * 256, qw0 = q0 + 32 * w, qpos = qw0 + r32;
        const bf16_t* Qg = QKV + (size_t)(b * SEQ + qpos) * ODD_PAD + O_Q + h * 64 + hi * 8;
        v8s qf[4];
#pragma unroll
        for (int s = 0; s < 4; ++s) qf[s] = *(const v8s*)(Qg + s * 16);
        const bf16_t* Kg = QKV + (size_t)(b * SEQ) * ODD_PAD + O_K + h * 64;
        const bf16_t* Vg = QKV + (size_t)(b * SEQ) * ODD_PAD + O_V + h * 64;
        v16f oT[2];
#pragma unroll
        for (int r = 0; r < 16; ++r) { oT[0][r] = 0.f; oT[1][r] = 0.f; }
        float m = -INFINITY, l = 0.f;
        const FoxSc sc{qw0, qpos, hi};
        attn_engine<true, VAR>(lds, Kg, Vg, ODD_PAD, CL2 + (size_t)(b * 32 + h) * SEQ, RangeSeq{0, (q0 + 256) / 64 - 1}, qf, oT, m, l, sc, tid, lane);
        l += __shfl_xor(l, 32);
        const float inv = 1.f / l;
        oT[0] = oT[0] * inv; oT[1] = oT[1] * inv;
        store_o(AO + (size_t)(b * SEQ + qpos) * DM + h * 64, oT, hi);
    }
}

__device__ __forceinline__ void fox_scores(v16f& p0, v16f& p1, const v16f& c0, const v16f& c1, bool diag, int t, int qpos, int hi) {
    p0 = p0 * C1 - c0; p1 = p1 * C1 - c1;
    if (diag) {
#pragma unroll
        for (int r = 0; r < 16; ++r) { const int kv = 64 * t + crow(r, hi); if (kv > qpos) p0[r] = -INFINITY; if (kv + 32 > qpos) p1[r] = -INFINITY; }
    }
}
__device__ __forceinline__ void fox2_phase(LAS unsigned char* lds, const bf16_t* QKV, const float* CL2, bf16_t* AO) {
    const int w = __builtin_amdgcn_readfirstlane(mk_ltid() >> 6);
    LAS float* AUXL = (LAS float*)(lds + ATT_AUX);
    for (int j = mk_bid(); j < NB * 32 * 8; j += mk_grid()) {
        const int tid = mk_ltid(), lane = tid & 63, r32 = lane & 31, hi = lane >> 5;
        const int rr = j >> 7, bh = j & 127, i2 = rr >> 1; int sel = rr & 1; if (i2 & 1) sel ^= 1;
        const int qb = 7 - (2 * i2 + sel), b = bh >> 5, h = bh & 31;
        const int q0 = qb * 512, qw0 = q0 + 64 * w, qposA = qw0 + r32, qposB = qposA + 32;
        const bf16_t* Qg = QKV + (size_t)(b * SEQ + qposA) * ODD_PAD + O_Q + h * 64 + hi * 8;
        v8s qa[4], qb_[4];
#pragma unroll
        for (int s = 0; s < 4; ++s) { qa[s] = *(const v8s*)(Qg + s * 16); qb_[s] = *(const v8s*)(Qg + (size_t)32 * ODD_PAD + s * 16); }
        const bf16_t* Kg = QKV + (size_t)(b * SEQ) * ODD_PAD + O_K + h * 64;
        const bf16_t* Vg = QKV + (size_t)(b * SEQ) * ODD_PAD + O_V + h * 64;
        const float* cl = CL2 + (size_t)(b * 32 + h) * SEQ;
        const int nt = (q0 + 512) / 64, tw = qw0 >> 6;
        v16f oA[2], oB[2];
#pragma unroll
        for (int r = 0; r < 16; ++r) { oA[0][r] = 0.f; oA[1][r] = 0.f; oB[0][r] = 0.f; oB[1][r] = 0.f; }
        float mA = -INFINITY, lA = 0.f, mB = -INFINITY, lB = 0.f;
        v4u kr = ld_tile(Kg, 0, ODD_PAD, tid), vr = ld_tile(Vg, 0, ODD_PAD, tid); float ar = (tid < 64) ? cl[tid] : 0.f;
        v4u kr2 = ld_tile(Kg, 64, ODD_PAD, tid), vr2 = ld_tile(Vg, 64, ODD_PAD, tid); float ar2 = (tid < 64) ? cl[64 + tid] : 0.f;
        __syncthreads();
        st_k(lds + ATT_K, kr, tid); st_v(lds + ATT_V, vr, tid); if (tid < 64) AUXL[tid] = ar;
        st_k(lds + ATT_K + KTB, kr2, tid); st_v(lds + ATT_V + VTB, vr2, tid); if (tid < 64) AUXL[64 + tid] = ar2;
        kr = ld_tile(Kg, 128, ODD_PAD, tid); vr = ld_tile(Vg, 128, ODD_PAD, tid); if (tid < 64) ar = cl[128 + tid];
        int bi = 0;
#pragma unroll 1
        for (int t = 0; t < nt; ++t) {
            __syncthreads();
            const int b2 = (bi >= 1) ? bi - 1 : 2;
            if (t + 2 < nt) { st_k(lds + ATT_K + b2 * KTB, kr, tid); st_v(lds + ATT_V + b2 * VTB, vr, tid); if (tid < 64) AUXL[b2 * 64 + tid] = ar;
                if (t + 3 < nt) { kr = ld_tile(Kg, 64 * (t + 3), ODD_PAD, tid); vr = ld_tile(Vg, 64 * (t + 3), ODD_PAD, tid); if (tid < 64) ar = cl[64 * (t + 3) + tid]; } }
            if (t <= tw) {
                const bool diag = (t == tw);
                v16f a0, a1, b0, b1;
                { v8s kf[8]; k_load(lds + ATT_K + bi * KTB, kf, r32, hi); qk_mma(kf, qa, a0, a1); qk_mma(kf, qb_, b0, b1); }
                { v16f c0, c1; const LAS float* kbp = AUXL + bi * 64 + 4 * hi;
#pragma unroll
                  for (int g = 0; g < 4; ++g) { const v4f x0 = *(const LAS v4f*)(kbp + 8 * g), x1 = *(const LAS v4f*)(kbp + 32 + 8 * g);
#pragma unroll
                      for (int e = 0; e < 4; ++e) { c0[4 * g + e] = x0[e]; c1[4 * g + e] = x1[e]; } }
                  fox_scores(a0, a1, c0, c1, diag, t, qposA, hi); fox_scores(b0, b1, c0, c1, diag, t, qposB, hi); }
#ifdef FOX2_VPRE
                { v4s vf[16]; v_load(lds + ATT_V + bi * VTB, vf, lane); __builtin_amdgcn_sched_barrier(0);
                  softmax_step(a0, a1, oA, mA, lA, true); softmax_step(b0, b1, oB, mB, lB, true);
                  pv_mma(vf, a0, a1, oA); pv_mma(vf, b0, b1, oB); }
#else
                softmax_step(a0, a1, oA, mA, lA, true); softmax_step(b0, b1, oB, mB, lB, true);
                { v4s vf[16]; v_load(lds + ATT_V + bi * VTB, vf, lane); pv_mma(vf, a0, a1, oA); pv_mma(vf, b0, b1, oB); }
#endif
            }
            bi = (bi == 2) ? 0 : bi + 1;
        }
        lA += __shfl_xor(lA, 32); lB += __shfl_xor(lB, 32);
        const float ia = 1.f / lA, ib = 1.f / lB;
        oA[0] = oA[0] * ia; oA[1] = oA[1] * ia; oB[0] = oB[0] * ib; oB[1] = oB[1] * ib;
        store_o(AO + (size_t)(b * SEQ + qposA) * DM + h * 64, oA, hi);
        store_o(AO + (size_t)(b * SEQ + qposB) * DM + h * 64, oB, hi);
    }
}


__device__ __forceinline__ float gelu_tanh(float x) {
    const float u = 0.7978845608028654f * (x + 0.044715f * x * x * x);
    const float t = 1.f - 2.f / (1.f + __expf(2.f * u));
    return 0.5f * x * (1.f + t);
}
__device__ __forceinline__ void compress_unit(LAS unsigned char* lds, int u, const bf16_t* QKV, const float* pe_k, const float* pe_v,
                                              const bf16_t* CW1  , const bf16_t* CW2  , bf16_t* KCMP, bf16_t* VCMP) {
    const int tid = mk_ltid(), lane = tid & 63, w = __builtin_amdgcn_readfirstlane(tid >> 6), r32 = lane & 31, hi = lane >> 5;
    const int kv = u >> 6, b = (u >> 4) & 3, g = (u >> 3) & 1, ch = u & 7;
    const float* pe = kv ? pe_v : pe_k;
    const bf16_t* W1 = CW1 + (size_t)kv * 256 * 2048; const bf16_t* W2 = CW2 + (size_t)kv * 64 * 256;
    bf16_t* OUT = (kv ? VCMP : KCMP) + (size_t)((b * 2 + g) * 256 + ch * 32) * 64;
    const int n = ch * 32 + r32;
    const bf16_t* Ag = QKV + (size_t)(b * SEQ + 16 * n) * EVEN_PAD + (kv ? E_VC : E_KC) + g * 64 + hi * 8;
    const bf16_t* Bg = W1 + (size_t)(32 * w + r32) * 2048 + hi * 8;
    LAS bf16_t* HID = (LAS bf16_t*)lds;
    LAS float* PE = (LAS float*)(lds + 20480);
    v16f acc;
#pragma unroll
    for (int r = 0; r < 16; ++r) acc[r] = 0.f;
    __syncthreads();
    *(LAS v4f*)(PE + tid * 4) = *(const v4f*)(pe + tid * 4);
    __syncthreads();
#pragma unroll 8
    for (int st = 0; st < 128; ++st) {
        const int li = st >> 2, d0 = (st & 3) * 16;
        const v4u ar = *(const v4u*)(Ag + (size_t)li * EVEN_PAD + d0);
        const v4f pa = *(const LAS v4f*)(PE + li * 64 + d0 + hi * 8), pb = *(const LAS v4f*)(PE + li * 64 + d0 + hi * 8 + 4);
        const v8s bfr = *(const v8s*)(Bg + st * 16);
        v4u aw;
        aw.x = pkbf(__uint_as_float(ar.x << 16) + pa.x, __uint_as_float(ar.x & 0xffff0000u) + pa.y);
        aw.y = pkbf(__uint_as_float(ar.y << 16) + pa.z, __uint_as_float(ar.y & 0xffff0000u) + pa.w);
        aw.z = pkbf(__uint_as_float(ar.z << 16) + pb.x, __uint_as_float(ar.z & 0xffff0000u) + pb.y);
        aw.w = pkbf(__uint_as_float(ar.w << 16) + pb.z, __uint_as_float(ar.w & 0xffff0000u) + pb.w);
        acc = mfma32(__builtin_bit_cast(v8s, aw), bfr, acc);
    }
#pragma unroll
    for (int r = 0; r < 16; ++r) HID[crow(r, hi) * 264 + 32 * w + r32] = (bf16_t)(pkbf(gelu_tanh(acc[r]), 0.f) & 0xffffu);
    __syncthreads();
    if (w < 2) {
        v16f o;
#pragma unroll
        for (int r = 0; r < 16; ++r) o[r] = 0.f;
        const bf16_t* B2 = W2 + (size_t)(32 * w + r32) * 256 + hi * 8;
#pragma unroll
        for (int st = 0; st < 16; ++st) {
            const v8s af = *(const LAS v8s*)(HID + r32 * 264 + st * 16 + hi * 8);
            const v8s bfr = *(const v8s*)(B2 + st * 16);
            o = mfma32(af, bfr, o);
        }
#pragma unroll
        for (int r = 0; r < 16; ++r) { const int nl = crow(r, hi); const bool valid = (ch * 32 + nl) < 255;
            OUT[(size_t)nl * 64 + 32 * w + r32] = valid ? (bf16_t)(pkbf(o[r], 0.f) & 0xffffu) : (bf16_t)0; }
    }
}

template <int NEGPAD>
struct TabSc {
    const LAS float* tb;
    int qpos, hi;
    __device__ __forceinline__ void apply_tab(v16f& p0, v16f& p1, int t) const {
        const LAS float* bp = tb + (NEGPAD + qpos - 64 * t - 63 - 4 * hi);
        v16f c0, c1;
#pragma unroll
        for (int r = 0; r < 16; ++r) { c0[r] = bp[63 - ((r & 3) + 8 * (r >> 2))]; c1[r] = bp[31 - ((r & 3) + 8 * (r >> 2))]; }
        p0 = p0 * C1 + c0; p1 = p1 * C1 + c1;
    }
};
struct SwaSc : TabSc<64> {
    int qw0;
    __device__ __forceinline__ bool active(int t) const { return 64 * t + 63 >= qw0 - 127 && 64 * t <= qw0 + 31; }
    __device__ __forceinline__ bool rowok(int) const { return true; }
    __device__ __forceinline__ void apply(v16f& p0, v16f& p1, int t, const LAS float*) const { apply_tab(p0, p1, t); }
};

__device__ __forceinline__ void swa_unit(LAS unsigned char* lds, int u, const bf16_t* QKV, const float* relb, const float* sinks, bf16_t* AO) {
    const int tid = mk_ltid(), lane = tid & 63, w = __builtin_amdgcn_readfirstlane(tid >> 6), r32 = lane & 31, hi = lane >> 5;
    LAS float* TB = (LAS float*)(lds + ATT_END);
    const int qblk = u >> 4, b = (u >> 2) & 3, g = u & 3;
    const int hq = 4 * g + (w >> 1), q0 = 64 * qblk, qw0 = q0 + 32 * (w & 1), qpos = qw0 + r32;
    __syncthreads();
    for (int i = tid; i < 1024; i += 512) { const int hh = i >> 8, d = (i & 255) - 64; TB[i] = (d >= 0 && d < 128) ? relb[rel_bucket(d) * 32 + 4 * g + hh] * LOG2E : -INFINITY; }
    const bf16_t* Qg = QKV + (size_t)(b * SEQ + qpos) * EVEN_PAD + E_QA + hq * 64 + hi * 8;
    v8s qf[4];
#pragma unroll
    for (int s = 0; s < 4; ++s) qf[s] = *(const v8s*)(Qg + s * 16);
    const bf16_t* Kg = QKV + (size_t)(b * SEQ) * EVEN_PAD + E_KA + g * 64;
    const bf16_t* Vg = QKV + (size_t)(b * SEQ) * EVEN_PAD + E_VA + g * 64;
    v16f oT[2];
#pragma unroll
    for (int r = 0; r < 16; ++r) { oT[0][r] = 0.f; oT[1][r] = 0.f; }
    float m = -INFINITY, l = 0.f;
    SwaSc sc; sc.tb = TB + (w >> 1) * 256; sc.qpos = qpos; sc.hi = hi; sc.qw0 = qw0;
    attn_engine<false>(lds, Kg, Vg, EVEN_PAD, nullptr, RangeSeq{(qblk >= 2) ? qblk - 2 : 0, qblk}, qf, oT, m, l, sc, tid, lane);
    l += __shfl_xor(l, 32);
    const float sk = sinks[hq] * LOG2E;
    const float mf = fmaxf(m, sk);
    const float a = ex2(m - mf);
    const float inv = a / (l * a + ex2(sk - mf));
    oT[0] = oT[0] * inv; oT[1] = oT[1] * inv;
    store_o(AO + (size_t)(b * SEQ + qpos) * DM + hq * 64, oT, hi);
}

__device__ __forceinline__ void evenA_phase(LAS unsigned char* lds, const bf16_t* QKV, const float* relb, const float* sinks, const float* pe_k, const float* pe_v,
                                            const bf16_t* CW1, const bf16_t* CW2, bf16_t* KCMP, bf16_t* VCMP, bf16_t* AO) {
    for (int u = mk_bid(); u < 128 + 1024; u += mk_grid()) {
        if (u < 128) compress_unit(lds, u, QKV, pe_k, pe_v, CW1, CW2, KCMP, VCMP);
        else swa_unit(lds, u - 128, QKV, relb, sinks, AO);
    }
}

constexpr int NSA_TS = 1184, NSA_TW = 704;
constexpr int NSA_OFF_TS = ATT_END, NSA_OFF_TW = NSA_OFF_TS + 8 * NSA_TS * 4, NSA_OFF_IMP = NSA_OFF_TW + 8 * NSA_TW * 4, NSA_OFF_SEL = NSA_OFF_IMP + 32 * 64 * 4, NSA_OFF_UNI = NSA_OFF_SEL + 32 * 8;
static_assert(NSA_OFF_UNI + 64 <= LDS_BYTES, "NSA LDS map");

struct NsaSelSc : TabSc<64> {
    int q0; unsigned mlo, mhi;
    __device__ __forceinline__ bool active(int) const { return true; }
    __device__ __forceinline__ bool rowok(int t) const { return ((t < 32 ? (mlo >> t) : (mhi >> (t - 32))) & 1u) != 0u; }
    __device__ __forceinline__ void apply(v16f& p0, v16f& p1, int t, const LAS float*) const {
        if (q0 - (64 * t + 63) >= 1024) { const float b31 = tb[64 + 1024]; p0 = p0 * C1 + b31; p1 = p1 * C1 + b31; }
        else apply_tab(p0, p1, t);
    }
};
struct NsaWinSc : TabSc<64> {
    __device__ __forceinline__ bool active(int) const { return true; }
    __device__ __forceinline__ bool rowok(int) const { return true; }
    __device__ __forceinline__ void apply(v16f& p0, v16f& p1, int t, const LAS float*) const { apply_tab(p0, p1, t); }
};

__device__ __forceinline__ void nsa_phase(LAS unsigned char* lds, const bf16_t* QKV, const float* relb, const bf16_t* KCMP, const bf16_t* VCMP, bf16_t* AO, float* SCRG, unsigned* CTR) {
    const int w = __builtin_amdgcn_readfirstlane(mk_ltid() >> 6);
    LAS unsigned char* KT = lds + ATT_K; LAS unsigned char* VT = lds + ATT_V;
    LAS float* TS = (LAS float*)(lds + NSA_OFF_TS); LAS float* TW = (LAS float*)(lds + NSA_OFF_TW); LAS unsigned* IMP = (LAS unsigned*)(lds + NSA_OFF_IMP);
    LAS unsigned* SEL = (LAS unsigned*)(lds + NSA_OFF_SEL); LAS unsigned* UNI = (LAS unsigned*)(lds + NSA_OFF_UNI);
    int cur_g = -1;
#define NSA_GATE(i) (1.f / (1.f + __expf(-bf2f(QKV[(size_t)(b * SEQ + qpos) * EVEN_PAD + E_GT + hq * 3 + (i)]))))
    LAS unsigned* UCUR = (LAS unsigned*)(lds + NSA_OFF_UNI + 16);
    for (;;) {
        const int g = mk_bid() & 1;
        __syncthreads();
        if (mk_ltid() == 0) UCUR[0] = __hip_atomic_fetch_add(CTR + 64 * g, 1u, __ATOMIC_RELAXED, __HIP_MEMORY_SCOPE_AGENT);
        __syncthreads();
        const int u = (int)__builtin_amdgcn_readfirstlane((int)UCUR[0]);
        if (u >= 512) break;
        const int qblk = 127 - (u >> 2), b = u & 3;
        const int hq = 8 * g + w, q0 = 32 * qblk, bg = b * 2 + g;
        v8s qf[4]; v16f oT[2];
        float* SCR = SCRG + (size_t)mk_bid() * (512 * 32);
        {
            const int tid = mk_ltid(), lane = tid & 63, r32 = lane & 31, hi = lane >> 5, qpos = q0 + r32;
            __syncthreads();
            if (g != cur_g) { cur_g = g;
                for (int i = tid; i < 8 * NSA_TS; i += 512) { const int hh = i / NSA_TS, d = i - hh * NSA_TS - 64;
                    TS[i] = (d >= 0) ? relb[rel_bucket(d < 1024 ? d : 1024) * 32 + 16 + 8 * g + hh] * LOG2E : -INFINITY; }
                for (int i = tid; i < 8 * NSA_TW; i += 512) { const int hh = i / NSA_TW, d = i - hh * NSA_TW - 64;
                    TW[i] = (d >= 0 && d < 512) ? relb[rel_bucket(d) * 32 + 16 + 8 * g + hh] * LOG2E : -INFINITY; } }
            for (int i = tid; i < 32 * 64; i += 512) IMP[i] = 0u;
            if (tid < 2) UNI[tid] = 0u;
            const bf16_t* Qrow = QKV + (size_t)(b * SEQ + qpos) * EVEN_PAD;
#pragma unroll
            for (int s = 0; s < 4; ++s) qf[s] = *(const v8s*)(Qrow + E_QB + hq * 64 + hi * 8 + s * 16);
        }
        const bf16_t* Kc = KCMP + (size_t)bg * 256 * 64; const bf16_t* Vc = VCMP + (size_t)bg * 256 * 64;
        const int nct = (2 * qblk) / 64 + 1;
        float m = -INFINITY, l = 0.f;
        {
            const int tid = mk_ltid(), lane = tid & 63, r32 = lane & 31, hi = lane >> 5, qpos = q0 + r32; const LAS float* tb = TS + w * NSA_TS + 64;
            v4u kr = ld_tile(Kc, 0, 64, tid);
            for (int t = 0; t < nct; ++t) {
                const int buf = t & 1;
                st_k(KT + buf * KTB, kr, tid);
                __syncthreads();
                if (t + 1 < nct) kr = ld_tile(Kc, 64 * (t + 1), 64, tid);
                v16f p0, p1;
                qk_tile(KT + buf * KTB, qf, p0, p1, r32, hi);
                float mx = -INFINITY;
#pragma unroll
                for (int r = 0; r < 16; ++r) {
                    const int c0 = 64 * t + crow(r, hi); const int d0 = qpos - 16 * c0 - 31, d1 = d0 - 512;
                    p0[r] = p0[r] * C1 + tb[min(max(d0, -1), 1024)]; p1[r] = p1[r] * C1 + tb[min(max(d1, -1), 1024)];
                    mx = fmaxf(mx, fmaxf(p0[r], p1[r]));
                }
                mx = xhalf_max(mx);
                const float mn = fmaxf(m, mx), mu = (mn == -INFINITY) ? 0.f : mn;
                float rs = 0.f;
#pragma unroll
                for (int r = 0; r < 16; ++r) rs += ex2(p0[r] - mu) + ex2(p1[r] - mu);
                l = l * ex2(m - mu) + rs; m = mn;
            }
        }
        l += __shfl_xor(l, 32);
        {
            const int tid = mk_ltid(), lane = tid & 63, r32 = lane & 31, hi = lane >> 5, qpos = q0 + r32; const LAS float* tb = TS + w * NSA_TS + 64;
            const float mu = (m == -INFINITY) ? 0.f : m, il = (l > 0.f) ? 1.f / l : 0.f;
            const float gt0 = NSA_GATE(0);
#pragma unroll
            for (int r = 0; r < 16; ++r) { oT[0][r] = 0.f; oT[1][r] = 0.f; }
            __syncthreads();
            v4u kr = ld_tile(Kc, 0, 64, tid), vr = ld_tile(Vc, 0, 64, tid);
            for (int t = 0; t < nct; ++t) {
                const int buf = t & 1;
                st_k(KT + buf * KTB, kr, tid); st_v(VT + buf * VTB, vr, tid);
                __syncthreads();
                if (t + 1 < nct) { kr = ld_tile(Kc, 64 * (t + 1), 64, tid); vr = ld_tile(Vc, 64 * (t + 1), 64, tid); }
                v16f p0, p1;
                qk_tile(KT + buf * KTB, qf, p0, p1, r32, hi);
#pragma unroll
                for (int r = 0; r < 16; ++r) {
                    const int c0 = 64 * t + crow(r, hi); const int d0 = qpos - 16 * c0 - 31, d1 = d0 - 512;
                    p0[r] = ex2(p0[r] * C1 + tb[min(max(d0, -1), 1024)] - mu) * il; p1[r] = ex2(p1[r] * C1 + tb[min(max(d1, -1), 1024)] - mu) * il;
                }
#pragma unroll
                for (int gq = 0; gq < 4; ++gq) {
                    const int sb0 = 16 * t + 2 * gq + hi, sb1 = sb0 + 8;
                    const unsigned a0 = (unsigned)(((p0[4 * gq] + p0[4 * gq + 1]) + (p0[4 * gq + 2] + p0[4 * gq + 3])) * 4194304.f + 0.5f);
                    const unsigned a1 = (unsigned)(((p1[4 * gq] + p1[4 * gq + 1]) + (p1[4 * gq + 2] + p1[4 * gq + 3])) * 4194304.f + 0.5f);
                    const unsigned e0 = (unsigned)(p0[4 * gq + 3] * 4194304.f + 0.5f), e1 = (unsigned)(p1[4 * gq + 3] * 4194304.f + 0.5f);
                    lds_add(IMP + r32 * 64 + sb0, a0); lds_add(IMP + r32 * 64 + sb1, a1);
                    lds_add(IMP + r32 * 64 + sb0 + 1, e0); if (sb1 + 1 < 64) lds_add(IMP + r32 * 64 + sb1 + 1, e1);
                }
                p0 = p0 * gt0; p1 = p1 * gt0;
                pv_tile(VT + buf * VTB, p0, p1, oT, lane);
            }
#pragma unroll
            for (int r = 0; r < 16; ++r) { SCR[r * 512 + tid] = oT[0][r]; SCR[(16 + r) * 512 + tid] = oT[1][r]; }
        }
        __syncthreads();
#pragma unroll 1
        for (int i = 0; i < 4; ++i) {
            const int lane = mk_ltid() & 63;
            const int qi = 4 * w + i, qp = q0 + qi, cur = qp >> 6;
            const unsigned v = IMP[qi * 64 + lane];
            const bool fut = lane > cur, forced = (lane == 0) || (lane == cur) || (lane == cur - 1);
            const unsigned key = ((fut ? 0u : (forced ? 0x3ffffffu : min(v + 1u, 0x3fffffeu))) << 6) | (unsigned)(63 - lane);
            int cnt = 0;
#pragma unroll
            for (int jj = 0; jj < 64; ++jj) { const unsigned kj = (unsigned)__builtin_amdgcn_readlane((int)key, jj); cnt += (kj > key) ? 1 : 0; }
            const unsigned long long msk = __ballot(!fut && cnt < 16);
            if (lane == 0) { SEL[2 * qi] = (unsigned)msk; SEL[2 * qi + 1] = (unsigned)(msk >> 32); lds_or(UNI, (unsigned)msk); lds_or(UNI + 1, (unsigned)(msk >> 32)); }
        }
        __syncthreads();
        {
            const int tid = mk_ltid(), lane = tid & 63, r32 = lane & 31, hi = lane >> 5, qpos = q0 + r32;
            const unsigned long long uni = ((unsigned long long)(unsigned)__builtin_amdgcn_readfirstlane((int)UNI[1]) << 32) | (unsigned)__builtin_amdgcn_readfirstlane((int)UNI[0]);
            const bf16_t* Kg = QKV + (size_t)(b * SEQ) * EVEN_PAD + E_KS + g * 64; const bf16_t* Vg = QKV + (size_t)(b * SEQ) * EVEN_PAD + E_VS + g * 64;
#pragma unroll
            for (int r = 0; r < 16; ++r) { oT[0][r] = 0.f; oT[1][r] = 0.f; }
            m = -INFINITY; l = 0.f;
            NsaSelSc sc; sc.tb = TS + w * NSA_TS; sc.qpos = qpos; sc.hi = hi; sc.q0 = q0; sc.mlo = SEL[2 * r32]; sc.mhi = SEL[2 * r32 + 1];
            attn_engine<false>(lds, Kg, Vg, EVEN_PAD, nullptr, MaskSeq{uni}, qf, oT, m, l, sc, tid, lane);
            l += __shfl_xor(l, 32);
            const float scl = (l > 0.f) ? NSA_GATE(1) / l : 0.f;
#pragma unroll
            for (int r = 0; r < 16; ++r) { SCR[r * 512 + tid] += oT[0][r] * scl; SCR[(16 + r) * 512 + tid] += oT[1][r] * scl; }
        }
        {
            const int tid = mk_ltid(), lane = tid & 63, r32 = lane & 31, hi = lane >> 5, qpos = q0 + r32;
            const bf16_t* Kg = QKV + (size_t)(b * SEQ) * EVEN_PAD + E_KW + g * 64; const bf16_t* Vg = QKV + (size_t)(b * SEQ) * EVEN_PAD + E_VW + g * 64;
#pragma unroll
            for (int r = 0; r < 16; ++r) { oT[0][r] = 0.f; oT[1][r] = 0.f; }
            m = -INFINITY; l = 0.f;
            NsaWinSc sc; sc.tb = TW + w * NSA_TW; sc.qpos = qpos; sc.hi = hi;
            attn_engine<false>(lds, Kg, Vg, EVEN_PAD, nullptr, RangeSeq{(q0 >= 511) ? ((q0 - 511) >> 6) : 0, (q0 + 31) >> 6}, qf, oT, m, l, sc, tid, lane);
            l += __shfl_xor(l, 32);
            const float scl = (l > 0.f) ? NSA_GATE(2) / l : 0.f;
#pragma unroll
            for (int r = 0; r < 16; ++r) { oT[0][r] = SCR[r * 512 + tid] + oT[0][r] * scl; oT[1][r] = SCR[(16 + r) * 512 + tid] + oT[1][r] * scl; }
            store_o(AO + (size_t)(b * SEQ + qpos) * DM + 1024 + hq * 64, oT, hi);
        }
    }
}

constexpr int N2_TS = 1216, N2_TW = 704;
constexpr int N2_OFF_TS = ATT_END, N2_OFF_TW = N2_OFF_TS + 8 * N2_TS * 4, N2_OFF_IMP = N2_OFF_TW + 8 * N2_TW * 4, N2_OFF_SEL = N2_OFF_IMP + 64 * 64 * 4, N2_OFF_UNI = N2_OFF_SEL + 64 * 8;
static_assert(N2_OFF_UNI + 64 <= LDS_BYTES - 64, "NSA2 LDS map");


__device__ __forceinline__ void k_load_half(const LAS unsigned char* Kt, int half, v8s (&kf)[4], int r32, int hi) {
    const LAS unsigned char* kb = Kt + (32 * half + r32) * KP + hi * 16;
#pragma unroll
    for (int s = 0; s < 4; ++s) kf[s] = *(const LAS v8s*)(kb + s * 32);
}
__device__ __forceinline__ void qk_half(const v8s (&kf)[4], const v8s (&qf)[4], v16f& p) {
#pragma unroll
    for (int s = 0; s < 4; ++s) p = mfma32(kf[s], qf[s], p);
}
__device__ __forceinline__ v8s scale_q(v8s q) {
    v4u u = __builtin_bit_cast(v4u, q), o;
    o.x = pkbf(__uint_as_float(u.x << 16) * C1, __uint_as_float(u.x & 0xffff0000u) * C1); o.y = pkbf(__uint_as_float(u.y << 16) * C1, __uint_as_float(u.y & 0xffff0000u) * C1);
    o.z = pkbf(__uint_as_float(u.z << 16) * C1, __uint_as_float(u.z & 0xffff0000u) * C1); o.w = pkbf(__uint_as_float(u.w << 16) * C1, __uint_as_float(u.w & 0xffff0000u) * C1);
    return __builtin_bit_cast(v8s, o);
}
__device__ __forceinline__ void v_load_half(const LAS unsigned char* Vt, int dt, v4s (&vf)[8], int lane) {
    const int hi = lane >> 5;
    const LAS unsigned char* vb = Vt + dt * VHB + (4 * hi + ((lane & 15) >> 2)) * 64 + (16 * ((lane >> 4) & 1) + 4 * (lane & 3)) * 2;
#pragma unroll
    for (int ks = 0; ks < 4; ++ks) { const int kvb = 16 * (ks & 1) + 32 * (ks >> 1); vf[2 * ks] = trrd(vb + kvb * 64); vf[2 * ks + 1] = trrd(vb + (kvb + 8) * 64); }
}
__device__ __forceinline__ void pv_half(const v4s (&vf)[8], const v4u (&w)[4], v16f& o) {
#pragma unroll
    for (int ks = 0; ks < 4; ++ks) { const v4s lo = vf[2 * ks], h4 = vf[2 * ks + 1];
        const v8s af = (v8s){lo[0], lo[1], lo[2], lo[3], h4[0], h4[1], h4[2], h4[3]};
        o = mfma32(af, __builtin_bit_cast(v8s, w[ks]), o); }
}
__device__ __forceinline__ void pack_p2(const v16f& p0, const v16f& p1, v4u (&w)[4]) {
    w[0] = (v4u){pkbf(p0[0], p0[1]), pkbf(p0[2], p0[3]), pkbf(p0[4], p0[5]), pkbf(p0[6], p0[7])};
    w[1] = (v4u){pkbf(p0[8], p0[9]), pkbf(p0[10], p0[11]), pkbf(p0[12], p0[13]), pkbf(p0[14], p0[15])};
    w[2] = (v4u){pkbf(p1[0], p1[1]), pkbf(p1[2], p1[3]), pkbf(p1[4], p1[5]), pkbf(p1[6], p1[7])};
    w[3] = (v4u){pkbf(p1[8], p1[9]), pkbf(p1[10], p1[11]), pkbf(p1[12], p1[13]), pkbf(p1[14], p1[15])};
}

__device__ __forceinline__ void softmax_half(v16f& p, v16f (&oT)[2], float& m, float& l, bool rowok) {
    float a = max3f(p[0], p[1], p[2]), b = max3f(p[3], p[4], p[5]);
    a = max3f(a, p[6], p[7]); b = max3f(b, p[8], p[9]); a = max3f(a, p[10], p[11]); b = max3f(b, p[12], p[13]); a = max3f(a, p[14], p[15]);
    float mx = fmaxf(a, b);
    mx = fmaxf(mx, __shfl_xor(mx, 32));
    if (!rowok) mx = -INFINITY;
    const float mn = fmaxf(m, mx);
    const float mu = (mn == -INFINITY) ? 0.f : mn;
    if (__any(mn > m)) { const float alpha = ex2(m - mu); oT[0] = oT[0] * alpha; oT[1] = oT[1] * alpha; l *= alpha; }
    const float mue = rowok ? mu : INFINITY;
    p = p - mue;
#pragma unroll
    for (int r = 0; r < 16; ++r) p[r] = ex2(p[r]);
    l += ((p[0] + p[1]) + (p[2] + p[3])) + ((p[4] + p[5]) + (p[6] + p[7])) + (((p[8] + p[9]) + (p[10] + p[11])) + ((p[12] + p[13]) + (p[14] + p[15])));
    m = mn;
}
__device__ __forceinline__ void v_load_khalf(const LAS unsigned char* Vt, int h, v4s (&vf)[8], int lane) {
    const int hi = lane >> 5;
    const LAS unsigned char* vb = Vt + (32 * h + 4 * hi + ((lane & 15) >> 2)) * 64 + (16 * ((lane >> 4) & 1) + 4 * (lane & 3)) * 2;
#pragma unroll
    for (int ksl = 0; ksl < 2; ++ksl)
#pragma unroll
        for (int dt = 0; dt < 2; ++dt) { vf[(ksl * 2 + dt) * 2] = trrd(vb + dt * VHB + (16 * ksl) * 64); vf[(ksl * 2 + dt) * 2 + 1] = trrd(vb + dt * VHB + (16 * ksl + 8) * 64); }
}
__device__ __forceinline__ void pv_khalf(const v4s (&vf)[8], const v16f& p, v16f (&oT)[2]) {
    v4u w[2];
    w[0] = (v4u){pkbf(p[0], p[1]), pkbf(p[2], p[3]), pkbf(p[4], p[5]), pkbf(p[6], p[7])};
    w[1] = (v4u){pkbf(p[8], p[9]), pkbf(p[10], p[11]), pkbf(p[12], p[13]), pkbf(p[14], p[15])};
#pragma unroll
    for (int ksl = 0; ksl < 2; ++ksl)
#pragma unroll
        for (int dt = 0; dt < 2; ++dt) { const v4s lo = vf[(ksl * 2 + dt) * 2], h4 = vf[(ksl * 2 + dt) * 2 + 1];
            const v8s af = (v8s){lo[0], lo[1], lo[2], lo[3], h4[0], h4[1], h4[2], h4[3]};
            oT[dt] = mfma32(af, __builtin_bit_cast(v8s, w[ksl]), oT[dt]); }
}
template <class Seq, class Sc>
__device__ __forceinline__ void attn_engine2(LAS unsigned char* lds, const bf16_t* Kg, const bf16_t* Vg, int pitch, Seq seq, const v8s (&qa)[4], const v8s (&qb)[4],
                                             v16f (&oA)[2], v16f (&oB)[2], float& mA, float& lA, float& mB, float& lB, const Sc& sc, int tid, int lane) {
    const int r32 = lane & 31, hi = lane >> 5;
    int tc = seq.pop(); if (tc < 0) return;
    int tn = seq.pop(), tnn = (tn >= 0) ? seq.pop() : -1;
    v4u kr = ld_tile(Kg, 64 * tc, pitch, tid), vr = ld_tile(Vg, 64 * tc, pitch, tid);
    __syncthreads();
    st_k(lds + ATT_K, kr, tid); st_v(lds + ATT_V, vr, tid);
    if (tn >= 0) { kr = ld_tile(Kg, 64 * tn, pitch, tid); vr = ld_tile(Vg, 64 * tn, pitch, tid); st_k(lds + ATT_K + KTB, kr, tid); st_v(lds + ATT_V + VTB, vr, tid); }
    if (tnn >= 0) { kr = ld_tile(Kg, 64 * tnn, pitch, tid); vr = ld_tile(Vg, 64 * tnn, pitch, tid); }
    int bi = 0;
#pragma unroll 1
    for (;;) {
        __syncthreads();
        const int b2 = (bi >= 1) ? bi - 1 : 2; int t3 = -1;
        if (tnn >= 0) { st_k(lds + ATT_K + b2 * KTB, kr, tid); st_v(lds + ATT_V + b2 * VTB, vr, tid);
            t3 = seq.pop();
            if (t3 >= 0) { kr = ld_tile(Kg, 64 * t3, pitch, tid); vr = ld_tile(Vg, 64 * t3, pitch, tid); } }
        const bool okA = sc.rowok(tc, 0), okB = sc.rowok(tc, 1);
#pragma unroll
        for (int h = 0; h < 2; ++h) {
            v16f a, b;
            sc.init_half(a, tc, 0, h); sc.init_half(b, tc, 1, h);
            { v8s kf[4]; k_load_half(lds + ATT_K + bi * KTB, h, kf, r32, hi); qk_half(kf, qa, a); qk_half(kf, qb, b); }
            softmax_half(a, oA, mA, lA, okA); softmax_half(b, oB, mB, lB, okB);
            { v4s vf[8]; v_load_khalf(lds + ATT_V + bi * VTB, h, vf, lane); pv_khalf(vf, a, oA); pv_khalf(vf, b, oB); }
        }
        tc = tn; tn = tnn; tnn = t3; bi = (bi == 2) ? 0 : bi + 1;
        if (tc < 0) break;
    }
}
struct Nsa2SelSc {
    const LAS float* tb; int qposA, hi, q0; unsigned mloA, mhiA, mloB, mhiB;
    __device__ __forceinline__ bool rowok(int t, int sub) const { const unsigned lo = sub ? mloB : mloA, hh = sub ? mhiB : mhiA; return ((t < 32 ? (lo >> t) : (hh >> (t - 32))) & 1u) != 0u; }
    __device__ __forceinline__ void init_half(v16f& p, int t, int sub, int h) const {
        if (q0 - (64 * t + 63) >= 1024) { const float b31 = tb[64 + 1024];
#pragma unroll
            for (int r = 0; r < 16; ++r) p[r] = b31; }
        else { const LAS float* bp = tb + (64 + qposA + 32 * sub - 64 * t - 63 - 4 * hi);
#pragma unroll
            for (int r = 0; r < 16; ++r) p[r] = bp[63 - 32 * h - ((r & 3) + 8 * (r >> 2))]; }
    }
};
struct Nsa2WinSc {
    const LAS float* tb; int qposA, hi;
    __device__ __forceinline__ bool rowok(int, int) const { return true; }
    __device__ __forceinline__ void init_half(v16f& p, int t, int sub, int h) const {
        const LAS float* bp = tb + (64 + qposA + 32 * sub - 64 * t - 63 - 4 * hi);
#pragma unroll
        for (int r = 0; r < 16; ++r) p[r] = bp[63 - 32 * h - ((r & 3) + 8 * (r >> 2))];
    }
};

__device__ __forceinline__ void nsa2_phase(LAS unsigned char* lds, const bf16_t* QKV, const float* relb, const bf16_t* KCMP, const bf16_t* VCMP, bf16_t* AO, float* SCRG) {
    const int w = __builtin_amdgcn_readfirstlane(mk_ltid() >> 6);
    LAS unsigned char* KT = lds + ATT_K; LAS unsigned char* VT = lds + ATT_V;
    LAS float* TS = (LAS float*)(lds + N2_OFF_TS); LAS float* TW = (LAS float*)(lds + N2_OFF_TW); LAS unsigned* IMP = (LAS unsigned*)(lds + N2_OFF_IMP);
    LAS unsigned* SEL = (LAS unsigned*)(lds + N2_OFF_SEL); LAS unsigned* UNI = (LAS unsigned*)(lds + N2_OFF_UNI);
    int cur_g = -1;
#define N2_LOADQ() { const bf16_t* Qrow_ = QKV + (size_t)(b * SEQ + q0 + (mk_ltid() & 31)) * EVEN_PAD + E_QB + hq * 64 + ((mk_ltid() >> 5) & 1) * 8; asm volatile("" : "+v"(Qrow_)); \
        _Pragma("unroll") for (int s = 0; s < 4; ++s) { qa[s] = scale_q(*(const v8s*)(Qrow_ + s * 16)); qb[s] = scale_q(*(const v8s*)(Qrow_ + (size_t)32 * EVEN_PAD + s * 16)); } }
#define N2_GATE(qp, i) (1.f / (1.f + __expf(-bf2f(QKV[(size_t)(b * SEQ + (qp)) * EVEN_PAD + E_GT + hq * 3 + (i)]))))
    for (int u = mk_bid(); u < 512; u += mk_grid()) {
        const int qblk = 63 - (u >> 3), b = (u >> 1) & 3, g = u & 1;
        const int hq = 8 * g + w, q0 = 64 * qblk, bg = b * 2 + g;
        v8s qa[4], qb[4]; v16f oA[2], oB[2];
        float* SCR = SCRG + (size_t)mk_bid() * (512 * 64);
        {
            const int tid = mk_ltid(), lane = tid & 63, r32 = lane & 31, hi = lane >> 5, qpos = q0 + r32;
            __syncthreads();
            if (g != cur_g) { cur_g = g;
                for (int i = tid; i < 8 * N2_TS; i += 512) { const int hh = i / N2_TS, d = i - hh * N2_TS - 64;
                    TS[i] = (d >= 0) ? relb[rel_bucket(d < 1024 ? d : 1024) * 32 + 16 + 8 * g + hh] * LOG2E : -INFINITY; }
                for (int i = tid; i < 8 * N2_TW; i += 512) { const int hh = i / N2_TW, d = i - hh * N2_TW - 64;
                    TW[i] = (d >= 0 && d < 512) ? relb[rel_bucket(d) * 32 + 16 + 8 * g + hh] * LOG2E : -INFINITY; } }
            for (int i = tid; i < 64 * 64; i += 512) IMP[i] = 0u;
            if (tid < 2) UNI[tid] = 0u;
            N2_LOADQ()
        }
        const bf16_t* Kc = KCMP + (size_t)bg * 256 * 64; const bf16_t* Vc = VCMP + (size_t)bg * 256 * 64;
        const int nct = ((q0 + 32) >> 4) / 64 + 1;
        float mA = -INFINITY, lA = 0.f, mB = -INFINITY, lB = 0.f;
#define N2_CSCORE(P0, P1, QP) { \
            _Pragma("unroll") for (int r = 0; r < 16; ++r) { const int c0_ = 64 * t + crow(r, hi); const int d0_ = (QP) - 16 * c0_ - 31, d1_ = d0_ - 512; \
                P0[r] = P0[r] + tb[min(max(d0_, -1), 1024)]; P1[r] = P1[r] + tb[min(max(d1_, -1), 1024)]; } }
#define N2_STAT(P0, P1, M, L) { float mx_ = -INFINITY; \
            _Pragma("unroll") for (int r = 0; r < 16; ++r) mx_ = fmaxf(mx_, fmaxf(P0[r], P1[r])); \
            mx_ = fmaxf(mx_, __shfl_xor(mx_, 32)); const float mn_ = fmaxf(M, mx_), mu_ = (mn_ == -INFINITY) ? 0.f : mn_; float rs_ = 0.f; \
            _Pragma("unroll") for (int r = 0; r < 16; ++r) rs_ += ex2(P0[r] - mu_) + ex2(P1[r] - mu_); \
            L = L * ex2(M - mu_) + rs_; M = mn_; }
        {
            const int tid = mk_ltid(), lane = tid & 63, r32 = lane & 31, hi = lane >> 5, qpos = q0 + r32; const LAS float* tb = TS + w * N2_TS + 64;
            v4u kr = ld_tile(Kc, 0, 64, tid);
            for (int t = 0; t < nct; ++t) {
                const int buf = t & 1;
                st_k(KT + buf * KTB, kr, tid);
                __syncthreads();
                if (t + 1 < nct) kr = ld_tile(Kc, 64 * (t + 1), 64, tid);
                { v16f a0, a1; { v8s kf[8]; k_load(KT + buf * KTB, kf, r32, hi); qk_mma(kf, qa, a0, a1); } N2_CSCORE(a0, a1, qpos) N2_STAT(a0, a1, mA, lA) }
                __builtin_amdgcn_sched_barrier(0);
                { v16f b0, b1; { v8s kf[8]; k_load(KT + buf * KTB, kf, r32, hi); qk_mma(kf, qb, b0, b1); } N2_CSCORE(b0, b1, qpos + 32) N2_STAT(b0, b1, mB, lB) }
            }
        }
        lA += __shfl_xor(lA, 32); lB += __shfl_xor(lB, 32);
        {
            const int tid = mk_ltid(), lane = tid & 63, r32 = lane & 31, hi = lane >> 5, qpos = q0 + r32; const LAS float* tb = TS + w * N2_TS + 64;
            const float muA = (mA == -INFINITY) ? 0.f : mA, ilA = (lA > 0.f) ? 1.f / lA : 0.f, muB = (mB == -INFINITY) ? 0.f : mB, ilB = (lB > 0.f) ? 1.f / lB : 0.f;
            const float gA = N2_GATE(qpos, 0), gB = N2_GATE(qpos + 32, 0);
#pragma unroll
            for (int r = 0; r < 16; ++r) { oA[0][r] = 0.f; oA[1][r] = 0.f; oB[0][r] = 0.f; oB[1][r] = 0.f; }
            __syncthreads();
            v4u kr = ld_tile(Kc, 0, 64, tid), vr = ld_tile(Vc, 0, 64, tid);
            for (int t = 0; t < nct; ++t) {
                const int buf = t & 1;
                st_k(KT + buf * KTB, kr, tid); st_v(VT + buf * VTB, vr, tid);
                __syncthreads();
                if (t + 1 < nct) { kr = ld_tile(Kc, 64 * (t + 1), 64, tid); vr = ld_tile(Vc, 64 * (t + 1), 64, tid); }
#define N2_IMP(P0, P1, MU, IL, ROW) { \
                _Pragma("unroll") for (int r = 0; r < 16; ++r) { P0[r] = ex2(P0[r] - MU) * IL; P1[r] = ex2(P1[r] - MU) * IL; } \
                _Pragma("unroll") for (int gq = 0; gq < 4; ++gq) { const int sb0 = 16 * t + 2 * gq + hi, sb1 = sb0 + 8; \
                    const unsigned x0 = (unsigned)(((P0[4 * gq] + P0[4 * gq + 1]) + (P0[4 * gq + 2] + P0[4 * gq + 3])) * 4194304.f + 0.5f); \
                    const unsigned x1 = (unsigned)(((P1[4 * gq] + P1[4 * gq + 1]) + (P1[4 * gq + 2] + P1[4 * gq + 3])) * 4194304.f + 0.5f); \
                    const unsigned e0 = (unsigned)(P0[4 * gq + 3] * 4194304.f + 0.5f), e1 = (unsigned)(P1[4 * gq + 3] * 4194304.f + 0.5f); \
                    lds_add(IMP + (ROW) * 64 + sb0, x0); lds_add(IMP + (ROW) * 64 + sb1, x1); \
                    lds_add(IMP + (ROW) * 64 + sb0 + 1, e0); if (sb1 + 1 < 64) lds_add(IMP + (ROW) * 64 + sb1 + 1, e1); } }
                { v16f a0, a1; { v8s kf[8]; k_load(KT + buf * KTB, kf, r32, hi); qk_mma(kf, qa, a0, a1); } N2_CSCORE(a0, a1, qpos) N2_IMP(a0, a1, muA, ilA, r32)
                  a0 = a0 * gA; a1 = a1 * gA; { v4s vf[16]; v_load(VT + buf * VTB, vf, lane); pv_mma(vf, a0, a1, oA); } }
                __builtin_amdgcn_sched_barrier(0);
                { v16f b0, b1; { v8s kf[8]; k_load(KT + buf * KTB, kf, r32, hi); qk_mma(kf, qb, b0, b1); } N2_CSCORE(b0, b1, qpos + 32) N2_IMP(b0, b1, muB, ilB, 32 + r32)
                  b0 = b0 * gB; b1 = b1 * gB; { v4s vf[16]; v_load(VT + buf * VTB, vf, lane); pv_mma(vf, b0, b1, oB); } }
            }
#pragma unroll
            for (int r = 0; r < 16; ++r) { SCR[r * 512 + tid] = oA[0][r]; SCR[(16 + r) * 512 + tid] = oA[1][r]; SCR[(32 + r) * 512 + tid] = oB[0][r]; SCR[(48 + r) * 512 + tid] = oB[1][r]; }
        }
        __syncthreads();
#pragma unroll 1
        for (int i = 0; i < 8; ++i) {
            const int lane = mk_ltid() & 63;
            const int qi = 8 * w + i, qp = q0 + qi, cur = qp >> 6;
            const unsigned v = IMP[qi * 64 + lane];
            const bool fut = lane > cur, forced = (lane == 0) || (lane == cur) || (lane == cur - 1);
            const unsigned key = ((fut ? 0u : (forced ? 0x3ffffffu : min(v + 1u, 0x3fffffeu))) << 6) | (unsigned)(63 - lane);
            int cnt = 0;
#pragma unroll
            for (int jj = 0; jj < 64; ++jj) { const unsigned kj = (unsigned)__builtin_amdgcn_readlane((int)key, jj); cnt += (kj > key) ? 1 : 0; }
            const unsigned long long msk = __ballot(!fut && cnt < 16);
            if (lane == 0) { SEL[2 * qi] = (unsigned)msk; SEL[2 * qi + 1] = (unsigned)(msk >> 32); lds_or(UNI, (unsigned)msk); lds_or(UNI + 1, (unsigned)(msk >> 32)); }
        }
        __syncthreads();
        {
            const int tid = mk_ltid(), lane = tid & 63, r32 = lane & 31, hi = lane >> 5, qpos = q0 + r32;
            const unsigned long long uni = ((unsigned long long)(unsigned)__builtin_amdgcn_readfirstlane((int)UNI[1]) << 32) | (unsigned)__builtin_amdgcn_readfirstlane((int)UNI[0]);
            const bf16_t* Kg = QKV + (size_t)(b * SEQ) * EVEN_PAD + E_KS + g * 64; const bf16_t* Vg = QKV + (size_t)(b * SEQ) * EVEN_PAD + E_VS + g * 64;
#pragma unroll
            for (int r = 0; r < 16; ++r) { oA[0][r] = 0.f; oA[1][r] = 0.f; oB[0][r] = 0.f; oB[1][r] = 0.f; }
            mA = -INFINITY; lA = 0.f; mB = -INFINITY; lB = 0.f;
            N2_LOADQ()
            Nsa2SelSc sc; sc.tb = TS + w * N2_TS; sc.qposA = qpos; sc.hi = hi; sc.q0 = q0; sc.mloA = SEL[2 * r32]; sc.mhiA = SEL[2 * r32 + 1]; sc.mloB = SEL[2 * (32 + r32)]; sc.mhiB = SEL[2 * (32 + r32) + 1];
            attn_engine2(lds, Kg, Vg, EVEN_PAD, MaskSeq{uni}, qa, qb, oA, oB, mA, lA, mB, lB, sc, tid, lane);
            lA += __shfl_xor(lA, 32); lB += __shfl_xor(lB, 32);
            const float sA = (lA > 0.f) ? N2_GATE(qpos, 1) / lA : 0.f, sB = (lB > 0.f) ? N2_GATE(qpos + 32, 1) / lB : 0.f;
#pragma unroll
            for (int r = 0; r < 16; ++r) { SCR[r * 512 + tid] += oA[0][r] * sA; SCR[(16 + r) * 512 + tid] += oA[1][r] * sA; SCR[(32 + r) * 512 + tid] += oB[0][r] * sB; SCR[(48 + r) * 512 + tid] += oB[1][r] * sB; }
        }
        {
            const int tid = mk_ltid(), lane = tid & 63, r32 = lane & 31, hi = lane >> 5, qpos = q0 + r32;
            const bf16_t* Kg = QKV + (size_t)(b * SEQ) * EVEN_PAD + E_KW + g * 64; const bf16_t* Vg = QKV + (size_t)(b * SEQ) * EVEN_PAD + E_VW + g * 64;
#pragma unroll
            for (int r = 0; r < 16; ++r) { oA[0][r] = 0.f; oA[1][r] = 0.f; oB[0][r] = 0.f; oB[1][r] = 0.f; }
            mA = -INFINITY; lA = 0.f; mB = -INFINITY; lB = 0.f;
            N2_LOADQ()
            Nsa2WinSc sc; sc.tb = TW + w * N2_TW; sc.qposA = qpos; sc.hi = hi;
            attn_engine2(lds, Kg, Vg, EVEN_PAD, RangeSeq{(q0 >= 511) ? ((q0 - 511) >> 6) : 0, (q0 + 63) >> 6}, qa, qb, oA, oB, mA, lA, mB, lB, sc, tid, lane);
            lA += __shfl_xor(lA, 32); lB += __shfl_xor(lB, 32);
            const float sA = (lA > 0.f) ? N2_GATE(qpos, 2) / lA : 0.f, sB = (lB > 0.f) ? N2_GATE(qpos + 32, 2) / lB : 0.f;
#pragma unroll
            for (int r = 0; r < 16; ++r) { oA[0][r] = SCR[r * 512 + tid] + oA[0][r] * sA; oA[1][r] = SCR[(16 + r) * 512 + tid] + oA[1][r] * sA;
                                           oB[0][r] = SCR[(32 + r) * 512 + tid] + oB[0][r] * sB; oB[1][r] = SCR[(48 + r) * 512 + tid] + oB[1][r] * sB; }
            store_o(AO + (size_t)(b * SEQ + qpos) * DM + 1024 + hq * 64, oA, hi);
            store_o(AO + (size_t)(b * SEQ + qpos + 32) * DM + 1024 + hq * 64, oB, hi);
        }
    }
#undef N2_GATE
#undef N2_LOADQ
#undef N2_CSCORE
#undef N2_STAT
#undef N2_IMP
}

__device__ __forceinline__ unsigned xb_ld(unsigned* p)              { return __hip_atomic_load(p, __ATOMIC_RELAXED, __HIP_MEMORY_SCOPE_AGENT); }
__device__ __forceinline__ unsigned xb_add(unsigned* p, unsigned v) { return __hip_atomic_fetch_add(p, v, __ATOMIC_RELAXED, __HIP_MEMORY_SCOPE_AGENT); }
__device__ __forceinline__ unsigned xb_xcc_id() { return (unsigned)__builtin_amdgcn_s_getreg((3 << 11) | 20) & 0xFu; }
#define XB_TMO      128
#define XB_XCNT(j)  (256  + 64 * (j))
#define XB_XSUB(j)  (1280 + 64 * (j))
#define XB_XGEN(j)  (2304 + 64 * (j))
#define XB_TOP      3328
#define XB_TOPGEN   3392
#define XCD_BAR_WORDS 3456
#define XB_SPIN_CAP (1u << 18)

#define XB_SPIN(cond, bar) do { unsigned _sp = 0; while (cond) { __builtin_amdgcn_s_sleep(1); \
    if ((++_sp & 255u) == 0u) { if (xb_ld(&(bar)[XB_TMO])) break; if (_sp > XB_SPIN_CAP) { atomicAdd(&(bar)[XB_TMO], 1u); break; } } } } while (0)

struct XcdBarrier {
    unsigned* bar; unsigned x;
    volatile LAS unsigned* st;
};

__device__ __forceinline__ XcdBarrier xcd_barrier_post(unsigned* bar, volatile LAS unsigned* st) {
    XcdBarrier b; b.bar = bar; b.x = xb_xcc_id(); b.st = st;
    if (threadIdx.x == 0) (void)xb_add(&bar[XB_XCNT(b.x)], 1u);
    return b;
}
__device__ __forceinline__ void xcd_barrier_complete(unsigned* bar, unsigned x, unsigned& nloc, unsigned& nx) {
    const unsigned G = gridDim.x * gridDim.y * gridDim.z;
    unsigned sum, cnt, mine, sp = 0u;
    for (;;) {
        sum = 0u; cnt = 0u; mine = 0u;
#pragma unroll
        for (unsigned j = 0; j < 16; ++j) { const unsigned c = xb_ld(&bar[XB_XCNT(j)]); sum += c; cnt += (c > 0u) ? 1u : 0u; mine = (j == x) ? c : mine; }
        if (sum == G) break;
        __builtin_amdgcn_s_sleep(1);
        if ((++sp & 255u) == 0u) { if (xb_ld(&bar[XB_TMO])) break; if (sp > XB_SPIN_CAP) { atomicAdd(&bar[XB_TMO], 1u); break; } }
    }
    nloc = mine > 0u ? mine : 1u; nx = cnt > 0u ? cnt : 1u;
}

__device__ __forceinline__ void xcd_barrier(const XcdBarrier& b) {
    asm volatile("s_waitcnt vmcnt(0)" ::: "memory");
    __syncthreads();
    if (threadIdx.x == 0) {
        unsigned* bar = b.bar;
        __builtin_amdgcn_s_waitcnt(0);
        unsigned nloc = b.st[0], nx = b.st[1];
        if (nloc == 0u) { xcd_barrier_complete(bar, b.x, nloc, nx); b.st[0] = nloc; b.st[1] = nx; }
        const unsigned old = xb_add(&bar[XB_XSUB(b.x)], 1u);
        const unsigned gen = old / nloc;
        if (old + 1u == (gen + 1u) * nloc) {
            __builtin_amdgcn_fence(__ATOMIC_RELEASE, "agent");
            asm volatile("s_waitcnt vmcnt(0)" ::: "memory");
            const unsigned og = xb_add(&bar[XB_TOP], 1u);
            const unsigned tg = og / nx;
            if (og + 1u == (tg + 1u) * nx) xb_add(&bar[XB_TOPGEN], 1u);
            else XB_SPIN(xb_ld(&bar[XB_TOPGEN]) == tg, bar);
            __builtin_amdgcn_fence(__ATOMIC_ACQUIRE, "agent");
            xb_add(&bar[XB_XGEN(b.x)], 1u);
            asm volatile("s_waitcnt vmcnt(0)" ::: "memory");
        } else {
            XB_SPIN(xb_ld(&bar[XB_XGEN(b.x)]) == gen, bar);
            __builtin_amdgcn_fence(__ATOMIC_ACQUIRE, "agent");
            asm volatile("s_waitcnt vmcnt(0)" ::: "memory");
        }
    }
    __syncthreads();
}

#ifndef BF_ALIGN
#define BF_ALIGN true
#endif
#ifndef RES_ALIGN
#define RES_ALIGN true
#endif
__global__ void __launch_bounds__(512, 2) fwd_mega(Args a_unused) {
    extern __shared__ __attribute__((aligned(16))) unsigned char lds_raw[];
    LAS unsigned char* lds = (LAS unsigned char*)lds_raw;
    cg::grid_group grid = cg::this_grid();
    volatile LAS unsigned* xst = (volatile LAS unsigned*)(lds + LDS_BYTES - 64);
    if (threadIdx.x < 2) xst[threadIdx.x] = 0u;
    __syncthreads();
    XcdBarrier xb = xcd_barrier_post((unsigned*)arg_ws(), xst);
#define WSP(off) (arg_ws() + (off))
#define RED_LDS ((PG8_LAS float*)(lds + 131072))
#define RL_LDS ((LAS float*)(lds + 131072 + 4096))
#define RBASE (2048 * (mk_bid() & 7))
    prologue_phase(lds);
    prep_phase(arg_in(0), (bf16_t*)WSP(WS_XN), (float*)WSP(WS_SSP));
    grid.sync();
#pragma unroll 1
    for (int L = 0; L < 4; ++L) {
        const int e = L >> 1;
        rs_table(RL_LDS, (const float*)WSP(WS_SSP), RBASE);
        if ((L & 1) == 0) {
            { pg8::Gemm gm{(const bf16_t*)WSP(WS_XN), (const bf16_t*)WSP(WS_WIE) + (size_t)e * EVEN_PAD * DM, MTOK, EVEN_PAD, DM}; pg8::StaticOrder S; S.init(MTOK, EVEN_PAD, mk_grid(), mk_bid());
              pg8::EpiBf16<0> E{(bf16_t*)WSP(WS_QKV), EVEN_PAD, (PG8_LAS const float*)RL_LDS, RBASE}; pg8::gemm_phase<pg8::EpiBf16<0>, pg8::StaticOrder, true, true>(lds, gm, S, E); }
            xcd_barrier(xb);
            evenA_phase(lds, (const bf16_t*)WSP(WS_QKV), arg_in(1), arg_in(7) + e * 16, arg_in(8) + e * 2048, arg_in(9) + e * 2048,
                        (const bf16_t*)WSP(WS_CW1) + (size_t)e * 2 * 256 * 2048, (const bf16_t*)WSP(WS_CW2) + (size_t)e * 2 * 64 * 256, (bf16_t*)WSP(WS_KCMP), (bf16_t*)WSP(WS_VCMP), (bf16_t*)WSP(WS_AO));
            xcd_barrier(xb);
            nsa_phase(lds, (const bf16_t*)WSP(WS_QKV), arg_in(1), (const bf16_t*)WSP(WS_KCMP), (const bf16_t*)WSP(WS_VCMP), (bf16_t*)WSP(WS_AO), (float*)WSP(WS_SCR), (unsigned*)arg_ws() + 3600 + 128 * e);
            xcd_barrier(xb);
            { pg8::Gemm gm{(const bf16_t*)WSP(WS_AO), (const bf16_t*)WSP(WS_WOE) + (size_t)e * DM * DM, MTOK, DM, DM}; pg8::StaticOrder S; S.init(MTOK, DM, mk_grid(), mk_bid());
              pg8::EpiRes E{(const bf16_t*)WSP(WS_XN), (bf16_t*)WSP(WS_XN), DM, (float*)WSP(WS_SSP), RED_LDS}; pg8::gemm_phase<pg8::EpiRes, pg8::StaticOrder, true, true>(lds, gm, S, E); }
#ifdef DUP_OUT0
            if (L == 0) { xcd_barrier(xb);
              pg8::Gemm gm{(const bf16_t*)WSP(WS_AO), (const bf16_t*)WSP(WS_WOE) + (size_t)e * DM * DM, MTOK, DM, DM}; pg8::StaticOrder S; S.init(MTOK, DM, mk_grid(), mk_bid());
              pg8::EpiRes E{(const bf16_t*)WSP(WS_XN), (bf16_t*)WSP(WS_XN), DM, (float*)WSP(WS_SSP), RED_LDS}; pg8::gemm_phase<pg8::EpiRes, pg8::StaticOrder, true, true>(lds, gm, S, E); }
#endif
        } else {
            { pg8::Gemm gm{(const bf16_t*)WSP(WS_XN), (const bf16_t*)WSP(WS_WIO) + (size_t)e * ODD_PAD * DM, MTOK, ODD_PAD, DM}; pg8::StaticOrder S; S.init(MTOK, ODD_PAD, mk_grid(), mk_bid());
              pg8::EpiBf16<0> E{(bf16_t*)WSP(WS_QKV), ODD_PAD, (PG8_LAS const float*)RL_LDS, RBASE}; pg8::gemm_phase<pg8::EpiBf16<0>, pg8::StaticOrder, true, true>(lds, gm, S, E); }
            xcd_barrier(xb);
            cumsum_phase(lds, (const bf16_t*)WSP(WS_QKV), arg_in(16) + e * 32, (float*)WSP(WS_C));
            xcd_barrier(xb);
            fox2_phase(lds, (const bf16_t*)WSP(WS_QKV), (const float*)WSP(WS_C), (bf16_t*)WSP(WS_AO));
            xcd_barrier(xb);
            { pg8::Gemm gm{(const bf16_t*)WSP(WS_AO), (const bf16_t*)WSP(WS_WOO) + (size_t)e * DM * DM, MTOK, DM, DM}; pg8::StaticOrder S; S.init(MTOK, DM, mk_grid(), mk_bid());
              pg8::EpiRes E{(const bf16_t*)WSP(WS_XN), (bf16_t*)WSP(WS_XN), DM, (float*)WSP(WS_SSP), RED_LDS}; pg8::gemm_phase<pg8::EpiRes, pg8::StaticOrder, true, true>(lds, gm, S, E); }
        }
        xcd_barrier(xb);
        rs_table(RL_LDS, (const float*)WSP(WS_SSP), RBASE);
        { pg8::Gemm gm{(const bf16_t*)WSP(WS_XN), (const bf16_t*)WSP(WS_WUP) + (size_t)L * DFF * DM, MTOK, DFF, DM}; pg8::StaticOrder S; S.init(MTOK, DFF, mk_grid(), mk_bid());
          pg8::EpiBf16<2> E{(bf16_t*)WSP(WS_H), DFF, (PG8_LAS const float*)RL_LDS, RBASE}; pg8::gemm_phase<pg8::EpiBf16<2>, pg8::StaticOrder, true, true>(lds, gm, S, E); }
        xcd_barrier(xb);
        { pg8::Gemm gm{(const bf16_t*)WSP(WS_H), (const bf16_t*)WSP(WS_WDN) + (size_t)L * DM * DFF, MTOK, DM, DFF}; pg8::StaticOrder S; S.init(MTOK, DM, mk_grid(), mk_bid());
          pg8::EpiRes E{(const bf16_t*)WSP(WS_XN), (bf16_t*)WSP(WS_XN), DM, (float*)WSP(WS_SSP), RED_LDS}; pg8::gemm_phase<pg8::EpiRes, pg8::StaticOrder, true, true>(lds, gm, S, E); }
        xcd_barrier(xb);
    }
    final_norm_phase((const bf16_t*)WSP(WS_XN), arg_in(4), arg_out());
#undef RED_LDS
#undef RL_LDS
#undef RBASE
#undef WSP
}

extern "C" void kernel_launch(void* const* d_in, const int* in_sizes, int n_in, void* d_out, int out_size, void* d_ws, size_t ws_size, hipStream_t stream) {
    static int grid = 0;
    if (grid == 0) {
        if (n_in != 19 || out_size != MTOK * DM || ws_size < WS_END) { fprintf(stderr, "kernel_launch: unexpected shapes (n_in %d out %d ws %zu)\n", n_in, out_size, ws_size); grid = -1; return; }
        int dev = 0, cus = 0, per_cu = 0;
        (void)hipGetDevice(&dev);
        (void)hipDeviceGetAttribute(&cus, hipDeviceAttributeMultiprocessorCount, dev);
        (void)hipFuncSetAttribute((const void*)fwd_mega, hipFuncAttributeMaxDynamicSharedMemorySize, LDS_BYTES);
        (void)hipOccupancyMaxActiveBlocksPerMultiprocessor(&per_cu, (const void*)fwd_mega, 512, LDS_BYTES);
        if (per_cu < 1) per_cu = 1;
        grid = cus * per_cu;
        fprintf(stderr, "kernel_launch: grid %d (cus %d x %d)\n", grid, cus, per_cu);
    }
    if (grid < 0) return;
    if (hipMemsetAsync(d_ws, 0, 16384, stream) != hipSuccess) { fprintf(stderr, "kernel_launch: memset of the barrier words failed\n"); return; }
    Args a{};
    for (int i = 0; i < 19; ++i) a.in[i] = (const float*)d_in[i];
    a.out = (float*)d_out; a.ws = (unsigned char*)d_ws;
    void* args[] = {&a};
    hipError_t e = hipLaunchCooperativeKernel((void*)fwd_mega, dim3(grid), dim3(512), args, LDS_BYTES, stream);
    if (e != hipSuccess) fprintf(stderr, "cooperative launch failed: %s (grid %d)\n", hipGetErrorString(e), grid);
}
```
